# Optimizing an MI355X kernel written in HIP

```python
import math
import jax, jax.numpy as jnp
from jax import lax
import numpy as np

D_MODEL = 1024
BATCH = 8
SEQ = 4096
DEPTH = 2

HEAD_DIM = 128
QBLOCK = 128
A_HEADS = 4
A_KV_RANK = 256
IDX_HEADS = 4
IDX_DIM = 64
DSA_TOPK = 256
B_HEADS = 4
CMP_LEN = 32
CMP_STRIDE = 16
SEL_BLOCK = 64
N_SEL = 8
WINDOW = 512
C_HEADS = 8
NUM_BUCKETS = 32
MAX_DISTANCE = 128
D_FF = 2816
N_EXPERTS = 8
TOP_K = 2
EXPERT_FF = 3584
RMS_EPS = 1e-6
NEG_BIG = -1e30

N_EVEN = (DEPTH + 1) // 2
N_ODD = DEPTH // 2
EVEN_SPLITS = (A_HEADS * HEAD_DIM, A_KV_RANK, IDX_HEADS * IDX_DIM, IDX_DIM, IDX_HEADS,
               B_HEADS * HEAD_DIM, 6 * HEAD_DIM, 3 * B_HEADS)
EVEN_IN = sum(EVEN_SPLITS)
MIX_EVEN = (A_HEADS + B_HEADS) * HEAD_DIM
MIX_ODD = C_HEADS * HEAD_DIM

kernel_name = 'hybrid_dsa_nsa_stickbreak_moe'


def rmsnorm(x, g):
    xf = x.astype(jnp.float32)
    y = xf * lax.rsqrt(jnp.mean(xf * xf, axis=-1, keepdims=True) + RMS_EPS)
    return (y * g.astype(jnp.float32)).astype(x.dtype)


def rel_bucket(dist):
    n = jnp.maximum(dist, 0)
    max_exact = NUM_BUCKETS // 2
    large = max_exact + (jnp.log(jnp.maximum(n, 1).astype(jnp.float32) / max_exact)
                         / math.log(MAX_DISTANCE / max_exact)
                         * (NUM_BUCKETS - max_exact)).astype(jnp.int32)
    large = jnp.minimum(large, NUM_BUCKETS - 1)
    return jnp.where(n < max_exact, n, large)


def masked_softmax(logits, mask):
    lf = jnp.where(mask, logits.astype(jnp.float32), NEG_BIG)
    return jnp.where(mask, jax.nn.softmax(lf, axis=-1), 0.0)


def to_blocks(a, nb):
    return jnp.moveaxis(a.reshape((a.shape[0], nb, QBLOCK) + a.shape[2:]), 1, 0)


def from_blocks(a):
    nb, b, qb = a.shape[:3]
    return jnp.moveaxis(a, 0, 1).reshape((b, nb * qb) + a.shape[3:])


def gather_rows(table, idx):
    return jax.vmap(lambda tb, ii: tb[ii])(table, idx)


def swiglu(h, wg, wu, wd):
    return (jax.nn.silu(h @ wg) * (h @ wu)) @ wd


def even_mixer(h, w_in, kv_norm, w_uk, w_uv, cmp_pos, cmp_w1, cmp_w2, w_out, rel_bias):
    b, s, _ = h.shape
    nb = s // QBLOCK
    offs = [int(o) for o in np.cumsum(EVEN_SPLITS)[:-1]]
    a_q, a_lat, i_q, i_k, i_w, b_q, b_kv, b_g = jnp.split(h @ w_in, offs, axis=-1)
    a_q = a_q.reshape(b, s, A_HEADS, HEAD_DIM)
    c_kv = rmsnorm(a_lat, kv_norm)
    a_k = c_kv @ w_uk
    a_v = c_kv @ w_uv
    i_q = i_q.reshape(b, s, IDX_HEADS, IDX_DIM)
    i_w = i_w * (IDX_HEADS ** -0.5)
    b_q = b_q.reshape(b, s, B_HEADS, HEAD_DIM)
    b_kv = b_kv.reshape(b, s, 6, HEAD_DIM)
    ck_raw, cv_raw, sk, sv, wk, wv = [b_kv[:, :, j] for j in range(6)]
    b_g = jax.nn.sigmoid(b_g.reshape(b, s, 3, B_HEADS))

    n_cmp = (s - CMP_LEN) // CMP_STRIDE + 1
    cmp_start = jnp.arange(n_cmp, dtype=jnp.int32) * CMP_STRIDE
    cmp_tok = cmp_start[:, None] + jnp.arange(CMP_LEN, dtype=jnp.int32)[None, :]
    cmp_end = cmp_start + CMP_LEN - 1

    def compress(kv, j):
        blk = kv[:, cmp_tok] + cmp_pos[j]
        hid = jax.nn.gelu(blk.reshape(b, n_cmp, CMP_LEN * HEAD_DIM) @ cmp_w1[j])
        return hid @ cmp_w2[j]

    ck = compress(ck_raw, 0)
    cv = compress(cv_raw, 1)

    n_sb = s // SEL_BLOCK
    n_sel = min(N_SEL, n_sb)
    sb_start = jnp.arange(n_sb, dtype=jnp.int32) * SEL_BLOCK
    overlap = ((cmp_start[:, None] < sb_start[None, :] + SEL_BLOCK)
               & (cmp_start[:, None] + CMP_LEN > sb_start[None, :])).astype(jnp.float32)
    sk_blocks = sk.reshape(b, n_sb, SEL_BLOCK, HEAD_DIM)
    sv_blocks = sv.reshape(b, n_sb, SEL_BLOCK, HEAD_DIM)
    blk_ids = jnp.arange(n_sb, dtype=jnp.int32)
    sel_off = jnp.arange(SEL_BLOCK, dtype=jnp.int32)

    pad = jnp.zeros((b, WINDOW, HEAD_DIM), wk.dtype)
    wk_pad = jnp.concatenate([pad, wk], axis=1)
    wv_pad = jnp.concatenate([pad, wv], axis=1)
    win_off = jnp.arange(WINDOW + QBLOCK, dtype=jnp.int32)

    k_dsa = min(DSA_TOPK, s // 4)
    key_pos = jnp.arange(s, dtype=jnp.int32)
    bias_a = rel_bias[:, :A_HEADS]
    bias_b = rel_bias[:, A_HEADS:]
    scale = HEAD_DIM ** -0.5
    idx_scale = IDX_DIM ** -0.5

    def block_fn(args):
        qi, qa, iq, iw, qb, g = args
        t = qi * QBLOCK + jnp.arange(QBLOCK, dtype=jnp.int32)
        isc = jax.nn.relu(jnp.einsum('bqhd,bsd->bqhs', iq, i_k) * idx_scale)
        isc = jnp.einsum('bqhs,bqh->bqs', isc, iw).astype(jnp.float32)
        isc = jnp.where(key_pos[None, None, :] <= t[None, :, None], isc, -jnp.inf)
        _, sel_a = lax.top_k(isc, k_dsa)
        ka = gather_rows(a_k, sel_a)
        va = gather_rows(a_v, sel_a)
        la = (jnp.einsum('bqhd,bqkd->bhqk', qa, ka) * scale
              + jnp.moveaxis(bias_a[rel_bucket(t[None, :, None] - sel_a)], -1, 1))
        pa = masked_softmax(la, (sel_a <= t[None, :, None])[:, None])
        oa = jnp.einsum('bhqk,bqkd->bqhd', pa, va)
        lc = (jnp.einsum('bqhd,bnd->bhqn', qb, ck) * scale
              + jnp.moveaxis(bias_b[rel_bucket(t[:, None] - cmp_end[None, :])], -1, 0))
        pc = masked_softmax(lc, (cmp_end[None, :] <= t[:, None])[None, None])
        oc = jnp.einsum('bhqn,bnd->bqhd', pc, cv)
        imp = jnp.einsum('bhqn,nm->bqm', pc, overlap)
        cur = t // SEL_BLOCK
        forced = ((blk_ids[None, :] == 0) | (blk_ids[None, :] == cur[:, None])
                  | (blk_ids[None, :] == cur[:, None] - 1))
        imp = jnp.where(forced[None], jnp.inf,
                        jnp.where(blk_ids[None, None, :] > cur[None, :, None], -jnp.inf, imp))
        _, sel_b = lax.top_k(imp, n_sel)
        ks = gather_rows(sk_blocks, sel_b).reshape(b, QBLOCK, n_sel * SEL_BLOCK, HEAD_DIM)
        vs = gather_rows(sv_blocks, sel_b).reshape(b, QBLOCK, n_sel * SEL_BLOCK, HEAD_DIM)
        tok = (sel_b[..., None] * SEL_BLOCK + sel_off).reshape(b, QBLOCK, n_sel * SEL_BLOCK)
        ls = (jnp.einsum('bqhd,bqkd->bhqk', qb, ks) * scale
              + jnp.moveaxis(bias_b[rel_bucket(t[None, :, None] - tok)], -1, 1))
        ps = masked_softmax(ls, (tok <= t[None, :, None])[:, None])
        osel = jnp.einsum('bhqk,bqkd->bqhd', ps, vs)
        kw = lax.dynamic_slice_in_dim(wk_pad, qi * QBLOCK, WINDOW + QBLOCK, axis=1)
        vw = lax.dynamic_slice_in_dim(wv_pad, qi * QBLOCK, WINDOW + QBLOCK, axis=1)
        wpos = qi * QBLOCK - WINDOW + win_off
        dist = t[:, None] - wpos[None, :]
        lw = (jnp.einsum('bqhd,bkd->bhqk', qb, kw) * scale
              + jnp.moveaxis(bias_b[rel_bucket(dist)], -1, 0))
        pw = masked_softmax(lw, ((wpos[None, :] >= 0) & (dist >= 0) & (dist < WINDOW))[None, None])
        ow = jnp.einsum('bhqk,bkd->bqhd', pw, vw)
        ob = (g[:, :, 0, :, None] * oc + g[:, :, 1, :, None] * osel
              + g[:, :, 2, :, None] * ow)
        o = jnp.concatenate([oa, ob], axis=2).reshape(b, QBLOCK, MIX_EVEN)
        return o.astype(h.dtype)

    xs = (jnp.arange(nb, dtype=jnp.int32), to_blocks(a_q, nb), to_blocks(i_q, nb),
          to_blocks(i_w, nb), to_blocks(b_q, nb), to_blocks(b_g, nb))
    o = from_blocks(lax.map(block_fn, xs))
    return o @ w_out


def odd_mixer(h, w_qkv, w_out):
    b, s, _ = h.shape
    nb = s // QBLOCK
    q, k, v = jnp.split(h @ w_qkv, 3, axis=-1)
    q = q.reshape(b, s, C_HEADS, HEAD_DIM)
    k = k.reshape(b, s, C_HEADS, HEAD_DIM)
    v = v.reshape(b, s, C_HEADS, HEAD_DIM)
    key_pos = jnp.arange(s, dtype=jnp.int32)
    scale = HEAD_DIM ** -0.5

    def block_fn(args):
        qi, qb = args
        t = qi * QBLOCK + jnp.arange(QBLOCK, dtype=jnp.int32)
        z = jnp.einsum('bqhd,bshd->bhqs', qb, k).astype(jnp.float32) * scale
        strict = key_pos[None, :] < t[:, None]
        log_1m = jnp.where(strict, jax.nn.log_sigmoid(-z), 0.0)
        after = lax.cumsum(log_1m, axis=3, reverse=True) - log_1m
        a = jnp.where(strict, jnp.exp(jax.nn.log_sigmoid(z) + after), 0.0)
        o = jnp.einsum('bhqs,bshd->bqhd', a, v)
        return o.reshape(b, QBLOCK, MIX_ODD).astype(h.dtype)

    o = from_blocks(lax.map(block_fn, (jnp.arange(nb, dtype=jnp.int32), to_blocks(q, nb))))
    return o @ w_out


def moe_swiglu(h, w_router, w_gate, w_up, w_down):
    logits = (h @ w_router).astype(jnp.float32)
    top_v, top_i = lax.top_k(logits, TOP_K)
    top_w = jax.nn.softmax(top_v, axis=-1)
    gates = jnp.sum(jax.nn.one_hot(top_i, N_EXPERTS, dtype=jnp.float32) * top_w[..., None], axis=-2)
    gates = gates.astype(h.dtype)
    y = jnp.zeros_like(h)
    for e in range(N_EXPERTS):
        y = y + gates[..., e:e + 1] * swiglu(h, w_gate[e], w_up[e], w_down[e])
    return y


def setup_inputs(seed: int = 0) -> dict:
    key = jax.random.key(seed)
    ks = jax.random.split(key, 32)
    f32 = jnp.float32

    def nrm(k, shape, scale):
        return jax.random.normal(k, shape, f32) * scale

    def gain(k, shape):
        return 1.0 + 0.02 * jax.random.normal(k, shape, f32)

    hd = HEAD_DIM
    return {
        'x': nrm(ks[0], (BATCH, SEQ, D_MODEL), 1.0),
        'rel_bias': nrm(ks[1], (NUM_BUCKETS, A_HEADS + B_HEADS), 0.2),
        'ev_norm_mix': gain(ks[2], (N_EVEN, D_MODEL)),
        'ev_w_in': nrm(ks[3], (N_EVEN, D_MODEL, EVEN_IN), D_MODEL ** -0.5),
        'ev_kv_norm': gain(ks[4], (N_EVEN, A_KV_RANK)),
        'ev_w_uk': nrm(ks[5], (N_EVEN, A_KV_RANK, hd), A_KV_RANK ** -0.5),
        'ev_w_uv': nrm(ks[6], (N_EVEN, A_KV_RANK, hd), A_KV_RANK ** -0.5),
        'ev_cmp_pos': nrm(ks[7], (N_EVEN, 2, CMP_LEN, hd), 0.02),
        'ev_cmp_w1': nrm(ks[8], (N_EVEN, 2, CMP_LEN * hd, hd), (CMP_LEN * hd) ** -0.5),
        'ev_cmp_w2': nrm(ks[9], (N_EVEN, 2, hd, hd), hd ** -0.5),
        'ev_w_out': nrm(ks[10], (N_EVEN, MIX_EVEN, D_MODEL), MIX_EVEN ** -0.5),
        'ev_norm_ffn': gain(ks[11], (N_EVEN, D_MODEL)),
        'ev_w_gate': nrm(ks[12], (N_EVEN, D_MODEL, D_FF), D_MODEL ** -0.5),
        'ev_w_up': nrm(ks[13], (N_EVEN, D_MODEL, D_FF), D_MODEL ** -0.5),
        'ev_w_down': nrm(ks[14], (N_EVEN, D_FF, D_MODEL), D_FF ** -0.5),
        'od_norm_mix': gain(ks[15], (N_ODD, D_MODEL)),
        'od_w_qkv': nrm(ks[16], (N_ODD, D_MODEL, 3 * MIX_ODD), D_MODEL ** -0.5),
        'od_w_out': nrm(ks[17], (N_ODD, MIX_ODD, D_MODEL), MIX_ODD ** -0.5),
        'od_norm_ffn': gain(ks[18], (N_ODD, D_MODEL)),
        'od_w_router': nrm(ks[19], (N_ODD, D_MODEL, N_EXPERTS), D_MODEL ** -0.5),
        'od_w_gate': nrm(ks[20], (N_ODD, N_EXPERTS, D_MODEL, EXPERT_FF), D_MODEL ** -0.5),
        'od_w_up': nrm(ks[21], (N_ODD, N_EXPERTS, D_MODEL, EXPERT_FF), D_MODEL ** -0.5),
        'od_w_down': nrm(ks[22], (N_ODD, N_EXPERTS, EXPERT_FF, D_MODEL), EXPERT_FF ** -0.5),
        'final_norm': gain(ks[23], (D_MODEL,)),
    }


def reference(x, rel_bias, ev_norm_mix, ev_w_in, ev_kv_norm, ev_w_uk, ev_w_uv, ev_cmp_pos,
              ev_cmp_w1, ev_cmp_w2, ev_w_out, ev_norm_ffn, ev_w_gate, ev_w_up, ev_w_down,
              od_norm_mix, od_w_qkv, od_w_out, od_norm_ffn, od_w_router, od_w_gate, od_w_up,
              od_w_down, final_norm):
    for layer in range(DEPTH):
        i = layer // 2
        if layer % 2 == 0:
            x = x + even_mixer(rmsnorm(x, ev_norm_mix[i]), ev_w_in[i], ev_kv_norm[i], ev_w_uk[i],
                               ev_w_uv[i], ev_cmp_pos[i], ev_cmp_w1[i], ev_cmp_w2[i], ev_w_out[i],
                               rel_bias)
            x = x + swiglu(rmsnorm(x, ev_norm_ffn[i]), ev_w_gate[i], ev_w_up[i], ev_w_down[i])
        else:
            x = x + odd_mixer(rmsnorm(x, od_norm_mix[i]), od_w_qkv[i], od_w_out[i])
            x = x + moe_swiglu(rmsnorm(x, od_norm_ffn[i]), od_w_router[i], od_w_gate[i],
                               od_w_up[i], od_w_down[i])
    return rmsnorm(x, final_norm)
```

```cpp
#include <hip/hip_runtime.h>
#include <cstdio>
#include <cstdint>

#define GAS __attribute__((address_space(1)))
#define LAS __attribute__((address_space(3)))
typedef unsigned short bf16;
typedef unsigned v4u __attribute__((ext_vector_type(4)));
typedef unsigned v2u __attribute__((ext_vector_type(2)));
typedef float f32x2 __attribute__((ext_vector_type(2)));
typedef float f32x4 __attribute__((ext_vector_type(4)));
typedef float f32x16 __attribute__((ext_vector_type(16)));
typedef short bf16x8 __attribute__((ext_vector_type(8)));
typedef short s16x4 __attribute__((ext_vector_type(4)));
typedef GAS unsigned gu32;
#define RLX_AGENT __ATOMIC_RELAXED, __HIP_MEMORY_SCOPE_AGENT
#define LDS_WAIT() asm volatile("s_waitcnt lgkmcnt(0)" ::: "memory")
#define VM_WAIT() asm volatile("s_waitcnt vmcnt(0)" ::: "memory")
#define SBAR() __builtin_amdgcn_sched_barrier(0)

constexpr int BATCH = 8, SEQ = 4096, DM = 1024, M = BATCH * SEQ, HD = 128;
constexpr int NPROJ = 2560;
constexpr int DFF = 2816, NEXP = 8, EFF = 3584;
constexpr float RMS_EPS = 1e-6f;
constexpr float LOG2E = 1.4426950408889634f;
constexpr float QSCALE = 0.08838834764831845f * LOG2E;
enum { I_X = 0, I_RELB, I_EV_NMIX, I_EV_WIN, I_EV_KVN, I_EV_WUK, I_EV_WUV, I_EV_CPOS, I_EV_CW1, I_EV_CW2, I_EV_WOUT, I_EV_NFFN, I_EV_WG, I_EV_WU, I_EV_WD,
       I_OD_NMIX, I_OD_WQKV, I_OD_WOUT, I_OD_NFFN, I_OD_WR, I_OD_WG, I_OD_WU, I_OD_WD, I_FNORM, N_IN };

enum { G_QA = 0  , G_LAT = 4  , G_IQ = 6  , G_QB = 8  , G_CKR = 12, G_CVR = 13, G_SK = 14, G_SV = 15, G_WK = 16, G_WV = 17, G_MISC = 18, G_PAD = 19 };
constexpr size_t GS = (size_t)M * 128;

constexpr size_t MiB = 1u << 20;
constexpr size_t WS_CTL = 0, CTL_ZERO_BYTES = 1 * MiB;
constexpr size_t WS_TAB = 1 * MiB;
constexpr size_t WS_WIN = 2 * MiB;
constexpr size_t WS_WUKV = 7 * MiB;
constexpr size_t WS_WC1 = 7 * MiB + 256 * 1024;
constexpr size_t WS_WOUT0 = 10 * MiB;
constexpr size_t WS_WGU0 = 12 * MiB;
constexpr size_t WS_WDN0 = 23 * MiB;
constexpr size_t WS_WQKV = 29 * MiB;
constexpr size_t WS_WOUT1 = 35 * MiB;
constexpr size_t WS_XN = 40 * MiB;
constexpr size_t WS_PROJ = 104 * MiB;
constexpr size_t WS_AK = 264 * MiB, WS_AV = 272 * MiB;
constexpr size_t WS_BM = 280 * MiB;
constexpr size_t WS_UV = 296 * MiB;
constexpr size_t WS_UVB = 432 * MiB;
constexpr size_t WS_CK = 300 * MiB;
constexpr size_t WS_CVT = 300 * MiB + 512 * 1024;
constexpr size_t WS_CV = 300 * MiB + 512 * 1024;
constexpr size_t WS_BLK = 301 * MiB;
constexpr size_t WS_RS0 = 302 * MiB;
constexpr size_t WS_RS1 = 296 * MiB;
constexpr size_t WS_OC = 304 * MiB;
constexpr size_t WS_O = 368 * MiB;
constexpr size_t WS_OC2 = 432 * MiB;
constexpr size_t WS_XB = 432 * MiB;
constexpr size_t WS_XB3 = 40 * MiB;
constexpr size_t WS_H0 = 104 * MiB;
constexpr size_t WS_QKV = 104 * MiB;
constexpr size_t WS_MW = 104 * MiB;
constexpr size_t MW_E = 21 * MiB, MW_DN = 14 * MiB;
constexpr size_t WS_LIST = 272 * MiB;
constexpr size_t WS_GW = WS_LIST + 2 * MiB;
constexpr size_t WS_TOK = WS_GW + 256 * 1024;
constexpr size_t WS_INV = WS_TOK + 512 * 1024;
constexpr size_t WS_GWS = WS_INV + 256 * 1024;
constexpr int XS_ROWS = M + 8 * 256;
constexpr size_t WS_XS = 276 * MiB;
constexpr int HM_TILES = 128, HM_SPLIT = 64;
constexpr int MOE_SPLITS = 4, MOE_SPLIT_TILES = 16;
constexpr size_t WS_YP = 2 * MiB;
constexpr size_t WS_HM = 412 * MiB;
constexpr size_t WS_END = 524 * MiB;
static_assert(WS_WIN + (size_t)NPROJ * DM * 2 <= WS_WUKV && WS_WC1 + 2ull * 256 * 2048 * 2 <= WS_WOUT0 && WS_WGU0 + 5632ull * 1024 * 2 <= WS_WDN0 && WS_WDN0 + 1024ull * 2816 * 2 <= WS_WQKV && WS_WQKV + 3072ull * 1024 * 2 <= WS_WOUT1 && WS_WOUT1 + 2 * MiB <= WS_XN, "weights map");
static_assert(WS_XN + (size_t)M * DM * 2 <= WS_PROJ && WS_PROJ + 20 * GS * 2 <= WS_AK && WS_BM + (size_t)M * 128 * 4 <= WS_UV && WS_UV + 4 * MiB <= WS_CK && WS_BLK + (size_t)M * 8 <= WS_OC && WS_OC + (size_t)M * 512 * 4 <= WS_O && WS_O + (size_t)M * DM * 2 <= 432 * MiB, "even map");
static_assert(WS_YP + (size_t)MOE_SPLITS * MOE_SPLIT_TILES * 256 * DM * 2 <= WS_XB3, "split partials fit under the residual stream copy");
static_assert(WS_H0 + (size_t)M * DFF * 2 <= WS_OC && WS_QKV + 24 * GS * 2 <= WS_O && WS_MW + 8 * MW_E <= WS_LIST && WS_GWS + 2ull * XS_ROWS * 4 <= WS_XS && WS_XS + 2ull * XS_ROWS * DM * 2 <= WS_HM && WS_HM + (size_t)HM_SPLIT * 256 * EFF * 2 <= WS_END && (size_t)(HM_TILES - HM_SPLIT) * 256 * EFF * 2 <= (size_t)M * DM * 4, "late map");
constexpr int CW_TMO = 0, CW_CODE = 1;
constexpr int CW_BAR = 4096;
constexpr int CW_CNT = 16384;

constexpr int RING_BYTES = 131072;
constexpr int MISC_OFF = RING_BYTES;
constexpr int LDS_BYTES = 147456;
constexpr int NWAVES = 8, NTHR = 512;

__device__ __forceinline__ unsigned f2bf(float f) { unsigned u = __builtin_bit_cast(unsigned, f); return (u + 0x7fffu + ((u >> 16) & 1u)) >> 16; }
__device__ __forceinline__ unsigned pk2(float lo, float hi) { return f2bf(lo) | (f2bf(hi) << 16); }
__device__ __forceinline__ float bf2f(bf16 b) { return __builtin_bit_cast(float, (unsigned)b << 16); }
__device__ __forceinline__ unsigned cvtpk(float lo, float hi) { unsigned r; asm volatile("v_cvt_pk_bf16_f32 %0, %1, %2" : "=v"(r) : "v"(lo), "v"(hi)); return r; }
__device__ __forceinline__ bf16x8 pack8(f32x4 a, f32x4 b) { v4u w = {cvtpk(a[0], a[1]), cvtpk(a[2], a[3]), cvtpk(b[0], b[1]), cvtpk(b[2], b[3])}; return __builtin_bit_cast(bf16x8, w); }
__device__ __forceinline__ float wave_sum(float v) {
#define WS_STEP(ctrl, rmask) v += __int_as_float(__builtin_amdgcn_update_dpp(0, __float_as_int(v), ctrl, rmask, 0xf, true))
    WS_STEP(0x111, 0xf); WS_STEP(0x112, 0xf); WS_STEP(0x114, 0xf); WS_STEP(0x118, 0xf); WS_STEP(0x142, 0xa); WS_STEP(0x143, 0xc);
#undef WS_STEP
    return __int_as_float(__builtin_amdgcn_readlane(__float_as_int(v), 63));
}
__device__ __forceinline__ float wave_max(float v) {
#define WM_STEP(ctrl, rmask) v = fmaxf(v, __int_as_float(__builtin_amdgcn_update_dpp(__float_as_int(v), __float_as_int(v), ctrl, rmask, 0xf, false)))
    WM_STEP(0x111, 0xf); WM_STEP(0x112, 0xf); WM_STEP(0x114, 0xf); WM_STEP(0x118, 0xf); WM_STEP(0x142, 0xa); WM_STEP(0x143, 0xc);
#undef WM_STEP
    return __int_as_float(__builtin_amdgcn_readlane(__float_as_int(v), 63));
}
__device__ __forceinline__ int rel_bucket_dev(int d) {
    if (d < 16) return d;
    if (d >= 113) return 31;
    int v = 16 + (int)(__log2f((float)d * 0.0625f) * (16.0f / 3.0f));
    return v > 31 ? 31 : v;
}
namespace pg8 {
constexpr int BM = 256, BK = 64, HALF = 128, HTB = HALF * BK * 2, STAGE_BYTES = 8 * HTB, NXCD = 8, WGM = 8;
__host__ __device__ __forceinline__ int lds_byte(int r, int c) { const int st = (r >> 4) * 2 + (c >> 5), rr = r & 15, cc = c & 31, ob = rr * 64 + cc * 2; return st * 1024 + (ob ^ (((ob >> 9) & 1) << 5)); }
__host__ __device__ __forceinline__ void stage_rc(int b, int& R, int& C) { const int st = b / 1024, sb = b % 1024, swz = sb ^ (((sb >> 9) & 1) << 5); R = (st >> 1) * 16 + swz / 64; C = (st & 1) * 32 + (swz % 64) / 2; }
__host__ __device__ __forceinline__ int perm32(int rho) { const int n = rho >> 4, i = rho & 15; return 8 * (i >> 2) + 4 * n + (i & 3); }

struct Unit { int pm, pn, aux; const char* A; const char* B; };
struct GemmK { int K; unsigned pitchA, pitchB; int kshA; unsigned gstrA; };

struct GridOrder {
    int nM, nN, nwg, G, c;
    __device__ __forceinline__ void init(int nM_, int nN_, int G_, int c_) { nM = nM_; nN = nN_; nwg = nM * nN; G = G_; c = c_; }
    __device__ __forceinline__ bool at(int i, int& pm, int& pn) const {
        const long L = (long)i * G + c; if (L >= nwg) return false;
        int wgid = (int)L; { const int q = nwg / NXCD, r = nwg % NXCD, xcd = wgid % NXCD, off = wgid / NXCD; wgid = (xcd < r ? xcd * (q + 1) : r * (q + 1) + (xcd - r) * q) + off; }
        const int nig = WGM * nN, gid = wgid / nig, fm = gid * WGM, gsz = (nM - fm) < WGM ? (nM - fm) : WGM;
        pm = fm + ((wgid % nig) % gsz); pn = (wgid % nig) / gsz; return true;
    }
};
struct PlainSched {
    GridOrder o; const char* A; const char* B; size_t tstepA, tstepB;
    __device__ __forceinline__ void init(int Mr, int Nc, int G, int c, const void* A_, size_t pitchA, const void* B_, size_t pitchB) { o.init(Mr / BM, Nc / BM, G, c); A = (const char*)A_; B = (const char*)B_; tstepA = 256 * pitchA; tstepB = 256 * pitchB; }
    __device__ __forceinline__ bool next(int i, Unit& u) const { if (!o.at(i, u.pm, u.pn)) return false; u.aux = 0; u.A = A + (size_t)u.pm * tstepA; u.B = B + (size_t)u.pn * tstepB; return true; }
};

__device__ __forceinline__ unsigned cvt_pk_bf16(float lo, float hi) { unsigned r; asm volatile("v_cvt_pk_bf16_f32 %0, %1, %2" : "=v"(r) : "v"(lo), "v"(hi)); return r; }

typedef float f32x8 __attribute__((ext_vector_type(8)));
__device__ __forceinline__ f32x8 row_rstd8(const float* rs, int row0, int fq) {
    f32x8 r = {1.f, 1.f, 1.f, 1.f, 1.f, 1.f, 1.f, 1.f};
    if (rs) {
#pragma unroll
        for (int i = 0; i < 8; ++i) { const f32x4 p = *(const f32x4*)(rs + (size_t)(row0 + (i >> 2) * HALF + (i & 3) * 16) * 16 + 4 * fq); float s = (p[0] + p[1]) + (p[2] + p[3]);
            s += __shfl_xor(s, 16); s += __shfl_xor(s, 32); r[i] = 1.0f / sqrtf(s * (1.0f / DM) + RMS_EPS); } }
    return r;
}
struct EpiGroups {
    static constexpr bool PERM = true;
    bf16* O; size_t gstride; unsigned scalemask; float scale; int gskip; const float* rs;
    __device__ __forceinline__ void operator()(const f32x4 (&acc)[2][2][4][2], const Unit& u, int wr, int wc, int fr, int fq) const {
        const int row0 = u.pm * BM + wr * 64 + fr, col0 = wc * 32 + 8 * fq;
        const f32x8 rstd = row_rstd8(rs, row0, fq);
#pragma unroll
        for (int bj = 0; bj < 2; ++bj) { const int g = 2 * u.pn + bj; if (g >= gskip) continue; const float sc = ((scalemask >> g) & 1u) ? scale : 1.f; bf16* base = O + (size_t)g * gstride;
#pragma unroll
            for (int ai = 0; ai < 2; ++ai)
#pragma unroll
                for (int m = 0; m < 4; ++m) { const float s2 = sc * rstd[ai * 4 + m]; const f32x4 v0 = acc[ai][bj][m][0] * s2, v1 = acc[ai][bj][m][1] * s2;
                    v4u w; w.x = cvt_pk_bf16(v0[0], v0[1]); w.y = cvt_pk_bf16(v0[2], v0[3]); w.z = cvt_pk_bf16(v1[0], v1[1]); w.w = cvt_pk_bf16(v1[2], v1[3]);
                    *(v4u*)(base + (size_t)(row0 + ai * HALF + m * 16) * 128 + col0) = w; } }
    }
};
struct OneSched { Unit u; __device__ __forceinline__ bool next(int i, Unit& o) const { if (i) return false; o = u; return true; } };
struct EpiAkv {
    static constexpr bool PERM = true;
    bf16* AK; bf16* AV; const LAS float* rstd;
    __device__ __forceinline__ void operator()(const f32x4 (&acc)[2][2][4][2], const Unit& u, int wr, int wc, int fr, int fq) const {
        const int col0 = wc * 32 + 8 * fq;
#pragma unroll
        for (int ai = 0; ai < 2; ++ai)
#pragma unroll
            for (int m = 0; m < 4; ++m) { const int rl = ai * HALF + wr * 64 + m * 16 + fr; const float rs = rstd[rl]; const size_t row = (size_t)u.pm * BM + rl;
#pragma unroll
                for (int bj = 0; bj < 2; ++bj) { const f32x4 v0 = acc[ai][bj][m][0] * rs, v1 = acc[ai][bj][m][1] * rs;
                    v4u w; w.x = cvt_pk_bf16(v0[0], v0[1]); w.y = cvt_pk_bf16(v0[2], v0[3]); w.z = cvt_pk_bf16(v1[0], v1[1]); w.w = cvt_pk_bf16(v1[2], v1[3]);
                    *(v4u*)((bj ? AV : AK) + row * 128 + col0) = w; } }
    }
};
struct EpiF32 {
    static constexpr bool PERM = false;
    const float* base; float* C; int ldc; float scale;
    __device__ __forceinline__ void operator()(const f32x4 (&acc)[2][2][4][2], const Unit& u, int wr, int wc, int fr, int fq) const {
        const int row0 = u.pm * BM + wr * 64 + fr, col0 = u.pn * BM + wc * 32 + 4 * fq;
#pragma unroll
        for (int ai = 0; ai < 2; ++ai)
#pragma unroll
            for (int m = 0; m < 4; ++m) { const size_t off = (size_t)(row0 + ai * HALF + m * 16) * ldc + col0;
#pragma unroll
                for (int bj = 0; bj < 2; ++bj)
#pragma unroll
                    for (int n = 0; n < 2; ++n) { f32x4 v = acc[ai][bj][m][n] * scale; if (base) v += *(const f32x4*)(base + off + bj * HALF + n * 16); *(f32x4*)(C + off + bj * HALF + n * 16) = v; } }
    }
};
struct EpiRes {
    static constexpr bool PERM = true;
    const float* basef; const bf16* baseb; bf16* out; float* rs; float scale;
    __device__ __forceinline__ void operator()(const f32x4 (&acc)[2][2][4][2], const Unit& u, int wr, int wc, int fr, int fq) const {
        const int row0 = u.pm * BM + wr * 64 + fr, col0 = u.pn * BM + wc * 32 + 8 * fq;
#pragma unroll
        for (int ai = 0; ai < 2; ++ai)
#pragma unroll
            for (int m = 0; m < 4; ++m) { const size_t off = (size_t)(row0 + ai * HALF + m * 16) * DM + col0; float ss = 0.f;
#pragma unroll
                for (int bj = 0; bj < 2; ++bj) { f32x4 v0 = acc[ai][bj][m][0] * scale, v1 = acc[ai][bj][m][1] * scale;
                    if (basef) { v0 += *(const f32x4*)(basef + off + bj * HALF); v1 += *(const f32x4*)(basef + off + bj * HALF + 4); }
                    else { const v4u w = *(const v4u*)(baseb + off + bj * HALF);
                        v0 += (f32x4){__uint_as_float(w.x << 16), __uint_as_float(w.x & 0xffff0000u), __uint_as_float(w.y << 16), __uint_as_float(w.y & 0xffff0000u)};
                        v1 += (f32x4){__uint_as_float(w.z << 16), __uint_as_float(w.z & 0xffff0000u), __uint_as_float(w.w << 16), __uint_as_float(w.w & 0xffff0000u)}; }
                    v4u o; o.x = cvt_pk_bf16(v0[0], v0[1]); o.y = cvt_pk_bf16(v0[2], v0[3]); o.z = cvt_pk_bf16(v1[0], v1[1]); o.w = cvt_pk_bf16(v1[2], v1[3]);
                    *(v4u*)(out + off + bj * HALF) = o;
#define RS_ACC(w) { const float a_ = __uint_as_float((w) << 16), c_ = __uint_as_float((w) & 0xffff0000u); ss = fmaf(a_, a_, fmaf(c_, c_, ss)); }
                    RS_ACC(o.x) RS_ACC(o.y) RS_ACC(o.z) RS_ACC(o.w)
#undef RS_ACC
                }
                { ss += __shfl_xor(ss, 16); ss += __shfl_xor(ss, 32); if (fq == 0) rs[(size_t)(row0 + ai * HALF + m * 16) * 16 + 4 * u.pn + wc] = ss; } }
    }
};
struct EpiMoeY {
    static constexpr bool PERM = true;
    bf16* Y; const float* gws;
    __device__ __forceinline__ void operator()(const f32x4 (&acc)[2][2][4][2], const Unit& u, int wr, int wc, int fr, int fq) const {
        const int col0 = u.pn * BM + wc * 32 + 8 * fq;
#pragma unroll
        for (int ai = 0; ai < 2; ++ai)
#pragma unroll
            for (int m = 0; m < 4; ++m) { const int slot = u.pm * BM + ai * HALF + wr * 64 + m * 16 + fr; const float g = gws[slot];
#pragma unroll
                for (int bj = 0; bj < 2; ++bj) { const f32x4 v0 = acc[ai][bj][m][0] * g, v1 = acc[ai][bj][m][1] * g;
                    v4u o; o.x = cvt_pk_bf16(v0[0], v0[1]); o.y = cvt_pk_bf16(v0[2], v0[3]); o.z = cvt_pk_bf16(v1[0], v1[1]); o.w = cvt_pk_bf16(v1[2], v1[3]);
                    *(v4u*)(Y + (size_t)slot * DM + col0 + bj * HALF) = o; } }
    }
};
struct EpiMoeYp {
    static constexpr bool PERM = true;
    bf16* YP; const float* gws; int pm0; size_t split_stride;
    __device__ __forceinline__ void operator()(const f32x4 (&acc)[2][2][4][2], const Unit& u, int wr, int wc, int fr, int fq) const {
        const int col0 = (u.pn & 3) * BM + wc * 32 + 8 * fq; bf16* base = YP + (size_t)(u.pn >> 2) * split_stride;
#pragma unroll
        for (int ai = 0; ai < 2; ++ai)
#pragma unroll
            for (int m = 0; m < 4; ++m) { const int rl = ai * HALF + wr * 64 + m * 16 + fr; const float g = gws[u.pm * BM + rl];
#pragma unroll
                for (int bj = 0; bj < 2; ++bj) { const f32x4 v0 = acc[ai][bj][m][0] * g, v1 = acc[ai][bj][m][1] * g;
                    v4u o; o.x = cvt_pk_bf16(v0[0], v0[1]); o.y = cvt_pk_bf16(v0[2], v0[3]); o.z = cvt_pk_bf16(v1[0], v1[1]); o.w = cvt_pk_bf16(v1[2], v1[3]);
                    *(v4u*)(base + (size_t)((u.pm - pm0) * BM + rl) * DM + col0 + bj * HALF) = o; } }
    }
};
struct EpiSwiglu {
    static constexpr bool PERM = true;
    bf16* H; int ldh; int pm0; const float* rs; bf16* H2; int hsplit;
    __device__ __forceinline__ void operator()(const f32x4 (&acc)[2][2][4][2], const Unit& u, int wr, int wc, int fr, int fq) const {
        const int lt = u.pm - pm0; bf16* Hb = (H2 && lt >= hsplit) ? H2 : H;
        const int row0 = ((H2 && lt >= hsplit) ? lt - hsplit : lt) * BM + wr * 64 + fr, col0 = u.pn * HALF + wc * 32 + 8 * fq;
        const f32x8 rstd = row_rstd8(rs, u.pm * BM + wr * 64 + fr, fq);
#pragma unroll
        for (int ai = 0; ai < 2; ++ai)
#pragma unroll
            for (int m = 0; m < 4; ++m) { float h[8];
#pragma unroll
                for (int n = 0; n < 2; ++n)
#pragma unroll
                    for (int j = 0; j < 4; ++j) { const float g = acc[ai][0][m][n][j] * rstd[ai * 4 + m], up = acc[ai][1][m][n][j] * rstd[ai * 4 + m]; h[n * 4 + j] = g * up * __builtin_amdgcn_rcpf(1.0f + __builtin_amdgcn_exp2f(-g * LOG2E)); }
                v4u w; w.x = cvt_pk_bf16(h[0], h[1]); w.y = cvt_pk_bf16(h[2], h[3]); w.z = cvt_pk_bf16(h[4], h[5]); w.w = cvt_pk_bf16(h[6], h[7]);
                *(v4u*)(Hb + (size_t)(row0 + ai * HALF + m * 16) * ldh + col0) = w; }
    }
};
struct EpiMoeDown {
    static constexpr bool PERM = false;
    float* out; const int* tok; const float* gw; int pm0; float scale;
    __device__ __forceinline__ void operator()(const f32x4 (&acc)[2][2][4][2], const Unit& u, int wr, int wc, int fr, int fq) const {
        const int col0 = u.pn * BM + wc * 32 + 4 * fq;
#pragma unroll
        for (int ai = 0; ai < 2; ++ai)
#pragma unroll
            for (int m = 0; m < 4; ++m) { const int slot = u.pm * BM + ai * HALF + wr * 64 + m * 16 + fr; const int t = tok[slot];
                if (t >= 0) { const float g = gw[t] * scale; float* rowp = out + (size_t)t * DM + col0;
#pragma unroll
                    for (int bj = 0; bj < 2; ++bj)
#pragma unroll
                        for (int n = 0; n < 2; ++n) { f32x4* p = (f32x4*)(rowp + bj * HALF + n * 16); *p = *p + acc[ai][bj][m][n] * g; } } }
    }
};

template <class Epi, class Sched, bool ALIGN_EPI = true>
__device__ __forceinline__ void gemm_phase(LAS unsigned char* lds, const GemmK gk, const Sched& S, const Epi& E) {
    int tid = threadIdx.x; asm volatile("" : "+v"(tid));
    const int wid = __builtin_amdgcn_readfirstlane(tid >> 6), lane = tid & 63, wr = wid >> 2, wc = wid & 3, fr = lane & 15, fq = lane >> 4;
    int nt = gk.K / BK; asm volatile("" : "+s"(nt));
    unsigned voffA[2], voffB[2];
#pragma unroll
    for (int i = 0; i < 2; ++i) { int R, C; stage_rc(tid * 16 + i * 8192, R, C); const int Rb = Epi::PERM ? ((R & ~31) + perm32(R & 31)) : R;
        voffA[i] = (unsigned)R * gk.pitchA + (unsigned)C * 2u; voffB[i] = (unsigned)Rb * gk.pitchB + (unsigned)C * 2u; }
    const size_t hstepA = (size_t)HALF * gk.pitchA, hstepB = (size_t)HALF * gk.pitchB;
    const int ksh = gk.kshA; const unsigned kmask = (1u << ksh) - 1u; const size_t gstr = gk.gstrA;
#define PG8_KOA(t) ((size_t)((unsigned)(t) >> ksh) * gstr + (size_t)((unsigned)(t) & kmask) * 128u)
    const unsigned ldsw = (unsigned)wid * 1024u;
    const int aoff = lds_byte(wr * 64 + fr, fq * 8), boff = lds_byte(wc * 32 + fr, fq * 8);
#define PG8_SA(b, h) (((b) * 2 + (h)) * HTB)
#define PG8_SB(b, h) ((4 + (b) * 2 + (h)) * HTB)
#define PG8_STAGE(bufoff, gbase, voff) do { _Pragma("unroll") for (int _i = 0; _i < 2; ++_i) \
        __builtin_amdgcn_global_load_lds((const unsigned*)((const char*)(gbase) + (voff)[_i]), (LAS unsigned*)(lds + (bufoff) + ldsw + _i * 8192), 16, 0, 0); } while (0)
#define PG8_LDA(dst, b, h) do { _Pragma("unroll") for (int m = 0; m < 4; ++m) _Pragma("unroll") for (int k = 0; k < 2; ++k) dst[m][k] = *(const LAS bf16x8*)(lds + PG8_SA(b, h) + aoff + m * 2048 + k * 1024); } while (0)
#define PG8_LDB(dst, b, h) do { _Pragma("unroll") for (int n = 0; n < 2; ++n) _Pragma("unroll") for (int k = 0; k < 2; ++k) dst[n][k] = *(const LAS bf16x8*)(lds + PG8_SB(b, h) + boff + n * 2048 + k * 1024); } while (0)
#define PG8_MMA(ai, bj, At, Bt) do { __builtin_amdgcn_s_setprio(1); _Pragma("unroll") for (int m = 0; m < 4; ++m) _Pragma("unroll") for (int n = 0; n < 2; ++n) _Pragma("unroll") for (int k = 0; k < 2; ++k) \
        acc[ai][bj][m][n] = __builtin_amdgcn_mfma_f32_16x16x32_bf16(Bt[n][k], At[m][k], acc[ai][bj][m][n], 0, 0, 0); __builtin_amdgcn_s_setprio(0); } while (0)
#define PG8_WAIT_V(n) asm volatile("s_waitcnt vmcnt(" #n ")" ::: "memory")
#define PG8_WAIT_L(n) asm volatile("s_waitcnt lgkmcnt(" #n ")" ::: "memory")
#define PG8_BAR __builtin_amdgcn_s_barrier()
#define PG8_SCHED __builtin_amdgcn_sched_barrier(0)
    Unit cur, nxt; int ui = 0;
    if (!S.next(0, cur)) return;
    f32x4 acc[2][2][4][2];
#pragma unroll
    for (int a = 0; a < 2; ++a)
#pragma unroll
        for (int b = 0; b < 2; ++b)
#pragma unroll
            for (int m = 0; m < 4; ++m)
#pragma unroll
                for (int n = 0; n < 2; ++n) acc[a][b][m][n] = (f32x4){0.f, 0.f, 0.f, 0.f};
    bf16x8 At[4][2], B0[2][2], B1[2][2];
    const char* cA = cur.A; const char* cB = cur.B;
    PG8_STAGE(PG8_SB(0, 0), cB, voffB); PG8_STAGE(PG8_SB(0, 1), cB + hstepB, voffB); PG8_STAGE(PG8_SA(0, 0), cA, voffA); PG8_STAGE(PG8_SA(0, 1), cA + hstepA, voffA);
    if (wr == 1) PG8_BAR;
    PG8_WAIT_V(2); PG8_BAR;
    PG8_STAGE(PG8_SB(1, 0), cB + 128, voffB); PG8_STAGE(PG8_SA(1, 0), cA + 128, voffA); PG8_STAGE(PG8_SB(1, 1), cB + hstepB + 128, voffB);
    PG8_WAIT_V(6); PG8_BAR;
    for (;;) {
        const bool has_next = S.next(ui + 1, nxt);
        const char* nA = has_next ? nxt.A : cA; const char* nB = has_next ? nxt.B : cB;
        for (int t = 0; t < nt; t += 2) {
            const bool last = (t == nt - 2);
            const char* a1 = cA + PG8_KOA(t + 1);
            const char* a2 = last ? nA : cA + PG8_KOA(t + 2); const char* b2 = last ? nB : cB + (size_t)(t + 2) * 128u;
            const char* a3 = a2 + 128; const char* b3 = b2 + 128;
            PG8_LDB(B0, 0, 0); PG8_LDB(B1, 0, 1); PG8_SCHED; PG8_LDA(At, 0, 0); PG8_STAGE(PG8_SA(1, 1), a1 + hstepA, voffA);
            PG8_WAIT_V(8); PG8_WAIT_L(0); PG8_BAR; PG8_MMA(0, 0, At, B0); PG8_MMA(0, 1, At, B1); PG8_BAR; PG8_SCHED;
            PG8_LDA(At, 0, 1); PG8_STAGE(PG8_SB(0, 0), b2, voffB); PG8_STAGE(PG8_SB(0, 1), b2 + hstepB, voffB); PG8_STAGE(PG8_SA(0, 0), a2, voffA);
            PG8_WAIT_V(8); PG8_WAIT_L(0); PG8_BAR; PG8_MMA(1, 0, At, B0); PG8_MMA(1, 1, At, B1); PG8_BAR; PG8_SCHED;
            PG8_LDB(B0, 1, 0); PG8_LDB(B1, 1, 1); PG8_SCHED; PG8_LDA(At, 1, 0); PG8_STAGE(PG8_SA(0, 1), a2 + hstepA, voffA);
            PG8_WAIT_V(8); PG8_WAIT_L(0); PG8_BAR; PG8_MMA(0, 0, At, B0); PG8_MMA(0, 1, At, B1); PG8_BAR; PG8_SCHED;
            PG8_LDA(At, 1, 1); PG8_STAGE(PG8_SB(1, 0), b3, voffB); PG8_STAGE(PG8_SB(1, 1), b3 + hstepB, voffB); PG8_STAGE(PG8_SA(1, 0), a3, voffA);
            PG8_WAIT_V(8); PG8_WAIT_L(0); PG8_BAR; PG8_MMA(1, 0, At, B0); PG8_MMA(1, 1, At, B1); PG8_BAR; PG8_SCHED;
        }
        if constexpr (ALIGN_EPI) { if (wr == 0) PG8_BAR; }
        E(acc, cur, wr, wc, fr, fq);
        if (!has_next) break;
#pragma unroll
        for (int a = 0; a < 2; ++a)
#pragma unroll
            for (int b = 0; b < 2; ++b)
#pragma unroll
                for (int m = 0; m < 4; ++m)
#pragma unroll
                    for (int n = 0; n < 2; ++n) acc[a][b][m][n] = (f32x4){0.f, 0.f, 0.f, 0.f};
        cur = nxt; cA = nA; cB = nB; ++ui;
        if constexpr (ALIGN_EPI) { if (wr == 1) PG8_BAR; }
    }
    PG8_WAIT_V(0);
    if constexpr (!ALIGN_EPI) { if (wr == 0) PG8_BAR; }
    PG8_BAR;
#undef PG8_KOA
#undef PG8_SA
#undef PG8_SB
#undef PG8_STAGE
#undef PG8_LDA
#undef PG8_LDB
#undef PG8_MMA
#undef PG8_WAIT_V
#undef PG8_WAIT_L
#undef PG8_BAR
#undef PG8_SCHED
}
}
#define XB_TMO      128
#define XB_XCNT(j)  (256  + 64 * (j))
#define XB_XSUB(j)  (1280 + 64 * (j))
#define XB_XGEN(j)  (2304 + 64 * (j))
#define XB_TOP      3328
#define XB_TOPGEN   3392
#define XCD_BAR_WORDS 3456
#define XB_SPIN_CAP (1u << 22)

__device__ __forceinline__ unsigned xb_ld(unsigned* p)              { return __hip_atomic_load(p, __ATOMIC_RELAXED, __HIP_MEMORY_SCOPE_AGENT); }
__device__ __forceinline__ unsigned xb_add(unsigned* p, unsigned v) { return __hip_atomic_fetch_add(p, v, __ATOMIC_RELAXED, __HIP_MEMORY_SCOPE_AGENT); }
__device__ __forceinline__ unsigned xb_xcc_id() { return (unsigned)__builtin_amdgcn_s_getreg((3 << 11) | 20) & 0xFu; }
#define XB_SPIN(cond, bar) do { unsigned _sp = 0; while (cond) { __builtin_amdgcn_s_sleep(1); \
    if ((++_sp & 255u) == 0u) { if (xb_ld(&(bar)[XB_TMO])) break; if (_sp > XB_SPIN_CAP) { atomicAdd(&(bar)[XB_TMO], 1u); break; } } } } while (0)

struct XcdBarrier { unsigned* bar; unsigned x; volatile LAS unsigned* st; };

__device__ __forceinline__ XcdBarrier xcd_barrier_post(unsigned* bar, volatile LAS unsigned* st) {
    XcdBarrier b; b.bar = bar; b.x = xb_xcc_id(); b.st = st;
    if (threadIdx.x == 0) (void)xb_add(&bar[XB_XCNT(b.x)], 1u);
    return b;
}
__device__ __forceinline__ void xcd_barrier_complete(unsigned* bar, unsigned x, unsigned& nloc, unsigned& nx) {
    const unsigned G = gridDim.x * gridDim.y * gridDim.z;
    unsigned sum, cnt, mine, sp = 0u;
    for (;;) {
        sum = 0u; cnt = 0u; mine = 0u;
#pragma unroll
        for (unsigned j = 0; j < 16; ++j) { const unsigned c = xb_ld(&bar[XB_XCNT(j)]); sum += c; cnt += (c > 0u) ? 1u : 0u; mine = (j == x) ? c : mine; }
        if (sum == G) break;
        __builtin_amdgcn_s_sleep(1);
        if ((++sp & 255u) == 0u) { if (xb_ld(&bar[XB_TMO])) break; if (sp > XB_SPIN_CAP) { atomicAdd(&bar[XB_TMO], 1u); break; } }
    }
    nloc = mine > 0u ? mine : 1u; nx = cnt > 0u ? cnt : 1u;
}
__device__ __forceinline__ void xcd_barrier(const XcdBarrier& b) {
    asm volatile("s_waitcnt vmcnt(0)" ::: "memory");
    __syncthreads();
    if (threadIdx.x == 0) {
        unsigned* bar = b.bar;
        __builtin_amdgcn_s_waitcnt(0);
        unsigned nloc = b.st[0], nx = b.st[1];
        if (nloc == 0u) { xcd_barrier_complete(bar, b.x, nloc, nx); b.st[0] = nloc; b.st[1] = nx; }
        const unsigned old = xb_add(&bar[XB_XSUB(b.x)], 1u);
        const unsigned gen = old / nloc;
        if (old + 1u == (gen + 1u) * nloc) {
            __builtin_amdgcn_fence(__ATOMIC_RELEASE, "agent");
            asm volatile("s_waitcnt vmcnt(0)" ::: "memory");
            const unsigned og = xb_add(&bar[XB_TOP], 1u);
            const unsigned tg = og / nx;
            if (og + 1u == (tg + 1u) * nx) xb_add(&bar[XB_TOPGEN], 1u);
            else XB_SPIN(xb_ld(&bar[XB_TOPGEN]) == tg, bar);
            __builtin_amdgcn_fence(__ATOMIC_ACQUIRE, "agent");
            xb_add(&bar[XB_XGEN(b.x)], 1u);
            asm volatile("s_waitcnt vmcnt(0)" ::: "memory");
        } else {
            XB_SPIN(xb_ld(&bar[XB_XGEN(b.x)]) == gen, bar);
            __builtin_amdgcn_fence(__ATOMIC_ACQUIRE, "agent");
            asm volatile("s_waitcnt vmcnt(0)" ::: "memory");
        }
    }
    __syncthreads();
}

struct Frame {
    LAS unsigned char* lds;
    char* ldsg;
    volatile LAS unsigned* MISC;
    gu32* ctl;
    int tid, lane, wave, vcu, G;
    const __attribute__((address_space(4))) char* kap;
    float* out; unsigned char* ws;
};
#define FIN(i) (*(const float* const __attribute__((address_space(4)))*)(F.kap + 8 * (i)))
#define PHASE_FENCE() do { unsigned long long k_ = (unsigned long long)F.kap; asm volatile("" : "+s"(k_)); F.kap = (const __attribute__((address_space(4))) char*)k_; \
    int t_ = F.tid; asm volatile("" : "+v"(t_)); F.tid = t_; F.lane = t_ & 63; } while (0)
#define WSP(T, off) ((T*)(F.ws + (off)))
#define GRP(g) (WSP(bf16, WS_PROJ) + (size_t)(g) * GS)
#define QKVG(g) (WSP(bf16, WS_QKV) + (size_t)(g) * GS)

__device__ __forceinline__ void rms_row(const float* xrow, const float* gain, int lane, f32x4 (&v)[4]) {
    const GAS f32x4* xr = (const GAS f32x4*)xrow + lane; float s = 0.f;
#pragma unroll
    for (int j = 0; j < 4; ++j) { v[j] = xr[64 * j]; s += (v[j].x * v[j].x + v[j].y * v[j].y) + (v[j].z * v[j].z + v[j].w * v[j].w); }
    const float rstd = 1.0f / sqrtf(wave_sum(s) * (1.f / DM) + RMS_EPS);
#pragma unroll
    for (int j = 0; j < 4; ++j) { const f32x4 g = ((const GAS f32x4*)gain)[lane + 64 * j]; v[j] = v[j] * rstd * g; }
}
__device__ __forceinline__ void store_row_bf16(bf16* orow, int lane, const f32x4 (&v)[4]) {
    GAS unsigned long long* o8 = (GAS unsigned long long*)orow + lane;
#pragma unroll
    for (int j = 0; j < 4; ++j) o8[64 * j] = (unsigned long long)cvtpk(v[j].x, v[j].y) | ((unsigned long long)cvtpk(v[j].z, v[j].w) << 32);
}
__device__ __forceinline__ void load_row_bf16(const bf16* row, int lane, float (&v)[16]) {
    const v4u a = ((const GAS v4u*)row)[lane], b = ((const GAS v4u*)row)[64 + lane];
#pragma unroll
    for (int q = 0; q < 4; ++q) { v[2 * q] = __uint_as_float(a[q] << 16); v[2 * q + 1] = __uint_as_float(a[q] & 0xffff0000u); v[8 + 2 * q] = __uint_as_float(b[q] << 16); v[8 + 2 * q + 1] = __uint_as_float(b[q] & 0xffff0000u); }
}
__device__ __forceinline__ void store_row16_bf16(bf16* row, int lane, const float (&v)[16]) {
    ((GAS v4u*)row)[lane] = (v4u){cvtpk(v[0], v[1]), cvtpk(v[2], v[3]), cvtpk(v[4], v[5]), cvtpk(v[6], v[7])};
    ((GAS v4u*)row)[64 + lane] = (v4u){cvtpk(v[8], v[9]), cvtpk(v[10], v[11]), cvtpk(v[12], v[13]), cvtpk(v[14], v[15])};
}
__device__ __forceinline__ void rms16(float (&v)[16], const float* gain, int lane) {
    float s = 0.f;
#pragma unroll
    for (int i = 0; i < 16; ++i) s += v[i] * v[i];
    const float rstd = 1.0f / sqrtf(wave_sum(s) * (1.f / DM) + RMS_EPS);
    const f32x4 g0 = ((const GAS f32x4*)gain)[2 * lane], g1 = ((const GAS f32x4*)gain)[2 * lane + 1], g2 = ((const GAS f32x4*)gain)[128 + 2 * lane], g3 = ((const GAS f32x4*)gain)[128 + 2 * lane + 1];
#pragma unroll
    for (int i = 0; i < 4; ++i) { v[i] *= rstd * g0[i]; v[4 + i] *= rstd * g1[i]; v[8 + i] *= rstd * g2[i]; v[12 + i] *= rstd * g3[i]; }
}
__device__ __forceinline__ void norm_phase(Frame& F, const float* srcf, const bf16* srcb, const float* gain) {
    const int gw = F.vcu * NWAVES + F.wave, NGW = F.G * NWAVES;
    if (srcf) { for (int m = gw; m < M; m += 2 * NGW) { f32x4 v[4], w[4]; const int mb = m + NGW;
            const GAS f32x4* xa = (const GAS f32x4*)(srcf + (size_t)m * DM) + F.lane; const GAS f32x4* xb = (const GAS f32x4*)(srcf + (size_t)(mb < M ? mb : m) * DM) + F.lane;
#pragma unroll
            for (int j = 0; j < 4; ++j) { v[j] = xa[64 * j]; w[j] = xb[64 * j]; }
            float sa = 0.f, sb = 0.f;
#pragma unroll
            for (int j = 0; j < 4; ++j) { sa += (v[j].x * v[j].x + v[j].y * v[j].y) + (v[j].z * v[j].z + v[j].w * v[j].w); sb += (w[j].x * w[j].x + w[j].y * w[j].y) + (w[j].z * w[j].z + w[j].w * w[j].w); }
            const float ra = 1.0f / sqrtf(wave_sum(sa) * (1.f / DM) + RMS_EPS), rb = 1.0f / sqrtf(wave_sum(sb) * (1.f / DM) + RMS_EPS);
#pragma unroll
            for (int j = 0; j < 4; ++j) { const f32x4 g = ((const GAS f32x4*)gain)[F.lane + 64 * j]; v[j] = v[j] * ra * g; w[j] = w[j] * rb * g; }
            store_row_bf16(WSP(bf16, WS_XN) + (size_t)m * DM, F.lane, v); if (mb < M) store_row_bf16(WSP(bf16, WS_XN) + (size_t)mb * DM, F.lane, w); } }
    else { for (int m = gw; m < M; m += NGW) { float v[16]; load_row_bf16(srcb + (size_t)m * DM, F.lane, v); rms16(v, gain, F.lane); store_row16_bf16(WSP(bf16, WS_XN) + (size_t)m * DM, F.lane, v); } }
}

struct SrcCol { const float* W; int col; int ldw; };
template <class Fn>
__device__ __forceinline__ void xpose_load(const Fn& fn, int K, const float* kgain, int item, int lane, float (&v)[32]) {
    const int nkb = K / 64, rb = item / nkb, kb = item % nkb, k0 = 64 * kb, r0 = 32 * rb;
    const SrcCol s = fn(r0 + (lane & 31));
#pragma unroll
    for (int i = 0; i < 32; ++i) { const int kk = 2 * i + (lane >> 5); float x = 0.f; if (s.W) { x = s.W[(size_t)(k0 + kk) * s.ldw + s.col]; if (kgain) x *= kgain[k0 + kk]; } v[i] = x; }
}
__device__ __forceinline__ void xpose_store(int K, bf16* WT, LAS float* scr, int item, int lane, const float (&v)[32]) {
    const int nkb = K / 64, rb = item / nkb, kb = item % nkb, k0 = 64 * kb, r0 = 32 * rb;
#pragma unroll
    for (int i = 0; i < 32; ++i) scr[(2 * i + (lane >> 5)) * 33 + (lane & 31)] = v[i];
    LDS_WAIT(); asm volatile("" ::: "memory");
    const int c = lane & 7;
#pragma unroll
    for (int j = 0; j < 4; ++j) { const int n = (lane >> 3) + 8 * j; const LAS float* sp = scr + (8 * c) * 33 + n;
        v4u o; o.x = cvtpk(sp[0 * 33], sp[1 * 33]); o.y = cvtpk(sp[2 * 33], sp[3 * 33]); o.z = cvtpk(sp[4 * 33], sp[5 * 33]); o.w = cvtpk(sp[6 * 33], sp[7 * 33]);
        *(GAS v4u*)(WT + (size_t)(r0 + n) * K + k0 + 8 * c) = o; }
    LDS_WAIT(); asm volatile("" ::: "memory");
}
template <class Fn>
__device__ __forceinline__ void xpose_matrix(const Fn& fn, int K, bf16* WT, const float* kgain, LAS float* scr, int first, int nitems, int stride, int lane) {
    float va[32], vb[32];
    int it = first;
    if (it < nitems) xpose_load(fn, K, kgain, it, lane, va);
    while (it < nitems) {
        const int i1 = it + stride, i2 = i1 + stride;
        if (i1 < nitems) xpose_load(fn, K, kgain, i1, lane, vb);
        xpose_store(K, WT, scr, it, lane, va);
        if (i1 >= nitems) break;
        if (i2 < nitems) xpose_load(fn, K, kgain, i2, lane, va);
        xpose_store(K, WT, scr, i1, lane, vb);
        it = i2;
    }
}
__device__ __forceinline__ int incol(int rho) {
    const int g = rho >> 7, c = rho & 127;
    if (g < 4) return rho;
    if (g < 6) return 512 + (rho - 512);
    if (g < 8) return 768 + (rho - 768);
    if (g < 12) return 1092 + (rho - 1024);
    if (g < 18) return 1604 + (rho - 1536);
    if (g == 18) { if (c < 64) return 1024 + c; if (c < 68) return 1088 + (c - 64); if (c < 80) return 2372 + (c - 68); return -1; }
    return -1;
}
struct FnIn { const float* W; __device__ __forceinline__ SrcCol operator()(int r) const { const int c = incol(r); return SrcCol{c >= 0 ? W : nullptr, c, 2384}; } };
struct FnPlain { const float* W; int ldw; int coff; __device__ __forceinline__ SrcCol operator()(int r) const { return SrcCol{W, r + coff, ldw}; } };
struct FnGU { const float* Wg; const float* Wu; int ldw; __device__ __forceinline__ SrcCol operator()(int r) const { const int pn = r >> 8, c = r & 127;
    const long long d = (r & 128) ? ((const char*)Wu - (const char*)Wg) : 0ll;
    return SrcCol{(const float*)((const char*)Wg + d), pn * 128 + c, ldw}; } };
namespace att {
constexpr int KVBLK = 64, SHM_K = KVBLK * 128 * 2, SHM_V = KVBLK * 128 * 2;
#define KSWZ(row, colB) ((row) * 256 + ((colB) ^ (((row) & 7) << 4)))
__device__ __forceinline__ int v_st(int k, int c) { const int kk = (k & ~0xC) | ((k & 4) << 1) | ((k & 8) >> 1); return ((kk >> 3) * 4 + (c >> 5)) * 512 + ((kk & 7) * 32 + (c & 31)) * 2; }
__device__ __forceinline__ int v_rd_base(int lane) { return ((lane & 3) << 3) | (((lane >> 2) & 3) << 6) | (((lane >> 4) & 1) << 5) | (((lane >> 5) & 1) << 8); }
constexpr int v_rd_off(int d0, int ks, int half) { return d0 * 512 + ks * 4096 + half * 2048; }
__device__ __forceinline__ int crow(int r, int hi) { return (r & 3) + 8 * (r >> 2) + 4 * hi; }
__device__ __forceinline__ void qkt(f32x16& p0, f32x16& p1, const char* K_lds, int r32, int hi, const bf16x8* qr) {
    p0 = f32x16{}; p1 = f32x16{};
    const char* kb[4];
#pragma unroll
    for (int dd = 0; dd < 4; ++dd) kb[dd] = K_lds + KSWZ(r32, (dd * 16 + hi * 8) * 2);
#pragma unroll
    for (int d0 = 0; d0 < 8; ++d0) { const char* a = kb[d0 & 3] + (d0 >> 2) * 128;
        bf16x8 b0 = *reinterpret_cast<const bf16x8*>(a);
        bf16x8 b1 = *reinterpret_cast<const bf16x8*>(a + 32 * 256);
        p0 = __builtin_amdgcn_mfma_f32_32x32x16_bf16(b0, qr[d0], p0, 0, 0, 0);
        p1 = __builtin_amdgcn_mfma_f32_32x32x16_bf16(b1, qr[d0], p1, 0, 0, 0);
        if (d0 == 3) SBAR(); }
}
__device__ __forceinline__ void qkt_lq(f32x16& p0, f32x16& p1, const char* K_lds, const char* Q_lds, int r32, int hi) {
    p0 = f32x16{}; p1 = f32x16{};
    int ko[4];
#pragma unroll
    for (int dd = 0; dd < 4; ++dd) ko[dd] = KSWZ(r32, (dd * 16 + hi * 8) * 2);
#pragma unroll
    for (int d0 = 0; d0 < 8; ++d0) { const int a = ko[d0 & 3] + (d0 >> 2) * 128;
        bf16x8 b0 = *reinterpret_cast<const bf16x8*>(K_lds + a);
        bf16x8 b1 = *reinterpret_cast<const bf16x8*>(K_lds + a + 32 * 256);
        bf16x8 q = *reinterpret_cast<const bf16x8*>(Q_lds + a);
        p0 = __builtin_amdgcn_mfma_f32_32x32x16_bf16(b0, q, p0, 0, 0, 0);
        p1 = __builtin_amdgcn_mfma_f32_32x32x16_bf16(b1, q, p1, 0, 0, 0);
        if (d0 == 3) SBAR(); }
}
__device__ __forceinline__ void pv_tile(f32x16* o, int vb0, bf16x8 pa0, bf16x8 pa1, bf16x8 pa2, bf16x8 pa3) {
#define TRRD(dst, off) asm volatile("ds_read_b64_tr_b16 %0, %1 offset:%2" : "=&v"(dst) : "v"(vb0), "i"(off) : "memory")
#define PV_D0(d0) do { s16x4 l0, l1, l2, l3, h0, h1, h2, h3; constexpr int b_ = v_rd_off(d0, 0, 0); \
        TRRD(l0, b_); TRRD(h0, b_ + 2048); TRRD(l1, b_ + 4096); TRRD(h1, b_ + 6144); TRRD(l2, b_ + 8192); TRRD(h2, b_ + 10240); TRRD(l3, b_ + 12288); TRRD(h3, b_ + 14336); \
        asm volatile("s_waitcnt lgkmcnt(0)" ::: "memory"); SBAR(); \
        o[d0] = __builtin_amdgcn_mfma_f32_32x32x16_bf16(pa0, (bf16x8){l0[0], l0[1], l0[2], l0[3], h0[0], h0[1], h0[2], h0[3]}, o[d0], 0, 0, 0);   \
        o[d0] = __builtin_amdgcn_mfma_f32_32x32x16_bf16(pa1, (bf16x8){l1[0], l1[1], l1[2], l1[3], h1[0], h1[1], h1[2], h1[3]}, o[d0], 0, 0, 0);   \
        o[d0] = __builtin_amdgcn_mfma_f32_32x32x16_bf16(pa2, (bf16x8){l2[0], l2[1], l2[2], l2[3], h2[0], h2[1], h2[2], h2[3]}, o[d0], 0, 0, 0);   \
        o[d0] = __builtin_amdgcn_mfma_f32_32x32x16_bf16(pa3, (bf16x8){l3[0], l3[1], l3[2], l3[3], h3[0], h3[1], h3[2], h3[3]}, o[d0], 0, 0, 0); } while (0)
    PV_D0(0); PV_D0(1); PV_D0(2); PV_D0(3);
#undef PV_D0
#undef TRRD
}
__device__ __forceinline__ void pack_p(const f32x16& p0, const f32x16& p1, bf16x8& pa0, bf16x8& pa1, bf16x8& pa2, bf16x8& pa3) {
#define PK4(P, B_, OUT) do { unsigned a0 = cvtpk(P[B_+0], P[B_+1]), a1 = cvtpk(P[B_+2], P[B_+3]);                          \
        unsigned b0 = cvtpk(P[B_+4], P[B_+5]), b1 = cvtpk(P[B_+6], P[B_+7]);                                             \
        auto r0 = __builtin_amdgcn_permlane32_swap(a0, b0, false, false); auto r1 = __builtin_amdgcn_permlane32_swap(a1, b1, false, false); \
        v4u w = {r0[0], r1[0], r0[1], r1[1]}; OUT = __builtin_bit_cast(bf16x8, w); } while (0)
    PK4(p0, 0, pa0); PK4(p0, 8, pa1); PK4(p1, 0, pa2); PK4(p1, 8, pa3);
#undef PK4
}
__device__ __forceinline__ float xhalf_max(float v) { auto rr = __builtin_amdgcn_permlane32_swap(__float_as_uint(v), __float_as_uint(v), false, false); return fmaxf(__uint_as_float(rr[0]), __uint_as_float(rr[1])); }
__device__ __forceinline__ float xhalf_sum(float v) { auto rr = __builtin_amdgcn_permlane32_swap(__float_as_uint(v), __float_as_uint(v), false, false); return __uint_as_float(rr[0]) + __uint_as_float(rr[1]); }
__device__ __forceinline__ void softmax_step(f32x16& p0, f32x16& p1, float& m_reg, float& l_reg, f32x16* o, float* al_l, int r32, int hi) {
    float pmax = p0[0];
#pragma unroll
    for (int r = 1; r < 16; ++r) pmax = fmaxf(pmax, p0[r]);
#pragma unroll
    for (int r = 0; r < 16; ++r) pmax = fmaxf(pmax, p1[r]);
    pmax = xhalf_max(pmax);
    float mn, alpha;
    if (__all(pmax - m_reg <= 8.f)) { mn = m_reg; alpha = 1.f; }
    else { mn = fmaxf(m_reg, pmax); alpha = __builtin_amdgcn_exp2f(m_reg - mn); m_reg = mn; }
#pragma unroll
    for (int r = 0; r < 16; ++r) { p0[r] = __builtin_amdgcn_exp2f(p0[r] - mn); p1[r] = __builtin_amdgcn_exp2f(p1[r] - mn); }
    float ps = 0.f;
#pragma unroll
    for (int r = 0; r < 16; ++r) ps += p0[r] + p1[r];
    ps = xhalf_sum(ps);
    l_reg = l_reg * alpha + ps;
    if (__any(alpha < 1.f)) { if (hi == 0) al_l[r32] = alpha; asm volatile("s_waitcnt lgkmcnt(0)" ::: "memory");
#pragma unroll
        for (int d_ = 0; d_ < 4; ++d_)
#pragma unroll
            for (int r = 0; r < 16; ++r) o[d_][r] *= al_l[crow(r, hi)];
        asm volatile("s_waitcnt lgkmcnt(0)" ::: "memory"); }
}
struct DmaOff { unsigned k[2], v[2]; };
__device__ __forceinline__ void dma_offsets(DmaOff& d, int tid) {
#pragma unroll
    for (int i = 0; i < 2; ++i) { const int L = i * 8192 + tid * 16;
        const int row = L >> 8, pos = (L >> 4) & 15, c = pos ^ (row & 7); d.k[i] = (unsigned)(row * 256 + c * 16);
        const int sub = L >> 9, within = L & 511, kk = (sub >> 2) * 8 + (within >> 6), ccol = (within & 63) >> 1, cblk = sub & 3;
        const int k = (kk & ~0xC) | ((kk & 4) << 1) | ((kk & 8) >> 1); d.v[i] = (unsigned)(k * 256 + (cblk * 32 + ccol) * 2); }
}
__device__ __forceinline__ void dma_tile(const DmaOff& d, const bf16* Kp, const bf16* Vp, int key0, LAS unsigned char* buf, int wid) {
    const char* kb = (const char*)(Kp + (size_t)key0 * 128); const char* vb = (const char*)(Vp + (size_t)key0 * 128);
#pragma unroll
    for (int i = 0; i < 2; ++i) {
        __builtin_amdgcn_global_load_lds((const unsigned*)(kb + d.k[i]), (LAS unsigned*)(buf + 16384 + i * 8192 + wid * 1024), 16, 0, 0);
        __builtin_amdgcn_global_load_lds((const unsigned*)(vb + d.v[i]), (LAS unsigned*)(buf + i * 8192 + wid * 1024), 16, 0, 0); }
}
}
constexpr int AL_BUF = 0  , AL_Q = 65536  ;
constexpr int AL_WS = MISC_OFF + 2048  , AL_TBL = AL_WS + 2048  , AL_UNI = AL_TBL + 4 * 320 * 4  , AL_TRI = AL_UNI + 256  , AL_GB = AL_TRI + 2048  , AL_TBL132 = MISC_OFF + 12288  ;
static_assert(AL_Q + 65536 <= RING_BYTES && AL_GB + 128 <= AL_TBL132 && AL_TBL132 + 4 * 132 * 4 <= LDS_BYTES, "attention LDS map");

__device__ __forceinline__ void fill_bias_tbl132(Frame& F, float* tbl, int h0) {
    const float* rb = FIN(I_RELB);
    for (int i = F.tid; i < 4 * 132; i += NTHR) { const int h = i / 132, d = i % 132; const int dd = d > 128 ? 128 : d;
        tbl[i] = (rb[rel_bucket_dev(dd) * 8 + h0 + h] - rb[31 * 8 + h0 + h]) * LOG2E; }
}
__device__ __forceinline__ void fill_bias_tbl(Frame& F, float* tbl, int h0) {
    const float* rb = FIN(I_RELB);
    for (int i = F.tid; i < 4 * 320; i += NTHR) { const int h = i / 320, d = i % 320 - 96;
        tbl[i] = (d >= 0 && d < 113) ? (rb[rel_bucket_dev(d) * 8 + h0 + h] - rb[31 * 8 + h0 + h]) * LOG2E : 0.f; }
}

template <int MODE>
__device__ __forceinline__ void attn_unit(Frame& F, int b, int qt) {
    using namespace att;
    char* lds = F.ldsg;
    int tid = F.tid; asm volatile("" : "+v"(tid));
    const int wid = F.wave, lane = tid & 63, r32 = lane & 31, hi = lane >> 5;
    const int hd = wid & 3, qh = wid >> 2, q0 = qt * 64, tw = q0 + 32 * qh, t = tw + r32;
    const size_t rowg = (size_t)b * SEQ;
    float* wsf = (float*)(lds + AL_WS) + wid * 64; float* li_l = wsf; float* al_l = wsf + 32;
    const float* tbl = (const float*)(lds + AL_TBL) + hd * 320;
    const bf16* Qp = GRP((MODE == 0 ? G_QA : G_QB) + hd) + (rowg + t) * 128;
    const bf16* Kp = (MODE == 0 ? WSP(bf16, WS_AK) : MODE == 1 ? GRP(G_SK) : GRP(G_WK)) + rowg * 128;
    const bf16* Vp = (MODE == 0 ? WSP(bf16, WS_AV) : MODE == 1 ? GRP(G_SV) : GRP(G_WV)) + rowg * 128;
    bf16x8 qr[8];
#pragma unroll
    for (int d0 = 0; d0 < 8; ++d0) qr[d0] = *(const bf16x8*)(Qp + d0 * 16 + hi * 8);
    unsigned long long todo = (qt == 63) ? ~0ull : ((2ull << qt) - 1ull);
    unsigned long long bm64 = 0ull;
    if (MODE == 1) {
        bm64 = WSP(unsigned long long, WS_BLK)[rowg + t];
        volatile LAS unsigned* uni = (volatile LAS unsigned*)(F.lds + AL_UNI);
        if (tid < 2) uni[tid] = 0u;
        __syncthreads();
        __hip_atomic_fetch_or((LAS unsigned*)(F.lds + AL_UNI), (unsigned)bm64, __ATOMIC_RELAXED, __HIP_MEMORY_SCOPE_WORKGROUP);
        __hip_atomic_fetch_or((LAS unsigned*)(F.lds + AL_UNI) + 1, (unsigned)(bm64 >> 32), __ATOMIC_RELAXED, __HIP_MEMORY_SCOPE_WORKGROUP);
        __syncthreads();
        const unsigned long long um = (unsigned long long)uni[0] | ((unsigned long long)uni[1] << 32);
        todo &= um;
    }
    if (MODE == 2) { const int jl = q0 >= 511 ? ((q0 - 511) >> 6) : 0; todo &= ~((1ull << jl) - 1ull); }
    todo = ((unsigned long long)__builtin_amdgcn_readfirstlane((unsigned)todo)) | ((unsigned long long)__builtin_amdgcn_readfirstlane((unsigned)(todo >> 32)) << 32);
    const unsigned* bmrow = WSP(unsigned, WS_BM) + (rowg + t) * 128;
    float m_reg = -1e30f, l_reg = 0.f; f32x16 o[4] = {};
    const int vrb = v_rd_base(lane);
    DmaOff dof; dma_offsets(dof, tid);
    int j = __builtin_ctzll(todo); todo &= todo - 1ull;
    int buf = 0;
    dma_tile(dof, Kp, Vp, j * 64, F.lds + AL_BUF, wid);
    for (;;) {
        asm volatile("s_waitcnt vmcnt(0)" ::: "memory");
        __syncthreads();
        const int jn = todo ? __builtin_ctzll(todo) : -1;
        if (jn >= 0) { todo &= todo - 1ull; dma_tile(dof, Kp, Vp, jn * 64, F.lds + AL_BUF + (buf ^ 1) * 32768, wid); }
        const char* V_lds = lds + AL_BUF + buf * 32768; const char* K_lds = V_lds + 16384;
        const int vb0 = (int)(uintptr_t)(lds + AL_BUF + buf * 32768) + vrb;
        const int kb = j * 64;
        bool act = true;
        if (MODE == 1) act = __any((int)((bm64 >> j) & 1ull));
        if (MODE == 2) act = (kb <= tw + 31) && (kb + 63 >= tw - 511);
        if (MODE == 0) act = (kb <= tw + 31);
        if (act) {
            f32x16 p0, p1;
            qkt(p0, p1, K_lds, r32, hi, qr); SBAR();
            const float NEG = -__builtin_inff();
            const int dq = t - kb - 4 * hi;
            if (tw - (kb + 63) < 128) {
                const float* tp = tbl + (dq + 37);
#pragma unroll
                for (int r = 0; r < 16; ++r) { const int c = (r & 3) + 8 * (r >> 2); p0[r] += tp[59 - c]; p1[r] += tp[27 - c]; }
            }
            if (MODE == 0) {
                const v2u w = *(const v2u*)(bmrow + 2 * j);
                const unsigned w0 = w.x >> (4 * hi), w1 = w.y >> (4 * hi);
#pragma unroll
                for (int r = 0; r < 16; ++r) { const int c = (r & 3) + 8 * (r >> 2);
                    if (!((w0 >> c) & 1u)) p0[r] = NEG;
                    if (!((w1 >> c) & 1u)) p1[r] = NEG; }
            } else {
                const unsigned W = (MODE == 2) ? 512u : 0x7fffffffu;
                const bool rowsel = (MODE == 1) ? (((bm64 >> j) & 1ull) != 0ull) : true;
#pragma unroll
                for (int r = 0; r < 16; ++r) { const int c = (r & 3) + 8 * (r >> 2);
                    if (!rowsel || (unsigned)(dq - c) >= W) p0[r] = NEG;
                    if (!rowsel || (unsigned)(dq - c - 32) >= W) p1[r] = NEG; }
            }
            SBAR(); softmax_step(p0, p1, m_reg, l_reg, o, al_l, r32, hi); SBAR();
            bf16x8 pa0, pa1, pa2, pa3;
            pack_p(p0, p1, pa0, pa1, pa2, pa3); SBAR();
            pv_tile(o, vb0, pa0, pa1, pa2, pa3); SBAR();
        }
        if (jn < 0) break;
        j = jn; buf ^= 1;
    }
    {
        float fac = l_reg > 0.f ? 1.0f / l_reg : 0.f;
        if (MODE != 0) { const float gl = bf2f(GRP(G_MISC)[(rowg + t) * 128 + 68 + MODE * 4 + hd]); fac *= 1.0f / (1.0f + __expf(-gl)); }
        if (hi == 0) li_l[r32] = fac;
        asm volatile("s_waitcnt lgkmcnt(0)" ::: "memory");
        float rli[16];
#pragma unroll
        for (int r = 0; r < 16; ++r) rli[r] = li_l[crow(r, hi)];
        const size_t row0 = rowg + tw;
        if (MODE == 1) {
            const float* OCp = WSP(float, WS_OC) + row0 * 512 + hd * 128; float* OC2p = WSP(float, WS_OC2) + row0 * 512 + hd * 128;
#pragma unroll
            for (int r = 0; r < 16; ++r) { const int orow = crow(r, hi);
#pragma unroll
                for (int d0 = 0; d0 < 4; ++d0) { const size_t ix = (size_t)orow * 512 + d0 * 32 + r32; OC2p[ix] = OCp[ix] + o[d0][r] * rli[r]; } }
        } else {
            bf16* Op = WSP(bf16, WS_O) + row0 * DM + (MODE == 2 ? 512 : 0) + hd * 128;
            const float* OCp = WSP(float, WS_OC2) + row0 * 512 + hd * 128;
#pragma unroll
            for (int r = 0; r < 16; ++r) { const int orow = crow(r, hi);
#pragma unroll
                for (int d0 = 0; d0 < 4; ++d0) { float v = o[d0][r] * rli[r];
                    if (MODE == 2) v += OCp[(size_t)orow * 512 + d0 * 32 + r32];
                    const float vn = __shfl_xor(v, 1);
                    if ((r32 & 1) == 0) *(unsigned*)(Op + (size_t)orow * DM + d0 * 32 + r32) = cvtpk(v, vn); } }
        }
    }
    __syncthreads();
}
__device__ __forceinline__ float idx_k2f(unsigned k) { return __uint_as_float((k & 0x80000000u) ? (k & 0x7fffffffu) : ~k); }
__device__ __forceinline__ unsigned idx_f2k(float f) { const unsigned u = __float_as_uint(f); return (u >> 31) ? ~u : (u | 0x80000000u); }
__device__ __forceinline__ unsigned half_sum_dpp(unsigned x) {
    x += (unsigned)__builtin_amdgcn_update_dpp(0, (int)x, 0x111, 0xf, 0xf, true);
    x += (unsigned)__builtin_amdgcn_update_dpp(0, (int)x, 0x112, 0xf, 0xf, true);
    x += (unsigned)__builtin_amdgcn_update_dpp(0, (int)x, 0x114, 0xf, 0xf, true);
    x += (unsigned)__builtin_amdgcn_update_dpp(0, (int)x, 0x118, 0xf, 0xf, true);
    x += (unsigned)__builtin_amdgcn_update_dpp(0, (int)x, 0x142, 0xa, 0xf, true);
    return x;
}
constexpr int IL_CAND = MISC_OFF + 2048, IL_HIST = IL_CAND + 4096;
__device__ __forceinline__ unsigned wave_sum_dpp63(unsigned x) {
    x = half_sum_dpp(x); x += (unsigned)__builtin_amdgcn_update_dpp(0, (int)x, 0x143, 0xc, 0xf, true); return (unsigned)__builtin_amdgcn_readlane((int)x, 63); }
__device__ __forceinline__ void idx_unit(Frame& F, int b, int tq, unsigned sub) {
    int tid = F.tid; asm volatile("" : "+v"(tid));
    const int wid = F.wave, lane = tid & 63, r32 = lane & 31, hi = lane >> 5;
    const int t0 = tq * 8; const size_t rowg = (size_t)b * SEQ;
    unsigned* bmrow = WSP(unsigned, WS_BM) + (rowg + t0) * 128;
    const int NT = 2 * (t0 >> 6) + 2;
    if (t0 + 8 <= 256) {
        for (int i = tid; i < 8 * NT; i += NTHR) { const int q = i / NT, wd = i % NT, t = t0 + q, lo = wd * 32;
            const unsigned word = (t >= lo + 31) ? 0xffffffffu : (t < lo ? 0u : ((2u << (t - lo)) - 1u)); bmrow[q * 128 + wd] = word; }
        return;
    }
    LAS unsigned* S = (LAS unsigned*)F.lds;
    const bf16* misc = GRP(G_MISC);
    {
        bf16x8 aq[4];
        { const int ql = r32 >> 2, h = r32 & 3; const bf16* p = GRP(G_IQ + (h >> 1)) + (rowg + t0 + ql) * 128 + (h & 1) * 64 + hi * 8;
#pragma unroll
          for (int c = 0; c < 4; ++c) aq[c] = *(const bf16x8*)(p + c * 16); }
        float wq[4][4];
#pragma unroll
        for (int qj = 0; qj < 4; ++qj) { const v2u w = *(const v2u*)(misc + (rowg + t0 + 2 * qj + hi) * 128 + 64);
            wq[qj][0] = __uint_as_float(w.x << 16); wq[qj][1] = __uint_as_float(w.x & 0xffff0000u); wq[qj][2] = __uint_as_float(w.y << 16); wq[qj][3] = __uint_as_float(w.y & 0xffff0000u); }
#define IDX_LOAD(g, u0) do { _Pragma("unroll") for (int u = (u0); u < (u0) + 2; ++u) { int tile = wid + 8 * (4 * (g) + u); tile = tile < NT ? tile : NT - 1; const bf16* kp = misc + (rowg + tile * 32 + r32) * 128 + hi * 8; \
            _Pragma("unroll") for (int c = 0; c < 4; ++c) bk[u][c] = *(const bf16x8*)(kp + c * 16); } } while (0)
#define IDX_MMA(u0) do { _Pragma("unroll") for (int u = 0; u < 2; ++u) { acc[u] = f32x16{}; \
            _Pragma("unroll") for (int c = 0; c < 4; ++c) acc[u] = __builtin_amdgcn_mfma_f32_32x32x16_bf16(aq[c], bk[(u0) + u][c], acc[u], 0, 0, 0); } } while (0)
#define IDX_COMB(g, u0) do { _Pragma("unroll") for (int u = 0; u < 2; ++u) { const int tile = wid + 8 * (4 * (g) + (u0) + u), kb = tile * 32; \
            if (tile < NT) { _Pragma("unroll") for (int qj = 0; qj < 4; ++qj) { float s = 0.f; \
                _Pragma("unroll") for (int h = 0; h < 4; ++h) s = fmaf(fmaxf(acc[u][4 * qj + h], 0.f), wq[qj][h], s); \
                S[(2 * qj + hi) * 4096 + kb + r32] = (kb + r32 <= t0 + 2 * qj + hi) ? idx_f2k(s) : 0u; } } } } while (0)
#pragma unroll 1
        for (int rk = 0; rk < 1 + (int)(sub & 1u); ++rk) {
            bf16x8 bk[4][4]; f32x16 acc[2];
            IDX_LOAD(0, 0); IDX_LOAD(0, 2);
#pragma unroll
            for (int g = 0; g < 4; ++g) if (wid + 32 * g < NT) { const bool nx = g < 3 && wid + 32 * (g + 1) < NT;
                IDX_MMA(0); SBAR(); if (nx) IDX_LOAD(g + 1, 0); SBAR(); IDX_COMB(g, 0); SBAR();
                IDX_MMA(2); SBAR(); if (nx) IDX_LOAD(g + 1, 2); SBAR(); IDX_COMB(g, 2); SBAR(); }
        }
#undef IDX_LOAD
#undef IDX_MMA
#undef IDX_COMB
    }
    __syncthreads();
    const int t = t0 + wid, NJ = (t >> 6) + 1;
    unsigned kreg[64];
#pragma unroll
    for (int j = 0; j < 64; ++j) { const unsigned v = S[wid * 4096 + 64 * j + lane]; kreg[j] = (j < NJ) ? v : 0u; }
    const int NG = (NJ + 15) >> 4;
    unsigned lo = 1u, hi_ = 0xffffffffu, clo = (unsigned)(t + 1), chi = 0u; float wlo = 0.f, whi = 0.f; int last = 0;
#pragma unroll 1
    for (int rs = 0; rs < 1 + (int)((sub >> 1) & 1u); ++rs) {
    {
        LAS unsigned* hist = (LAS unsigned*)(F.lds + IL_HIST) + wid * 256;
        *(LAS v4u*)(hist + 4 * lane) = (v4u){0u, 0u, 0u, 0u};
        asm volatile("s_waitcnt lgkmcnt(0)" ::: "memory");
#pragma unroll
        for (int g = 0; g < 4; ++g) if (g < NG) {
#pragma unroll
            for (int j = 0; j < 16; ++j) { const unsigned k = kreg[16 * g + j];
                if (k) { int b_ = (int)floorf(idx_k2f(k)) + 128; b_ = b_ < 0 ? 0 : (b_ > 255 ? 255 : b_); __hip_atomic_fetch_add(hist + (255 - b_), 1u, __ATOMIC_RELAXED, __HIP_MEMORY_SCOPE_WAVEFRONT); } } }
        asm volatile("s_waitcnt lgkmcnt(0)" ::: "memory");
        const v4u h4 = *(LAS v4u*)(hist + 4 * lane);
        unsigned pre = h4.x + h4.y + h4.z + h4.w;
        pre += (unsigned)__builtin_amdgcn_update_dpp(0, (int)pre, 0x111, 0xf, 0xf, true);
        pre += (unsigned)__builtin_amdgcn_update_dpp(0, (int)pre, 0x112, 0xf, 0xf, true);
        pre += (unsigned)__builtin_amdgcn_update_dpp(0, (int)pre, 0x114, 0xf, 0xf, true);
        pre += (unsigned)__builtin_amdgcn_update_dpp(0, (int)pre, 0x118, 0xf, 0xf, true);
        pre += (unsigned)__builtin_amdgcn_update_dpp(0, (int)pre, 0x142, 0xa, 0xf, true);
        pre += (unsigned)__builtin_amdgcn_update_dpp(0, (int)pre, 0x143, 0xc, 0xf, true);
        const unsigned long long ge = __ballot(pre >= 256u);
        const int L = __builtin_ctzll(ge);
        const unsigned pL = (unsigned)__builtin_amdgcn_readlane((int)pre, L);
        const unsigned b0 = (unsigned)__builtin_amdgcn_readlane((int)h4.x, L), b1 = (unsigned)__builtin_amdgcn_readlane((int)h4.y, L), b2 = (unsigned)__builtin_amdgcn_readlane((int)h4.z, L), b3 = (unsigned)__builtin_amdgcn_readlane((int)h4.w, L);
        unsigned above = pL - (b0 + b1 + b2 + b3); int bsel = 4 * L; unsigned cb = b0;
        if (above + cb < 256u) { above += cb; cb = b1; bsel = 4 * L + 1; if (above + cb < 256u) { above += cb; cb = b2; bsel = 4 * L + 2; if (above + cb < 256u) { above += cb; cb = b3; bsel = 4 * L + 3; } } }
        const int B = 255 - bsel;
        lo = B == 0 ? 1u : idx_f2k((float)(B - 128)); hi_ = B == 255 ? 0xffffffffu : idx_f2k((float)(B - 127));
        chi = above; clo = above + cb;
    }
    wlo = (float)clo - 255.5f; whi = (float)chi - 255.5f; last = 0;
#pragma unroll 1
    for (int it = 0; it < 72; ++it) {
        if (clo - chi <= 64u || hi_ - lo == 1u) break;
        unsigned mid;
        { const float lf = idx_k2f(lo), hf = idx_k2f(hi_); float mf = lf + (hf - lf) * (wlo / (wlo - whi));
          mid = idx_f2k(mf);
          if (it >= 36 || !(fabsf(lf) < 1e30f && fabsf(hf) < 1e30f)) mid = lo + ((hi_ - lo) >> 1);
          mid = mid <= lo ? lo + 1u : (mid >= hi_ ? hi_ - 1u : mid);
          mid = (unsigned)__builtin_amdgcn_readfirstlane((int)mid); }
        unsigned cnt = 0u;
#pragma unroll
        for (int g = 0; g < 4; ++g) if (g < NG) {
#pragma unroll
            for (int j = 0; j < 16; ++j) cnt += (kreg[16 * g + j] >= mid) ? 1u : 0u; }
        const unsigned tot = wave_sum_dpp63(cnt);
        if (tot >= 256u) { lo = mid; clo = tot; wlo = (float)tot - 255.5f; if (last == 1) whi *= 0.5f; last = 1; }
        else { hi_ = mid; chi = tot; whi = (float)tot - 255.5f; if (last == 2) wlo *= 0.5f; last = 2; }
    }
    }
    unsigned T = lo; int J = 0x7fffffff; bool tie = true;
    const int need = 256 - (int)chi;
    if (clo - chi <= 64u) {
        volatile LAS unsigned* cand = (volatile LAS unsigned*)(F.lds + IL_CAND) + wid * 128;
        int pos = 0;
#pragma unroll
        for (int j = 0; j < 64; ++j) if ((j >> 4) < NG) { const unsigned kq = kreg[j]; const bool inb = kq >= lo && kq < hi_; const unsigned long long bal = __ballot(inb);
            if (bal) { const int slot = pos + __builtin_amdgcn_mbcnt_hi((unsigned)(bal >> 32), __builtin_amdgcn_mbcnt_lo((unsigned)bal, 0u));
                if (inb) { cand[2 * slot] = kreg[j]; cand[2 * slot + 1] = (unsigned)(64 * j + lane); } pos += __popcll(bal); } }
        const int m = pos;
        asm volatile("s_waitcnt lgkmcnt(0)" ::: "memory");
        const unsigned ki = lane < m ? cand[2 * lane] : 0u; const unsigned ii = lane < m ? cand[2 * lane + 1] : 0u;
        int rk = 0;
        for (int jx = 0; jx < m; ++jx) { const unsigned kj = (unsigned)__builtin_amdgcn_readlane((int)ki, jx), ij = (unsigned)__builtin_amdgcn_readlane((int)ii, jx); rk += (kj > ki || (kj == ki && ij < ii)) ? 1 : 0; }
        const unsigned long long hit = __ballot(lane < m && rk == need - 1);
        const int src = hit ? __builtin_ctzll(hit) : 0;
        T = (unsigned)__builtin_amdgcn_readlane((int)ki, src); J = (int)__builtin_amdgcn_readlane((int)ii, src);
        tie = __builtin_popcountll(__ballot(lane < m && ki == T)) != 1;
    } else if (clo > 256u) {
        int ilo = -1, ihi = t;
        for (int it = 0; it < 16 && ihi - ilo > 1; ++it) { const int imid = (ilo + ihi) >> 1; unsigned cnt = 0u;
#pragma unroll
            for (int j = 0; j < 64; ++j) if ((j >> 4) < NG) cnt += (kreg[j] == T && 64 * j + lane <= imid) ? 1u : 0u;
            const int tot = (int)wave_sum_dpp63(cnt);
            if (tot >= need) ihi = imid; else ilo = imid; }
        J = ihi;
    }
    unsigned long long w64 = 0ull;
    if (!tie) {
        int wl = 0, wh = 0;
#pragma unroll
        for (int j = 0; j < 64; ++j) if ((j >> 4) < NG) { const unsigned long long bal = __ballot(kreg[j] >= T); asm volatile("s_nop 4\n\tv_writelane_b32 %0, %2, %4\n\tv_writelane_b32 %1, %3, %4" : "+v"(wl), "+v"(wh) : "s"((unsigned)bal), "s"((unsigned)(bal >> 32)), "n"(j)); }
        w64 = (unsigned long long)(unsigned)wl | ((unsigned long long)(unsigned)wh << 32);
    } else {
#pragma unroll
        for (int j = 0; j < 64; ++j) if ((j >> 4) < NG) { const unsigned k = kreg[j]; const unsigned long long bal = __ballot(k > T || (k == T && 64 * j + lane <= J)); if (lane == j) w64 = bal; }
    }
    if (lane < NJ) *(unsigned long long*)(bmrow + wid * 128 + 2 * lane) = w64;
    __syncthreads();
}

__device__ __forceinline__ float gelu_tanh(float x) { const float y = 0.7978845608028654f * (x + 0.044715f * x * x * x); const float e = __expf(2.0f * y); return 0.5f * x * (2.0f - 2.0f / (1.0f + e)); }
__device__ __forceinline__ void cmp_finalize_item(Frame& F, int b, int j, int rc) {
    float* hid = (float*)F.ldsg + 2048;
    const float* W2 = FIN(I_EV_CW2) + (size_t)j * 128 * 128;
    const float* UV = WSP(float, WS_UV) + ((size_t)j * 2048 + (size_t)b * 256) * 256; const float* UVb = WSP(float, WS_UVB) + ((size_t)j * 2048 + (size_t)b * 256) * 256;
    const float* cbp = WSP(float, WS_TAB) + (size_t)j * 16 * 128;
    const int n0 = rc * 16;
    for (int i = F.tid; i < 16 * 128; i += NTHR) { const int r = i >> 7, c = i & 127, n = n0 + r;
        float cbv = 0.f;
#pragma unroll
        for (int q = 0; q < 16; ++q) cbv += cbp[q * 128 + c];
        float v = 0.f; if (n < 255) v = gelu_tanh((UV[(size_t)n * 256 + c] + UVb[(size_t)n * 256 + c]) + (UV[(size_t)(n + 1) * 256 + 128 + c] + UVb[(size_t)(n + 1) * 256 + 128 + c]) + cbv);
        hid[i] = v; }
    __syncthreads();
    const int c2 = F.tid & 127, rg = F.tid >> 7;
    float acc[4] = {0.f, 0.f, 0.f, 0.f};
#pragma unroll 4
    for (int c = 0; c < 128; ++c) { const float w = W2[c * 128 + c2];
#pragma unroll
        for (int q = 0; q < 4; ++q) acc[q] = fmaf(hid[(rg + 4 * q) * 128 + c], w, acc[q]); }
#pragma unroll
    for (int q = 0; q < 4; ++q) { const int n = n0 + rg + 4 * q; const float a = n >= 255 ? 0.f : acc[q];
        if (j == 0) WSP(bf16, WS_CK)[((size_t)b * 256 + n) * 128 + c2] = (bf16)f2bf(a);
        else WSP(bf16, WS_CV)[((size_t)b * 256 + n) * 128 + c2] = (bf16)f2bf(a); }
    __syncthreads();
}
constexpr int CL_S = 0;
constexpr int CL_P = 64 * 260 * 4;
constexpr int CL_IMP = CL_P + 64 * 264 * 2;
constexpr int CL_TBL = CL_IMP + 16 * 64 * 4;
static_assert(CL_TBL + 4 * 132 * 4 <= RING_BYTES, "cmp LDS map");
__device__ __forceinline__ void cmp_unit(Frame& F, int b, int qt16, unsigned sub) {
    char* lds = F.ldsg;
    float* S = (float*)(lds + CL_S); bf16* Pb = (bf16*)(lds + CL_P); float* impL = (float*)(lds + CL_IMP); const float* tbl = (const float*)(lds + CL_TBL);
    int tid = F.tid; asm volatile("" : "+v"(tid));
    const int wid = F.wave, lane = tid & 63, l15 = lane & 15, l4 = lane >> 4;
    const int q0 = qt16 * 16; const size_t rowg = (size_t)b * SEQ;
#pragma unroll 1
    for (int r1 = 0; r1 < 1 + (int)(sub & 1u); ++r1) {
    {
        const int rb = wid & 3;
        const bf16* qp = GRP(G_QB + rb) + (rowg + q0 + l15) * 128 + l4 * 8;
        bf16x8 qa[4];
#pragma unroll
        for (int c = 0; c < 4; ++c) qa[c] = *(const bf16x8*)(qp + c * 32);
        const bf16* ckb = WSP(bf16, WS_CK) + (size_t)b * 256 * 128;
#pragma unroll
        for (int i = 0; i < 8; ++i) { const int kb = (wid >> 2) * 8 + i;
            const bf16* kp = ckb + (size_t)(kb * 16 + l15) * 128 + l4 * 8;
            f32x4 acc = {0.f, 0.f, 0.f, 0.f};
#pragma unroll
            for (int c = 0; c < 4; ++c) { const bf16x8 bk = *(const bf16x8*)(kp + c * 32); acc = __builtin_amdgcn_mfma_f32_16x16x32_bf16(qa[c], bk, acc, 0, 0, 0); }
            const int n = kb * 16 + l15, kend = 16 * n + 31;
#pragma unroll
            for (int jj = 0; jj < 4; ++jj) { const int ql = l4 * 4 + jj, t = q0 + ql; int d = t - kend; const bool valid = (d >= 0) && (n < 255); d = d < 0 ? 0 : (d > 128 ? 128 : d);
                S[(rb * 16 + ql) * 260 + n] = valid ? acc[jj] + tbl[rb * 132 + d] : -__builtin_inff(); } }
    }
    __syncthreads();
#pragma unroll 1
    for (int rr = 0; rr < 8; ++rr) { const int row = wid * 8 + rr;
        f32x4 v = *(const f32x4*)(S + row * 260 + lane * 4);
        const float mx = wave_max(fmaxf(fmaxf(v[0], v[1]), fmaxf(v[2], v[3])));
        f32x4 p = {0.f, 0.f, 0.f, 0.f};
        if (mx > -1e37f) { p[0] = __builtin_amdgcn_exp2f(v[0] - mx); p[1] = __builtin_amdgcn_exp2f(v[1] - mx); p[2] = __builtin_amdgcn_exp2f(v[2] - mx); p[3] = __builtin_amdgcn_exp2f(v[3] - mx);
            const float inv = 1.0f / wave_sum((p[0] + p[1]) + (p[2] + p[3])); p = p * inv; }
        *(f32x4*)(S + row * 260 + lane * 4) = p;
        *(v2u*)(Pb + row * 264 + lane * 4) = (v2u){cvtpk(p[0], p[1]), cvtpk(p[2], p[3])}; }
    __syncthreads();
    }
#pragma unroll 1
    for (int r3 = 0; r3 < 1 + (int)((sub >> 1) & 1u); ++r3) {
    for (int i = tid; i < 16 * 64; i += NTHR) { const int q = i >> 6, m = i & 63; float s = 0.f;
#pragma unroll
        for (int h = 0; h < 4; ++h)
#pragma unroll
            for (int dn = -1; dn <= 3; ++dn) { const int n = 4 * m + dn; if (n >= 0 && n < 255) s += S[(h * 16 + q) * 260 + n]; }
        impL[i] = s; }
    __syncthreads();
#pragma unroll 1
    for (int qq = 0; qq < 2; ++qq) { const int q = wid * 2 + qq, t = q0 + q, cur = t >> 6, m = lane;
        const bool forced = (m == 0) || (m == cur) || (m == cur - 1);
        const bool cand = !forced && (m < cur);
        float val = cand ? impL[q * 64 + m] : -__builtin_inff();
        bool sel = forced;
        const int picks = 8 - __popcll(__ballot(forced));
        for (int p = 0; p < picks; ++p) { const float vm = wave_max(val); if (!(vm > -__builtin_inff())) break;
            const unsigned long long win = __ballot(val == vm); const int first = __builtin_ctzll(win);
            if (lane == first) { sel = true; val = -__builtin_inff(); } }
        const unsigned long long msk = __ballot(sel);
        if (lane == 0) WSP(unsigned long long, WS_BLK)[rowg + t] = msk; }
    }
#pragma unroll 1
    for (int r5 = 0; r5 < 1 + (int)((sub >> 2) & 1u); ++r5)
    {
        const int rb = wid & 3;
        const bf16* cvt = WSP(bf16, WS_CVT) + (size_t)b * 128 * 256;
        float g0[4];
#pragma unroll
        for (int jj = 0; jj < 4; ++jj) { const float gl = bf2f(GRP(G_MISC)[(rowg + q0 + l4 * 4 + jj) * 128 + 68 + rb]); g0[jj] = 1.0f / (1.0f + __expf(-gl)); }
#pragma unroll
        for (int i = 0; i < 4; ++i) { const int db = (wid >> 2) * 4 + i;
            f32x4 acc = {0.f, 0.f, 0.f, 0.f};
#pragma unroll
            for (int kc = 0; kc < 8; ++kc) { const bf16x8 pa = *(const bf16x8*)(Pb + (rb * 16 + l15) * 264 + kc * 32 + l4 * 8);
                const bf16x8 vb = *(const bf16x8*)(cvt + (size_t)(db * 16 + l15) * 256 + kc * 32 + l4 * 8);
                acc = __builtin_amdgcn_mfma_f32_16x16x32_bf16(pa, vb, acc, 0, 0, 0); }
#pragma unroll
            for (int jj = 0; jj < 4; ++jj) WSP(float, WS_OC)[(rowg + q0 + l4 * 4 + jj) * 512 + rb * 128 + db * 16 + l15] = acc[jj] * g0[jj]; }
    }
    __syncthreads();
}

constexpr int CL2_IMP = 65536;
__device__ __forceinline__ void cmp_unit64(Frame& F, int b, int qt) {
    using namespace att;
    char* lds = F.ldsg;
    int tid = F.tid; asm volatile("" : "+v"(tid));
    const int wid = F.wave, lane = tid & 63, r32 = lane & 31, hi = lane >> 5;
    const int hd = wid & 3, qh = wid >> 2, q0 = qt * 64, tw = q0 + 32 * qh, t = tw + r32;
    const size_t rowg = (size_t)b * SEQ;
    float* wsf = (float*)(lds + AL_WS) + wid * 64; float* li_l = wsf;
    const float* tbl = (const float*)(lds + AL_TBL132) + hd * 132;
    float* impW = (float*)(lds + CL2_IMP);
    const bf16* Qp = GRP(G_QB + hd) + (rowg + t) * 128;
    const bf16* Kp = WSP(bf16, WS_CK) + (size_t)b * 256 * 128; const bf16* Vp = WSP(bf16, WS_CV) + (size_t)b * 256 * 128;
    bf16x8 qr[8];
#pragma unroll
    for (int d0 = 0; d0 < 8; ++d0) qr[d0] = *(const bf16x8*)(Qp + d0 * 16 + hi * 8);
    const int vrb = v_rd_base(lane);
    DmaOff dof; dma_offsets(dof, tid);
    float m_reg = -1e30f, l_reg = 0.f;
    const float NEG = -__builtin_inff();
#define CMP_SCORES(j) \
            const char* V_lds = lds + AL_BUF + buf * 32768; const char* K_lds = V_lds + 16384; \
            f32x16 p0, p1; \
            qkt(p0, p1, K_lds, r32, hi, qr); SBAR(); \
            if (16 * (64 * (j) + 63) + 31 + 128 > tw) {            \
                _Pragma("unroll") for (int rq = 0; rq < 4; ++rq) { \
                    _Pragma("unroll") for (int ri = 0; ri < 4; ++ri) { const int r = 4 * rq + ri; const int n0 = 64 * (j) + (r & 3) + 8 * (r >> 2) + 4 * hi, n1 = n0 + 32; \
                        int d0 = t - (16 * n0 + 31), d1 = t - (16 * n1 + 31); \
                        const bool v0 = d0 >= 0, v1 = d1 >= 0 && n1 < 255; \
                        d0 = d0 < 0 ? 0 : (d0 > 128 ? 128 : d0); d1 = d1 < 0 ? 0 : (d1 > 128 ? 128 : d1); \
                        p0[r] = v0 ? p0[r] + tbl[d0] : NEG; p1[r] = v1 ? p1[r] + tbl[d1] : NEG; } \
                    SBAR(); } \
            } else if ((j) == 3) { if (hi == 1) p1[15] = NEG; }    \
            SBAR();
    {
        int buf = 0;
        dma_tile(dof, Kp, Vp, 0, F.lds + AL_BUF, wid);
#pragma unroll 1
        for (int j = 0; j < 4; ++j) {
            asm volatile("s_waitcnt vmcnt(0)" ::: "memory");
            __syncthreads();
            dma_tile(dof, Kp, Vp, ((j + 1) & 3) * 64, F.lds + AL_BUF + (buf ^ 1) * 32768, wid);
            CMP_SCORES(j)
            float pmax = p0[0];
#pragma unroll
            for (int r = 1; r < 16; ++r) pmax = fmaxf(pmax, p0[r]);
#pragma unroll
            for (int r = 0; r < 16; ++r) pmax = fmaxf(pmax, p1[r]);
            pmax = xhalf_max(pmax);
            const float mn = fmaxf(m_reg, pmax); float ps = 0.f;
#pragma unroll
            for (int r = 0; r < 16; ++r) ps += __builtin_amdgcn_exp2f(p0[r] - mn) + __builtin_amdgcn_exp2f(p1[r] - mn);
            ps = xhalf_sum(ps);
            l_reg = l_reg * __builtin_amdgcn_exp2f(m_reg - mn) + ps; m_reg = mn;
            buf ^= 1;
        }
    }
    const float inv_l = l_reg > 0.f ? 1.0f / l_reg : 0.f;
    float carry = 0.f; f32x16 o[4] = {};
    {
        int buf = 0;
#pragma unroll 1
        for (int j = 0; j < 4; ++j) {
            asm volatile("s_waitcnt vmcnt(0)" ::: "memory");
            __syncthreads();
            if (j < 3) dma_tile(dof, Kp, Vp, (j + 1) * 64, F.lds + AL_BUF + (buf ^ 1) * 32768, wid);
            CMP_SCORES(j)
            const int vb0 = (int)(uintptr_t)(lds + AL_BUF + buf * 32768) + vrb;
#pragma unroll
            for (int r = 0; r < 16; ++r) { p0[r] = __builtin_amdgcn_exp2f(p0[r] - m_reg) * inv_l; p1[r] = __builtin_amdgcn_exp2f(p1[r] - m_reg) * inv_l; }
            float oa[4], ob[4];
#pragma unroll
            for (int g = 0; g < 4; ++g) { auto ra = __builtin_amdgcn_permlane32_swap(__float_as_uint(p0[4 * g + 3]), __float_as_uint(p0[4 * g + 3]), false, false);
                auto rb = __builtin_amdgcn_permlane32_swap(__float_as_uint(p1[4 * g + 3]), __float_as_uint(p1[4 * g + 3]), false, false);
                oa[g] = __uint_as_float(hi ? ra[0] : ra[1]); ob[g] = __uint_as_float(hi ? rb[0] : rb[1]); }
            float* iw = impW + ((size_t)hd * 64 + 32 * qh + r32) * 64 + 16 * j + hi;
#pragma unroll
            for (int g = 0; g < 4; ++g) {
                const float pla = hi ? oa[g] : (g > 0 ? oa[g - 1] : carry);
                const float plb = hi ? ob[g] : (g > 0 ? ob[g - 1] : oa[3]);
                iw[2 * g] = ((p0[4 * g] + p0[4 * g + 1]) + (p0[4 * g + 2] + p0[4 * g + 3])) + pla;
                iw[8 + 2 * g] = ((p1[4 * g] + p1[4 * g + 1]) + (p1[4 * g + 2] + p1[4 * g + 3])) + plb; }
            carry = ob[3];
            bf16x8 pa0, pa1, pa2, pa3;
            pack_p(p0, p1, pa0, pa1, pa2, pa3); SBAR();
            pv_tile(o, vb0, pa0, pa1, pa2, pa3); SBAR();
            buf ^= 1;
        }
    }
#undef CMP_SCORES
    __syncthreads();
#pragma unroll 1
    for (int qq = 0; qq < 8; ++qq) { const int q = wid * 8 + qq, tq = q0 + q, cur = tq >> 6, m = lane;
        const bool forced = (m == 0) || (m == cur) || (m == cur - 1);
        const bool cand = !forced && (m < cur);
        float val = cand ? ((impW[(0 * 64 + q) * 64 + m] + impW[(1 * 64 + q) * 64 + m]) + (impW[(2 * 64 + q) * 64 + m] + impW[(3 * 64 + q) * 64 + m])) : -__builtin_inff();
        bool sel = forced;
        const int picks = 8 - __popcll(__ballot(forced));
        for (int p = 0; p < picks; ++p) { const float vm = wave_max(val); if (!(vm > -__builtin_inff())) break;
            const unsigned long long win = __ballot(val == vm); const int first = __builtin_ctzll(win);
            if (lane == first) { sel = true; val = -__builtin_inff(); } }
        const unsigned long long msk = __ballot(sel);
        if (lane == 0) WSP(unsigned long long, WS_BLK)[rowg + tq] = msk; }
    {
        const float gl = bf2f(GRP(G_MISC)[(rowg + t) * 128 + 68 + hd]);
        if (hi == 0) li_l[r32] = 1.0f / (1.0f + __expf(-gl));
        asm volatile("s_waitcnt lgkmcnt(0)" ::: "memory");
        float* OCp = WSP(float, WS_OC) + (rowg + tw) * 512 + hd * 128;
#pragma unroll
        for (int r = 0; r < 16; ++r) { const int orow = crow(r, hi); const float g0 = li_l[orow];
#pragma unroll
            for (int d0 = 0; d0 < 4; ++d0) OCp[(size_t)orow * 512 + d0 * 32 + r32] = o[d0][r] * g0; }
    }
    __syncthreads();
}
__device__ __forceinline__ void stick_unit(Frame& F, int b, int h, int qb) {
    using namespace att;
    char* lds = F.ldsg;
    int tid = F.tid; asm volatile("" : "+v"(tid));
    const int wid = F.wave, lane = tid & 63, r32 = lane & 31, hi = lane >> 5;
    const size_t rowg = (size_t)b * SEQ;
    const int tw = qb * 256 + wid * 32, t = tw + r32;
    const bf16* Qp = QKVG(h) + (rowg + t) * 128;
    const bf16* Kp = QKVG(8 + h) + rowg * 128;
    const bf16* Vp = QKVG(16 + h) + rowg * 128;
    char* Qw = lds + AL_Q + wid * 8192;
#pragma unroll
    for (int d0 = 0; d0 < 8; ++d0) { const bf16x8 v = *(const bf16x8*)(Qp + d0 * 16 + hi * 8); *(bf16x8*)(Qw + KSWZ(r32, (d0 * 16 + hi * 8) * 2)) = v; }
    asm volatile("s_waitcnt lgkmcnt(0)" ::: "memory");
    {
        bf16x8 trd0, trd1;
#pragma unroll
        for (int jj = 0; jj < 8; ++jj) { const int k0 = 8 * (jj >> 2) + 4 * hi + (jj & 3);
            trd0[jj] = (short)((k0 >= r32) ? 0x3F80 : 0); trd1[jj] = (short)((16 + k0 >= r32) ? 0x3F80 : 0); }
        if (wid == 0) { *(bf16x8*)(lds + AL_TRI + lane * 32) = trd0; *(bf16x8*)(lds + AL_TRI + lane * 32 + 16) = trd1; }
    }
    const bf16x8 ones = {(short)0x3F80, (short)0x3F80, (short)0x3F80, (short)0x3F80, (short)0x3F80, (short)0x3F80, (short)0x3F80, (short)0x3F80};
    f32x16 o[4] = {};
    float carry = 0.f;
    const int vrb = v_rd_base(lane);
    DmaOff dof; dma_offsets(dof, tid);
    int j = qb * 4 + 3, buf = 0;
    bool wdone = false; int par = 0;
    volatile LAS unsigned* fl = (volatile LAS unsigned*)(F.lds + AL_UNI + 64);
    dma_tile(dof, Kp, Vp, j * 64, F.lds + AL_BUF, wid);
    for (;;) {
        if (lane == 0) fl[par * 8 + wid] = wdone ? 1u : 0u;
        asm volatile("s_waitcnt vmcnt(0)" ::: "memory");
        __syncthreads();
        { unsigned a = 1u;
#pragma unroll
          for (int w = 0; w < 8; ++w) a &= fl[par * 8 + w];
          par ^= 1; if (a) break; }
        if (j > 0) dma_tile(dof, Kp, Vp, (j - 1) * 64, F.lds + AL_BUF + (buf ^ 1) * 32768, wid);
        const char* K_lds = lds + AL_BUF + buf * 32768 + 16384;
        const int vb0 = (int)(uintptr_t)(lds + AL_BUF + buf * 32768) + vrb;
        const int kb = j * 64;
        if (!wdone && kb < tw + 32) {
            f32x16 s0, s1;
            qkt_lq(s0, s1, K_lds, Qw, r32, hi);
            const int dq = t - kb - 4 * hi;
            const bool diag = (kb + 63 >= tw);
            bf16x8 cb0, cb1, cb2, cb3; float csum = 0.f;
#define ST_C(ZV, OFF, R) ({ const int c_ = ((R) & 3) + 8 * ((R) >> 2); float z_ = ZV[R]; \
                float a_ = -__builtin_amdgcn_logf(1.0f + __builtin_amdgcn_exp2f(fminf(z_, 126.f))); a_ = fminf(a_, -z_); \
                if (diag && (dq - c_ - (OFF) < 1)) { a_ = 0.f; z_ = -__builtin_inff(); } \
                csum += a_; ZV[R] = z_ + carry; a_; })
#define ST_PK(ZV, OFF, B_) ({ v4u w_; { const float e0 = ST_C(ZV, OFF, B_ + 0), e1 = ST_C(ZV, OFF, B_ + 1), e2 = ST_C(ZV, OFF, B_ + 2), e3 = ST_C(ZV, OFF, B_ + 3); w_.x = cvtpk(e0, e1); w_.y = cvtpk(e2, e3); } SBAR(); \
                { const float e4 = ST_C(ZV, OFF, B_ + 4), e5 = ST_C(ZV, OFF, B_ + 5), e6 = ST_C(ZV, OFF, B_ + 6), e7 = ST_C(ZV, OFF, B_ + 7); w_.z = cvtpk(e4, e5); w_.w = cvtpk(e6, e7); } __builtin_bit_cast(bf16x8, w_); })
            SBAR(); cb0 = ST_PK(s0, 0, 0); SBAR(); cb1 = ST_PK(s0, 0, 8); SBAR(); cb2 = ST_PK(s1, 32, 0); SBAR(); cb3 = ST_PK(s1, 32, 8); SBAR();
#undef ST_PK
#undef ST_C
            const bf16x8 trd0 = *(const bf16x8*)(lds + AL_TRI + lane * 32), trd1 = *(const bf16x8*)(lds + AL_TRI + lane * 32 + 16);
            s1 = __builtin_amdgcn_mfma_f32_32x32x16_bf16(trd0, cb2, s1, 0, 0, 0);
            s1 = __builtin_amdgcn_mfma_f32_32x32x16_bf16(trd1, cb3, s1, 0, 0, 0);
            s0 = __builtin_amdgcn_mfma_f32_32x32x16_bf16(trd0, cb0, s0, 0, 0, 0);
            s0 = __builtin_amdgcn_mfma_f32_32x32x16_bf16(trd1, cb1, s0, 0, 0, 0);
            s0 = __builtin_amdgcn_mfma_f32_32x32x16_bf16(ones, cb2, s0, 0, 0, 0);
            s0 = __builtin_amdgcn_mfma_f32_32x32x16_bf16(ones, cb3, s0, 0, 0, 0);
            carry += xhalf_sum(csum);
#pragma unroll
            for (int r = 0; r < 16; ++r) { s0[r] = __builtin_amdgcn_exp2f(s0[r]); s1[r] = __builtin_amdgcn_exp2f(s1[r]); }
            bf16x8 pa0, pa1, pa2, pa3;
            pack_p(s0, s1, pa0, pa1, pa2, pa3);
            pv_tile(o, vb0, pa0, pa1, pa2, pa3);
            if (__all(carry < -160.f)) wdone = true;
        }
        if (j == 0) wdone = true;
        j = j > 0 ? j - 1 : 0; buf ^= 1;
    }
    asm volatile("s_waitcnt vmcnt(0)" ::: "memory");
    bf16* Op = WSP(bf16, WS_O) + (rowg + tw) * DM + h * 128;
#pragma unroll
    for (int r = 0; r < 16; ++r) { const int orow = crow(r, hi);
#pragma unroll
        for (int d0 = 0; d0 < 4; ++d0) { const float v = o[d0][r]; const float vn = __shfl_xor(v, 1);
            if ((r32 & 1) == 0) *(unsigned*)(Op + (size_t)orow * DM + d0 * 32 + r32) = cvtpk(v, vn); } }
    __syncthreads();
}
__device__ __forceinline__ void router_phase(Frame& F) {
    const int lane = F.lane;
    const float* wr = FIN(I_OD_WR);
    int* list = WSP(int, WS_LIST); float* gwt = WSP(float, WS_GW);
    volatile LAS unsigned* lcnt = (volatile LAS unsigned*)(F.lds);
    volatile LAS unsigned* rec = (volatile LAS unsigned*)(F.lds + 256);
    const int nper = (M + F.G - 1) / F.G, m0 = (int)blockIdx.x * nper, m1 = (m0 + nper < M) ? m0 + nper : M;
    if (F.tid < 32) lcnt[F.tid] = 0u;
    __syncthreads();
    f32x4 wq[16][2];
#pragma unroll
    for (int i = 0; i < 16; ++i) { const int k = (i < 8 ? 0 : 512) + 8 * lane + (i & 7); wq[i][0] = *(const f32x4*)(wr + (size_t)k * 8); wq[i][1] = *(const f32x4*)(wr + (size_t)k * 8 + 4); }
    for (int m = m0 + F.wave; m < m1; m += NWAVES) {
        float v[16]; load_row_bf16(WSP(bf16, WS_XB3) + (size_t)m * DM, lane, v); rms16(v, FIN(I_OD_NFFN), lane);
        float lg[8];
#pragma unroll
        for (int e = 0; e < 8; ++e) lg[e] = 0.f;
#pragma unroll
        for (int i = 0; i < 16; ++i) { const f32x4 w0 = wq[i][0], w1 = wq[i][1]; const float x = v[i];
            lg[0] = fmaf(x, w0[0], lg[0]); lg[1] = fmaf(x, w0[1], lg[1]); lg[2] = fmaf(x, w0[2], lg[2]); lg[3] = fmaf(x, w0[3], lg[3]);
            lg[4] = fmaf(x, w1[0], lg[4]); lg[5] = fmaf(x, w1[1], lg[5]); lg[6] = fmaf(x, w1[2], lg[6]); lg[7] = fmaf(x, w1[3], lg[7]); }
#pragma unroll
        for (int e = 0; e < 8; ++e) lg[e] = wave_sum(lg[e]);
        int i0 = 0; float v0 = lg[0];
#pragma unroll
        for (int e = 1; e < 8; ++e) if (lg[e] > v0) { v0 = lg[e]; i0 = e; }
        int i1 = -1; float v1 = -__builtin_inff();
#pragma unroll
        for (int e = 0; e < 8; ++e) if (e != i0 && lg[e] > v1) { v1 = lg[e]; i1 = e; }
        const float e1 = __expf(v1 - v0), w0 = 1.0f / (1.0f + e1), w1 = e1 * w0;
        if (lane == 0) {
            const unsigned s0 = __hip_atomic_fetch_add((LAS unsigned*)F.lds + i0, 1u, __ATOMIC_RELAXED, __HIP_MEMORY_SCOPE_WORKGROUP);
            const unsigned s1 = __hip_atomic_fetch_add((LAS unsigned*)F.lds + 8 + i1, 1u, __ATOMIC_RELAXED, __HIP_MEMORY_SCOPE_WORKGROUP);
            rec[2 * (m - m0)] = (unsigned)i0 | (s0 << 8); rec[2 * (m - m0) + 1] = (unsigned)i1 | (s1 << 8);
            gwt[m] = w0; gwt[M + m] = w1;
        }
    }
    __syncthreads();
    if (F.tid < 16) lcnt[16 + F.tid] = atomicAdd((unsigned*)(F.ctl + CW_CNT) + F.tid, lcnt[F.tid]);
    __syncthreads();
    for (int i = F.tid; i < m1 - m0; i += NTHR) { const unsigned r0 = rec[2 * i], r1 = rec[2 * i + 1]; const int i0 = r0 & 255, i1 = r1 & 255;
        list[(size_t)i0 * M + lcnt[16 + i0] + (r0 >> 8)] = m0 + i; list[(size_t)(8 + i1) * M + lcnt[24 + i1] + (r1 >> 8)] = m0 + i; }
    __syncthreads();
}
struct MoeLayout { int off[17]; };
__device__ __forceinline__ void moe_layout(Frame& F, MoeLayout& L) {
    int o = 0;
#pragma unroll
    for (int l = 0; l < 16; ++l) { L.off[l] = o; const int c = (int)__hip_atomic_load(F.ctl + CW_CNT + l, RLX_AGENT); o += (c + 255) & ~255; }
    L.off[16] = o;
}
__device__ __forceinline__ void gather_phase(Frame& F) {
    const int gw = F.vcu * NWAVES + F.wave, NGW = F.G * NWAVES, lane = F.lane;
    MoeLayout L; moe_layout(F, L);
    const int* list = WSP(int, WS_LIST); int* inv = WSP(int, WS_INV); float* gws = WSP(float, WS_GWS); const float* gwt = WSP(float, WS_GW);
    bf16* XS = WSP(bf16, WS_XS);
    for (int s = gw; s < L.off[16]; s += NGW) {
        int l = 0, offl = 0;
#pragma unroll
        for (int q = 1; q < 16; ++q) if (s >= L.off[q]) { l = q; offl = L.off[q]; }
        const int idx = s - offl; const int c = (int)__hip_atomic_load(F.ctl + CW_CNT + l, RLX_AGENT);
        const int t = idx < c ? list[(size_t)l * M + idx] : -1;
        float v[16];
        if (t >= 0) { load_row_bf16(WSP(bf16, WS_XB3) + (size_t)t * DM, lane, v); rms16(v, FIN(I_OD_NFFN), lane); }
        else {
#pragma unroll
            for (int i = 0; i < 16; ++i) v[i] = 0.f; }
        store_row16_bf16(XS + (size_t)s * DM, lane, v);
        if (lane == 0) { const int k = l >> 3; gws[s] = t >= 0 ? gwt[(size_t)k * M + t] : 0.f; if (t >= 0) inv[(size_t)k * M + t] = s; }
    }
}
struct MoeSched {
    pg8::GridOrder o; int t0; const char* A; size_t tstepA; const char* W; size_t tstepB; int off[17]; bool a_local; const char* A2;
    __device__ __forceinline__ bool next(int i, pg8::Unit& u) const {
        int pm, pn; if (!o.at(i, pm, pn)) return false; pm += t0; u.pm = pm; u.pn = pn;
        int l = 0;
#pragma unroll
        for (int q = 1; q < 16; ++q) if (pm * 256 >= off[q]) l = q;
        const int lt = pm - t0;
        u.aux = l; u.A = !a_local ? A + (size_t)pm * tstepA : (lt >= HM_SPLIT ? A2 + (size_t)(lt - HM_SPLIT) * tstepA : A + (size_t)lt * tstepA); u.B = W + (size_t)(l & 7) * MW_E + (size_t)pn * tstepB; return true;
    }
};

struct MoeSplitSched {
    pg8::GridOrder o; int t0; const char* A; size_t tstepA; const char* W; size_t tstepB; int off[17];
    __device__ __forceinline__ bool next(int i, pg8::Unit& u) const {
        int pm, pn; if (!o.at(i, pm, pn)) return false; pm += t0; u.pm = pm; u.pn = pn;
        int l = 0;
#pragma unroll
        for (int q = 1; q < 16; ++q) if (pm * 256 >= off[q]) l = q;
        u.aux = l; const size_t ko = (size_t)(pn >> 2) * (EFF / MOE_SPLITS) * 2;
        u.A = A + (size_t)(pm - t0) * tstepA + ko; u.B = W + (size_t)(l & 7) * MW_E + (size_t)(pn & 3) * tstepB + ko; return true;
    }
};

constexpr int N_PHASES = 27;
struct Args { const float* in[N_IN]; float* out; unsigned char* ws; int ph_lo, ph_hi; unsigned rep_mask, pad; };
__global__ void __launch_bounds__(NTHR, 2) fwd(Args args) {
    extern __shared__ __attribute__((aligned(16))) unsigned char lds[];
    Frame F;
    F.lds = (LAS unsigned char*)lds; F.ldsg = (char*)lds;
    F.MISC = (volatile LAS unsigned*)(F.lds + MISC_OFF);
    F.tid = threadIdx.x; F.lane = F.tid & 63; F.wave = __builtin_amdgcn_readfirstlane(F.tid >> 6);
    F.G = gridDim.x; { const int bx = blockIdx.x; F.vcu = (F.G % 8 == 0) ? (bx % 8) * (F.G / 8) + bx / 8 : bx; }
    F.ws = args.ws; F.ctl = (gu32*)(args.ws + WS_CTL); F.out = args.out;
    F.kap = (const __attribute__((address_space(4))) char*)__builtin_amdgcn_kernarg_segment_ptr();
    static_assert(offsetof(Args, in) == 0, "FIN() reads the input pointers at the start of the kernarg segment");
    for (int u = F.tid; u < 64; u += NTHR) ((LAS unsigned*)(F.lds + MISC_OFF))[u] = 0u;
    __syncthreads();
    const int lo = args.ph_lo, hi = args.ph_hi;
    const bool multi = (hi - lo) > 1;
    XcdBarrier bar; bar.bar = (unsigned*)(F.ctl + CW_BAR); bar.x = 0; bar.st = nullptr;
    if (multi) bar = xcd_barrier_post((unsigned*)(F.ctl + CW_BAR), F.MISC + 8);
#ifdef PHASE_ONLY
#define IN(k) ((k) == PHASE_ONLY && lo <= (k) && (k) < hi)
#else
#define IN(k) (lo <= (k) && (k) < hi)
#endif
#ifndef PROBE_BUILD
#define PROBE_BUILD 0
#endif
#if PROBE_BUILD
    const unsigned repmask = args.rep_mask;
#define REPLOOP(k) _Pragma("unroll 1") for (int rep_ = 0, nrep_ = 1 + (int)((repmask >> (k)) & 1u); rep_ < nrep_; ++rep_)
#else
    const unsigned repmask = 0u;
#define REPLOOP(k)
#endif
#define SEAM(k) do { if (IN(k) && IN((k) + 1)) xcd_barrier(bar); PHASE_FENCE(); } while (0)
    const int gwv = F.vcu * NWAVES + F.wave, NGW = F.G * NWAVES;
    const int bx = blockIdx.x;

    REPLOOP(0) {
    if (IN(0)) {
        LAS float* scr = (LAS float*)(F.lds + F.wave * 16384);
        int ibase = 0;
#define XPOSE_MAT(fn, destrows, K, WT, kgain) do { const int _n = ((destrows) / 32) * ((K) / 64); const int _s = (gwv + NGW - (ibase % NGW)) % NGW; \
            xpose_matrix(fn, K, WT, kgain, scr, _s, _n, NGW, F.lane); ibase += _n; } while (0)
        { FnIn f{FIN(I_EV_WIN)}; XPOSE_MAT(f, NPROJ, 1024, WSP(bf16, WS_WIN), (const float*)nullptr); }
        { FnPlain f{FIN(I_EV_WUK), 128, 0}; XPOSE_MAT(f, 128, 256, WSP(bf16, WS_WUKV), FIN(I_EV_KVN)); }
        { FnPlain f{FIN(I_EV_WUV), 128, 0}; XPOSE_MAT(f, 128, 256, WSP(bf16, WS_WUKV) + 128 * 256, FIN(I_EV_KVN)); }
#pragma unroll 1
        for (int j = 0; j < 2; ++j) { const float* W1 = FIN(I_EV_CW1) + (size_t)j * 4096 * 128; bf16* d = WSP(bf16, WS_WC1) + (size_t)j * 256 * 2048;
            { FnPlain f{W1, 128, 0}; XPOSE_MAT(f, 128, 2048, d, (const float*)nullptr); }
            { FnPlain f{W1 + (size_t)2048 * 128, 128, 0}; XPOSE_MAT(f, 128, 2048, d + (size_t)128 * 2048, (const float*)nullptr); } }
        { FnPlain f{FIN(I_EV_WOUT), 1024, 0}; XPOSE_MAT(f, 1024, 1024, WSP(bf16, WS_WOUT0), (const float*)nullptr); }
        { FnGU f{FIN(I_EV_WG), FIN(I_EV_WU), DFF}; XPOSE_MAT(f, 2 * DFF, 1024, WSP(bf16, WS_WGU0), FIN(I_EV_NFFN)); }
        { FnPlain f{FIN(I_EV_WD), 1024, 0}; XPOSE_MAT(f, 1024, DFF, WSP(bf16, WS_WDN0), (const float*)nullptr); }
        { FnPlain f{FIN(I_OD_WQKV), 3072, 0}; XPOSE_MAT(f, 3072, 1024, WSP(bf16, WS_WQKV), FIN(I_OD_NMIX)); }
        { FnPlain f{FIN(I_OD_WOUT), 1024, 0}; XPOSE_MAT(f, 1024, 1024, WSP(bf16, WS_WOUT1), (const float*)nullptr); }
        norm_phase(F, FIN(I_X), nullptr, FIN(I_EV_NMIX));
        for (int oi = gwv; oi < 32; oi += NGW) { const int j = oi >> 4, part = oi & 15; const float* pos = FIN(I_EV_CPOS) + (size_t)j * 4096 + part * 256; const float* W1 = FIN(I_EV_CW1) + ((size_t)j * 4096 + part * 256) * 128;
            float s0 = 0.f, s1 = 0.f;
#pragma unroll 8
            for (int i = 0; i < 256; ++i) { const float pv_ = pos[i]; s0 = fmaf(pv_, W1[(size_t)i * 128 + F.lane], s0); s1 = fmaf(pv_, W1[(size_t)i * 128 + 64 + F.lane], s1); }
            WSP(float, WS_TAB)[(size_t)oi * 128 + F.lane] = s0; WSP(float, WS_TAB)[(size_t)oi * 128 + 64 + F.lane] = s1; }
    }
    }
    SEAM(0);
    REPLOOP(1) {
    if (IN(1)) {
        pg8::PlainSched S; S.init(M, NPROJ, F.G, bx, WSP(bf16, WS_XN), 2048, WSP(bf16, WS_WIN), 2048);
        pg8::EpiGroups E{WSP(bf16, WS_PROJ), GS, 0x0F0Fu, QSCALE, G_PAD, nullptr};
        pg8::gemm_phase<pg8::EpiGroups, pg8::PlainSched>(F.lds, pg8::GemmK{1024, 2048u, 2048u, 30, 0u}, S, E);
    }
    }
    SEAM(1);
    REPLOOP(2) {
    if (IN(2)) {
        if (bx < 128) {
            LAS float* rstd = (LAS float*)(F.lds + MISC_OFF + 1024);
            { const int r = F.tid >> 1, g = F.tid & 1; const bf16* p = GRP(G_LAT + g) + ((size_t)bx * 256 + r) * 128; float s = 0.f;
#pragma unroll
              for (int i = 0; i < 16; ++i) { const v4u w = *(const v4u*)(p + i * 8);
#pragma unroll
                  for (int q = 0; q < 4; ++q) { const float a = __builtin_bit_cast(float, w[q] << 16), c = __builtin_bit_cast(float, w[q] & 0xffff0000u); s += a * a + c * c; } }
              s += __shfl_xor(s, 1);
              if (g == 0) rstd[r] = 1.0f / sqrtf(s * (1.f / 256.f) + RMS_EPS); }
            __syncthreads();
            pg8::OneSched S;
            S.u.pm = bx; S.u.pn = 0; S.u.aux = 0; S.u.A = (const char*)(GRP(G_LAT) + (size_t)bx * 256 * 128); S.u.B = (const char*)WSP(bf16, WS_WUKV);
            pg8::EpiAkv E{WSP(bf16, WS_AK), WSP(bf16, WS_AV), rstd};
            pg8::gemm_phase<pg8::EpiAkv, pg8::OneSched>(F.lds, pg8::GemmK{256, 256u, 512u, 1, (unsigned)(GS * 2)}, S, E);
        } else if (bx < 160) {
            const int u = bx - 128, j = u >> 4, pm = (u >> 1) & 7, kh = u & 1;
            pg8::OneSched S;
            S.u.pm = pm; S.u.pn = 0; S.u.aux = 0; S.u.A = (const char*)(GRP(j == 0 ? G_CKR : G_CVR) + (size_t)pm * 256 * 2048 + (size_t)kh * 1024); S.u.B = (const char*)(WSP(bf16, WS_WC1) + (size_t)j * 256 * 2048 + (size_t)kh * 1024);
            pg8::EpiF32 E{nullptr, (kh ? WSP(float, WS_UVB) : WSP(float, WS_UV)) + (size_t)j * 2048 * 256, 256, 1.f};
            pg8::gemm_phase<pg8::EpiF32, pg8::OneSched>(F.lds, pg8::GemmK{1024, 4096u, 4096u, 30, 0u}, S, E);
        }
    }
    }
    SEAM(2);
    REPLOOP(3) {
    if (IN(3)) {
        for (int it = bx; it < 256; it += F.G) cmp_finalize_item(F, it >> 5, (it >> 4) & 1, it & 15);
        for (int r = 0; r < 4096 / 256 + 1; ++r) { const int cc = (r & 1) ? (F.G - 1 - bx) : bx; const int ui = r * F.G + cc; if (ui >= 4096) break;
            const int tq = 511 - (ui >> 3), b = ui & 7; idx_unit(F, b, tq, repmask >> 24); }
    }
    }
    SEAM(3);
    PHASE_FENCE();
    REPLOOP(5) {
    if (IN(5)) {
        fill_bias_tbl(F, (float*)(F.ldsg + AL_TBL), 0); __syncthreads();
#pragma unroll 1
        for (int p2 = 2 * bx; p2 < 512; p2 += 2 * F.G) {
#pragma unroll 1
            for (int u = 0; u < 2; ++u) { const int p = p2 >> 1, b = p >> 5, q = p & 31; attn_unit<0>(F, b, u ? q : 63 - q); } }
        __syncthreads();
        fill_bias_tbl(F, (float*)(F.ldsg + AL_TBL), 4); fill_bias_tbl132(F, (float*)(F.ldsg + AL_TBL132), 4); __syncthreads();
#pragma unroll 1
        for (int p2 = 2 * bx; p2 < 512; p2 += 2 * F.G) {
#pragma unroll 1
            for (int u = 0; u < 2; ++u) { const int p = p2 >> 1, b = p >> 5, q = p & 31, qt = u ? q : 63 - q;
                cmp_unit64(F, b, qt); asm volatile("s_waitcnt vmcnt(0)" ::: "memory"); __syncthreads();
                attn_unit<1>(F, b, qt); attn_unit<2>(F, b, qt); } }
    }
    }
    SEAM(5);
    REPLOOP(6) {
    if (IN(6)) {
        pg8::PlainSched S; S.init(M, DM, F.G, bx, WSP(bf16, WS_O), 2048, WSP(bf16, WS_WOUT0), 2048);
        pg8::EpiRes E{FIN(I_X), nullptr, WSP(bf16, WS_XB), WSP(float, WS_RS0), 1.f};
        pg8::gemm_phase<pg8::EpiRes, pg8::PlainSched>(F.lds, pg8::GemmK{1024, 2048u, 2048u, 30, 0u}, S, E);
    }
    }
    if (IN(6) && IN(8)) xcd_barrier(bar); PHASE_FENCE();
    REPLOOP(8) {
    if (IN(8)) {
        pg8::PlainSched S; S.init(M, 2 * DFF, F.G, bx, WSP(bf16, WS_XB), 2048, WSP(bf16, WS_WGU0), 2048);
        pg8::EpiSwiglu E{WSP(bf16, WS_H0), DFF, 0, WSP(float, WS_RS0), nullptr, 0};
        pg8::gemm_phase<pg8::EpiSwiglu, pg8::PlainSched>(F.lds, pg8::GemmK{1024, 2048u, 2048u, 30, 0u}, S, E);
    }
    }
    SEAM(8);
    if (IN(9)) {
        pg8::PlainSched S; S.init(M, DM, F.G, bx, WSP(bf16, WS_H0), DFF * 2, WSP(bf16, WS_WDN0), DFF * 2);
        pg8::EpiRes E{nullptr, WSP(bf16, WS_XB), WSP(bf16, WS_XB), WSP(float, WS_RS1), ((repmask >> 10) & 1u) ? 0.5f : 1.f};
        REPLOOP(10) pg8::gemm_phase<pg8::EpiRes, pg8::PlainSched>(F.lds, pg8::GemmK{DFF, DFF * 2u, DFF * 2u, 30, 0u}, S, E);
    }
    if (IN(9) && IN(11)) xcd_barrier(bar); PHASE_FENCE();
    REPLOOP(11) {
    if (IN(11)) {
        pg8::PlainSched S; S.init(M, 3072, F.G, bx, WSP(bf16, WS_XB), 2048, WSP(bf16, WS_WQKV), 2048);
        pg8::EpiGroups E{WSP(bf16, WS_QKV), GS, 0xFFu, QSCALE, 1000, WSP(float, WS_RS1)};
        pg8::gemm_phase<pg8::EpiGroups, pg8::PlainSched>(F.lds, pg8::GemmK{1024, 2048u, 2048u, 30, 0u}, S, E);
    }
    }
    SEAM(11);
    REPLOOP(12) {
    if (IN(12)) {
        for (int ui = bx; ui < 1024; ui += F.G) { const int qb = 15 - (ui >> 6), bh = ui & 63; stick_unit(F, bh >> 3, bh & 7, qb); }
    }
    }
    SEAM(12);
    if (IN(13)) {
        pg8::PlainSched S; S.init(M, DM, F.G, bx, WSP(bf16, WS_O), 2048, WSP(bf16, WS_WOUT1), 2048);
        pg8::EpiRes E{nullptr, WSP(bf16, WS_XB), WSP(bf16, WS_XB3), WSP(float, WS_RS0), 1.f};
        REPLOOP(14) pg8::gemm_phase<pg8::EpiRes, pg8::PlainSched>(F.lds, pg8::GemmK{1024, 2048u, 2048u, 30, 0u}, S, E);
        LAS float* scr = (LAS float*)(F.lds + F.wave * 16384);
        REPLOOP(13) {
        int ibase = 0;
#pragma unroll 1
        for (int e = 0; e < NEXP; ++e) {
            { FnGU f{FIN(I_OD_WG) + (size_t)e * 1024 * EFF, FIN(I_OD_WU) + (size_t)e * 1024 * EFF, EFF}; XPOSE_MAT(f, 2 * EFF, 1024, (bf16*)(F.ws + WS_MW + (size_t)e * MW_E), (const float*)nullptr); }
            { FnPlain f{FIN(I_OD_WD) + (size_t)e * EFF * 1024, 1024, 0}; XPOSE_MAT(f, 1024, EFF, (bf16*)(F.ws + WS_MW + (size_t)e * MW_E + MW_DN), (const float*)nullptr); }
        }
        }
    }
    SEAM(13);
    if (IN(14)) router_phase(F);
    SEAM(14);
    REPLOOP(15) { if (IN(15)) gather_phase(F); }
    SEAM(15);
#pragma unroll 1
    for (int ch = 0; ch < 3; ++ch) {
        const int t0 = ch * HM_TILES, ph = 16 + 2 * ch;
        MoeLayout L; moe_layout(F, L);
        const int ntile = L.off[16] >> 8;
        const int nt = (ntile - t0) < HM_TILES ? (ntile - t0) : HM_TILES;
        if (IN(ph) && nt > 0) {
            MoeSched S; S.o.init(nt, 2 * EFF / 256, F.G, bx); S.t0 = t0; S.A = (const char*)WSP(bf16, WS_XS); S.tstepA = 256 * 2048; S.W = (const char*)(F.ws + WS_MW); S.tstepB = 256 * 2048; S.a_local = false; S.A2 = nullptr;
#pragma unroll
            for (int q = 0; q < 17; ++q) S.off[q] = L.off[q];
            pg8::EpiSwiglu E{WSP(bf16, WS_HM), EFF, t0, nullptr, (bf16*)F.out, HM_SPLIT};
            REPLOOP(16) pg8::gemm_phase<pg8::EpiSwiglu, MoeSched>(F.lds, pg8::GemmK{1024, 2048u, 2048u, 30, 0u}, S, E);
        }
        SEAM(ph);
        const bool split = ch == 2 && nt > 0 && nt <= MOE_SPLIT_TILES;
        if (IN(ph + 1) && split) {
            MoeSplitSched S; S.o.init(nt, 4 * MOE_SPLITS, F.G, bx); S.t0 = t0; S.A = (const char*)WSP(bf16, WS_HM); S.tstepA = (size_t)256 * EFF * 2; S.W = (const char*)(F.ws + WS_MW + MW_DN); S.tstepB = (size_t)256 * EFF * 2;
#pragma unroll
            for (int q = 0; q < 17; ++q) S.off[q] = L.off[q];
            pg8::EpiMoeYp E{WSP(bf16, WS_YP), WSP(float, WS_GWS), t0, (size_t)MOE_SPLIT_TILES * 256 * DM};
            pg8::gemm_phase<pg8::EpiMoeYp, MoeSplitSched>(F.lds, pg8::GemmK{EFF / MOE_SPLITS, EFF * 2u, EFF * 2u, 30, 0u}, S, E);
        }
        if (IN(ph + 1) && nt > 0 && !split) {
            MoeSched S; S.o.init(nt, DM / 256, F.G, bx); S.t0 = t0; S.A = (const char*)WSP(bf16, WS_HM); S.tstepA = (size_t)256 * EFF * 2; S.W = (const char*)(F.ws + WS_MW + MW_DN); S.tstepB = (size_t)256 * EFF * 2; S.a_local = true; S.A2 = (const char*)F.out;
#pragma unroll
            for (int q = 0; q < 17; ++q) S.off[q] = L.off[q];
            pg8::EpiMoeY E{WSP(bf16, WS_XS), WSP(float, WS_GWS)};
            REPLOOP(17) pg8::gemm_phase<pg8::EpiMoeY, MoeSched>(F.lds, pg8::GemmK{EFF, EFF * 2u, EFF * 2u, 30, 0u}, S, E);
        }
        SEAM(ph + 1);
    }
    REPLOOP(18)
    if (IN(26)) {
        const bf16* XS0 = WSP(bf16, WS_XS); const int* inv = WSP(int, WS_INV);
        MoeLayout L; moe_layout(F, L);
        const int ntl = (L.off[16] >> 8) - 2 * HM_TILES; const int srow = (ntl > 0 && ntl <= MOE_SPLIT_TILES) ? 2 * HM_TILES * 256 : 0x7fffffff;
#define FIN_ROW(m_, v_) do { load_row_bf16(WSP(bf16, WS_XB3) + (size_t)(m_) * DM, F.lane, v_); \
            _Pragma("unroll 1") for (int k = 0; k < 2; ++k) { const int s = inv[(size_t)k * M + (m_)]; float y[16]; \
                if (s < srow) { load_row_bf16(XS0 + (size_t)s * DM, F.lane, y); _Pragma("unroll") for (int i = 0; i < 16; ++i) v_[i] += y[i]; } \
                else { _Pragma("unroll 1") for (int sp = 0; sp < MOE_SPLITS; ++sp) { load_row_bf16(WSP(bf16, WS_YP) + ((size_t)sp * MOE_SPLIT_TILES * 256 + (s - srow)) * DM, F.lane, y); \
                        _Pragma("unroll") for (int i = 0; i < 16; ++i) v_[i] += y[i]; } } } } while (0)
#define FIN_OUT(m_, v_) do { rms16(v_, FIN(I_FNORM), F.lane); GAS f32x4* o = (GAS f32x4*)(F.out + (size_t)(m_) * DM); \
            o[2 * F.lane] = (f32x4){v_[0], v_[1], v_[2], v_[3]}; o[2 * F.lane + 1] = (f32x4){v_[4], v_[5], v_[6], v_[7]}; \
            o[128 + 2 * F.lane] = (f32x4){v_[8], v_[9], v_[10], v_[11]}; o[128 + 2 * F.lane + 1] = (f32x4){v_[12], v_[13], v_[14], v_[15]}; } while (0)
        for (int m = gwv; m < M; m += 2 * NGW) { float va[16], vb[16]; const int mb = m + NGW;
            FIN_ROW(m, va); if (mb < M) FIN_ROW(mb, vb);
            FIN_OUT(m, va); if (mb < M) FIN_OUT(mb, vb); }
#undef FIN_ROW
#undef FIN_OUT
    }
#undef IN
#undef SEAM
#undef XPOSE_MAT
}

#ifndef PROBE_REP
#define PROBE_REP 0u
#endif
#ifndef MK_FUSED
#define MK_FUSED 1
#endif
extern "C" void kernel_launch(void* const* d_in, const int* in_sizes, int n_in, void* d_out, int out_size, void* d_ws, size_t ws_size, hipStream_t stream) {
    static int grid = 0;
    if (grid == 0) {
        if (n_in != N_IN || in_sizes[0] != M * DM || out_size != M * DM || ws_size < WS_END) {
            fprintf(stderr, "kernel_launch: built for %d inputs, x/out of %d floats, >= %zu bytes of workspace; got n_in %d, in0 %d, out %d, ws %zu; nothing launched\n", N_IN, M * DM, (size_t)WS_END, n_in, n_in > 0 ? in_sizes[0] : -1, out_size, ws_size);
            grid = -1; return; }
        int dev = 0, cus = 0, per_cu = 0;
        if (hipGetDevice(&dev) != hipSuccess || hipDeviceGetAttribute(&cus, hipDeviceAttributeMultiprocessorCount, dev) != hipSuccess) { fprintf(stderr, "kernel_launch: device query failed\n"); grid = -1; return; }
        if (hipFuncSetAttribute((const void*)fwd, hipFuncAttributeMaxDynamicSharedMemorySize, LDS_BYTES) != hipSuccess) { fprintf(stderr, "kernel_launch: hipFuncSetAttribute failed\n"); grid = -1; return; }
        if (hipOccupancyMaxActiveBlocksPerMultiprocessor(&per_cu, (const void*)fwd, NTHR, LDS_BYTES) != hipSuccess || per_cu < 1)
            fprintf(stderr, "kernel_launch: note: occupancy query reports %d workgroups per CU\n", per_cu);
        (void)hipGetLastError();
        grid = cus;
    }
    if (grid < 0) return;
    if (hipMemsetAsync((char*)d_ws + WS_CTL, 0, CTL_ZERO_BYTES, stream) != hipSuccess) { fprintf(stderr, "kernel_launch: memset failed\n"); return; }
    Args a{};
    for (int i = 0; i < N_IN; ++i) a.in[i] = (const float*)d_in[i];
    a.out = (float*)d_out; a.ws = (unsigned char*)d_ws; a.rep_mask = PROBE_REP; a.pad = 0u;
#if MK_FUSED
    a.ph_lo = 0; a.ph_hi = N_PHASES;
    hipLaunchKernelGGL(fwd, dim3(grid), dim3(NTHR), LDS_BYTES, stream, a);
#else
    for (int p = 0; p < N_PHASES; ++p) { a.ph_lo = p; a.ph_hi = p + 1; hipLaunchKernelGGL(fwd, dim3(grid), dim3(NTHR), LDS_BYTES, stream, a); }
#endif
    const hipError_t le = hipPeekAtLastError();
    if (le != hipSuccess) fprintf(stderr, "kernel_launch: launch failed: %s\n", hipGetErrorName(le));
}
```

```cpp
#include <hip/hip_runtime.h>
#include <cstdio>
#include <cstdint>

#define GAS __attribute__((address_space(1)))
#define LAS __attribute__((address_space(3)))
typedef unsigned short bf16;
typedef unsigned v4u __attribute__((ext_vector_type(4)));
typedef unsigned v2u __attribute__((ext_vector_type(2)));
typedef float f32x2 __attribute__((ext_vector_type(2)));
typedef float f32x4 __attribute__((ext_vector_type(4)));
typedef float f32x16 __attribute__((ext_vector_type(16)));
typedef short bf16x8 __attribute__((ext_vector_type(8)));
typedef short s16x4 __attribute__((ext_vector_type(4)));
typedef GAS unsigned gu32;
#define RLX_AGENT __ATOMIC_RELAXED, __HIP_MEMORY_SCOPE_AGENT
#define LDS_WAIT() asm volatile("s_waitcnt lgkmcnt(0)" ::: "memory")
#define VM_WAIT() asm volatile("s_waitcnt vmcnt(0)" ::: "memory")
#define SBAR() __builtin_amdgcn_sched_barrier(0)

constexpr int BATCH = 8, SEQ = 4096, DM = 1024, M = BATCH * SEQ, HD = 128;
constexpr int NPROJ = 2560;
constexpr int DFF = 2816, NEXP = 8, EFF = 3584;
constexpr float RMS_EPS = 1e-6f;
constexpr float LOG2E = 1.4426950408889634f;
constexpr float QSCALE = 0.08838834764831845f * LOG2E;
enum { I_X = 0, I_RELB, I_EV_NMIX, I_EV_WIN, I_EV_KVN, I_EV_WUK, I_EV_WUV, I_EV_CPOS, I_EV_CW1, I_EV_CW2, I_EV_WOUT, I_EV_NFFN, I_EV_WG, I_EV_WU, I_EV_WD,
       I_OD_NMIX, I_OD_WQKV, I_OD_WOUT, I_OD_NFFN, I_OD_WR, I_OD_WG, I_OD_WU, I_OD_WD, I_FNORM, N_IN };

enum { G_QA = 0  , G_LAT = 4  , G_IQ = 6  , G_QB = 8  , G_CKR = 12, G_CVR = 13, G_SK = 14, G_SV = 15, G_WK = 16, G_WV = 17, G_MISC = 18, G_PAD = 19 };
constexpr size_t GS = (size_t)M * 128;

constexpr size_t MiB = 1u << 20;
constexpr size_t WS_CTL = 0, CTL_ZERO_BYTES = 1 * MiB;
constexpr size_t WS_TAB = 1 * MiB;
constexpr size_t WS_WIN = 2 * MiB;
constexpr size_t WS_WUKV = 7 * MiB;
constexpr size_t WS_WC1 = 7 * MiB + 256 * 1024;
constexpr size_t WS_WOUT0 = 10 * MiB;
constexpr size_t WS_WGU0 = 12 * MiB;
constexpr size_t WS_WDN0 = 23 * MiB;
constexpr size_t WS_WQKV = 29 * MiB;
constexpr size_t WS_WOUT1 = 35 * MiB;
constexpr size_t WS_XN = 40 * MiB;
constexpr size_t WS_PROJ = 104 * MiB;
constexpr size_t WS_AK = 264 * MiB, WS_AV = 272 * MiB;
constexpr size_t WS_BM = 280 * MiB;
constexpr size_t WS_UV = 296 * MiB;
constexpr size_t WS_UVB = 432 * MiB;
constexpr size_t WS_CK = 300 * MiB;
constexpr size_t WS_CVT = 300 * MiB + 512 * 1024;
constexpr size_t WS_CV = 300 * MiB + 512 * 1024;
constexpr size_t WS_BLK = 301 * MiB;
constexpr size_t WS_RS0 = 302 * MiB;
constexpr size_t WS_RS1 = 296 * MiB;
constexpr size_t WS_OC = 304 * MiB;
constexpr size_t WS_O = 368 * MiB;
constexpr size_t WS_OC2 = 432 * MiB;
constexpr size_t WS_XB = 432 * MiB;
constexpr size_t WS_XB3 = 40 * MiB;
constexpr size_t WS_H0 = 104 * MiB;
constexpr size_t WS_QKV = 104 * MiB;
constexpr size_t WS_MW = 104 * MiB;
constexpr size_t MW_E = 21 * MiB, MW_DN = 14 * MiB;
constexpr size_t WS_LIST = 272 * MiB;
constexpr size_t WS_GW = WS_LIST + 2 * MiB;
constexpr size_t WS_TOK = WS_GW + 256 * 1024;
constexpr size_t WS_INV = WS_TOK + 512 * 1024;
constexpr size_t WS_GWS = WS_INV + 256 * 1024;
constexpr int XS_ROWS = M + 8 * 256;
constexpr size_t WS_XS = 276 * MiB;
constexpr int HM_TILES = 128, HM_SPLIT = 64;
constexpr int MOE_SPLITS = 4, MOE_SPLIT_TILES = 16;
constexpr size_t WS_YP = 2 * MiB;
constexpr size_t WS_HM = 412 * MiB;
constexpr size_t WS_END = 524 * MiB;
static_assert(WS_WIN + (size_t)NPROJ * DM * 2 <= WS_WUKV && WS_WC1 + 2ull * 256 * 2048 * 2 <= WS_WOUT0 && WS_WGU0 + 5632ull * 1024 * 2 <= WS_WDN0 && WS_WDN0 + 1024ull * 2816 * 2 <= WS_WQKV && WS_WQKV + 3072ull * 1024 * 2 <= WS_WOUT1 && WS_WOUT1 + 2 * MiB <= WS_XN, "weights map");
static_assert(WS_XN + (size_t)M * DM * 2 <= WS_PROJ && WS_PROJ + 20 * GS * 2 <= WS_AK && WS_BM + (size_t)M * 128 * 4 <= WS_UV && WS_UV + 4 * MiB <= WS_CK && WS_BLK + (size_t)M * 8 <= WS_OC && WS_OC + (size_t)M * 512 * 4 <= WS_O && WS_O + (size_t)M * DM * 2 <= 432 * MiB, "even map");
static_assert(WS_YP + (size_t)MOE_SPLITS * MOE_SPLIT_TILES * 256 * DM * 2 <= WS_XB3, "split partials fit under the residual stream copy");
static_assert(WS_H0 + (size_t)M * DFF * 2 <= WS_OC && WS_QKV + 24 * GS * 2 <= WS_O && WS_MW + 8 * MW_E <= WS_LIST && WS_GWS + 2ull * XS_ROWS * 4 <= WS_XS && WS_XS + 2ull * XS_ROWS * DM * 2 <= WS_HM && WS_HM + (size_t)HM_SPLIT * 256 * EFF * 2 <= WS_END && (size_t)(HM_TILES - HM_SPLIT) * 256 * EFF * 2 <= (size_t)M * DM * 4, "late map");
constexpr int CW_TMO = 0, CW_CODE = 1;
constexpr int CW_BAR = 4096;
constexpr int CW_CNT = 16384;

constexpr int RING_BYTES = 131072;
constexpr int MISC_OFF = RING_BYTES;
constexpr int LDS_BYTES = 147456;
constexpr int NWAVES = 8, NTHR = 512;

__device__ __forceinline__ unsigned f2bf(float f) { unsigned u = __builtin_bit_cast(unsigned, f); return (u + 0x7fffu + ((u >> 16) & 1u)) >> 16; }
__device__ __forceinline__ unsigned pk2(float lo, float hi) { return f2bf(lo) | (f2bf(hi) << 16); }
__device__ __forceinline__ float bf2f(bf16 b) { return __builtin_bit_cast(float, (unsigned)b << 16); }
__device__ __forceinline__ unsigned cvtpk(float lo, float hi) { unsigned r; asm volatile("v_cvt_pk_bf16_f32 %0, %1, %2" : "=v"(r) : "v"(lo), "v"(hi)); return r; }
__device__ __forceinline__ bf16x8 pack8(f32x4 a, f32x4 b) { v4u w = {cvtpk(a[0], a[1]), cvtpk(a[2], a[3]), cvtpk(b[0], b[1]), cvtpk(b[2], b[3])}; return __builtin_bit_cast(bf16x8, w); }
__device__ __forceinline__ float wave_sum(float v) {
#define WS_STEP(ctrl, rmask) v += __int_as_float(__builtin_amdgcn_update_dpp(0, __float_as_int(v), ctrl, rmask, 0xf, true))
    WS_STEP(0x111, 0xf); WS_STEP(0x112, 0xf); WS_STEP(0x114, 0xf); WS_STEP(0x118, 0xf); WS_STEP(0x142, 0xa); WS_STEP(0x143, 0xc);
#undef WS_STEP
    return __int_as_float(__builtin_amdgcn_readlane(__float_as_int(v), 63));
}
__device__ __forceinline__ float wave_max(float v) {
#define WM_STEP(ctrl, rmask) v = fmaxf(v, __int_as_float(__builtin_amdgcn_update_dpp(__float_as_int(v), __float_as_int(v), ctrl, rmask, 0xf, false)))
    WM_STEP(0x111, 0xf); WM_STEP(0x112, 0xf); WM_STEP(0x114, 0xf); WM_STEP(0x118, 0xf); WM_STEP(0x142, 0xa); WM_STEP(0x143, 0xc);
#undef WM_STEP
    return __int_as_float(__builtin_amdgcn_readlane(__float_as_int(v), 63));
}
__device__ __forceinline__ int rel_bucket_dev(int d) {
    if (d < 16) return d;
    if (d >= 113) return 31;
    int v = 16 + (int)(__log2f((float)d * 0.0625f) * (16.0f / 3.0f));
    return v > 31 ? 31 : v;
}
namespace pg8 {
constexpr int BM = 256, BK = 64, HALF = 128, HTB = HALF * BK * 2, STAGE_BYTES = 8 * HTB, NXCD = 8, WGM = 8;
__host__ __device__ __forceinline__ int lds_byte(int r, int c) { const int st = (r >> 4) * 2 + (c >> 5), rr = r & 15, cc = c & 31, ob = rr * 64 + cc * 2; return st * 1024 + (ob ^ (((ob >> 9) & 1) << 5)); }
__host__ __device__ __forceinline__ void stage_rc(int b, int& R, int& C) { const int st = b / 1024, sb = b % 1024, swz = sb ^ (((sb >> 9) & 1) << 5); R = (st >> 1) * 16 + swz / 64; C = (st & 1) * 32 + (swz % 64) / 2; }
__host__ __device__ __forceinline__ int perm32(int rho) { const int n = rho >> 4, i = rho & 15; return 8 * (i >> 2) + 4 * n + (i & 3); }

struct Unit { int pm, pn, aux; const char* A; const char* B; };
struct GemmK { int K; unsigned pitchA, pitchB; int kshA; unsigned gstrA; };

struct GridOrder {
    int nM, nN, nwg, G, c;
    __device__ __forceinline__ void init(int nM_, int nN_, int G_, int c_) { nM = nM_; nN = nN_; nwg = nM * nN; G = G_; c = c_; }
    __device__ __forceinline__ bool at(int i, int& pm, int& pn) const {
        const long L = (long)i * G + c; if (L >= nwg) return false;
        int wgid = (int)L; { const int q = nwg / NXCD, r = nwg % NXCD, xcd = wgid % NXCD, off = wgid / NXCD; wgid = (xcd < r ? xcd * (q + 1) : r * (q + 1) + (xcd - r) * q) + off; }
        const int nig = WGM * nN, gid = wgid / nig, fm = gid * WGM, gsz = (nM - fm) < WGM ? (nM - fm) : WGM;
        pm = fm + ((wgid % nig) % gsz); pn = (wgid % nig) / gsz; return true;
    }
};
struct PlainSched {
    GridOrder o; const char* A; const char* B; size_t tstepA, tstepB;
    __device__ __forceinline__ void init(int Mr, int Nc, int G, int c, const void* A_, size_t pitchA, const void* B_, size_t pitchB) { o.init(Mr / BM, Nc / BM, G, c); A = (const char*)A_; B = (const char*)B_; tstepA = 256 * pitchA; tstepB = 256 * pitchB; }
    __device__ __forceinline__ bool next(int i, Unit& u) const { if (!o.at(i, u.pm, u.pn)) return false; u.aux = 0; u.A = A + (size_t)u.pm * tstepA; u.B = B + (size_t)u.pn * tstepB; return true; }
};

__device__ __forceinline__ unsigned cvt_pk_bf16(float lo, float hi) { unsigned r; asm volatile("v_cvt_pk_bf16_f32 %0, %1, %2" : "=v"(r) : "v"(lo), "v"(hi)); return r; }

typedef float f32x8 __attribute__((ext_vector_type(8)));
__device__ __forceinline__ f32x8 row_rstd8(const float* rs, int row0, int fq) {
    f32x8 r = {1.f, 1.f, 1.f, 1.f, 1.f, 1.f, 1.f, 1.f};
    if (rs) {
#pragma unroll
        for (int i = 0; i < 8; ++i) { const f32x4 p = *(const f32x4*)(rs + (size_t)(row0 + (i >> 2) * HALF + (i & 3) * 16) * 16 + 4 * fq); float s = (p[0] + p[1]) + (p[2] + p[3]);
            s += __shfl_xor(s, 16); s += __shfl_xor(s, 32); r[i] = 1.0f / sqrtf(s * (1.0f / DM) + RMS_EPS); } }
    return r;
}
struct EpiGroups {
    static constexpr bool PERM = true;
    bf16* O; size_t gstride; unsigned scalemask; float scale; int gskip; const float* rs;
    __device__ __forceinline__ void operator()(const f32x4 (&acc)[2][2][4][2], const Unit& u, int wr, int wc, int fr, int fq) const {
        const int row0 = u.pm * BM + wr * 64 + fr, col0 = wc * 32 + 8 * fq;
        const f32x8 rstd = row_rstd8(rs, row0, fq);
#pragma unroll
        for (int bj = 0; bj < 2; ++bj) { const int g = 2 * u.pn + bj; if (g >= gskip) continue; const float sc = ((scalemask >> g) & 1u) ? scale : 1.f; bf16* base = O + (size_t)g * gstride;
#pragma unroll
            for (int ai = 0; ai < 2; ++ai)
#pragma unroll
                for (int m = 0; m < 4; ++m) { const float s2 = sc * rstd[ai * 4 + m]; const f32x4 v0 = acc[ai][bj][m][0] * s2, v1 = acc[ai][bj][m][1] * s2;
                    v4u w; w.x = cvt_pk_bf16(v0[0], v0[1]); w.y = cvt_pk_bf16(v0[2], v0[3]); w.z = cvt_pk_bf16(v1[0], v1[1]); w.w = cvt_pk_bf16(v1[2], v1[3]);
                    *(v4u*)(base + (size_t)(row0 + ai * HALF + m * 16) * 128 + col0) = w; } }
    }
};
struct OneSched { Unit u; __device__ __forceinline__ bool next(int i, Unit& o) const { if (i) return false; o = u; return true; } };
struct EpiAkv {
    static constexpr bool PERM = true;
    bf16* AK; bf16* AV; const LAS float* rstd;
    __device__ __forceinline__ void operator()(const f32x4 (&acc)[2][2][4][2], const Unit& u, int wr, int wc, int fr, int fq) const {
        const int col0 = wc * 32 + 8 * fq;
#pragma unroll
        for (int ai = 0; ai < 2; ++ai)
#pragma unroll
            for (int m = 0; m < 4; ++m) { const int rl = ai * HALF + wr * 64 + m * 16 + fr; const float rs = rstd[rl]; const size_t row = (size_t)u.pm * BM + rl;
#pragma unroll
                for (int bj = 0; bj < 2; ++bj) { const f32x4 v0 = acc[ai][bj][m][0] * rs, v1 = acc[ai][bj][m][1] * rs;
                    v4u w; w.x = cvt_pk_bf16(v0[0], v0[1]); w.y = cvt_pk_bf16(v0[2], v0[3]); w.z = cvt_pk_bf16(v1[0], v1[1]); w.w = cvt_pk_bf16(v1[2], v1[3]);
                    *(v4u*)((bj ? AV : AK) + row * 128 + col0) = w; } }
    }
};
struct EpiF32 {
    static constexpr bool PERM = false;
    const float* base; float* C; int ldc; float scale;
    __device__ __forceinline__ void operator()(const f32x4 (&acc)[2][2][4][2], const Unit& u, int wr, int wc, int fr, int fq) const {
        const int row0 = u.pm * BM + wr * 64 + fr, col0 = u.pn * BM + wc * 32 + 4 * fq;
#pragma unroll
        for (int ai = 0; ai < 2; ++ai)
#pragma unroll
            for (int m = 0; m < 4; ++m) { const size_t off = (size_t)(row0 + ai * HALF + m * 16) * ldc + col0;
#pragma unroll
                for (int bj = 0; bj < 2; ++bj)
#pragma unroll
                    for (int n = 0; n < 2; ++n) { f32x4 v = acc[ai][bj][m][n] * scale; if (base) v += *(const f32x4*)(base + off + bj * HALF + n * 16); *(f32x4*)(C + off + bj * HALF + n * 16) = v; } }
    }
};
struct EpiRes {
    static constexpr bool PERM = true;
    const float* basef; const bf16* baseb; bf16* out; float* rs; float scale;
    __device__ __forceinline__ void operator()(const f32x4 (&acc)[2][2][4][2], const Unit& u, int wr, int wc, int fr, int fq) const {
        const int row0 = u.pm * BM + wr * 64 + fr, col0 = u.pn * BM + wc * 32 + 8 * fq;
#pragma unroll
        for (int ai = 0; ai < 2; ++ai)
#pragma unroll
            for (int m = 0; m < 4; ++m) { const size_t off = (size_t)(row0 + ai * HALF + m * 16) * DM + col0; float ss = 0.f;
#pragma unroll
                for (int bj = 0; bj < 2; ++bj) { f32x4 v0 = acc[ai][bj][m][0] * scale, v1 = acc[ai][bj][m][1] * scale;
                    if (basef) { v0 += *(const f32x4*)(basef + off + bj * HALF); v1 += *(const f32x4*)(basef + off + bj * HALF + 4); }
                    else { const v4u w = *(const v4u*)(baseb + off + bj * HALF);
                        v0 += (f32x4){__uint_as_float(w.x << 16), __uint_as_float(w.x & 0xffff0000u), __uint_as_float(w.y << 16), __uint_as_float(w.y & 0xffff0000u)};
                        v1 += (f32x4){__uint_as_float(w.z << 16), __uint_as_float(w.z & 0xffff0000u), __uint_as_float(w.w << 16), __uint_as_float(w.w & 0xffff0000u)}; }
                    v4u o; o.x = cvt_pk_bf16(v0[0], v0[1]); o.y = cvt_pk_bf16(v0[2], v0[3]); o.z = cvt_pk_bf16(v1[0], v1[1]); o.w = cvt_pk_bf16(v1[2], v1[3]);
                    *(v4u*)(out + off + bj * HALF) = o;
#define RS_ACC(w) { const float a_ = __uint_as_float((w) << 16), c_ = __uint_as_float((w) & 0xffff0000u); ss = fmaf(a_, a_, fmaf(c_, c_, ss)); }
                    RS_ACC(o.x) RS_ACC(o.y) RS_ACC(o.z) RS_ACC(o.w)
#undef RS_ACC
                }
                { ss += __shfl_xor(ss, 16); ss += __shfl_xor(ss, 32); if (fq == 0) rs[(size_t)(row0 + ai * HALF + m * 16) * 16 + 4 * u.pn + wc] = ss; } }
    }
};
struct EpiMoeY {
    static constexpr bool PERM = true;
    bf16* Y; const float* gws;
    __device__ __forceinline__ void operator()(const f32x4 (&acc)[2][2][4][2], const Unit& u, int wr, int wc, int fr, int fq) const {
        const int col0 = u.pn * BM + wc * 32 + 8 * fq;
#pragma unroll
        for (int ai = 0; ai < 2; ++ai)
#pragma unroll
            for (int m = 0; m < 4; ++m) { const int slot = u.pm * BM + ai * HALF + wr * 64 + m * 16 + fr; const float g = gws[slot];
#pragma unroll
                for (int bj = 0; bj < 2; ++bj) { const f32x4 v0 = acc[ai][bj][m][0] * g, v1 = acc[ai][bj][m][1] * g;
                    v4u o; o.x = cvt_pk_bf16(v0[0], v0[1]); o.y = cvt_pk_bf16(v0[2], v0[3]); o.z = cvt_pk_bf16(v1[0], v1[1]); o.w = cvt_pk_bf16(v1[2], v1[3]);
                    *(v4u*)(Y + (size_t)slot * DM + col0 + bj * HALF) = o; } }
    }
};
struct EpiMoeYp {
    static constexpr bool PERM = true;
    bf16* YP; const float* gws; int pm0; size_t split_stride;
    __device__ __forceinline__ void operator()(const f32x4 (&acc)[2][2][4][2], const Unit& u, int wr, int wc, int fr, int fq) const {
        const int col0 = (u.pn & 3) * BM + wc * 32 + 8 * fq; bf16* base = YP + (size_t)(u.pn >> 2) * split_stride;
#pragma unroll
        for (int ai = 0; ai < 2; ++ai)
#pragma unroll
            for (int m = 0; m < 4; ++m) { const int rl = ai * HALF + wr * 64 + m * 16 + fr; const float g = gws[u.pm * BM + rl];
#pragma unroll
                for (int bj = 0; bj < 2; ++bj) { const f32x4 v0 = acc[ai][bj][m][0] * g, v1 = acc[ai][bj][m][1] * g;
                    v4u o; o.x = cvt_pk_bf16(v0[0], v0[1]); o.y = cvt_pk_bf16(v0[2], v0[3]); o.z = cvt_pk_bf16(v1[0], v1[1]); o.w = cvt_pk_bf16(v1[2], v1[3]);
                    *(v4u*)(base + (size_t)((u.pm - pm0) * BM + rl) * DM + col0 + bj * HALF) = o; } }
    }
};
struct EpiSwiglu {
    static constexpr bool PERM = true;
    bf16* H; int ldh; int pm0; const float* rs; bf16* H2; int hsplit;
    __device__ __forceinline__ void operator()(const f32x4 (&acc)[2][2][4][2], const Unit& u, int wr, int wc, int fr, int fq) const {
        const int lt = u.pm - pm0; bf16* Hb = (H2 && lt >= hsplit) ? H2 : H;
        const int row0 = ((H2 && lt >= hsplit) ? lt - hsplit : lt) * BM + wr * 64 + fr, col0 = u.pn * HALF + wc * 32 + 8 * fq;
        const f32x8 rstd = row_rstd8(rs, u.pm * BM + wr * 64 + fr, fq);
#pragma unroll
        for (int ai = 0; ai < 2; ++ai)
#pragma unroll
            for (int m = 0; m < 4; ++m) { float h[8];
#pragma unroll
                for (int n = 0; n < 2; ++n)
#pragma unroll
                    for (int j = 0; j < 4; ++j) { const float g = acc[ai][0][m][n][j] * rstd[ai * 4 + m], up = acc[ai][1][m][n][j] * rstd[ai * 4 + m]; h[n * 4 + j] = g * up * __builtin_amdgcn_rcpf(1.0f + __builtin_amdgcn_exp2f(-g * LOG2E)); }
                v4u w; w.x = cvt_pk_bf16(h[0], h[1]); w.y = cvt_pk_bf16(h[2], h[3]); w.z = cvt_pk_bf16(h[4], h[5]); w.w = cvt_pk_bf16(h[6], h[7]);
                *(v4u*)(Hb + (size_t)(row0 + ai * HALF + m * 16) * ldh + col0) = w; }
    }
};
struct EpiMoeDown {
    static constexpr bool PERM = false;
    float* out; const int* tok; const float* gw; int pm0; float scale;
    __device__ __forceinline__ void operator()(const f32x4 (&acc)[2][2][4][2], const Unit& u, int wr, int wc, int fr, int fq) const {
        const int col0 = u.pn * BM + wc * 32 + 4 * fq;
#pragma unroll
        for (int ai = 0; ai < 2; ++ai)
#pragma unroll
            for (int m = 0; m < 4; ++m) { const int slot = u.pm * BM + ai * HALF + wr * 64 + m * 16 + fr; const int t = tok[slot];
                if (t >= 0) { const float g = gw[t] * scale; float* rowp = out + (size_t)t * DM + col0;
#pragma unroll
                    for (int bj = 0; bj < 2; ++bj)
#pragma unroll
                        for (int n = 0; n < 2; ++n) { f32x4* p = (f32x4*)(rowp + bj * HALF + n * 16); *p = *p + acc[ai][bj][m][n] * g; } } }
    }
};

template <class Epi, class Sched, bool ALIGN_EPI = true>
__device__ __forceinline__ void gemm_phase(LAS unsigned char* lds, const GemmK gk, const Sched& S, const Epi& E) {
    int tid = threadIdx.x; asm volatile("" : "+v"(tid));
    const int wid = __builtin_amdgcn_readfirstlane(tid >> 6), lane = tid & 63, wr = wid >> 2, wc = wid & 3, fr = lane & 15, fq = lane >> 4;
    int nt = gk.K / BK; asm volatile("" : "+s"(nt));
    unsigned voffA[2], voffB[2];
#pragma unroll
    for (int i = 0; i < 2; ++i) { int R, C; stage_rc(tid * 16 + i * 8192, R, C); const int Rb = Epi::PERM ? ((R & ~31) + perm32(R & 31)) : R;
        voffA[i] = (unsigned)R * gk.pitchA + (unsigned)C * 2u; voffB[i] = (unsigned)Rb * gk.pitchB + (unsigned)C * 2u; }
    const size_t hstepA = (size_t)HALF * gk.pitchA, hstepB = (size_t)HALF * gk.pitchB;
    const int ksh = gk.kshA; const unsigned kmask = (1u << ksh) - 1u; const size_t gstr = gk.gstrA;
#define PG8_KOA(t) ((size_t)((unsigned)(t) >> ksh) * gstr + (size_t)((unsigned)(t) & kmask) * 128u)
    const unsigned ldsw = (unsigned)wid * 1024u;
    const int aoff = lds_byte(wr * 64 + fr, fq * 8), boff = lds_byte(wc * 32 + fr, fq * 8);
#define PG8_SA(b, h) (((b) * 2 + (h)) * HTB)
#define PG8_SB(b, h) ((4 + (b) * 2 + (h)) * HTB)
#define PG8_STAGE(bufoff, gbase, voff) do { _Pragma("unroll") for (int _i = 0; _i < 2; ++_i) \
        __builtin_amdgcn_global_load_lds((const unsigned*)((const char*)(gbase) + (voff)[_i]), (LAS unsigned*)(lds + (bufoff) + ldsw + _i * 8192), 16, 0, 0); } while (0)
#define PG8_LDA(dst, b, h) do { _Pragma("unroll") for (int m = 0; m < 4; ++m) _Pragma("unroll") for (int k = 0; k < 2; ++k) dst[m][k] = *(const LAS bf16x8*)(lds + PG8_SA(b, h) + aoff + m * 2048 + k * 1024); } while (0)
#define PG8_LDB(dst, b, h) do { _Pragma("unroll") for (int n = 0; n < 2; ++n) _Pragma("unroll") for (int k = 0; k < 2; ++k) dst[n][k] = *(const LAS bf16x8*)(lds + PG8_SB(b, h) + boff + n * 2048 + k * 1024); } while (0)
#define PG8_MMA(ai, bj, At, Bt) do { __builtin_amdgcn_s_setprio(1); _Pragma("unroll") for (int m = 0; m < 4; ++m) _Pragma("unroll") for (int n = 0; n < 2; ++n) _Pragma("unroll") for (int k = 0; k < 2; ++k) \
        acc[ai][bj][m][n] = __builtin_amdgcn_mfma_f32_16x16x32_bf16(Bt[n][k], At[m][k], acc[ai][bj][m][n], 0, 0, 0); __builtin_amdgcn_s_setprio(0); } while (0)
#define PG8_WAIT_V(n) asm volatile("s_waitcnt vmcnt(" #n ")" ::: "memory")
#define PG8_WAIT_L(n) asm volatile("s_waitcnt lgkmcnt(" #n ")" ::: "memory")
#define PG8_BAR __builtin_amdgcn_s_barrier()
#define PG8_SCHED __builtin_amdgcn_sched_barrier(0)
    Unit cur, nxt; int ui = 0;
    if (!S.next(0, cur)) return;
    f32x4 acc[2][2][4][2];
#pragma unroll
    for (int a = 0; a < 2; ++a)
#pragma unroll
        for (int b = 0; b < 2; ++b)
#pragma unroll
            for (int m = 0; m < 4; ++m)
#pragma unroll
                for (int n = 0; n < 2; ++n) acc[a][b][m][n] = (f32x4){0.f, 0.f, 0.f, 0.f};
    bf16x8 At[4][2], B0[2][2], B1[2][2];
    const char* cA = cur.A; const char* cB = cur.B;
    PG8_STAGE(PG8_SB(0, 0), cB, voffB); PG8_STAGE(PG8_SB(0, 1), cB + hstepB, voffB); PG8_STAGE(PG8_SA(0, 0), cA, voffA); PG8_STAGE(PG8_SA(0, 1), cA + hstepA, voffA);
    if (wr == 1) PG8_BAR;
    PG8_WAIT_V(2); PG8_BAR;
    PG8_STAGE(PG8_SB(1, 0), cB + 128, voffB); PG8_STAGE(PG8_SA(1, 0), cA + 128, voffA); PG8_STAGE(PG8_SB(1, 1), cB + hstepB + 128, voffB);
    PG8_WAIT_V(6); PG8_BAR;
    for (;;) {
        const bool has_next = S.next(ui + 1, nxt);
        const char* nA = has_next ? nxt.A : cA; const char* nB = has_next ? nxt.B : cB;
        for (int t = 0; t < nt; t += 2) {
            const bool last = (t == nt - 2);
            const char* a1 = cA + PG8_KOA(t + 1);
            const char* a2 = last ? nA : cA + PG8_KOA(t + 2); const char* b2 = last ? nB : cB + (size_t)(t + 2) * 128u;
            const char* a3 = a2 + 128; const char* b3 = b2 + 128;
            PG8_LDB(B0, 0, 0); PG8_LDB(B1, 0, 1); PG8_SCHED; PG8_LDA(At, 0, 0); PG8_STAGE(PG8_SA(1, 1), a1 + hstepA, voffA);
            PG8_WAIT_V(8); PG8_WAIT_L(0); PG8_BAR; PG8_MMA(0, 0, At, B0); PG8_MMA(0, 1, At, B1); PG8_BAR; PG8_SCHED;
            PG8_LDA(At, 0, 1); PG8_STAGE(PG8_SB(0, 0), b2, voffB); PG8_STAGE(PG8_SB(0, 1), b2 + hstepB, voffB); PG8_STAGE(PG8_SA(0, 0), a2, voffA);
            PG8_WAIT_V(8); PG8_WAIT_L(0); PG8_BAR; PG8_MMA(1, 0, At, B0); PG8_MMA(1, 1, At, B1); PG8_BAR; PG8_SCHED;
            PG8_LDB(B0, 1, 0); PG8_LDB(B1, 1, 1); PG8_SCHED; PG8_LDA(At, 1, 0); PG8_STAGE(PG8_SA(0, 1), a2 + hstepA, voffA);
            PG8_WAIT_V(8); PG8_WAIT_L(0); PG8_BAR; PG8_MMA(0, 0, At, B0); PG8_MMA(0, 1, At, B1); PG8_BAR; PG8_SCHED;
            PG8_LDA(At, 1, 1); PG8_STAGE(PG8_SB(1, 0), b3, voffB); PG8_STAGE(PG8_SB(1, 1), b3 + hstepB, voffB); PG8_STAGE(PG8_SA(1, 0), a3, voffA);
            PG8_WAIT_V(8); PG8_WAIT_L(0); PG8_BAR; PG8_MMA(1, 0, At, B0); PG8_MMA(1, 1, At, B1); PG8_BAR; PG8_SCHED;
        }
        if constexpr (ALIGN_EPI) { if (wr == 0) PG8_BAR; }
        E(acc, cur, wr, wc, fr, fq);
        if (!has_next) break;
#pragma unroll
        for (int a = 0; a < 2; ++a)
#pragma unroll
            for (int b = 0; b < 2; ++b)
#pragma unroll
                for (int m = 0; m < 4; ++m)
#pragma unroll
                    for (int n = 0; n < 2; ++n) acc[a][b][m][n] = (f32x4){0.f, 0.f, 0.f, 0.f};
        cur = nxt; cA = nA; cB = nB; ++ui;
        if constexpr (ALIGN_EPI) { if (wr == 1) PG8_BAR; }
    }
    PG8_WAIT_V(0);
    if constexpr (!ALIGN_EPI) { if (wr == 0) PG8_BAR; }
    PG8_BAR;
#undef PG8_KOA
#undef PG8_SA
#undef PG8_SB
#undef PG8_STAGE
#undef PG8_LDA
#undef PG8_LDB
#undef PG8_MMA
#undef PG8_WAIT_V
#undef PG8_WAIT_L
#undef PG8_BAR
#undef PG8_SCHED
}
}
#define XB_TMO      128
#define XB_XCNT(j)  (256  + 64 * (j))
#define XB_XSUB(j)  (1280 + 64 * (j))
#define XB_XGEN(j)  (2304 + 64 * (j))
#define XB_TOP      3328
#define XB_TOPGEN   3392
#define XCD_BAR_WORDS 3456
#define XB_SPIN_CAP (1u << 22)

__device__ __forceinline__ unsigned xb_ld(unsigned* p)              { return __hip_atomic_load(p, __ATOMIC_RELAXED, __HIP_MEMORY_SCOPE_AGENT); }
__device__ __forceinline__ unsigned xb_add(unsigned* p, unsigned v) { return __hip_atomic_fetch_add(p, v, __ATOMIC_RELAXED, __HIP_MEMORY_SCOPE_AGENT); }
__device__ __forceinline__ unsigned xb_xcc_id() { return (unsigned)__builtin_amdgcn_s_getreg((3 << 11) | 20) & 0xFu; }
#define XB_SPIN(cond, bar) do { unsigned _sp = 0; while (cond) { __builtin_amdgcn_s_sleep(1); \
    if ((++_sp & 255u) == 0u) { if (xb_ld(&(bar)[XB_TMO])) break; if (_sp > XB_SPIN_CAP) { atomicAdd(&(bar)[XB_TMO], 1u); break; } } } } while (0)

struct XcdBarrier { unsigned* bar; unsigned x; volatile LAS unsigned* st; };

__device__ __forceinline__ XcdBarrier xcd_barrier_post(unsigned* bar, volatile LAS unsigned* st) {
    XcdBarrier b; b.bar = bar; b.x = xb_xcc_id(); b.st = st;
    if (threadIdx.x == 0) (void)xb_add(&bar[XB_XCNT(b.x)], 1u);
    return b;
}
__device__ __forceinline__ void xcd_barrier_complete(unsigned* bar, unsigned x, unsigned& nloc, unsigned& nx) {
    const unsigned G = gridDim.x * gridDim.y * gridDim.z;
    unsigned sum, cnt, mine, sp = 0u;
    for (;;) {
        sum = 0u; cnt = 0u; mine = 0u;
#pragma unroll
        for (unsigned j = 0; j < 16; ++j) { const unsigned c = xb_ld(&bar[XB_XCNT(j)]); sum += c; cnt += (c > 0u) ? 1u : 0u; mine = (j == x) ? c : mine; }
        if (sum == G) break;
        __builtin_amdgcn_s_sleep(1);
        if ((++sp & 255u) == 0u) { if (xb_ld(&bar[XB_TMO])) break; if (sp > XB_SPIN_CAP) { atomicAdd(&bar[XB_TMO], 1u); break; } }
    }
    nloc = mine > 0u ? mine : 1u; nx = cnt > 0u ? cnt : 1u;
}
__device__ __forceinline__ void xcd_barrier(const XcdBarrier& b) {
    asm volatile("s_waitcnt vmcnt(0)" ::: "memory");
    __syncthreads();
    if (threadIdx.x == 0) {
        unsigned* bar = b.bar;
        __builtin_amdgcn_s_waitcnt(0);
        unsigned nloc = b.st[0], nx = b.st[1];
        if (nloc == 0u) { xcd_barrier_complete(bar, b.x, nloc, nx); b.st[0] = nloc; b.st[1] = nx; }
        const unsigned old = xb_add(&bar[XB_XSUB(b.x)], 1u);
        const unsigned gen = old / nloc;
        if (old + 1u == (gen + 1u) * nloc) {
            __builtin_amdgcn_fence(__ATOMIC_RELEASE, "agent");
            asm volatile("s_waitcnt vmcnt(0)" ::: "memory");
            const unsigned og = xb_add(&bar[XB_TOP], 1u);
            const unsigned tg = og / nx;
            if (og + 1u == (tg + 1u) * nx) xb_add(&bar[XB_TOPGEN], 1u);
            else XB_SPIN(xb_ld(&bar[XB_TOPGEN]) == tg, bar);
            __builtin_amdgcn_fence(__ATOMIC_ACQUIRE, "agent");
            xb_add(&bar[XB_XGEN(b.x)], 1u);
            asm volatile("s_waitcnt vmcnt(0)" ::: "memory");
        } else {
            XB_SPIN(xb_ld(&bar[XB_XGEN(b.x)]) == gen, bar);
            __builtin_amdgcn_fence(__ATOMIC_ACQUIRE, "agent");
            asm volatile("s_waitcnt vmcnt(0)" ::: "memory");
        }
    }
    __syncthreads();
}

struct Frame {
    LAS unsigned char* lds;
    char* ldsg;
    volatile LAS unsigned* MISC;
    gu32* ctl;
    int tid, lane, wave, vcu, G;
    const __attribute__((address_space(4))) char* kap;
    float* out; unsigned char* ws;
};
#define FIN(i) (*(const float* const __attribute__((address_space(4)))*)(F.kap + 8 * (i)))
#define PHASE_FENCE() do { unsigned long long k_ = (unsigned long long)F.kap; asm volatile("" : "+s"(k_)); F.kap = (const __attribute__((address_space(4))) char*)k_; \
    int t_ = F.tid; asm volatile("" : "+v"(t_)); F.tid = t_; F.lane = t_ & 63; } while (0)
#define WSP(T, off) ((T*)(F.ws + (off)))
#define GRP(g) (WSP(bf16, WS_PROJ) + (size_t)(g) * GS)
#define QKVG(g) (WSP(bf16, WS_QKV) + (size_t)(g) * GS)

__device__ __forceinline__ void rms_row(const float* xrow, const float* gain, int lane, f32x4 (&v)[4]) {
    const GAS f32x4* xr = (const GAS f32x4*)xrow + lane; float s = 0.f;
#pragma unroll
    for (int j = 0; j < 4; ++j) { v[j] = xr[64 * j]; s += (v[j].x * v[j].x + v[j].y * v[j].y) + (v[j].z * v[j].z + v[j].w * v[j].w); }
    const float rstd = 1.0f / sqrtf(wave_sum(s) * (1.f / DM) + RMS_EPS);
#pragma unroll
    for (int j = 0; j < 4; ++j) { const f32x4 g = ((const GAS f32x4*)gain)[lane + 64 * j]; v[j] = v[j] * rstd * g; }
}
__device__ __forceinline__ void store_row_bf16(bf16* orow, int lane, const f32x4 (&v)[4]) {
    GAS unsigned long long* o8 = (GAS unsigned long long*)orow + lane;
#pragma unroll
    for (int j = 0; j < 4; ++j) o8[64 * j] = (unsigned long long)cvtpk(v[j].x, v[j].y) | ((unsigned long long)cvtpk(v[j].z, v[j].w) << 32);
}
__device__ __forceinline__ void load_row_bf16(const bf16* row, int lane, float (&v)[16]) {
    const v4u a = ((const GAS v4u*)row)[lane], b = ((const GAS v4u*)row)[64 + lane];
#pragma unroll
    for (int q = 0; q < 4; ++q) { v[2 * q] = __uint_as_float(a[q] << 16); v[2 * q + 1] = __uint_as_float(a[q] & 0xffff0000u); v[8 + 2 * q] = __uint_as_float(b[q] << 16); v[8 + 2 * q + 1] = __uint_as_float(b[q] & 0xffff0000u); }
}
__device__ __forceinline__ void store_row16_bf16(bf16* row, int lane, const float (&v)[16]) {
    ((GAS v4u*)row)[lane] = (v4u){cvtpk(v[0], v[1]), cvtpk(v[2], v[3]), cvtpk(v[4], v[5]), cvtpk(v[6], v[7])};
    ((GAS v4u*)row)[64 + lane] = (v4u){cvtpk(v[8], v[9]), cvtpk(v[10], v[11]), cvtpk(v[12], v[13]), cvtpk(v[14], v[15])};
}
__device__ __forceinline__ void rms16(float (&v)[16], const float* gain, int lane) {
    float s = 0.f;
#pragma unroll
    for (int i = 0; i < 16; ++i) s += v[i] * v[i];
    const float rstd = 1.0f / sqrtf(wave_sum(s) * (1.f / DM) + RMS_EPS);
    const f32x4 g0 = ((const GAS f32x4*)gain)[2 * lane], g1 = ((const GAS f32x4*)gain)[2 * lane + 1], g2 = ((const GAS f32x4*)gain)[128 + 2 * lane], g3 = ((const GAS f32x4*)gain)[128 + 2 * lane + 1];
#pragma unroll
    for (int i = 0; i < 4; ++i) { v[i] *= rstd * g0[i]; v[4 + i] *= rstd * g1[i]; v[8 + i] *= rstd * g2[i]; v[12 + i] *= rstd * g3[i]; }
}
__device__ __forceinline__ void norm_phase(Frame& F, const float* srcf, const bf16* srcb, const float* gain) {
    const int gw = F.vcu * NWAVES + F.wave, NGW = F.G * NWAVES;
    if (srcf) { for (int m = gw; m < M; m += 2 * NGW) { f32x4 v[4], w[4]; const int mb = m + NGW;
            const GAS f32x4* xa = (const GAS f32x4*)(srcf + (size_t)m * DM) + F.lane; const GAS f32x4* xb = (const GAS f32x4*)(srcf + (size_t)(mb < M ? mb : m) * DM) + F.lane;
#pragma unroll
            for (int j = 0; j < 4; ++j) { v[j] = xa[64 * j]; w[j] = xb[64 * j]; }
            float sa = 0.f, sb = 0.f;
#pragma unroll
            for (int j = 0; j < 4; ++j) { sa += (v[j].x * v[j].x + v[j].y * v[j].y) + (v[j].z * v[j].z + v[j].w * v[j].w); sb += (w[j].x * w[j].x + w[j].y * w[j].y) + (w[j].z * w[j].z + w[j].w * w[j].w); }
            const float ra = 1.0f / sqrtf(wave_sum(sa) * (1.f / DM) + RMS_EPS), rb = 1.0f / sqrtf(wave_sum(sb) * (1.f / DM) + RMS_EPS);
#pragma unroll
            for (int j = 0; j < 4; ++j) { const f32x4 g = ((const GAS f32x4*)gain)[F.lane + 64 * j]; v[j] = v[j] * ra * g; w[j] = w[j] * rb * g; }
            store_row_bf16(WSP(bf16, WS_XN) + (size_t)m * DM, F.lane, v); if (mb < M) store_row_bf16(WSP(bf16, WS_XN) + (size_t)mb * DM, F.lane, w); } }
    else { for (int m = gw; m < M; m += NGW) { float v[16]; load_row_bf16(srcb + (size_t)m * DM, F.lane, v); rms16(v, gain, F.lane); store_row16_bf16(WSP(bf16, WS_XN) + (size_t)m * DM, F.lane, v); } }
}

struct SrcCol { const float* W; int col; int ldw; };
template <class Fn>
__device__ __forceinline__ void xpose_load(const Fn& fn, int K, const float* kgain, int item, int lane, float (&v)[32]) {
    const int nkb = K / 64, rb = item / nkb, kb = item % nkb, k0 = 64 * kb, r0 = 32 * rb;
    const SrcCol s = fn(r0 + (lane & 31));
#pragma unroll
    for (int i = 0; i < 32; ++i) { const int kk = 2 * i + (lane >> 5); float x = 0.f; if (s.W) { x = s.W[(size_t)(k0 + kk) * s.ldw + s.col]; if (kgain) x *= kgain[k0 + kk]; } v[i] = x; }
}
__device__ __forceinline__ void xpose_store(int K, bf16* WT, LAS float* scr, int item, int lane, const float (&v)[32]) {
    const int nkb = K / 64, rb = item / nkb, kb = item % nkb, k0 = 64 * kb, r0 = 32 * rb;
#pragma unroll
    for (int i = 0; i < 32; ++i) scr[(2 * i + (lane >> 5)) * 33 + (lane & 31)] = v[i];
    LDS_WAIT(); asm volatile("" ::: "memory");
    const int c = lane & 7;
#pragma unroll
    for (int j = 0; j < 4; ++j) { const int n = (lane >> 3) + 8 * j; const LAS float* sp = scr + (8 * c) * 33 + n;
        v4u o; o.x = cvtpk(sp[0 * 33], sp[1 * 33]); o.y = cvtpk(sp[2 * 33], sp[3 * 33]); o.z = cvtpk(sp[4 * 33], sp[5 * 33]); o.w = cvtpk(sp[6 * 33], sp[7 * 33]);
        *(GAS v4u*)(WT + (size_t)(r0 + n) * K + k0 + 8 * c) = o; }
    LDS_WAIT(); asm volatile("" ::: "memory");
}
template <class Fn>
__device__ __forceinline__ void xpose_matrix(const Fn& fn, int K, bf16* WT, const float* kgain, LAS float* scr, int first, int nitems, int stride, int lane) {
    float va[32], vb[32];
    int it = first;
    if (it < nitems) xpose_load(fn, K, kgain, it, lane, va);
    while (it < nitems) {
        const int i1 = it + stride, i2 = i1 + stride;
        if (i1 < nitems) xpose_load(fn, K, kgain, i1, lane, vb);
        xpose_store(K, WT, scr, it, lane, va);
        if (i1 >= nitems) break;
        if (i2 < nitems) xpose_load(fn, K, kgain, i2, lane, va);
        xpose_store(K, WT, scr, i1, lane, vb);
        it = i2;
    }
}
__device__ __forceinline__ int incol(int rho) {
    const int g = rho >> 7, c = rho & 127;
    if (g < 4) return rho;
    if (g < 6) return 512 + (rho - 512);
    if (g < 8) return 768 + (rho - 768);
    if (g < 12) return 1092 + (rho - 1024);
    if (g < 18) return 1604 + (rho - 1536);
    if (g == 18) { if (c < 64) return 1024 + c; if (c < 68) return 1088 + (c - 64); if (c < 80) return 2372 + (c - 68); return -1; }
    return -1;
}
struct FnIn { const float* W; __device__ __forceinline__ SrcCol operator()(int r) const { const int c = incol(r); return SrcCol{c >= 0 ? W : nullptr, c, 2384}; } };
struct FnPlain { const float* W; int ldw; int coff; __device__ __forceinline__ SrcCol operator()(int r) const { return SrcCol{W, r + coff, ldw}; } };
struct FnGU { const float* Wg; const float* Wu; int ldw; __device__ __forceinline__ SrcCol operator()(int r) const { const int pn = r >> 8, c = r & 127;
    const long long d = (r & 128) ? ((const char*)Wu - (const char*)Wg) : 0ll;
    return SrcCol{(const float*)((const char*)Wg + d), pn * 128 + c, ldw}; } };
namespace att {
constexpr int KVBLK = 64, SHM_K = KVBLK * 128 * 2, SHM_V = KVBLK * 128 * 2;
#define KSWZ(row, colB) ((row) * 256 + ((colB) ^ (((row) & 7) << 4)))
__device__ __forceinline__ int v_st(int k, int c) { const int kk = (k & ~0xC) | ((k & 4) << 1) | ((k & 8) >> 1); return ((kk >> 3) * 4 + (c >> 5)) * 512 + ((kk & 7) * 32 + (c & 31)) * 2; }
__device__ __forceinline__ int v_rd_base(int lane) { return ((lane & 3) << 3) | (((lane >> 2) & 3) << 6) | (((lane >> 4) & 1) << 5) | (((lane >> 5) & 1) << 8); }
constexpr int v_rd_off(int d0, int ks, int half) { return d0 * 512 + ks * 4096 + half * 2048; }
__device__ __forceinline__ int crow(int r, int hi) { return (r & 3) + 8 * (r >> 2) + 4 * hi; }
__device__ __forceinline__ void qkt(f32x16& p0, f32x16& p1, const char* K_lds, int r32, int hi, const bf16x8* qr) {
    p0 = f32x16{}; p1 = f32x16{};
    const char* kb[4];
#pragma unroll
    for (int dd = 0; dd < 4; ++dd) kb[dd] = K_lds + KSWZ(r32, (dd * 16 + hi * 8) * 2);
#pragma unroll
    for (int d0 = 0; d0 < 8; ++d0) { const char* a = kb[d0 & 3] + (d0 >> 2) * 128;
        bf16x8 b0 = *reinterpret_cast<const bf16x8*>(a);
        bf16x8 b1 = *reinterpret_cast<const bf16x8*>(a + 32 * 256);
        p0 = __builtin_amdgcn_mfma_f32_32x32x16_bf16(b0, qr[d0], p0, 0, 0, 0);
        p1 = __builtin_amdgcn_mfma_f32_32x32x16_bf16(b1, qr[d0], p1, 0, 0, 0);
        if (d0 == 3) SBAR(); }
}
__device__ __forceinline__ void qkt_lq(f32x16& p0, f32x16& p1, const char* K_lds, const char* Q_lds, int r32, int hi) {
    p0 = f32x16{}; p1 = f32x16{};
    int ko[4];
#pragma unroll
    for (int dd = 0; dd < 4; ++dd) ko[dd] = KSWZ(r32, (dd * 16 + hi * 8) * 2);
#pragma unroll
    for (int d0 = 0; d0 < 8; ++d0) { const int a = ko[d0 & 3] + (d0 >> 2) * 128;
        bf16x8 b0 = *reinterpret_cast<const bf16x8*>(K_lds + a);
        bf16x8 b1 = *reinterpret_cast<const bf16x8*>(K_lds + a + 32 * 256);
        bf16x8 q = *reinterpret_cast<const bf16x8*>(Q_lds + a);
        p0 = __builtin_amdgcn_mfma_f32_32x32x16_bf16(b0, q, p0, 0, 0, 0);
        p1 = __builtin_amdgcn_mfma_f32_32x32x16_bf16(b1, q, p1, 0, 0, 0);
        if (d0 == 3) SBAR(); }
}
__device__ __forceinline__ void pv_tile(f32x16* o, int vb0, bf16x8 pa0, bf16x8 pa1, bf16x8 pa2, bf16x8 pa3) {
#define TRRD(dst, off) asm volatile("ds_read_b64_tr_b16 %0, %1 offset:%2" : "=&v"(dst) : "v"(vb0), "i"(off) : "memory")
#define PV_D0(d0) do { s16x4 l0, l1, l2, l3, h0, h1, h2, h3; constexpr int b_ = v_rd_off(d0, 0, 0); \
        TRRD(l0, b_); TRRD(h0, b_ + 2048); TRRD(l1, b_ + 4096); TRRD(h1, b_ + 6144); TRRD(l2, b_ + 8192); TRRD(h2, b_ + 10240); TRRD(l3, b_ + 12288); TRRD(h3, b_ + 14336); \
        asm volatile("s_waitcnt lgkmcnt(0)" ::: "memory"); SBAR(); \
        o[d0] = __builtin_amdgcn_mfma_f32_32x32x16_bf16(pa0, (bf16x8){l0[0], l0[1], l0[2], l0[3], h0[0], h0[1], h0[2], h0[3]}, o[d0], 0, 0, 0);   \
        o[d0] = __builtin_amdgcn_mfma_f32_32x32x16_bf16(pa1, (bf16x8){l1[0], l1[1], l1[2], l1[3], h1[0], h1[1], h1[2], h1[3]}, o[d0], 0, 0, 0);   \
        o[d0] = __builtin_amdgcn_mfma_f32_32x32x16_bf16(pa2, (bf16x8){l2[0], l2[1], l2[2], l2[3], h2[0], h2[1], h2[2], h2[3]}, o[d0], 0, 0, 0);   \
        o[d0] = __builtin_amdgcn_mfma_f32_32x32x16_bf16(pa3, (bf16x8){l3[0], l3[1], l3[2], l3[3], h3[0], h3[1], h3[2], h3[3]}, o[d0], 0, 0, 0); } while (0)
    PV_D0(0); PV_D0(1); PV_D0(2); PV_D0(3);
#undef PV_D0
#undef TRRD
}
__device__ __forceinline__ void pack_p(const f32x16& p0, const f32x16& p1, bf16x8& pa0, bf16x8& pa1, bf16x8& pa2, bf16x8& pa3) {
#define PK4(P, B_, OUT) do { unsigned a0 = cvtpk(P[B_+0], P[B_+1]), a1 = cvtpk(P[B_+2], P[B_+3]);                          \
        unsigned b0 = cvtpk(P[B_+4], P[B_+5]), b1 = cvtpk(P[B_+6], P[B_+7]);                                             \
        auto r0 = __builtin_amdgcn_permlane32_swap(a0, b0, false, false); auto r1 = __builtin_amdgcn_permlane32_swap(a1, b1, false, false); \
        v4u w = {r0[0], r1[0], r0[1], r1[1]}; OUT = __builtin_bit_cast(bf16x8, w); } while (0)
    PK4(p0, 0, pa0); PK4(p0, 8, pa1); PK4(p1, 0, pa2); PK4(p1, 8, pa3);
#undef PK4
}
__device__ __forceinline__ float xhalf_max(float v) { auto rr = __builtin_amdgcn_permlane32_swap(__float_as_uint(v), __float_as_uint(v), false, false); return fmaxf(__uint_as_float(rr[0]), __uint_as_float(rr[1])); }
__device__ __forceinline__ float xhalf_sum(float v) { auto rr = __builtin_amdgcn_permlane32_swap(__float_as_uint(v), __float_as_uint(v), false, false); return __uint_as_float(rr[0]) + __uint_as_float(rr[1]); }
__device__ __forceinline__ void softmax_step(f32x16& p0, f32x16& p1, float& m_reg, float& l_reg, f32x16* o, float* al_l, int r32, int hi) {
    float pmax = p0[0];
#pragma unroll
    for (int r = 1; r < 16; ++r) pmax = fmaxf(pmax, p0[r]);
#pragma unroll
    for (int r = 0; r < 16; ++r) pmax = fmaxf(pmax, p1[r]);
    pmax = xhalf_max(pmax);
    float mn, alpha;
    if (__all(pmax - m_reg <= 8.f)) { mn = m_reg; alpha = 1.f; }
    else { mn = fmaxf(m_reg, pmax); alpha = __builtin_amdgcn_exp2f(m_reg - mn); m_reg = mn; }
#pragma unroll
    for (int r = 0; r < 16; ++r) { p0[r] = __builtin_amdgcn_exp2f(p0[r] - mn); p1[r] = __builtin_amdgcn_exp2f(p1[r] - mn); }
    float ps = 0.f;
#pragma unroll
    for (int r = 0; r < 16; ++r) ps += p0[r] + p1[r];
    ps = xhalf_sum(ps);
    l_reg = l_reg * alpha + ps;
    if (__any(alpha < 1.f)) { if (hi == 0) al_l[r32] = alpha; asm volatile("s_waitcnt lgkmcnt(0)" ::: "memory");
#pragma unroll
        for (int d_ = 0; d_ < 4; ++d_)
#pragma unroll
            for (int r = 0; r < 16; ++r) o[d_][r] *= al_l[crow(r, hi)];
        asm volatile("s_waitcnt lgkmcnt(0)" ::: "memory"); }
}
struct DmaOff { unsigned k[2], v[2]; };
__device__ __forceinline__ void dma_offsets(DmaOff& d, int tid) {
#pragma unroll
    for (int i = 0; i < 2; ++i) { const int L = i * 8192 + tid * 16;
        const int row = L >> 8, pos = (L >> 4) & 15, c = pos ^ (row & 7); d.k[i] = (unsigned)(row * 256 + c * 16);
        const int sub = L >> 9, within = L & 511, kk = (sub >> 2) * 8 + (within >> 6), ccol = (within & 63) >> 1, cblk = sub & 3;
        const int k = (kk & ~0xC) | ((kk & 4) << 1) | ((kk & 8) >> 1); d.v[i] = (unsigned)(k * 256 + (cblk * 32 + ccol) * 2); }
}
__device__ __forceinline__ void dma_tile(const DmaOff& d, const bf16* Kp, const bf16* Vp, int key0, LAS unsigned char* buf, int wid) {
    const char* kb = (const char*)(Kp + (size_t)key0 * 128); const char* vb = (const char*)(Vp + (size_t)key0 * 128);
#pragma unroll
    for (int i = 0; i < 2; ++i) {
        __builtin_amdgcn_global_load_lds((const unsigned*)(kb + d.k[i]), (LAS unsigned*)(buf + 16384 + i * 8192 + wid * 1024), 16, 0, 0);
        __builtin_amdgcn_global_load_lds((const unsigned*)(vb + d.v[i]), (LAS unsigned*)(buf + i * 8192 + wid * 1024), 16, 0, 0); }
}
}
constexpr int AL_BUF = 0  , AL_Q = 65536  ;
constexpr int AL_WS = MISC_OFF + 2048  , AL_TBL = AL_WS + 2048  , AL_UNI = AL_TBL + 4 * 320 * 4  , AL_TRI = AL_UNI + 256  , AL_GB = AL_TRI + 2048  , AL_TBL132 = MISC_OFF + 12288  ;
static_assert(AL_Q + 65536 <= RING_BYTES && AL_GB + 128 <= AL_TBL132 && AL_TBL132 + 4 * 132 * 4 <= LDS_BYTES, "attention LDS map");

__device__ __forceinline__ void fill_bias_tbl132(Frame& F, float* tbl, int h0) {
    const float* rb = FIN(I_RELB);
    for (int i = F.tid; i < 4 * 132; i += NTHR) { const int h = i / 132, d = i % 132; const int dd = d > 128 ? 128 : d;
        tbl[i] = (rb[rel_bucket_dev(dd) * 8 + h0 + h] - rb[31 * 8 + h0 + h]) * LOG2E; }
}
__device__ __forceinline__ void fill_bias_tbl(Frame& F, float* tbl, int h0) {
    const float* rb = FIN(I_RELB);
    for (int i = F.tid; i < 4 * 320; i += NTHR) { const int h = i / 320, d = i % 320 - 96;
        tbl[i] = (d >= 0 && d < 113) ? (rb[rel_bucket_dev(d) * 8 + h0 + h] - rb[31 * 8 + h0 + h]) * LOG2E : 0.f; }
}

template <int MODE>
__device__ __forceinline__ void attn_unit(Frame& F, int b, int qt) {
    using namespace att;
    char* lds = F.ldsg;
    int tid = F.tid; asm volatile("" : "+v"(tid));
    const int wid = F.wave, lane = tid & 63, r32 = lane & 31, hi = lane >> 5;
    const int hd = wid & 3, qh = wid >> 2, q0 = qt * 64, tw = q0 + 32 * qh, t = tw + r32;
    const size_t rowg = (size_t)b * SEQ;
    float* wsf = (float*)(lds + AL_WS) + wid * 64; float* li_l = wsf; float* al_l = wsf + 32;
    const float* tbl = (const float*)(lds + AL_TBL) + hd * 320;
    const bf16* Qp = GRP((MODE == 0 ? G_QA : G_QB) + hd) + (rowg + t) * 128;
    const bf16* Kp = (MODE == 0 ? WSP(bf16, WS_AK) : MODE == 1 ? GRP(G_SK) : GRP(G_WK)) + rowg * 128;
    const bf16* Vp = (MODE == 0 ? WSP(bf16, WS_AV) : MODE == 1 ? GRP(G_SV) : GRP(G_WV)) + rowg * 128;
    bf16x8 qr[8];
#pragma unroll
    for (int d0 = 0; d0 < 8; ++d0) qr[d0] = *(const bf16x8*)(Qp + d0 * 16 + hi * 8);
    unsigned long long todo = (qt == 63) ? ~0ull : ((2ull << qt) - 1ull);
    unsigned long long bm64 = 0ull;
    if (MODE == 1) {
        bm64 = WSP(unsigned long long, WS_BLK)[rowg + t];
        volatile LAS unsigned* uni = (volatile LAS unsigned*)(F.lds + AL_UNI);
        if (tid < 2) uni[tid] = 0u;
        __syncthreads();
        __hip_atomic_fetch_or((LAS unsigned*)(F.lds + AL_UNI), (unsigned)bm64, __ATOMIC_RELAXED, __HIP_MEMORY_SCOPE_WORKGROUP);
        __hip_atomic_fetch_or((LAS unsigned*)(F.lds + AL_UNI) + 1, (unsigned)(bm64 >> 32), __ATOMIC_RELAXED, __HIP_MEMORY_SCOPE_WORKGROUP);
        __syncthreads();
        const unsigned long long um = (unsigned long long)uni[0] | ((unsigned long long)uni[1] << 32);
        todo &= um;
    }
    if (MODE == 2) { const int jl = q0 >= 511 ? ((q0 - 511) >> 6) : 0; todo &= ~((1ull << jl) - 1ull); }
    todo = ((unsigned long long)__builtin_amdgcn_readfirstlane((unsigned)todo)) | ((unsigned long long)__builtin_amdgcn_readfirstlane((unsigned)(todo >> 32)) << 32);
    const unsigned* bmrow = WSP(unsigned, WS_BM) + (rowg + t) * 128;
    float m_reg = -1e30f, l_reg = 0.f; f32x16 o[4] = {};
    const int vrb = v_rd_base(lane);
    DmaOff dof; dma_offsets(dof, tid);
    int j = __builtin_ctzll(todo); todo &= todo - 1ull;
    int buf = 0;
    v2u wsel = {0u, 0u}, wnx = {0u, 0u};
    if (MODE == 0) wnx = *(const v2u*)(bmrow + 2 * j);
    dma_tile(dof, Kp, Vp, j * 64, F.lds + AL_BUF, wid);
    for (;;) {
        asm volatile("s_waitcnt vmcnt(0)" ::: "memory");
        __syncthreads();
        const int jn = todo ? __builtin_ctzll(todo) : -1;
        if (MODE == 0) { wsel = wnx; if (jn >= 0) wnx = *(const v2u*)(bmrow + 2 * jn); }
        if (jn >= 0) { todo &= todo - 1ull; dma_tile(dof, Kp, Vp, jn * 64, F.lds + AL_BUF + (buf ^ 1) * 32768, wid); }
        const char* V_lds = lds + AL_BUF + buf * 32768; const char* K_lds = V_lds + 16384;
        const int vb0 = (int)(uintptr_t)(lds + AL_BUF + buf * 32768) + vrb;
        const int kb = j * 64;
        bool act = true;
        if (MODE == 1) act = __any((int)((bm64 >> j) & 1ull));
        if (MODE == 2) act = (kb <= tw + 31) && (kb + 63 >= tw - 511);
        if (MODE == 0) act = (kb <= tw + 31);
        if (act) {
            f32x16 p0, p1;
            qkt(p0, p1, K_lds, r32, hi, qr); SBAR();
            const float NEG = -__builtin_inff();
            const int dq = t - kb - 4 * hi;
            if (tw - (kb + 63) < 128) {
                const float* tp = tbl + (dq + 37);
#pragma unroll
                for (int r = 0; r < 16; ++r) { const int c = (r & 3) + 8 * (r >> 2); p0[r] += tp[59 - c]; p1[r] += tp[27 - c]; }
            }
            if (MODE == 0) {
                const unsigned w0 = wsel.x >> (4 * hi), w1 = wsel.y >> (4 * hi);
#pragma unroll
                for (int r = 0; r < 16; ++r) { const int c = (r & 3) + 8 * (r >> 2);
                    if (!((w0 >> c) & 1u)) p0[r] = NEG;
                    if (!((w1 >> c) & 1u)) p1[r] = NEG; }
            } else {
                const unsigned W = (MODE == 2) ? 512u : 0x7fffffffu;
                const bool rowsel = (MODE == 1) ? (((bm64 >> j) & 1ull) != 0ull) : true;
#pragma unroll
                for (int r = 0; r < 16; ++r) { const int c = (r & 3) + 8 * (r >> 2);
                    if (!rowsel || (unsigned)(dq - c) >= W) p0[r] = NEG;
                    if (!rowsel || (unsigned)(dq - c - 32) >= W) p1[r] = NEG; }
            }
            SBAR(); softmax_step(p0, p1, m_reg, l_reg, o, al_l, r32, hi); SBAR();
            bf16x8 pa0, pa1, pa2, pa3;
            pack_p(p0, p1, pa0, pa1, pa2, pa3); SBAR();
            pv_tile(o, vb0, pa0, pa1, pa2, pa3); SBAR();
        }
        if (jn < 0) break;
        j = jn; buf ^= 1;
    }
    {
        float fac = l_reg > 0.f ? 1.0f / l_reg : 0.f;
        if (MODE != 0) { const float gl = bf2f(GRP(G_MISC)[(rowg + t) * 128 + 68 + MODE * 4 + hd]); fac *= 1.0f / (1.0f + __expf(-gl)); }
        if (hi == 0) li_l[r32] = fac;
        asm volatile("s_waitcnt lgkmcnt(0)" ::: "memory");
        float rli[16];
#pragma unroll
        for (int r = 0; r < 16; ++r) rli[r] = li_l[crow(r, hi)];
        const size_t row0 = rowg + tw;
        if (MODE == 1) {
            const float* OCp = WSP(float, WS_OC) + row0 * 512 + hd * 128; float* OC2p = WSP(float, WS_OC2) + row0 * 512 + hd * 128;
#pragma unroll
            for (int r = 0; r < 16; ++r) { const int orow = crow(r, hi);
#pragma unroll
                for (int d0 = 0; d0 < 4; ++d0) { const size_t ix = (size_t)orow * 512 + d0 * 32 + r32; OC2p[ix] = OCp[ix] + o[d0][r] * rli[r]; } }
        } else {
            bf16* Op = WSP(bf16, WS_O) + row0 * DM + (MODE == 2 ? 512 : 0) + hd * 128;
            const float* OCp = WSP(float, WS_OC2) + row0 * 512 + hd * 128;
#pragma unroll
            for (int r = 0; r < 16; ++r) { const int orow = crow(r, hi);
#pragma unroll
                for (int d0 = 0; d0 < 4; ++d0) { float v = o[d0][r] * rli[r];
                    if (MODE == 2) v += OCp[(size_t)orow * 512 + d0 * 32 + r32];
                    const float vn = __shfl_xor(v, 1);
                    if ((r32 & 1) == 0) *(unsigned*)(Op + (size_t)orow * DM + d0 * 32 + r32) = cvtpk(v, vn); } }
        }
    }
    __syncthreads();
}
__device__ __forceinline__ float idx_k2f(unsigned k) { return __uint_as_float((k & 0x80000000u) ? (k & 0x7fffffffu) : ~k); }
__device__ __forceinline__ unsigned idx_f2k(float f) { const unsigned u = __float_as_uint(f); return (u >> 31) ? ~u : (u | 0x80000000u); }
__device__ __forceinline__ unsigned half_sum_dpp(unsigned x) {
    x += (unsigned)__builtin_amdgcn_update_dpp(0, (int)x, 0x111, 0xf, 0xf, true);
    x += (unsigned)__builtin_amdgcn_update_dpp(0, (int)x, 0x112, 0xf, 0xf, true);
    x += (unsigned)__builtin_amdgcn_update_dpp(0, (int)x, 0x114, 0xf, 0xf, true);
    x += (unsigned)__builtin_amdgcn_update_dpp(0, (int)x, 0x118, 0xf, 0xf, true);
    x += (unsigned)__builtin_amdgcn_update_dpp(0, (int)x, 0x142, 0xa, 0xf, true);
    return x;
}
constexpr int IL_CAND = MISC_OFF + 2048, IL_HIST = IL_CAND + 4096;
__device__ __forceinline__ unsigned wave_sum_dpp63(unsigned x) {
    x = half_sum_dpp(x); x += (unsigned)__builtin_amdgcn_update_dpp(0, (int)x, 0x143, 0xc, 0xf, true); return (unsigned)__builtin_amdgcn_readlane((int)x, 63); }
__device__ __forceinline__ void idx_unit(Frame& F, int b, int tq, unsigned sub) {
    int tid = F.tid; asm volatile("" : "+v"(tid));
    const int wid = F.wave, lane = tid & 63, r32 = lane & 31, hi = lane >> 5;
    const int t0 = tq * 8; const size_t rowg = (size_t)b * SEQ;
    unsigned* bmrow = WSP(unsigned, WS_BM) + (rowg + t0) * 128;
    const int NT = 2 * (t0 >> 6) + 2;
    if (t0 + 8 <= 256) {
        for (int i = tid; i < 8 * NT; i += NTHR) { const int q = i / NT, wd = i % NT, t = t0 + q, lo = wd * 32;
            const unsigned word = (t >= lo + 31) ? 0xffffffffu : (t < lo ? 0u : ((2u << (t - lo)) - 1u)); bmrow[q * 128 + wd] = word; }
        return;
    }
    LAS unsigned* S = (LAS unsigned*)F.lds;
    const bf16* misc = GRP(G_MISC);
    {
        bf16x8 aq[4];
        { const int ql = r32 >> 2, h = r32 & 3; const bf16* p = GRP(G_IQ + (h >> 1)) + (rowg + t0 + ql) * 128 + (h & 1) * 64 + hi * 8;
#pragma unroll
          for (int c = 0; c < 4; ++c) aq[c] = *(const bf16x8*)(p + c * 16); }
        float wq[4][4];
#pragma unroll
        for (int qj = 0; qj < 4; ++qj) { const v2u w = *(const v2u*)(misc + (rowg + t0 + 2 * qj + hi) * 128 + 64);
            wq[qj][0] = __uint_as_float(w.x << 16); wq[qj][1] = __uint_as_float(w.x & 0xffff0000u); wq[qj][2] = __uint_as_float(w.y << 16); wq[qj][3] = __uint_as_float(w.y & 0xffff0000u); }
#define IDX_LOAD(g, u0) do { _Pragma("unroll") for (int u = (u0); u < (u0) + 2; ++u) { int tile = wid + 8 * (4 * (g) + u); tile = tile < NT ? tile : NT - 1; const bf16* kp = misc + (rowg + tile * 32 + r32) * 128 + hi * 8; \
            _Pragma("unroll") for (int c = 0; c < 4; ++c) bk[u][c] = *(const bf16x8*)(kp + c * 16); } } while (0)
#define IDX_MMA(u0) do { _Pragma("unroll") for (int u = 0; u < 2; ++u) { acc[u] = f32x16{}; \
            _Pragma("unroll") for (int c = 0; c < 4; ++c) acc[u] = __builtin_amdgcn_mfma_f32_32x32x16_bf16(aq[c], bk[(u0) + u][c], acc[u], 0, 0, 0); } } while (0)
#define IDX_COMB(g, u0) do { _Pragma("unroll") for (int u = 0; u < 2; ++u) { const int tile = wid + 8 * (4 * (g) + (u0) + u), kb = tile * 32; \
            if (tile < NT) { _Pragma("unroll") for (int qj = 0; qj < 4; ++qj) { float s = 0.f; \
                _Pragma("unroll") for (int h = 0; h < 4; ++h) s = fmaf(fmaxf(acc[u][4 * qj + h], 0.f), wq[qj][h], s); \
                S[(2 * qj + hi) * 4096 + kb + r32] = (kb + r32 <= t0 + 2 * qj + hi) ? idx_f2k(s) : 0u; } } } } while (0)
#pragma unroll 1
        for (int rk = 0; rk < 1 + (int)(sub & 1u); ++rk) {
            bf16x8 bk[4][4]; f32x16 acc[2];
            IDX_LOAD(0, 0); IDX_LOAD(0, 2);
#pragma unroll
            for (int g = 0; g < 4; ++g) if (wid + 32 * g < NT) { const bool nx = g < 3 && wid + 32 * (g + 1) < NT;
                IDX_MMA(0); SBAR(); if (nx) IDX_LOAD(g + 1, 0); SBAR(); IDX_COMB(g, 0); SBAR();
                IDX_MMA(2); SBAR(); if (nx) IDX_LOAD(g + 1, 2); SBAR(); IDX_COMB(g, 2); SBAR(); }
        }
#undef IDX_LOAD
#undef IDX_MMA
#undef IDX_COMB
    }
    __syncthreads();
    const int t = t0 + wid, NJ = (t >> 6) + 1;
    unsigned kreg[64];
#pragma unroll
    for (int j = 0; j < 64; ++j) { const unsigned v = S[wid * 4096 + 64 * j + lane]; kreg[j] = (j < NJ) ? v : 0u; }
    const int NG = (NJ + 15) >> 4;
    unsigned lo = 1u, hi_ = 0xffffffffu, clo = (unsigned)(t + 1), chi = 0u; float wlo = 0.f, whi = 0.f; int last = 0;
#pragma unroll 1
    for (int rs = 0; rs < 1 + (int)((sub >> 1) & 1u); ++rs) {
    {
        LAS unsigned* hist = (LAS unsigned*)(F.lds + IL_HIST) + wid * 256;
        *(LAS v4u*)(hist + 4 * lane) = (v4u){0u, 0u, 0u, 0u};
        asm volatile("s_waitcnt lgkmcnt(0)" ::: "memory");
#pragma unroll
        for (int g = 0; g < 4; ++g) if (g < NG) {
#pragma unroll
            for (int j = 0; j < 16; ++j) { const unsigned k = kreg[16 * g + j];
                if (k) { int b_ = (int)floorf(idx_k2f(k)) + 128; b_ = b_ < 0 ? 0 : (b_ > 255 ? 255 : b_); __hip_atomic_fetch_add(hist + (255 - b_), 1u, __ATOMIC_RELAXED, __HIP_MEMORY_SCOPE_WAVEFRONT); } } }
        asm volatile("s_waitcnt lgkmcnt(0)" ::: "memory");
        const v4u h4 = *(LAS v4u*)(hist + 4 * lane);
        unsigned pre = h4.x + h4.y + h4.z + h4.w;
        pre += (unsigned)__builtin_amdgcn_update_dpp(0, (int)pre, 0x111, 0xf, 0xf, true);
        pre += (unsigned)__builtin_amdgcn_update_dpp(0, (int)pre, 0x112, 0xf, 0xf, true);
        pre += (unsigned)__builtin_amdgcn_update_dpp(0, (int)pre, 0x114, 0xf, 0xf, true);
        pre += (unsigned)__builtin_amdgcn_update_dpp(0, (int)pre, 0x118, 0xf, 0xf, true);
        pre += (unsigned)__builtin_amdgcn_update_dpp(0, (int)pre, 0x142, 0xa, 0xf, true);
        pre += (unsigned)__builtin_amdgcn_update_dpp(0, (int)pre, 0x143, 0xc, 0xf, true);
        const unsigned long long ge = __ballot(pre >= 256u);
        const int L = __builtin_ctzll(ge);
        const unsigned pL = (unsigned)__builtin_amdgcn_readlane((int)pre, L);
        const unsigned b0 = (unsigned)__builtin_amdgcn_readlane((int)h4.x, L), b1 = (unsigned)__builtin_amdgcn_readlane((int)h4.y, L), b2 = (unsigned)__builtin_amdgcn_readlane((int)h4.z, L), b3 = (unsigned)__builtin_amdgcn_readlane((int)h4.w, L);
        unsigned above = pL - (b0 + b1 + b2 + b3); int bsel = 4 * L; unsigned cb = b0;
        if (above + cb < 256u) { above += cb; cb = b1; bsel = 4 * L + 1; if (above + cb < 256u) { above += cb; cb = b2; bsel = 4 * L + 2; if (above + cb < 256u) { above += cb; cb = b3; bsel = 4 * L + 3; } } }
        const int B = 255 - bsel;
        lo = B == 0 ? 1u : idx_f2k((float)(B - 128)); hi_ = B == 255 ? 0xffffffffu : idx_f2k((float)(B - 127));
        chi = above; clo = above + cb;
    }
    wlo = (float)clo - 255.5f; whi = (float)chi - 255.5f; last = 0;
#pragma unroll 1
    for (int it = 0; it < 72; ++it) {
        if (clo - chi <= 64u || hi_ - lo == 1u) break;
        unsigned mid;
        { const float lf = idx_k2f(lo), hf = idx_k2f(hi_); float mf = lf + (hf - lf) * (wlo / (wlo - whi));
          mid = idx_f2k(mf);
          if (it >= 36 || !(fabsf(lf) < 1e30f && fabsf(hf) < 1e30f)) mid = lo + ((hi_ - lo) >> 1);
          mid = mid <= lo ? lo + 1u : (mid >= hi_ ? hi_ - 1u : mid);
          mid = (unsigned)__builtin_amdgcn_readfirstlane((int)mid); }
        unsigned cnt = 0u;
#pragma unroll
        for (int g = 0; g < 4; ++g) if (g < NG) {
#pragma unroll
            for (int j = 0; j < 16; ++j) cnt += (kreg[16 * g + j] >= mid) ? 1u : 0u; }
        const unsigned tot = wave_sum_dpp63(cnt);
        if (tot >= 256u) { lo = mid; clo = tot; wlo = (float)tot - 255.5f; if (last == 1) whi *= 0.5f; last = 1; }
        else { hi_ = mid; chi = tot; whi = (float)tot - 255.5f; if (last == 2) wlo *= 0.5f; last = 2; }
    }
    }
    unsigned T = lo; int J = 0x7fffffff; bool tie = true;
    const int need = 256 - (int)chi;
    if (clo - chi <= 64u) {
        volatile LAS unsigned* cand = (volatile LAS unsigned*)(F.lds + IL_CAND) + wid * 128;
        int pos = 0;
#pragma unroll
        for (int j = 0; j < 64; ++j) if ((j >> 4) < NG) { const unsigned kq = kreg[j]; const bool inb = kq >= lo && kq < hi_; const unsigned long long bal = __ballot(inb);
            if (bal) { const int slot = pos + __builtin_amdgcn_mbcnt_hi((unsigned)(bal >> 32), __builtin_amdgcn_mbcnt_lo((unsigned)bal, 0u));
                if (inb) { cand[2 * slot] = kreg[j]; cand[2 * slot + 1] = (unsigned)(64 * j + lane); } pos += __popcll(bal); } }
        const int m = pos;
        asm volatile("s_waitcnt lgkmcnt(0)" ::: "memory");
        const unsigned ki = lane < m ? cand[2 * lane] : 0u; const unsigned ii = lane < m ? cand[2 * lane + 1] : 0u;
        int rk = 0;
        for (int jx = 0; jx < m; ++jx) { const unsigned kj = (unsigned)__builtin_amdgcn_readlane((int)ki, jx), ij = (unsigned)__builtin_amdgcn_readlane((int)ii, jx); rk += (kj > ki || (kj == ki && ij < ii)) ? 1 : 0; }
        const unsigned long long hit = __ballot(lane < m && rk == need - 1);
        const int src = hit ? __builtin_ctzll(hit) : 0;
        T = (unsigned)__builtin_amdgcn_readlane((int)ki, src); J = (int)__builtin_amdgcn_readlane((int)ii, src);
        tie = __builtin_popcountll(__ballot(lane < m && ki == T)) != 1;
    } else if (clo > 256u) {
        int ilo = -1, ihi = t;
        for (int it = 0; it < 16 && ihi - ilo > 1; ++it) { const int imid = (ilo + ihi) >> 1; unsigned cnt = 0u;
#pragma unroll
            for (int j = 0; j < 64; ++j) if ((j >> 4) < NG) cnt += (kreg[j] == T && 64 * j + lane <= imid) ? 1u : 0u;
            const int tot = (int)wave_sum_dpp63(cnt);
            if (tot >= need) ihi = imid; else ilo = imid; }
        J = ihi;
    }
    unsigned long long w64 = 0ull;
    if (!tie) {
        int wl = 0, wh = 0;
#pragma unroll
        for (int j = 0; j < 64; ++j) if ((j >> 4) < NG) { const unsigned long long bal = __ballot(kreg[j] >= T); asm volatile("s_nop 4\n\tv_writelane_b32 %0, %2, %4\n\tv_writelane_b32 %1, %3, %4" : "+v"(wl), "+v"(wh) : "s"((unsigned)bal), "s"((unsigned)(bal >> 32)), "n"(j)); }
        w64 = (unsigned long long)(unsigned)wl | ((unsigned long long)(unsigned)wh << 32);
    } else {
#pragma unroll
        for (int j = 0; j < 64; ++j) if ((j >> 4) < NG) { const unsigned k = kreg[j]; const unsigned long long bal = __ballot(k > T || (k == T && 64 * j + lane <= J)); if (lane == j) w64 = bal; }
    }
    if (lane < NJ) *(unsigned long long*)(bmrow + wid * 128 + 2 * lane) = w64;
    __syncthreads();
}

__device__ __forceinline__ float gelu_tanh(float x) { const float y = 0.7978845608028654f * (x + 0.044715f * x * x * x); const float e = __expf(2.0f * y); return 0.5f * x * (2.0f - 2.0f / (1.0f + e)); }
__device__ __forceinline__ void cmp_finalize_item(Frame& F, int b, int j, int rc) {
    float* hid = (float*)F.ldsg + 2048;
    const float* W2 = FIN(I_EV_CW2) + (size_t)j * 128 * 128;
    const float* UV = WSP(float, WS_UV) + ((size_t)j * 2048 + (size_t)b * 256) * 256; const float* UVb = WSP(float, WS_UVB) + ((size_t)j * 2048 + (size_t)b * 256) * 256;
    const float* cbp = WSP(float, WS_TAB) + (size_t)j * 16 * 128;
    const int n0 = rc * 16;
    for (int i = F.tid; i < 16 * 128; i += NTHR) { const int r = i >> 7, c = i & 127, n = n0 + r;
        float cbv = 0.f;
#pragma unroll
        for (int q = 0; q < 16; ++q) cbv += cbp[q * 128 + c];
        float v = 0.f; if (n < 255) v = gelu_tanh((UV[(size_t)n * 256 + c] + UVb[(size_t)n * 256 + c]) + (UV[(size_t)(n + 1) * 256 + 128 + c] + UVb[(size_t)(n + 1) * 256 + 128 + c]) + cbv);
        hid[i] = v; }
    __syncthreads();
    const int c2 = F.tid & 127, rg = F.tid >> 7;
    float acc[4] = {0.f, 0.f, 0.f, 0.f};
#pragma unroll 4
    for (int c = 0; c < 128; ++c) { const float w = W2[c * 128 + c2];
#pragma unroll
        for (int q = 0; q < 4; ++q) acc[q] = fmaf(hid[(rg + 4 * q) * 128 + c], w, acc[q]); }
#pragma unroll
    for (int q = 0; q < 4; ++q) { const int n = n0 + rg + 4 * q; const float a = n >= 255 ? 0.f : acc[q];
        if (j == 0) WSP(bf16, WS_CK)[((size_t)b * 256 + n) * 128 + c2] = (bf16)f2bf(a);
        else WSP(bf16, WS_CV)[((size_t)b * 256 + n) * 128 + c2] = (bf16)f2bf(a); }
    __syncthreads();
}
constexpr int CL_S = 0;
constexpr int CL_P = 64 * 260 * 4;
constexpr int CL_IMP = CL_P + 64 * 264 * 2;
constexpr int CL_TBL = CL_IMP + 16 * 64 * 4;
static_assert(CL_TBL + 4 * 132 * 4 <= RING_BYTES, "cmp LDS map");
__device__ __forceinline__ void cmp_unit(Frame& F, int b, int qt16, unsigned sub) {
    char* lds = F.ldsg;
    float* S = (float*)(lds + CL_S); bf16* Pb = (bf16*)(lds + CL_P); float* impL = (float*)(lds + CL_IMP); const float* tbl = (const float*)(lds + CL_TBL);
    int tid = F.tid; asm volatile("" : "+v"(tid));
    const int wid = F.wave, lane = tid & 63, l15 = lane & 15, l4 = lane >> 4;
    const int q0 = qt16 * 16; const size_t rowg = (size_t)b * SEQ;
#pragma unroll 1
    for (int r1 = 0; r1 < 1 + (int)(sub & 1u); ++r1) {
    {
        const int rb = wid & 3;
        const bf16* qp = GRP(G_QB + rb) + (rowg + q0 + l15) * 128 + l4 * 8;
        bf16x8 qa[4];
#pragma unroll
        for (int c = 0; c < 4; ++c) qa[c] = *(const bf16x8*)(qp + c * 32);
        const bf16* ckb = WSP(bf16, WS_CK) + (size_t)b * 256 * 128;
#pragma unroll
        for (int i = 0; i < 8; ++i) { const int kb = (wid >> 2) * 8 + i;
            const bf16* kp = ckb + (size_t)(kb * 16 + l15) * 128 + l4 * 8;
            f32x4 acc = {0.f, 0.f, 0.f, 0.f};
#pragma unroll
            for (int c = 0; c < 4; ++c) { const bf16x8 bk = *(const bf16x8*)(kp + c * 32); acc = __builtin_amdgcn_mfma_f32_16x16x32_bf16(qa[c], bk, acc, 0, 0, 0); }
            const int n = kb * 16 + l15, kend = 16 * n + 31;
#pragma unroll
            for (int jj = 0; jj < 4; ++jj) { const int ql = l4 * 4 + jj, t = q0 + ql; int d = t - kend; const bool valid = (d >= 0) && (n < 255); d = d < 0 ? 0 : (d > 128 ? 128 : d);
                S[(rb * 16 + ql) * 260 + n] = valid ? acc[jj] + tbl[rb * 132 + d] : -__builtin_inff(); } }
    }
    __syncthreads();
#pragma unroll 1
    for (int rr = 0; rr < 8; ++rr) { const int row = wid * 8 + rr;
        f32x4 v = *(const f32x4*)(S + row * 260 + lane * 4);
        const float mx = wave_max(fmaxf(fmaxf(v[0], v[1]), fmaxf(v[2], v[3])));
        f32x4 p = {0.f, 0.f, 0.f, 0.f};
        if (mx > -1e37f) { p[0] = __builtin_amdgcn_exp2f(v[0] - mx); p[1] = __builtin_amdgcn_exp2f(v[1] - mx); p[2] = __builtin_amdgcn_exp2f(v[2] - mx); p[3] = __builtin_amdgcn_exp2f(v[3] - mx);
            const float inv = 1.0f / wave_sum((p[0] + p[1]) + (p[2] + p[3])); p = p * inv; }
        *(f32x4*)(S + row * 260 + lane * 4) = p;
        *(v2u*)(Pb + row * 264 + lane * 4) = (v2u){cvtpk(p[0], p[1]), cvtpk(p[2], p[3])}; }
    __syncthreads();
    }
#pragma unroll 1
    for (int r3 = 0; r3 < 1 + (int)((sub >> 1) & 1u); ++r3) {
    for (int i = tid; i < 16 * 64; i += NTHR) { const int q = i >> 6, m = i & 63; float s = 0.f;
#pragma unroll
        for (int h = 0; h < 4; ++h)
#pragma unroll
            for (int dn = -1; dn <= 3; ++dn) { const int n = 4 * m + dn; if (n >= 0 && n < 255) s += S[(h * 16 + q) * 260 + n]; }
        impL[i] = s; }
    __syncthreads();
#pragma unroll 1
    for (int qq = 0; qq < 2; ++qq) { const int q = wid * 2 + qq, t = q0 + q, cur = t >> 6, m = lane;
        const bool forced = (m == 0) || (m == cur) || (m == cur - 1);
        const bool cand = !forced && (m < cur);
        float val = cand ? impL[q * 64 + m] : -__builtin_inff();
        bool sel = forced;
        const int picks = 8 - __popcll(__ballot(forced));
        for (int p = 0; p < picks; ++p) { const float vm = wave_max(val); if (!(vm > -__builtin_inff())) break;
            const unsigned long long win = __ballot(val == vm); const int first = __builtin_ctzll(win);
            if (lane == first) { sel = true; val = -__builtin_inff(); } }
        const unsigned long long msk = __ballot(sel);
        if (lane == 0) WSP(unsigned long long, WS_BLK)[rowg + t] = msk; }
    }
#pragma unroll 1
    for (int r5 = 0; r5 < 1 + (int)((sub >> 2) & 1u); ++r5)
    {
        const int rb = wid & 3;
        const bf16* cvt = WSP(bf16, WS_CVT) + (size_t)b * 128 * 256;
        float g0[4];
#pragma unroll
        for (int jj = 0; jj < 4; ++jj) { const float gl = bf2f(GRP(G_MISC)[(rowg + q0 + l4 * 4 + jj) * 128 + 68 + rb]); g0[jj] = 1.0f / (1.0f + __expf(-gl)); }
#pragma unroll
        for (int i = 0; i < 4; ++i) { const int db = (wid >> 2) * 4 + i;
            f32x4 acc = {0.f, 0.f, 0.f, 0.f};
#pragma unroll
            for (int kc = 0; kc < 8; ++kc) { const bf16x8 pa = *(const bf16x8*)(Pb + (rb * 16 + l15) * 264 + kc * 32 + l4 * 8);
                const bf16x8 vb = *(const bf16x8*)(cvt + (size_t)(db * 16 + l15) * 256 + kc * 32 + l4 * 8);
                acc = __builtin_amdgcn_mfma_f32_16x16x32_bf16(pa, vb, acc, 0, 0, 0); }
#pragma unroll
            for (int jj = 0; jj < 4; ++jj) WSP(float, WS_OC)[(rowg + q0 + l4 * 4 + jj) * 512 + rb * 128 + db * 16 + l15] = acc[jj] * g0[jj]; }
    }
    __syncthreads();
}

constexpr int CL2_IMP = 65536;
__device__ __forceinline__ void cmp_unit64(Frame& F, int b, int qt) {
    using namespace att;
    char* lds = F.ldsg;
    int tid = F.tid; asm volatile("" : "+v"(tid));
    const int wid = F.wave, lane = tid & 63, r32 = lane & 31, hi = lane >> 5;
    const int hd = wid & 3, qh = wid >> 2, q0 = qt * 64, tw = q0 + 32 * qh, t = tw + r32;
    const size_t rowg = (size_t)b * SEQ;
    float* wsf = (float*)(lds + AL_WS) + wid * 64; float* li_l = wsf;
    const float* tbl = (const float*)(lds + AL_TBL132) + hd * 132;
    float* impW = (float*)(lds + CL2_IMP);
    const bf16* Qp = GRP(G_QB + hd) + (rowg + t) * 128;
    const bf16* Kp = WSP(bf16, WS_CK) + (size_t)b * 256 * 128; const bf16* Vp = WSP(bf16, WS_CV) + (size_t)b * 256 * 128;
    bf16x8 qr[8];
#pragma unroll
    for (int d0 = 0; d0 < 8; ++d0) qr[d0] = *(const bf16x8*)(Qp + d0 * 16 + hi * 8);
    const int vrb = v_rd_base(lane);
    DmaOff dof; dma_offsets(dof, tid);
    float m_reg = -1e30f, l_reg = 0.f;
    const float NEG = -__builtin_inff();
#define CMP_SCORES(j) \
            const char* V_lds = lds + AL_BUF + buf * 32768; const char* K_lds = V_lds + 16384; \
            f32x16 p0, p1; \
            qkt(p0, p1, K_lds, r32, hi, qr); SBAR(); \
            if (16 * (64 * (j) + 63) + 31 + 128 > tw) {            \
                _Pragma("unroll") for (int rq = 0; rq < 4; ++rq) { \
                    _Pragma("unroll") for (int ri = 0; ri < 4; ++ri) { const int r = 4 * rq + ri; const int n0 = 64 * (j) + (r & 3) + 8 * (r >> 2) + 4 * hi, n1 = n0 + 32; \
                        int d0 = t - (16 * n0 + 31), d1 = t - (16 * n1 + 31); \
                        const bool v0 = d0 >= 0, v1 = d1 >= 0 && n1 < 255; \
                        d0 = d0 < 0 ? 0 : (d0 > 128 ? 128 : d0); d1 = d1 < 0 ? 0 : (d1 > 128 ? 128 : d1); \
                        p0[r] = v0 ? p0[r] + tbl[d0] : NEG; p1[r] = v1 ? p1[r] + tbl[d1] : NEG; } \
                    SBAR(); } \
            } else if ((j) == 3) { if (hi == 1) p1[15] = NEG; }    \
            SBAR();
    {
        int buf = 0;
        dma_tile(dof, Kp, Vp, 0, F.lds + AL_BUF, wid);
#pragma unroll 1
        for (int j = 0; j < 4; ++j) {
            asm volatile("s_waitcnt vmcnt(0)" ::: "memory");
            __syncthreads();
            dma_tile(dof, Kp, Vp, ((j + 1) & 3) * 64, F.lds + AL_BUF + (buf ^ 1) * 32768, wid);
            CMP_SCORES(j)
            float pmax = p0[0];
#pragma unroll
            for (int r = 1; r < 16; ++r) pmax = fmaxf(pmax, p0[r]);
#pragma unroll
            for (int r = 0; r < 16; ++r) pmax = fmaxf(pmax, p1[r]);
            pmax = xhalf_max(pmax);
            const float mn = fmaxf(m_reg, pmax); float ps = 0.f;
#pragma unroll
            for (int r = 0; r < 16; ++r) ps += __builtin_amdgcn_exp2f(p0[r] - mn) + __builtin_amdgcn_exp2f(p1[r] - mn);
            ps = xhalf_sum(ps);
            l_reg = l_reg * __builtin_amdgcn_exp2f(m_reg - mn) + ps; m_reg = mn;
            buf ^= 1;
        }
    }
    const float inv_l = l_reg > 0.f ? 1.0f / l_reg : 0.f;
    float carry = 0.f; f32x16 o[4] = {};
    {
        int buf = 0;
#pragma unroll 1
        for (int j = 0; j < 4; ++j) {
            asm volatile("s_waitcnt vmcnt(0)" ::: "memory");
            __syncthreads();
            if (j < 3) dma_tile(dof, Kp, Vp, (j + 1) * 64, F.lds + AL_BUF + (buf ^ 1) * 32768, wid);
            CMP_SCORES(j)
            const int vb0 = (int)(uintptr_t)(lds + AL_BUF + buf * 32768) + vrb;
#pragma unroll
            for (int r = 0; r < 16; ++r) { p0[r] = __builtin_amdgcn_exp2f(p0[r] - m_reg) * inv_l; p1[r] = __builtin_amdgcn_exp2f(p1[r] - m_reg) * inv_l; }
            float oa[4], ob[4];
#pragma unroll
            for (int g = 0; g < 4; ++g) { auto ra = __builtin_amdgcn_permlane32_swap(__float_as_uint(p0[4 * g + 3]), __float_as_uint(p0[4 * g + 3]), false, false);
                auto rb = __builtin_amdgcn_permlane32_swap(__float_as_uint(p1[4 * g + 3]), __float_as_uint(p1[4 * g + 3]), false, false);
                oa[g] = __uint_as_float(hi ? ra[0] : ra[1]); ob[g] = __uint_as_float(hi ? rb[0] : rb[1]); }
            float* iw = impW + ((size_t)hd * 64 + 32 * qh + r32) * 64 + 16 * j + hi;
#pragma unroll
            for (int g = 0; g < 4; ++g) {
                const float pla = hi ? oa[g] : (g > 0 ? oa[g - 1] : carry);
                const float plb = hi ? ob[g] : (g > 0 ? ob[g - 1] : oa[3]);
                iw[2 * g] = ((p0[4 * g] + p0[4 * g + 1]) + (p0[4 * g + 2] + p0[4 * g + 3])) + pla;
                iw[8 + 2 * g] = ((p1[4 * g] + p1[4 * g + 1]) + (p1[4 * g + 2] + p1[4 * g + 3])) + plb; }
            carry = ob[3];
            bf16x8 pa0, pa1, pa2, pa3;
            pack_p(p0, p1, pa0, pa1, pa2, pa3); SBAR();
            pv_tile(o, vb0, pa0, pa1, pa2, pa3); SBAR();
            buf ^= 1;
        }
    }
#undef CMP_SCORES
    __syncthreads();
#pragma unroll 1
    for (int qq = 0; qq < 8; ++qq) { const int q = wid * 8 + qq, tq = q0 + q, cur = tq >> 6, m = lane;
        const bool forced = (m == 0) || (m == cur) || (m == cur - 1);
        const bool cand = !forced && (m < cur);
        float val = cand ? ((impW[(0 * 64 + q) * 64 + m] + impW[(1 * 64 + q) * 64 + m]) + (impW[(2 * 64 + q) * 64 + m] + impW[(3 * 64 + q) * 64 + m])) : -__builtin_inff();
        bool sel = forced;
        const int picks = 8 - __popcll(__ballot(forced));
        for (int p = 0; p < picks; ++p) { const float vm = wave_max(val); if (!(vm > -__builtin_inff())) break;
            const unsigned long long win = __ballot(val == vm); const int first = __builtin_ctzll(win);
            if (lane == first) { sel = true; val = -__builtin_inff(); } }
        const unsigned long long msk = __ballot(sel);
        if (lane == 0) WSP(unsigned long long, WS_BLK)[rowg + tq] = msk; }
    {
        const float gl = bf2f(GRP(G_MISC)[(rowg + t) * 128 + 68 + hd]);
        if (hi == 0) li_l[r32] = 1.0f / (1.0f + __expf(-gl));
        asm volatile("s_waitcnt lgkmcnt(0)" ::: "memory");
        float* OCp = WSP(float, WS_OC) + (rowg + tw) * 512 + hd * 128;
#pragma unroll
        for (int r = 0; r < 16; ++r) { const int orow = crow(r, hi); const float g0 = li_l[orow];
#pragma unroll
            for (int d0 = 0; d0 < 4; ++d0) OCp[(size_t)orow * 512 + d0 * 32 + r32] = o[d0][r] * g0; }
    }
    __syncthreads();
}
__device__ __forceinline__ void stick_unit(Frame& F, int b, int h, int qb) {
    using namespace att;
    char* lds = F.ldsg;
    int tid = F.tid; asm volatile("" : "+v"(tid));
    const int wid = F.wave, lane = tid & 63, r32 = lane & 31, hi = lane >> 5;
    const size_t rowg = (size_t)b * SEQ;
    const int tw = qb * 256 + wid * 32, t = tw + r32;
    const bf16* Qp = QKVG(h) + (rowg + t) * 128;
    const bf16* Kp = QKVG(8 + h) + rowg * 128;
    const bf16* Vp = QKVG(16 + h) + rowg * 128;
    char* Qw = lds + AL_Q + wid * 8192;
#pragma unroll
    for (int d0 = 0; d0 < 8; ++d0) { const bf16x8 v = *(const bf16x8*)(Qp + d0 * 16 + hi * 8); *(bf16x8*)(Qw + KSWZ(r32, (d0 * 16 + hi * 8) * 2)) = v; }
    asm volatile("s_waitcnt lgkmcnt(0)" ::: "memory");
    {
        bf16x8 trd0, trd1;
#pragma unroll
        for (int jj = 0; jj < 8; ++jj) { const int k0 = 8 * (jj >> 2) + 4 * hi + (jj & 3);
            trd0[jj] = (short)((k0 >= r32) ? 0x3F80 : 0); trd1[jj] = (short)((16 + k0 >= r32) ? 0x3F80 : 0); }
        if (wid == 0) { *(bf16x8*)(lds + AL_TRI + lane * 32) = trd0; *(bf16x8*)(lds + AL_TRI + lane * 32 + 16) = trd1; }
    }
    const bf16x8 ones = {(short)0x3F80, (short)0x3F80, (short)0x3F80, (short)0x3F80, (short)0x3F80, (short)0x3F80, (short)0x3F80, (short)0x3F80};
    f32x16 o[4] = {};
    float carry = 0.f;
    const int vrb = v_rd_base(lane);
    DmaOff dof; dma_offsets(dof, tid);
    int j = qb * 4 + 3, buf = 0;
    bool wdone = false; int par = 0;
    volatile LAS unsigned* fl = (volatile LAS unsigned*)(F.lds + AL_UNI + 64);
    dma_tile(dof, Kp, Vp, j * 64, F.lds + AL_BUF, wid);
    for (;;) {
        if (lane == 0) fl[par * 8 + wid] = wdone ? 1u : 0u;
        asm volatile("s_waitcnt vmcnt(0)" ::: "memory");
        __syncthreads();
        { unsigned a = 1u;
#pragma unroll
          for (int w = 0; w < 8; ++w) a &= fl[par * 8 + w];
          par ^= 1; if (a) break; }
        if (j > 0) dma_tile(dof, Kp, Vp, (j - 1) * 64, F.lds + AL_BUF + (buf ^ 1) * 32768, wid);
        const char* K_lds = lds + AL_BUF + buf * 32768 + 16384;
        const int vb0 = (int)(uintptr_t)(lds + AL_BUF + buf * 32768) + vrb;
        const int kb = j * 64;
        if (!wdone && kb < tw + 32) {
            f32x16 s0, s1;
            qkt_lq(s0, s1, K_lds, Qw, r32, hi);
            const int dq = t - kb - 4 * hi;
            const bool diag = (kb + 63 >= tw);
            bf16x8 cb0, cb1, cb2, cb3; float csum = 0.f;
#define ST_C(ZV, OFF, R) ({ const int c_ = ((R) & 3) + 8 * ((R) >> 2); float z_ = ZV[R]; \
                float a_ = -__builtin_amdgcn_logf(1.0f + __builtin_amdgcn_exp2f(fminf(z_, 126.f))); a_ = fminf(a_, -z_); \
                if (diag && (dq - c_ - (OFF) < 1)) { a_ = 0.f; z_ = -__builtin_inff(); } \
                csum += a_; ZV[R] = z_ + carry; a_; })
#define ST_PK(ZV, OFF, B_) ({ v4u w_; { const float e0 = ST_C(ZV, OFF, B_ + 0), e1 = ST_C(ZV, OFF, B_ + 1), e2 = ST_C(ZV, OFF, B_ + 2), e3 = ST_C(ZV, OFF, B_ + 3); w_.x = cvtpk(e0, e1); w_.y = cvtpk(e2, e3); } SBAR(); \
                { const float e4 = ST_C(ZV, OFF, B_ + 4), e5 = ST_C(ZV, OFF, B_ + 5), e6 = ST_C(ZV, OFF, B_ + 6), e7 = ST_C(ZV, OFF, B_ + 7); w_.z = cvtpk(e4, e5); w_.w = cvtpk(e6, e7); } __builtin_bit_cast(bf16x8, w_); })
            SBAR(); cb0 = ST_PK(s0, 0, 0); SBAR(); cb1 = ST_PK(s0, 0, 8); SBAR(); cb2 = ST_PK(s1, 32, 0); SBAR(); cb3 = ST_PK(s1, 32, 8); SBAR();
#undef ST_PK
#undef ST_C
            const bf16x8 trd0 = *(const bf16x8*)(lds + AL_TRI + lane * 32), trd1 = *(const bf16x8*)(lds + AL_TRI + lane * 32 + 16);
            s1 = __builtin_amdgcn_mfma_f32_32x32x16_bf16(trd0, cb2, s1, 0, 0, 0);
            s1 = __builtin_amdgcn_mfma_f32_32x32x16_bf16(trd1, cb3, s1, 0, 0, 0);
            s0 = __builtin_amdgcn_mfma_f32_32x32x16_bf16(trd0, cb0, s0, 0, 0, 0);
            s0 = __builtin_amdgcn_mfma_f32_32x32x16_bf16(trd1, cb1, s0, 0, 0, 0);
            s0 = __builtin_amdgcn_mfma_f32_32x32x16_bf16(ones, cb2, s0, 0, 0, 0);
            s0 = __builtin_amdgcn_mfma_f32_32x32x16_bf16(ones, cb3, s0, 0, 0, 0);
            carry += xhalf_sum(csum);
#pragma unroll
            for (int r = 0; r < 16; ++r) { s0[r] = __builtin_amdgcn_exp2f(s0[r]); s1[r] = __builtin_amdgcn_exp2f(s1[r]); }
            bf16x8 pa0, pa1, pa2, pa3;
            pack_p(s0, s1, pa0, pa1, pa2, pa3);
            pv_tile(o, vb0, pa0, pa1, pa2, pa3);
            if (__all(carry < -160.f)) wdone = true;
        }
        if (j == 0) wdone = true;
        j = j > 0 ? j - 1 : 0; buf ^= 1;
    }
    asm volatile("s_waitcnt vmcnt(0)" ::: "memory");
    bf16* Op = WSP(bf16, WS_O) + (rowg + tw) * DM + h * 128;
#pragma unroll
    for (int r = 0; r < 16; ++r) { const int orow = crow(r, hi);
#pragma unroll
        for (int d0 = 0; d0 < 4; ++d0) { const float v = o[d0][r]; const float vn = __shfl_xor(v, 1);
            if ((r32 & 1) == 0) *(unsigned*)(Op + (size_t)orow * DM + d0 * 32 + r32) = cvtpk(v, vn); } }
    __syncthreads();
}
__device__ __forceinline__ void router_phase(Frame& F) {
    const int lane = F.lane;
    const float* wr = FIN(I_OD_WR);
    int* list = WSP(int, WS_LIST); float* gwt = WSP(float, WS_GW);
    volatile LAS unsigned* lcnt = (volatile LAS unsigned*)(F.lds);
    volatile LAS unsigned* rec = (volatile LAS unsigned*)(F.lds + 256);
    const int nper = (M + F.G - 1) / F.G, m0 = (int)blockIdx.x * nper, m1 = (m0 + nper < M) ? m0 + nper : M;
    if (F.tid < 32) lcnt[F.tid] = 0u;
    __syncthreads();
    f32x4 wq[16][2];
#pragma unroll
    for (int i = 0; i < 16; ++i) { const int k = (i < 8 ? 0 : 512) + 8 * lane + (i & 7); wq[i][0] = *(const f32x4*)(wr + (size_t)k * 8); wq[i][1] = *(const f32x4*)(wr + (size_t)k * 8 + 4); }
    for (int m = m0 + F.wave; m < m1; m += NWAVES) {
        float v[16]; load_row_bf16(WSP(bf16, WS_XB3) + (size_t)m * DM, lane, v); rms16(v, FIN(I_OD_NFFN), lane);
        float lg[8];
#pragma unroll
        for (int e = 0; e < 8; ++e) lg[e] = 0.f;
#pragma unroll
        for (int i = 0; i < 16; ++i) { const f32x4 w0 = wq[i][0], w1 = wq[i][1]; const float x = v[i];
            lg[0] = fmaf(x, w0[0], lg[0]); lg[1] = fmaf(x, w0[1], lg[1]); lg[2] = fmaf(x, w0[2], lg[2]); lg[3] = fmaf(x, w0[3], lg[3]);
            lg[4] = fmaf(x, w1[0], lg[4]); lg[5] = fmaf(x, w1[1], lg[5]); lg[6] = fmaf(x, w1[2], lg[6]); lg[7] = fmaf(x, w1[3], lg[7]); }
#pragma unroll
        for (int e = 0; e < 8; ++e) lg[e] = wave_sum(lg[e]);
        int i0 = 0; float v0 = lg[0];
#pragma unroll
        for (int e = 1; e < 8; ++e) if (lg[e] > v0) { v0 = lg[e]; i0 = e; }
        int i1 = -1; float v1 = -__builtin_inff();
#pragma unroll
        for (int e = 0; e < 8; ++e) if (e != i0 && lg[e] > v1) { v1 = lg[e]; i1 = e; }
        const float e1 = __expf(v1 - v0), w0 = 1.0f / (1.0f + e1), w1 = e1 * w0;
        if (lane == 0) {
            const unsigned s0 = __hip_atomic_fetch_add((LAS unsigned*)F.lds + i0, 1u, __ATOMIC_RELAXED, __HIP_MEMORY_SCOPE_WORKGROUP);
            const unsigned s1 = __hip_atomic_fetch_add((LAS unsigned*)F.lds + 8 + i1, 1u, __ATOMIC_RELAXED, __HIP_MEMORY_SCOPE_WORKGROUP);
            rec[2 * (m - m0)] = (unsigned)i0 | (s0 << 8); rec[2 * (m - m0) + 1] = (unsigned)i1 | (s1 << 8);
            gwt[m] = w0; gwt[M + m] = w1;
        }
    }
    __syncthreads();
    if (F.tid < 16) lcnt[16 + F.tid] = atomicAdd((unsigned*)(F.ctl + CW_CNT) + F.tid, lcnt[F.tid]);
    __syncthreads();
    for (int i = F.tid; i < m1 - m0; i += NTHR) { const unsigned r0 = rec[2 * i], r1 = rec[2 * i + 1]; const int i0 = r0 & 255, i1 = r1 & 255;
        list[(size_t)i0 * M + lcnt[16 + i0] + (r0 >> 8)] = m0 + i; list[(size_t)(8 + i1) * M + lcnt[24 + i1] + (r1 >> 8)] = m0 + i; }
    __syncthreads();
}
struct MoeLayout { int off[17]; };
__device__ __forceinline__ void moe_layout(Frame& F, MoeLayout& L) {
    int o = 0;
#pragma unroll
    for (int l = 0; l < 16; ++l) { L.off[l] = o; const int c = (int)__hip_atomic_load(F.ctl + CW_CNT + l, RLX_AGENT); o += (c + 255) & ~255; }
    L.off[16] = o;
}
__device__ __forceinline__ void gather_phase(Frame& F) {
    const int gw = F.vcu * NWAVES + F.wave, NGW = F.G * NWAVES, lane = F.lane;
    MoeLayout L; moe_layout(F, L);
    const int* list = WSP(int, WS_LIST); int* inv = WSP(int, WS_INV); float* gws = WSP(float, WS_GWS); const float* gwt = WSP(float, WS_GW);
    bf16* XS = WSP(bf16, WS_XS);
    for (int s = gw; s < L.off[16]; s += NGW) {
        int l = 0, offl = 0;
#pragma unroll
        for (int q = 1; q < 16; ++q) if (s >= L.off[q]) { l = q; offl = L.off[q]; }
        const int idx = s - offl; const int c = (int)__hip_atomic_load(F.ctl + CW_CNT + l, RLX_AGENT);
        const int t = idx < c ? list[(size_t)l * M + idx] : -1;
        float v[16];
        if (t >= 0) { load_row_bf16(WSP(bf16, WS_XB3) + (size_t)t * DM, lane, v); rms16(v, FIN(I_OD_NFFN), lane); }
        else {
#pragma unroll
            for (int i = 0; i < 16; ++i) v[i] = 0.f; }
        store_row16_bf16(XS + (size_t)s * DM, lane, v);
        if (lane == 0) { const int k = l >> 3; gws[s] = t >= 0 ? gwt[(size_t)k * M + t] : 0.f; if (t >= 0) inv[(size_t)k * M + t] = s; }
    }
}
struct MoeSched {
    pg8::GridOrder o; int t0; const char* A; size_t tstepA; const char* W; size_t tstepB; int off[17]; bool a_local; const char* A2;
    __device__ __forceinline__ bool next(int i, pg8::Unit& u) const {
        int pm, pn; if (!o.at(i, pm, pn)) return false; pm += t0; u.pm = pm; u.pn = pn;
        int l = 0;
#pragma unroll
        for (int q = 1; q < 16; ++q) if (pm * 256 >= off[q]) l = q;
        const int lt = pm - t0;
        u.aux = l; u.A = !a_local ? A + (size_t)pm * tstepA : (lt >= HM_SPLIT ? A2 + (size_t)(lt - HM_SPLIT) * tstepA : A + (size_t)lt * tstepA); u.B = W + (size_t)(l & 7) * MW_E + (size_t)pn * tstepB; return true;
    }
};

struct MoeSplitSched {
    pg8::GridOrder o; int t0; const char* A; size_t tstepA; const char* W; size_t tstepB; int off[17];
    __device__ __forceinline__ bool next(int i, pg8::Unit& u) const {
        int pm, pn; if (!o.at(i, pm, pn)) return false; pm += t0; u.pm = pm; u.pn = pn;
        int l = 0;
#pragma unroll
        for (int q = 1; q < 16; ++q) if (pm * 256 >= off[q]) l = q;
        u.aux = l; const size_t ko = (size_t)(pn >> 2) * (EFF / MOE_SPLITS) * 2;
        u.A = A + (size_t)(pm - t0) * tstepA + ko; u.B = W + (size_t)(l & 7) * MW_E + (size_t)(pn & 3) * tstepB + ko; return true;
    }
};

constexpr int N_PHASES = 27;
struct Args { const float* in[N_IN]; float* out; unsigned char* ws; int ph_lo, ph_hi; unsigned rep_mask, pad; };
__global__ void __launch_bounds__(NTHR, 2) fwd(Args args) {
    extern __shared__ __attribute__((aligned(16))) unsigned char lds[];
    Frame F;
    F.lds = (LAS unsigned char*)lds; F.ldsg = (char*)lds;
    F.MISC = (volatile LAS unsigned*)(F.lds + MISC_OFF);
    F.tid = threadIdx.x; F.lane = F.tid & 63; F.wave = __builtin_amdgcn_readfirstlane(F.tid >> 6);
    F.G = gridDim.x; { const int bx = blockIdx.x; F.vcu = (F.G % 8 == 0) ? (bx % 8) * (F.G / 8) + bx / 8 : bx; }
    F.ws = args.ws; F.ctl = (gu32*)(args.ws + WS_CTL); F.out = args.out;
    F.kap = (const __attribute__((address_space(4))) char*)__builtin_amdgcn_kernarg_segment_ptr();
    static_assert(offsetof(Args, in) == 0, "FIN() reads the input pointers at the start of the kernarg segment");
    for (int u = F.tid; u < 64; u += NTHR) ((LAS unsigned*)(F.lds + MISC_OFF))[u] = 0u;
    __syncthreads();
    const int lo = args.ph_lo, hi = args.ph_hi;
    const bool multi = (hi - lo) > 1;
    XcdBarrier bar; bar.bar = (unsigned*)(F.ctl + CW_BAR); bar.x = 0; bar.st = nullptr;
    if (multi) bar = xcd_barrier_post((unsigned*)(F.ctl + CW_BAR), F.MISC + 8);
#ifdef PHASE_ONLY
#define IN(k) ((k) == PHASE_ONLY && lo <= (k) && (k) < hi)
#else
#define IN(k) (lo <= (k) && (k) < hi)
#endif
#ifndef PROBE_BUILD
#define PROBE_BUILD 0
#endif
#if PROBE_BUILD
    const unsigned repmask = args.rep_mask;
#define REPLOOP(k) _Pragma("unroll 1") for (int rep_ = 0, nrep_ = 1 + (int)((repmask >> (k)) & 1u); rep_ < nrep_; ++rep_)
#else
    const unsigned repmask = 0u;
#define REPLOOP(k)
#endif
#define SEAM(k) do { if (IN(k) && IN((k) + 1)) xcd_barrier(bar); PHASE_FENCE(); } while (0)
    const int gwv = F.vcu * NWAVES + F.wave, NGW = F.G * NWAVES;
    const int bx = blockIdx.x;

    REPLOOP(0) {
    if (IN(0)) {
        LAS float* scr = (LAS float*)(F.lds + F.wave * 16384);
        int ibase = 0;
#define XPOSE_MAT(fn, destrows, K, WT, kgain) do { const int _n = ((destrows) / 32) * ((K) / 64); const int _s = (gwv + NGW - (ibase % NGW)) % NGW; \
            xpose_matrix(fn, K, WT, kgain, scr, _s, _n, NGW, F.lane); ibase += _n; } while (0)
        { FnIn f{FIN(I_EV_WIN)}; XPOSE_MAT(f, NPROJ, 1024, WSP(bf16, WS_WIN), (const float*)nullptr); }
        { FnPlain f{FIN(I_EV_WUK), 128, 0}; XPOSE_MAT(f, 128, 256, WSP(bf16, WS_WUKV), FIN(I_EV_KVN)); }
        { FnPlain f{FIN(I_EV_WUV), 128, 0}; XPOSE_MAT(f, 128, 256, WSP(bf16, WS_WUKV) + 128 * 256, FIN(I_EV_KVN)); }
#pragma unroll 1
        for (int j = 0; j < 2; ++j) { const float* W1 = FIN(I_EV_CW1) + (size_t)j * 4096 * 128; bf16* d = WSP(bf16, WS_WC1) + (size_t)j * 256 * 2048;
            { FnPlain f{W1, 128, 0}; XPOSE_MAT(f, 128, 2048, d, (const float*)nullptr); }
            { FnPlain f{W1 + (size_t)2048 * 128, 128, 0}; XPOSE_MAT(f, 128, 2048, d + (size_t)128 * 2048, (const float*)nullptr); } }
        { FnPlain f{FIN(I_EV_WOUT), 1024, 0}; XPOSE_MAT(f, 1024, 1024, WSP(bf16, WS_WOUT0), (const float*)nullptr); }
        { FnGU f{FIN(I_EV_WG), FIN(I_EV_WU), DFF}; XPOSE_MAT(f, 2 * DFF, 1024, WSP(bf16, WS_WGU0), FIN(I_EV_NFFN)); }
        { FnPlain f{FIN(I_EV_WD), 1024, 0}; XPOSE_MAT(f, 1024, DFF, WSP(bf16, WS_WDN0), (const float*)nullptr); }
        { FnPlain f{FIN(I_OD_WQKV), 3072, 0}; XPOSE_MAT(f, 3072, 1024, WSP(bf16, WS_WQKV), FIN(I_OD_NMIX)); }
        { FnPlain f{FIN(I_OD_WOUT), 1024, 0}; XPOSE_MAT(f, 1024, 1024, WSP(bf16, WS_WOUT1), (const float*)nullptr); }
        norm_phase(F, FIN(I_X), nullptr, FIN(I_EV_NMIX));
        for (int oi = gwv; oi < 32; oi += NGW) { const int j = oi >> 4, part = oi & 15; const float* pos = FIN(I_EV_CPOS) + (size_t)j * 4096 + part * 256; const float* W1 = FIN(I_EV_CW1) + ((size_t)j * 4096 + part * 256) * 128;
            float s0 = 0.f, s1 = 0.f;
#pragma unroll 8
            for (int i = 0; i < 256; ++i) { const float pv_ = pos[i]; s0 = fmaf(pv_, W1[(size_t)i * 128 + F.lane], s0); s1 = fmaf(pv_, W1[(size_t)i * 128 + 64 + F.lane], s1); }
            WSP(float, WS_TAB)[(size_t)oi * 128 + F.lane] = s0; WSP(float, WS_TAB)[(size_t)oi * 128 + 64 + F.lane] = s1; }
    }
    }
    SEAM(0);
    REPLOOP(1) {
    if (IN(1)) {
        pg8::PlainSched S; S.init(M, NPROJ, F.G, bx, WSP(bf16, WS_XN), 2048, WSP(bf16, WS_WIN), 2048);
        pg8::EpiGroups E{WSP(bf16, WS_PROJ), GS, 0x0F0Fu, QSCALE, G_PAD, nullptr};
        pg8::gemm_phase<pg8::EpiGroups, pg8::PlainSched>(F.lds, pg8::GemmK{1024, 2048u, 2048u, 30, 0u}, S, E);
    }
    }
    SEAM(1);
    REPLOOP(2) {
    if (IN(2)) {
        if (bx < 128) {
            LAS float* rstd = (LAS float*)(F.lds + MISC_OFF + 1024);
            { const int r = F.tid >> 1, g = F.tid & 1; const bf16* p = GRP(G_LAT + g) + ((size_t)bx * 256 + r) * 128; float s = 0.f;
#pragma unroll
              for (int i = 0; i < 16; ++i) { const v4u w = *(const v4u*)(p + i * 8);
#pragma unroll
                  for (int q = 0; q < 4; ++q) { const float a = __builtin_bit_cast(float, w[q] << 16), c = __builtin_bit_cast(float, w[q] & 0xffff0000u); s += a * a + c * c; } }
              s += __shfl_xor(s, 1);
              if (g == 0) rstd[r] = 1.0f / sqrtf(s * (1.f / 256.f) + RMS_EPS); }
            __syncthreads();
            pg8::OneSched S;
            S.u.pm = bx; S.u.pn = 0; S.u.aux = 0; S.u.A = (const char*)(GRP(G_LAT) + (size_t)bx * 256 * 128); S.u.B = (const char*)WSP(bf16, WS_WUKV);
            pg8::EpiAkv E{WSP(bf16, WS_AK), WSP(bf16, WS_AV), rstd};
            pg8::gemm_phase<pg8::EpiAkv, pg8::OneSched>(F.lds, pg8::GemmK{256, 256u, 512u, 1, (unsigned)(GS * 2)}, S, E);
        } else if (bx < 160) {
            const int u = bx - 128, j = u >> 4, pm = (u >> 1) & 7, kh = u & 1;
            pg8::OneSched S;
            S.u.pm = pm; S.u.pn = 0; S.u.aux = 0; S.u.A = (const char*)(GRP(j == 0 ? G_CKR : G_CVR) + (size_t)pm * 256 * 2048 + (size_t)kh * 1024); S.u.B = (const char*)(WSP(bf16, WS_WC1) + (size_t)j * 256 * 2048 + (size_t)kh * 1024);
            pg8::EpiF32 E{nullptr, (kh ? WSP(float, WS_UVB) : WSP(float, WS_UV)) + (size_t)j * 2048 * 256, 256, 1.f};
            pg8::gemm_phase<pg8::EpiF32, pg8::OneSched>(F.lds, pg8::GemmK{1024, 4096u, 4096u, 30, 0u}, S, E);
        }
    }
    }
    SEAM(2);
    REPLOOP(3) {
    if (IN(3)) {
        for (int it = bx; it < 256; it += F.G) cmp_finalize_item(F, it >> 5, (it >> 4) & 1, it & 15);
        for (int r = 0; r < 4096 / 256 + 1; ++r) { const int cc = (r & 1) ? (F.G - 1 - bx) : bx; const int ui = r * F.G + cc; if (ui >= 4096) break;
            const int tq = 511 - (ui >> 3), b = ui & 7; idx_unit(F, b, tq, repmask >> 24); }
    }
    }
    SEAM(3);
    PHASE_FENCE();
    REPLOOP(5) {
    if (IN(5)) {
        fill_bias_tbl(F, (float*)(F.ldsg + AL_TBL), 0); __syncthreads();
#pragma unroll 1
        for (int p2 = 2 * bx; p2 < 512; p2 += 2 * F.G) {
#pragma unroll 1
            for (int u = 0; u < 2; ++u) { const int p = p2 >> 1, b = p >> 5, q = p & 31; attn_unit<0>(F, b, u ? q : 63 - q); } }
        __syncthreads();
        fill_bias_tbl(F, (float*)(F.ldsg + AL_TBL), 4); fill_bias_tbl132(F, (float*)(F.ldsg + AL_TBL132), 4); __syncthreads();
#pragma unroll 1
        for (int p2 = 2 * bx; p2 < 512; p2 += 2 * F.G) {
#pragma unroll 1
            for (int u = 0; u < 2; ++u) { const int p = p2 >> 1, b = p >> 5, q = p & 31, qt = u ? q : 63 - q;
                cmp_unit64(F, b, qt); asm volatile("s_waitcnt vmcnt(0)" ::: "memory"); __syncthreads();
                attn_unit<1>(F, b, qt); attn_unit<2>(F, b, qt); } }
    }
    }
    SEAM(5);
    REPLOOP(6) {
    if (IN(6)) {
        pg8::PlainSched S; S.init(M, DM, F.G, bx, WSP(bf16, WS_O), 2048, WSP(bf16, WS_WOUT0), 2048);
        pg8::EpiRes E{FIN(I_X), nullptr, WSP(bf16, WS_XB), WSP(float, WS_RS0), 1.f};
        pg8::gemm_phase<pg8::EpiRes, pg8::PlainSched>(F.lds, pg8::GemmK{1024, 2048u, 2048u, 30, 0u}, S, E);
    }
    }
    if (IN(6) && IN(8)) xcd_barrier(bar); PHASE_FENCE();
    REPLOOP(8) {
    if (IN(8)) {
        pg8::PlainSched S; S.init(M, 2 * DFF, F.G, bx, WSP(bf16, WS_XB), 2048, WSP(bf16, WS_WGU0), 2048);
        pg8::EpiSwiglu E{WSP(bf16, WS_H0), DFF, 0, WSP(float, WS_RS0), nullptr, 0};
        pg8::gemm_phase<pg8::EpiSwiglu, pg8::PlainSched>(F.lds, pg8::GemmK{1024, 2048u, 2048u, 30, 0u}, S, E);
    }
    }
    SEAM(8);
    if (IN(9)) {
        pg8::PlainSched S; S.init(M, DM, F.G, bx, WSP(bf16, WS_H0), DFF * 2, WSP(bf16, WS_WDN0), DFF * 2);
        pg8::EpiRes E{nullptr, WSP(bf16, WS_XB), WSP(bf16, WS_XB), WSP(float, WS_RS1), ((repmask >> 10) & 1u) ? 0.5f : 1.f};
        REPLOOP(10) pg8::gemm_phase<pg8::EpiRes, pg8::PlainSched>(F.lds, pg8::GemmK{DFF, DFF * 2u, DFF * 2u, 30, 0u}, S, E);
    }
    if (IN(9) && IN(11)) xcd_barrier(bar); PHASE_FENCE();
    REPLOOP(11) {
    if (IN(11)) {
        pg8::PlainSched S; S.init(M, 3072, F.G, bx, WSP(bf16, WS_XB), 2048, WSP(bf16, WS_WQKV), 2048);
        pg8::EpiGroups E{WSP(bf16, WS_QKV), GS, 0xFFu, QSCALE, 1000, WSP(float, WS_RS1)};
        pg8::gemm_phase<pg8::EpiGroups, pg8::PlainSched>(F.lds, pg8::GemmK{1024, 2048u, 2048u, 30, 0u}, S, E);
    }
    }
    SEAM(11);
    REPLOOP(12) {
    if (IN(12)) {
        for (int ui = bx; ui < 1024; ui += F.G) { const int qb = 15 - (ui >> 6), bh = ui & 63; stick_unit(F, bh >> 3, bh & 7, qb); }
    }
    }
    SEAM(12);
    if (IN(13)) {
        pg8::PlainSched S; S.init(M, DM, F.G, bx, WSP(bf16, WS_O), 2048, WSP(bf16, WS_WOUT1), 2048);
        pg8::EpiRes E{nullptr, WSP(bf16, WS_XB), WSP(bf16, WS_XB3), WSP(float, WS_RS0), 1.f};
        REPLOOP(14) pg8::gemm_phase<pg8::EpiRes, pg8::PlainSched>(F.lds, pg8::GemmK{1024, 2048u, 2048u, 30, 0u}, S, E);
        LAS float* scr = (LAS float*)(F.lds + F.wave * 16384);
        REPLOOP(13) {
        int ibase = 0;
#pragma unroll 1
        for (int e = 0; e < NEXP; ++e) {
            { FnGU f{FIN(I_OD_WG) + (size_t)e * 1024 * EFF, FIN(I_OD_WU) + (size_t)e * 1024 * EFF, EFF}; XPOSE_MAT(f, 2 * EFF, 1024, (bf16*)(F.ws + WS_MW + (size_t)e * MW_E), (const float*)nullptr); }
            { FnPlain f{FIN(I_OD_WD) + (size_t)e * EFF * 1024, 1024, 0}; XPOSE_MAT(f, 1024, EFF, (bf16*)(F.ws + WS_MW + (size_t)e * MW_E + MW_DN), (const float*)nullptr); }
        }
        }
    }
    SEAM(13);
    if (IN(14)) router_phase(F);
    SEAM(14);
    REPLOOP(15) { if (IN(15)) gather_phase(F); }
    SEAM(15);
#pragma unroll 1
    for (int ch = 0; ch < 3; ++ch) {
        const int t0 = ch * HM_TILES, ph = 16 + 2 * ch;
        MoeLayout L; moe_layout(F, L);
        const int ntile = L.off[16] >> 8;
        const int nt = (ntile - t0) < HM_TILES ? (ntile - t0) : HM_TILES;
        if (IN(ph) && nt > 0) {
            MoeSched S; S.o.init(nt, 2 * EFF / 256, F.G, bx); S.t0 = t0; S.A = (const char*)WSP(bf16, WS_XS); S.tstepA = 256 * 2048; S.W = (const char*)(F.ws + WS_MW); S.tstepB = 256 * 2048; S.a_local = false; S.A2 = nullptr;
#pragma unroll
            for (int q = 0; q < 17; ++q) S.off[q] = L.off[q];
            pg8::EpiSwiglu E{WSP(bf16, WS_HM), EFF, t0, nullptr, (bf16*)F.out, HM_SPLIT};
            REPLOOP(16) pg8::gemm_phase<pg8::EpiSwiglu, MoeSched>(F.lds, pg8::GemmK{1024, 2048u, 2048u, 30, 0u}, S, E);
        }
        SEAM(ph);
        const bool split = ch == 2 && nt > 0 && nt <= MOE_SPLIT_TILES;
        if (IN(ph + 1) && split) {
            MoeSplitSched S; S.o.init(nt, 4 * MOE_SPLITS, F.G, bx); S.t0 = t0; S.A = (const char*)WSP(bf16, WS_HM); S.tstepA = (size_t)256 * EFF * 2; S.W = (const char*)(F.ws + WS_MW + MW_DN); S.tstepB = (size_t)256 * EFF * 2;
#pragma unroll
            for (int q = 0; q < 17; ++q) S.off[q] = L.off[q];
            pg8::EpiMoeYp E{WSP(bf16, WS_YP), WSP(float, WS_GWS), t0, (size_t)MOE_SPLIT_TILES * 256 * DM};
            pg8::gemm_phase<pg8::EpiMoeYp, MoeSplitSched>(F.lds, pg8::GemmK{EFF / MOE_SPLITS, EFF * 2u, EFF * 2u, 30, 0u}, S, E);
        }
        if (IN(ph + 1) && nt > 0 && !split) {
            MoeSched S; S.o.init(nt, DM / 256, F.G, bx); S.t0 = t0; S.A = (const char*)WSP(bf16, WS_HM); S.tstepA = (size_t)256 * EFF * 2; S.W = (const char*)(F.ws + WS_MW + MW_DN); S.tstepB = (size_t)256 * EFF * 2; S.a_local = true; S.A2 = (const char*)F.out;
#pragma unroll
            for (int q = 0; q < 17; ++q) S.off[q] = L.off[q];
            pg8::EpiMoeY E{WSP(bf16, WS_XS), WSP(float, WS_GWS)};
            REPLOOP(17) pg8::gemm_phase<pg8::EpiMoeY, MoeSched>(F.lds, pg8::GemmK{EFF, EFF * 2u, EFF * 2u, 30, 0u}, S, E);
        }
        SEAM(ph + 1);
    }
    REPLOOP(18)
    if (IN(26)) {
        const bf16* XS0 = WSP(bf16, WS_XS); const int* inv = WSP(int, WS_INV);
        MoeLayout L; moe_layout(F, L);
        const int ntl = (L.off[16] >> 8) - 2 * HM_TILES; const int srow = (ntl > 0 && ntl <= MOE_SPLIT_TILES) ? 2 * HM_TILES * 256 : 0x7fffffff;
#define FIN_ROW(m_, v_) do { load_row_bf16(WSP(bf16, WS_XB3) + (size_t)(m_) * DM, F.lane, v_); \
            _Pragma("unroll 1") for (int k = 0; k < 2; ++k) { const int s = inv[(size_t)k * M + (m_)]; float y[16]; \
                if (s < srow) { load_row_bf16(XS0 + (size_t)s * DM, F.lane, y); _Pragma("unroll") for (int i = 0; i < 16; ++i) v_[i] += y[i]; } \
                else { _Pragma("unroll 1") for (int sp = 0; sp < MOE_SPLITS; ++sp) { load_row_bf16(WSP(bf16, WS_YP) + ((size_t)sp * MOE_SPLIT_TILES * 256 + (s - srow)) * DM, F.lane, y); \
                        _Pragma("unroll") for (int i = 0; i < 16; ++i) v_[i] += y[i]; } } } } while (0)
#define FIN_OUT(m_, v_) do { rms16(v_, FIN(I_FNORM), F.lane); GAS f32x4* o = (GAS f32x4*)(F.out + (size_t)(m_) * DM); \
            o[2 * F.lane] = (f32x4){v_[0], v_[1], v_[2], v_[3]}; o[2 * F.lane + 1] = (f32x4){v_[4], v_[5], v_[6], v_[7]}; \
            o[128 + 2 * F.lane] = (f32x4){v_[8], v_[9], v_[10], v_[11]}; o[128 + 2 * F.lane + 1] = (f32x4){v_[12], v_[13], v_[14], v_[15]}; } while (0)
        for (int m = gwv; m < M; m += 2 * NGW) { float va[16], vb[16]; const int mb = m + NGW;
            FIN_ROW(m, va); if (mb < M) FIN_ROW(mb, vb);
            FIN_OUT(m, va); if (mb < M) FIN_OUT(mb, vb); }
#undef FIN_ROW
#undef FIN_OUT
    }
#undef IN
#undef SEAM
#undef XPOSE_MAT
}

#ifndef PROBE_REP
#define PROBE_REP 0u
#endif
#ifndef MK_FUSED
#define MK_FUSED 1
#endif
extern "C" void kernel_launch(void* const* d_in, const int* in_sizes, int n_in, void* d_out, int out_size, void* d_ws, size_t ws_size, hipStream_t stream) {
    static int grid = 0;
    if (grid == 0) {
        if (n_in != N_IN || in_sizes[0] != M * DM || out_size != M * DM || ws_size < WS_END) {
            fprintf(stderr, "kernel_launch: built for %d inputs, x/out of %d floats, >= %zu bytes of workspace; got n_in %d, in0 %d, out %d, ws %zu; nothing launched\n", N_IN, M * DM, (size_t)WS_END, n_in, n_in > 0 ? in_sizes[0] : -1, out_size, ws_size);
            grid = -1; return; }
        int dev = 0, cus = 0, per_cu = 0;
        if (hipGetDevice(&dev) != hipSuccess || hipDeviceGetAttribute(&cus, hipDeviceAttributeMultiprocessorCount, dev) != hipSuccess) { fprintf(stderr, "kernel_launch: device query failed\n"); grid = -1; return; }
        if (hipFuncSetAttribute((const void*)fwd, hipFuncAttributeMaxDynamicSharedMemorySize, LDS_BYTES) != hipSuccess) { fprintf(stderr, "kernel_launch: hipFuncSetAttribute failed\n"); grid = -1; return; }
        if (hipOccupancyMaxActiveBlocksPerMultiprocessor(&per_cu, (const void*)fwd, NTHR, LDS_BYTES) != hipSuccess || per_cu < 1)
            fprintf(stderr, "kernel_launch: note: occupancy query reports %d workgroups per CU\n", per_cu);
        (void)hipGetLastError();
        grid = cus;
    }
    if (grid < 0) return;
    if (hipMemsetAsync((char*)d_ws + WS_CTL, 0, CTL_ZERO_BYTES, stream) != hipSuccess) { fprintf(stderr, "kernel_launch: memset failed\n"); return; }
    Args a{};
    for (int i = 0; i < N_IN; ++i) a.in[i] = (const float*)d_in[i];
    a.out = (float*)d_out; a.ws = (unsigned char*)d_ws; a.rep_mask = PROBE_REP; a.pad = 0u;
#if MK_FUSED
    a.ph_lo = 0; a.ph_hi = N_PHASES;
    hipLaunchKernelGGL(fwd, dim3(grid), dim3(NTHR), LDS_BYTES, stream, a);
#else
    for (int p = 0; p < N_PHASES; ++p) { a.ph_lo = p; a.ph_hi = p + 1; hipLaunchKernelGGL(fwd, dim3(grid), dim3(NTHR), LDS_BYTES, stream, a); }
#endif
    const hipError_t le = hipPeekAtLastError();
    if (le != hipSuccess) fprintf(stderr, "kernel_launch: launch failed: %s\n", hipGetErrorName(le));
}
```

```cpp
#include <hip/hip_runtime.h>
#include <cstdio>
#include <cstdint>

#define GAS __attribute__((address_space(1)))
#define LAS __attribute__((address_space(3)))
typedef unsigned short bf16;
typedef unsigned v4u __attribute__((ext_vector_type(4)));
typedef unsigned v2u __attribute__((ext_vector_type(2)));
typedef float f32x2 __attribute__((ext_vector_type(2)));
typedef float f32x4 __attribute__((ext_vector_type(4)));
typedef float f32x16 __attribute__((ext_vector_type(16)));
typedef short bf16x8 __attribute__((ext_vector_type(8)));
typedef short s16x4 __attribute__((ext_vector_type(4)));
typedef GAS unsigned gu32;
#define RLX_AGENT __ATOMIC_RELAXED, __HIP_MEMORY_SCOPE_AGENT
#define LDS_WAIT() asm volatile("s_waitcnt lgkmcnt(0)" ::: "memory")
#define VM_WAIT() asm volatile("s_waitcnt vmcnt(0)" ::: "memory")
#define SBAR() __builtin_amdgcn_sched_barrier(0)

constexpr int BATCH = 8, SEQ = 4096, DM = 1024, M = BATCH * SEQ, HD = 128;
constexpr int NPROJ = 2560;
constexpr int DFF = 2816, NEXP = 8, EFF = 3584;
constexpr float RMS_EPS = 1e-6f;
constexpr float LOG2E = 1.4426950408889634f;
constexpr float QSCALE = 0.08838834764831845f * LOG2E;
enum { I_X = 0, I_RELB, I_EV_NMIX, I_EV_WIN, I_EV_KVN, I_EV_WUK, I_EV_WUV, I_EV_CPOS, I_EV_CW1, I_EV_CW2, I_EV_WOUT, I_EV_NFFN, I_EV_WG, I_EV_WU, I_EV_WD,
       I_OD_NMIX, I_OD_WQKV, I_OD_WOUT, I_OD_NFFN, I_OD_WR, I_OD_WG, I_OD_WU, I_OD_WD, I_FNORM, N_IN };

enum { G_QA = 0  , G_LAT = 4  , G_IQ = 6  , G_QB = 8  , G_CKR = 12, G_CVR = 13, G_SK = 14, G_SV = 15, G_WK = 16, G_WV = 17, G_MISC = 18, G_PAD = 19 };
constexpr size_t GS = (size_t)M * 128;

constexpr size_t MiB = 1u << 20;
constexpr size_t WS_CTL = 0, CTL_ZERO_BYTES = 1 * MiB;
constexpr size_t WS_TAB = 1 * MiB;
constexpr size_t WS_WIN = 2 * MiB;
constexpr size_t WS_WUKV = 7 * MiB;
constexpr size_t WS_WC1 = 7 * MiB + 256 * 1024;
constexpr size_t WS_WOUT0 = 10 * MiB;
constexpr size_t WS_WGU0 = 12 * MiB;
constexpr size_t WS_WDN0 = 23 * MiB;
constexpr size_t WS_WQKV = 29 * MiB;
constexpr size_t WS_WOUT1 = 35 * MiB;
constexpr size_t WS_XN = 40 * MiB;
constexpr size_t WS_PROJ = 104 * MiB;
constexpr size_t WS_AK = 264 * MiB, WS_AV = 272 * MiB;
constexpr size_t WS_BM = 280 * MiB;
constexpr size_t WS_UV = 296 * MiB;
constexpr size_t WS_UVB = 432 * MiB;
constexpr size_t WS_CK = 300 * MiB;
constexpr size_t WS_CVT = 300 * MiB + 512 * 1024;
constexpr size_t WS_CV = 300 * MiB + 512 * 1024;
constexpr size_t WS_BLK = 301 * MiB;
constexpr size_t WS_RS0 = 302 * MiB;
constexpr size_t WS_RS1 = 296 * MiB;
constexpr size_t WS_OC = 304 * MiB;
constexpr size_t WS_O = 368 * MiB;
constexpr size_t WS_OC2 = 432 * MiB;
constexpr size_t WS_XB = 432 * MiB;
constexpr size_t WS_XB3 = 40 * MiB;
constexpr size_t WS_H0 = 104 * MiB;
constexpr size_t WS_QKV = 104 * MiB;
constexpr size_t WS_MW = 104 * MiB;
constexpr size_t MW_E = 21 * MiB, MW_DN = 14 * MiB;
constexpr size_t WS_LIST = 272 * MiB;
constexpr size_t WS_GW = WS_LIST + 2 * MiB;
constexpr size_t WS_TOK = WS_GW + 256 * 1024;
constexpr size_t WS_INV = WS_TOK + 512 * 1024;
constexpr size_t WS_GWS = WS_INV + 256 * 1024;
constexpr int XS_ROWS = M + 8 * 256;
constexpr size_t WS_XS = 276 * MiB;
constexpr int HM_TILES = 128, HM_SPLIT = 64;
constexpr int MOE_SPLITS = 4, MOE_SPLIT_TILES = 16;
constexpr size_t WS_YP = 2 * MiB;
constexpr size_t WS_HM = 412 * MiB;
constexpr size_t WS_END = 524 * MiB;
static_assert(WS_WIN + (size_t)NPROJ * DM * 2 <= WS_WUKV && WS_WC1 + 2ull * 256 * 2048 * 2 <= WS_WOUT0 && WS_WGU0 + 5632ull * 1024 * 2 <= WS_WDN0 && WS_WDN0 + 1024ull * 2816 * 2 <= WS_WQKV && WS_WQKV + 3072ull * 1024 * 2 <= WS_WOUT1 && WS_WOUT1 + 2 * MiB <= WS_XN, "weights map");
static_assert(WS_XN + (size_t)M * DM * 2 <= WS_PROJ && WS_PROJ + 20 * GS * 2 <= WS_AK && WS_BM + (size_t)M * 128 * 4 <= WS_UV && WS_UV + 4 * MiB <= WS_CK && WS_BLK + (size_t)M * 8 <= WS_OC && WS_OC + (size_t)M * 512 * 4 <= WS_O && WS_O + (size_t)M * DM * 2 <= 432 * MiB, "even map");
static_assert(WS_YP + (size_t)MOE_SPLITS * MOE_SPLIT_TILES * 256 * DM * 2 <= WS_XB3, "split partials fit under the residual stream copy");
static_assert(WS_H0 + (size_t)M * DFF * 2 <= WS_OC && WS_QKV + 24 * GS * 2 <= WS_O && WS_MW + 8 * MW_E <= WS_LIST && WS_GWS + 2ull * XS_ROWS * 4 <= WS_XS && WS_XS + 2ull * XS_ROWS * DM * 2 <= WS_HM && WS_HM + (size_t)HM_SPLIT * 256 * EFF * 2 <= WS_END && (size_t)(HM_TILES - HM_SPLIT) * 256 * EFF * 2 <= (size_t)M * DM * 4, "late map");
constexpr int CW_TMO = 0, CW_CODE = 1;
constexpr int CW_BAR = 4096;
constexpr int CW_CNT = 16384;

constexpr int RING_BYTES = 131072;
constexpr int MISC_OFF = RING_BYTES;
constexpr int LDS_BYTES = 147456;
constexpr int NWAVES = 8, NTHR = 512;

__device__ __forceinline__ unsigned f2bf(float f) { unsigned u = __builtin_bit_cast(unsigned, f); return (u + 0x7fffu + ((u >> 16) & 1u)) >> 16; }
__device__ __forceinline__ unsigned pk2(float lo, float hi) { return f2bf(lo) | (f2bf(hi) << 16); }
__device__ __forceinline__ float bf2f(bf16 b) { return __builtin_bit_cast(float, (unsigned)b << 16); }
__device__ __forceinline__ unsigned cvtpk(float lo, float hi) { unsigned r; asm volatile("v_cvt_pk_bf16_f32 %0, %1, %2" : "=v"(r) : "v"(lo), "v"(hi)); return r; }
__device__ __forceinline__ bf16x8 pack8(f32x4 a, f32x4 b) { v4u w = {cvtpk(a[0], a[1]), cvtpk(a[2], a[3]), cvtpk(b[0], b[1]), cvtpk(b[2], b[3])}; return __builtin_bit_cast(bf16x8, w); }
__device__ __forceinline__ float wave_sum(float v) {
#define WS_STEP(ctrl, rmask) v += __int_as_float(__builtin_amdgcn_update_dpp(0, __float_as_int(v), ctrl, rmask, 0xf, true))
    WS_STEP(0x111, 0xf); WS_STEP(0x112, 0xf); WS_STEP(0x114, 0xf); WS_STEP(0x118, 0xf); WS_STEP(0x142, 0xa); WS_STEP(0x143, 0xc);
#undef WS_STEP
    return __int_as_float(__builtin_amdgcn_readlane(__float_as_int(v), 63));
}
__device__ __forceinline__ float wave_max(float v) {
#define WM_STEP(ctrl, rmask) v = fmaxf(v, __int_as_float(__builtin_amdgcn_update_dpp(__float_as_int(v), __float_as_int(v), ctrl, rmask, 0xf, false)))
    WM_STEP(0x111, 0xf); WM_STEP(0x112, 0xf); WM_STEP(0x114, 0xf); WM_STEP(0x118, 0xf); WM_STEP(0x142, 0xa); WM_STEP(0x143, 0xc);
#undef WM_STEP
    return __int_as_float(__builtin_amdgcn_readlane(__float_as_int(v), 63));
}
__device__ __forceinline__ int rel_bucket_dev(int d) {
    if (d < 16) return d;
    if (d >= 113) return 31;
    int v = 16 + (int)(__log2f((float)d * 0.0625f) * (16.0f / 3.0f));
    return v > 31 ? 31 : v;
}
namespace pg8 {
constexpr int BM = 256, BK = 64, HALF = 128, HTB = HALF * BK * 2, STAGE_BYTES = 8 * HTB, NXCD = 8, WGM = 8;
__host__ __device__ __forceinline__ int lds_byte(int r, int c) { const int st = (r >> 4) * 2 + (c >> 5), rr = r & 15, cc = c & 31, ob = rr * 64 + cc * 2; return st * 1024 + (ob ^ (((ob >> 9) & 1) << 5)); }
__host__ __device__ __forceinline__ void stage_rc(int b, int& R, int& C) { const int st = b / 1024, sb = b % 1024, swz = sb ^ (((sb >> 9) & 1) << 5); R = (st >> 1) * 16 + swz / 64; C = (st & 1) * 32 + (swz % 64) / 2; }
__host__ __device__ __forceinline__ int perm32(int rho) { const int n = rho >> 4, i = rho & 15; return 8 * (i >> 2) + 4 * n + (i & 3); }

struct Unit { int pm, pn, aux; const char* A; const char* B; };
struct GemmK { int K; unsigned pitchA, pitchB; int kshA; unsigned gstrA; };

struct GridOrder {
    int nM, nN, nwg, G, c;
    __device__ __forceinline__ void init(int nM_, int nN_, int G_, int c_) { nM = nM_; nN = nN_; nwg = nM * nN; G = G_; c = c_; }
    __device__ __forceinline__ bool at(int i, int& pm, int& pn) const {
        const long L = (long)i * G + c; if (L >= nwg) return false;
        int wgid = (int)L; { const int q = nwg / NXCD, r = nwg % NXCD, xcd = wgid % NXCD, off = wgid / NXCD; wgid = (xcd < r ? xcd * (q + 1) : r * (q + 1) + (xcd - r) * q) + off; }
        const int nig = WGM * nN, gid = wgid / nig, fm = gid * WGM, gsz = (nM - fm) < WGM ? (nM - fm) : WGM;
        pm = fm + ((wgid % nig) % gsz); pn = (wgid % nig) / gsz; return true;
    }
};
struct PlainSched {
    GridOrder o; const char* A; const char* B; size_t tstepA, tstepB;
    __device__ __forceinline__ void init(int Mr, int Nc, int G, int c, const void* A_, size_t pitchA, const void* B_, size_t pitchB) { o.init(Mr / BM, Nc / BM, G, c); A = (const char*)A_; B = (const char*)B_; tstepA = 256 * pitchA; tstepB = 256 * pitchB; }
    __device__ __forceinline__ bool next(int i, Unit& u) const { if (!o.at(i, u.pm, u.pn)) return false; u.aux = 0; u.A = A + (size_t)u.pm * tstepA; u.B = B + (size_t)u.pn * tstepB; return true; }
};

__device__ __forceinline__ unsigned cvt_pk_bf16(float lo, float hi) { unsigned r; asm volatile("v_cvt_pk_bf16_f32 %0, %1, %2" : "=v"(r) : "v"(lo), "v"(hi)); return r; }

typedef float f32x8 __attribute__((ext_vector_type(8)));
__device__ __forceinline__ f32x8 row_rstd8(const float* rs, int row0, int fq) {
    f32x8 r = {1.f, 1.f, 1.f, 1.f, 1.f, 1.f, 1.f, 1.f};
    if (rs) {
#pragma unroll
        for (int i = 0; i < 8; ++i) { const f32x4 p = *(const f32x4*)(rs + (size_t)(row0 + (i >> 2) * HALF + (i & 3) * 16) * 16 + 4 * fq); float s = (p[0] + p[1]) + (p[2] + p[3]);
            s += __shfl_xor(s, 16); s += __shfl_xor(s, 32); r[i] = 1.0f / sqrtf(s * (1.0f / DM) + RMS_EPS); } }
    return r;
}
struct EpiGroups {
    static constexpr bool PERM = true;
    bf16* O; size_t gstride; unsigned scalemask; float scale; int gskip; const float* rs;
    __device__ __forceinline__ void operator()(const f32x4 (&acc)[2][2][4][2], const Unit& u, int wr, int wc, int fr, int fq) const {
        const int row0 = u.pm * BM + wr * 64 + fr, col0 = wc * 32 + 8 * fq;
        const f32x8 rstd = row_rstd8(rs, row0, fq);
#pragma unroll
        for (int bj = 0; bj < 2; ++bj) { const int g = 2 * u.pn + bj; if (g >= gskip) continue; const float sc = ((scalemask >> g) & 1u) ? scale : 1.f; bf16* base = O + (size_t)g * gstride;
#pragma unroll
            for (int ai = 0; ai < 2; ++ai)
#pragma unroll
                for (int m = 0; m < 4; ++m) { const float s2 = sc * rstd[ai * 4 + m]; const f32x4 v0 = acc[ai][bj][m][0] * s2, v1 = acc[ai][bj][m][1] * s2;
                    v4u w; w.x = cvt_pk_bf16(v0[0], v0[1]); w.y = cvt_pk_bf16(v0[2], v0[3]); w.z = cvt_pk_bf16(v1[0], v1[1]); w.w = cvt_pk_bf16(v1[2], v1[3]);
                    *(v4u*)(base + (size_t)(row0 + ai * HALF + m * 16) * 128 + col0) = w; } }
    }
};
struct OneSched { Unit u; __device__ __forceinline__ bool next(int i, Unit& o) const { if (i) return false; o = u; return true; } };
struct EpiAkv {
    static constexpr bool PERM = true;
    bf16* AK; bf16* AV; const LAS float* rstd;
    __device__ __forceinline__ void operator()(const f32x4 (&acc)[2][2][4][2], const Unit& u, int wr, int wc, int fr, int fq) const {
        const int col0 = wc * 32 + 8 * fq;
#pragma unroll
        for (int ai = 0; ai < 2; ++ai)
#pragma unroll
            for (int m = 0; m < 4; ++m) { const int rl = ai * HALF + wr * 64 + m * 16 + fr; const float rs = rstd[rl]; const size_t row = (size_t)u.pm * BM + rl;
#pragma unroll
                for (int bj = 0; bj < 2; ++bj) { const f32x4 v0 = acc[ai][bj][m][0] * rs, v1 = acc[ai][bj][m][1] * rs;
                    v4u w; w.x = cvt_pk_bf16(v0[0], v0[1]); w.y = cvt_pk_bf16(v0[2], v0[3]); w.z = cvt_pk_bf16(v1[0], v1[1]); w.w = cvt_pk_bf16(v1[2], v1[3]);
                    *(v4u*)((bj ? AV : AK) + row * 128 + col0) = w; } }
    }
};
struct EpiF32 {
    static constexpr bool PERM = false;
    const float* base; float* C; int ldc; float scale;
    __device__ __forceinline__ void operator()(const f32x4 (&acc)[2][2][4][2], const Unit& u, int wr, int wc, int fr, int fq) const {
        const int row0 = u.pm * BM + wr * 64 + fr, col0 = u.pn * BM + wc * 32 + 4 * fq;
#pragma unroll
        for (int ai = 0; ai < 2; ++ai)
#pragma unroll
            for (int m = 0; m < 4; ++m) { const size_t off = (size_t)(row0 + ai * HALF + m * 16) * ldc + col0;
#pragma unroll
                for (int bj = 0; bj < 2; ++bj)
#pragma unroll
                    for (int n = 0; n < 2; ++n) { f32x4 v = acc[ai][bj][m][n] * scale; if (base) v += *(const f32x4*)(base + off + bj * HALF + n * 16); *(f32x4*)(C + off + bj * HALF + n * 16) = v; } }
    }
};
struct EpiRes {
    static constexpr bool PERM = true;
    const float* basef; const bf16* baseb; bf16* out; float* rs; float scale;
    __device__ __forceinline__ void operator()(const f32x4 (&acc)[2][2][4][2], const Unit& u, int wr, int wc, int fr, int fq) const {
        const int row0 = u.pm * BM + wr * 64 + fr, col0 = u.pn * BM + wc * 32 + 8 * fq;
#pragma unroll
        for (int ai = 0; ai < 2; ++ai)
#pragma unroll
            for (int m = 0; m < 4; ++m) { const size_t off = (size_t)(row0 + ai * HALF + m * 16) * DM + col0; float ss = 0.f;
#pragma unroll
                for (int bj = 0; bj < 2; ++bj) { f32x4 v0 = acc[ai][bj][m][0] * scale, v1 = acc[ai][bj][m][1] * scale;
                    if (basef) { v0 += *(const f32x4*)(basef + off + bj * HALF); v1 += *(const f32x4*)(basef + off + bj * HALF + 4); }
                    else { const v4u w = *(const v4u*)(baseb + off + bj * HALF);
                        v0 += (f32x4){__uint_as_float(w.x << 16), __uint_as_float(w.x & 0xffff0000u), __uint_as_float(w.y << 16), __uint_as_float(w.y & 0xffff0000u)};
                        v1 += (f32x4){__uint_as_float(w.z << 16), __uint_as_float(w.z & 0xffff0000u), __uint_as_float(w.w << 16), __uint_as_float(w.w & 0xffff0000u)}; }
                    v4u o; o.x = cvt_pk_bf16(v0[0], v0[1]); o.y = cvt_pk_bf16(v0[2], v0[3]); o.z = cvt_pk_bf16(v1[0], v1[1]); o.w = cvt_pk_bf16(v1[2], v1[3]);
                    *(v4u*)(out + off + bj * HALF) = o;
#define RS_ACC(w) { const float a_ = __uint_as_float((w) << 16), c_ = __uint_as_float((w) & 0xffff0000u); ss = fmaf(a_, a_, fmaf(c_, c_, ss)); }
                    RS_ACC(o.x) RS_ACC(o.y) RS_ACC(o.z) RS_ACC(o.w)
#undef RS_ACC
                }
                { ss += __shfl_xor(ss, 16); ss += __shfl_xor(ss, 32); if (fq == 0) rs[(size_t)(row0 + ai * HALF + m * 16) * 16 + 4 * u.pn + wc] = ss; } }
    }
};
struct EpiMoeY {
    static constexpr bool PERM = true;
    bf16* Y; const float* gws;
    __device__ __forceinline__ void operator()(const f32x4 (&acc)[2][2][4][2], const Unit& u, int wr, int wc, int fr, int fq) const {
        const int col0 = u.pn * BM + wc * 32 + 8 * fq;
#pragma unroll
        for (int ai = 0; ai < 2; ++ai)
#pragma unroll
            for (int m = 0; m < 4; ++m) { const int slot = u.pm * BM + ai * HALF + wr * 64 + m * 16 + fr; const float g = gws[slot];
#pragma unroll
                for (int bj = 0; bj < 2; ++bj) { const f32x4 v0 = acc[ai][bj][m][0] * g, v1 = acc[ai][bj][m][1] * g;
                    v4u o; o.x = cvt_pk_bf16(v0[0], v0[1]); o.y = cvt_pk_bf16(v0[2], v0[3]); o.z = cvt_pk_bf16(v1[0], v1[1]); o.w = cvt_pk_bf16(v1[2], v1[3]);
                    *(v4u*)(Y + (size_t)slot * DM + col0 + bj * HALF) = o; } }
    }
};
struct EpiMoeYp {
    static constexpr bool PERM = true;
    bf16* YP; const float* gws; int pm0; size_t split_stride;
    __device__ __forceinline__ void operator()(const f32x4 (&acc)[2][2][4][2], const Unit& u, int wr, int wc, int fr, int fq) const {
        const int col0 = (u.pn & 3) * BM + wc * 32 + 8 * fq; bf16* base = YP + (size_t)(u.pn >> 2) * split_stride;
#pragma unroll
        for (int ai = 0; ai < 2; ++ai)
#pragma unroll
            for (int m = 0; m < 4; ++m) { const int rl = ai * HALF + wr * 64 + m * 16 + fr; const float g = gws[u.pm * BM + rl];
#pragma unroll
                for (int bj = 0; bj < 2; ++bj) { const f32x4 v0 = acc[ai][bj][m][0] * g, v1 = acc[ai][bj][m][1] * g;
                    v4u o; o.x = cvt_pk_bf16(v0[0], v0[1]); o.y = cvt_pk_bf16(v0[2], v0[3]); o.z = cvt_pk_bf16(v1[0], v1[1]); o.w = cvt_pk_bf16(v1[2], v1[3]);
                    *(v4u*)(base + (size_t)((u.pm - pm0) * BM + rl) * DM + col0 + bj * HALF) = o; } }
    }
};
struct EpiSwiglu {
    static constexpr bool PERM = true;
    bf16* H; int ldh; int pm0; const float* rs; bf16* H2; int hsplit;
    __device__ __forceinline__ void operator()(const f32x4 (&acc)[2][2][4][2], const Unit& u, int wr, int wc, int fr, int fq) const {
        const int lt = u.pm - pm0; bf16* Hb = (H2 && lt >= hsplit) ? H2 : H;
        const int row0 = ((H2 && lt >= hsplit) ? lt - hsplit : lt) * BM + wr * 64 + fr, col0 = u.pn * HALF + wc * 32 + 8 * fq;
        const f32x8 rstd = row_rstd8(rs, u.pm * BM + wr * 64 + fr, fq);
#pragma unroll
        for (int ai = 0; ai < 2; ++ai)
#pragma unroll
            for (int m = 0; m < 4; ++m) { float h[8];
#pragma unroll
                for (int n = 0; n < 2; ++n)
#pragma unroll
                    for (int j = 0; j < 4; ++j) { const float g = acc[ai][0][m][n][j] * rstd[ai * 4 + m], up = acc[ai][1][m][n][j] * rstd[ai * 4 + m]; h[n * 4 + j] = g * up * __builtin_amdgcn_rcpf(1.0f + __builtin_amdgcn_exp2f(-g * LOG2E)); }
                v4u w; w.x = cvt_pk_bf16(h[0], h[1]); w.y = cvt_pk_bf16(h[2], h[3]); w.z = cvt_pk_bf16(h[4], h[5]); w.w = cvt_pk_bf16(h[6], h[7]);
                *(v4u*)(Hb + (size_t)(row0 + ai * HALF + m * 16) * ldh + col0) = w; }
    }
};
struct EpiMoeDown {
    static constexpr bool PERM = false;
    float* out; const int* tok; const float* gw; int pm0; float scale;
    __device__ __forceinline__ void operator()(const f32x4 (&acc)[2][2][4][2], const Unit& u, int wr, int wc, int fr, int fq) const {
        const int col0 = u.pn * BM + wc * 32 + 4 * fq;
#pragma unroll
        for (int ai = 0; ai < 2; ++ai)
#pragma unroll
            for (int m = 0; m < 4; ++m) { const int slot = u.pm * BM + ai * HALF + wr * 64 + m * 16 + fr; const int t = tok[slot];
                if (t >= 0) { const float g = gw[t] * scale; float* rowp = out + (size_t)t * DM + col0;
#pragma unroll
                    for (int bj = 0; bj < 2; ++bj)
#pragma unroll
                        for (int n = 0; n < 2; ++n) { f32x4* p = (f32x4*)(rowp + bj * HALF + n * 16); *p = *p + acc[ai][bj][m][n] * g; } } }
    }
};

template <class Epi, class Sched, bool ALIGN_EPI = true>
__device__ __forceinline__ void gemm_phase(LAS unsigned char* lds, const GemmK gk, const Sched& S, const Epi& E) {
    int tid = threadIdx.x; asm volatile("" : "+v"(tid));
    const int wid = __builtin_amdgcn_readfirstlane(tid >> 6), lane = tid & 63, wr = wid >> 2, wc = wid & 3, fr = lane & 15, fq = lane >> 4;
    int nt = gk.K / BK; asm volatile("" : "+s"(nt));
    unsigned voffA[2], voffB[2];
#pragma unroll
    for (int i = 0; i < 2; ++i) { int R, C; stage_rc(tid * 16 + i * 8192, R, C); const int Rb = Epi::PERM ? ((R & ~31) + perm32(R & 31)) : R;
        voffA[i] = (unsigned)R * gk.pitchA + (unsigned)C * 2u; voffB[i] = (unsigned)Rb * gk.pitchB + (unsigned)C * 2u; }
    const size_t hstepA = (size_t)HALF * gk.pitchA, hstepB = (size_t)HALF * gk.pitchB;
    const int ksh = gk.kshA; const unsigned kmask = (1u << ksh) - 1u; const size_t gstr = gk.gstrA;
#define PG8_KOA(t) ((size_t)((unsigned)(t) >> ksh) * gstr + (size_t)((unsigned)(t) & kmask) * 128u)
    const unsigned ldsw = (unsigned)wid * 1024u;
    const int aoff = lds_byte(wr * 64 + fr, fq * 8), boff = lds_byte(wc * 32 + fr, fq * 8);
#define PG8_SA(b, h) (((b) * 2 + (h)) * HTB)
#define PG8_SB(b, h) ((4 + (b) * 2 + (h)) * HTB)
#define PG8_STAGE(bufoff, gbase, voff) do { _Pragma("unroll") for (int _i = 0; _i < 2; ++_i) \
        __builtin_amdgcn_global_load_lds((const unsigned*)((const char*)(gbase) + (voff)[_i]), (LAS unsigned*)(lds + (bufoff) + ldsw + _i * 8192), 16, 0, 0); } while (0)
#define PG8_LDA(dst, b, h) do { _Pragma("unroll") for (int m = 0; m < 4; ++m) _Pragma("unroll") for (int k = 0; k < 2; ++k) dst[m][k] = *(const LAS bf16x8*)(lds + PG8_SA(b, h) + aoff + m * 2048 + k * 1024); } while (0)
#define PG8_LDB(dst, b, h) do { _Pragma("unroll") for (int n = 0; n < 2; ++n) _Pragma("unroll") for (int k = 0; k < 2; ++k) dst[n][k] = *(const LAS bf16x8*)(lds + PG8_SB(b, h) + boff + n * 2048 + k * 1024); } while (0)
#define PG8_MMA(ai, bj, At, Bt) do { __builtin_amdgcn_s_setprio(1); _Pragma("unroll") for (int m = 0; m < 4; ++m) _Pragma("unroll") for (int n = 0; n < 2; ++n) _Pragma("unroll") for (int k = 0; k < 2; ++k) \
        acc[ai][bj][m][n] = __builtin_amdgcn_mfma_f32_16x16x32_bf16(Bt[n][k], At[m][k], acc[ai][bj][m][n], 0, 0, 0); __builtin_amdgcn_s_setprio(0); } while (0)
#define PG8_WAIT_V(n) asm volatile("s_waitcnt vmcnt(" #n ")" ::: "memory")
#define PG8_WAIT_L(n) asm volatile("s_waitcnt lgkmcnt(" #n ")" ::: "memory")
#define PG8_BAR __builtin_amdgcn_s_barrier()
#define PG8_SCHED __builtin_amdgcn_sched_barrier(0)
    Unit cur, nxt; int ui = 0;
    if (!S.next(0, cur)) return;
    f32x4 acc[2][2][4][2];
#pragma unroll
    for (int a = 0; a < 2; ++a)
#pragma unroll
        for (int b = 0; b < 2; ++b)
#pragma unroll
            for (int m = 0; m < 4; ++m)
#pragma unroll
                for (int n = 0; n < 2; ++n) acc[a][b][m][n] = (f32x4){0.f, 0.f, 0.f, 0.f};
    bf16x8 At[4][2], B0[2][2], B1[2][2];
    const char* cA = cur.A; const char* cB = cur.B;
    PG8_STAGE(PG8_SB(0, 0), cB, voffB); PG8_STAGE(PG8_SB(0, 1), cB + hstepB, voffB); PG8_STAGE(PG8_SA(0, 0), cA, voffA); PG8_STAGE(PG8_SA(0, 1), cA + hstepA, voffA);
    if (wr == 1) PG8_BAR;
    PG8_WAIT_V(2); PG8_BAR;
    PG8_STAGE(PG8_SB(1, 0), cB + 128, voffB); PG8_STAGE(PG8_SA(1, 0), cA + 128, voffA); PG8_STAGE(PG8_SB(1, 1), cB + hstepB + 128, voffB);
    PG8_WAIT_V(6); PG8_BAR;
    for (;;) {
        const bool has_next = S.next(ui + 1, nxt);
        const char* nA = has_next ? nxt.A : cA; const char* nB = has_next ? nxt.B : cB;
        for (int t = 0; t < nt; t += 2) {
            const bool last = (t == nt - 2);
            const char* a1 = cA + PG8_KOA(t + 1);
            const char* a2 = last ? nA : cA + PG8_KOA(t + 2); const char* b2 = last ? nB : cB + (size_t)(t + 2) * 128u;
            const char* a3 = a2 + 128; const char* b3 = b2 + 128;
            PG8_LDB(B0, 0, 0); PG8_LDB(B1, 0, 1); PG8_SCHED; PG8_LDA(At, 0, 0); PG8_STAGE(PG8_SA(1, 1), a1 + hstepA, voffA);
            PG8_WAIT_V(8); PG8_WAIT_L(0); PG8_BAR; PG8_MMA(0, 0, At, B0); PG8_MMA(0, 1, At, B1); PG8_BAR; PG8_SCHED;
            PG8_LDA(At, 0, 1); PG8_STAGE(PG8_SB(0, 0), b2, voffB); PG8_STAGE(PG8_SB(0, 1), b2 + hstepB, voffB); PG8_STAGE(PG8_SA(0, 0), a2, voffA);
            PG8_WAIT_V(8); PG8_WAIT_L(0); PG8_BAR; PG8_MMA(1, 0, At, B0); PG8_MMA(1, 1, At, B1); PG8_BAR; PG8_SCHED;
            PG8_LDB(B0, 1, 0); PG8_LDB(B1, 1, 1); PG8_SCHED; PG8_LDA(At, 1, 0); PG8_STAGE(PG8_SA(0, 1), a2 + hstepA, voffA);
            PG8_WAIT_V(8); PG8_WAIT_L(0); PG8_BAR; PG8_MMA(0, 0, At, B0); PG8_MMA(0, 1, At, B1); PG8_BAR; PG8_SCHED;
            PG8_LDA(At, 1, 1); PG8_STAGE(PG8_SB(1, 0), b3, voffB); PG8_STAGE(PG8_SB(1, 1), b3 + hstepB, voffB); PG8_STAGE(PG8_SA(1, 0), a3, voffA);
            PG8_WAIT_V(8); PG8_WAIT_L(0); PG8_BAR; PG8_MMA(1, 0, At, B0); PG8_MMA(1, 1, At, B1); PG8_BAR; PG8_SCHED;
        }
        if constexpr (ALIGN_EPI) { if (wr == 0) PG8_BAR; }
        E(acc, cur, wr, wc, fr, fq);
        if (!has_next) break;
#pragma unroll
        for (int a = 0; a < 2; ++a)
#pragma unroll
            for (int b = 0; b < 2; ++b)
#pragma unroll
                for (int m = 0; m < 4; ++m)
#pragma unroll
                    for (int n = 0; n < 2; ++n) acc[a][b][m][n] = (f32x4){0.f, 0.f, 0.f, 0.f};
        cur = nxt; cA = nA; cB = nB; ++ui;
        if constexpr (ALIGN_EPI) { if (wr == 1) PG8_BAR; }
    }
    PG8_WAIT_V(0);
    if constexpr (!ALIGN_EPI) { if (wr == 0) PG8_BAR; }
    PG8_BAR;
#undef PG8_KOA
#undef PG8_SA
#undef PG8_SB
#undef PG8_STAGE
#undef PG8_LDA
#undef PG8_LDB
#undef PG8_MMA
#undef PG8_WAIT_V
#undef PG8_WAIT_L
#undef PG8_BAR
#undef PG8_SCHED
}
}
#define XB_TMO      128
#define XB_XCNT(j)  (256  + 64 * (j))
#define XB_XSUB(j)  (1280 + 64 * (j))
#define XB_XGEN(j)  (2304 + 64 * (j))
#define XB_TOP      3328
#define XB_TOPGEN   3392
#define XCD_BAR_WORDS 3456
#define XB_SPIN_CAP (1u << 22)

__device__ __forceinline__ unsigned xb_ld(unsigned* p)              { return __hip_atomic_load(p, __ATOMIC_RELAXED, __HIP_MEMORY_SCOPE_AGENT); }
__device__ __forceinline__ unsigned xb_add(unsigned* p, unsigned v) { return __hip_atomic_fetch_add(p, v, __ATOMIC_RELAXED, __HIP_MEMORY_SCOPE_AGENT); }
__device__ __forceinline__ unsigned xb_xcc_id() { return (unsigned)__builtin_amdgcn_s_getreg((3 << 11) | 20) & 0xFu; }
#define XB_SPIN(cond, bar) do { unsigned _sp = 0; while (cond) { __builtin_amdgcn_s_sleep(1); \
    if ((++_sp & 255u) == 0u) { if (xb_ld(&(bar)[XB_TMO])) break; if (_sp > XB_SPIN_CAP) { atomicAdd(&(bar)[XB_TMO], 1u); break; } } } } while (0)

struct XcdBarrier { unsigned* bar; unsigned x; volatile LAS unsigned* st; };

__device__ __forceinline__ XcdBarrier xcd_barrier_post(unsigned* bar, volatile LAS unsigned* st) {
    XcdBarrier b; b.bar = bar; b.x = xb_xcc_id(); b.st = st;
    if (threadIdx.x == 0) (void)xb_add(&bar[XB_XCNT(b.x)], 1u);
    return b;
}
__device__ __forceinline__ void xcd_barrier_complete(unsigned* bar, unsigned x, unsigned& nloc, unsigned& nx) {
    const unsigned G = gridDim.x * gridDim.y * gridDim.z;
    unsigned sum, cnt, mine, sp = 0u;
    for (;;) {
        sum = 0u; cnt = 0u; mine = 0u;
#pragma unroll
        for (unsigned j = 0; j < 16; ++j) { const unsigned c = xb_ld(&bar[XB_XCNT(j)]); sum += c; cnt += (c > 0u) ? 1u : 0u; mine = (j == x) ? c : mine; }
        if (sum == G) break;
        __builtin_amdgcn_s_sleep(1);
        if ((++sp & 255u) == 0u) { if (xb_ld(&bar[XB_TMO])) break; if (sp > XB_SPIN_CAP) { atomicAdd(&bar[XB_TMO], 1u); break; } }
    }
    nloc = mine > 0u ? mine : 1u; nx = cnt > 0u ? cnt : 1u;
}
__device__ __forceinline__ void xcd_barrier(const XcdBarrier& b) {
    asm volatile("s_waitcnt vmcnt(0)" ::: "memory");
    __syncthreads();
    if (threadIdx.x == 0) {
        unsigned* bar = b.bar;
        __builtin_amdgcn_s_waitcnt(0);
        unsigned nloc = b.st[0], nx = b.st[1];
        if (nloc == 0u) { xcd_barrier_complete(bar, b.x, nloc, nx); b.st[0] = nloc; b.st[1] = nx; }
        const unsigned old = xb_add(&bar[XB_XSUB(b.x)], 1u);
        const unsigned gen = old / nloc;
        if (old + 1u == (gen + 1u) * nloc) {
            __builtin_amdgcn_fence(__ATOMIC_RELEASE, "agent");
            asm volatile("s_waitcnt vmcnt(0)" ::: "memory");
            const unsigned og = xb_add(&bar[XB_TOP], 1u);
            const unsigned tg = og / nx;
            if (og + 1u == (tg + 1u) * nx) xb_add(&bar[XB_TOPGEN], 1u);
            else XB_SPIN(xb_ld(&bar[XB_TOPGEN]) == tg, bar);
            __builtin_amdgcn_fence(__ATOMIC_ACQUIRE, "agent");
            xb_add(&bar[XB_XGEN(b.x)], 1u);
            asm volatile("s_waitcnt vmcnt(0)" ::: "memory");
        } else {
            XB_SPIN(xb_ld(&bar[XB_XGEN(b.x)]) == gen, bar);
            __builtin_amdgcn_fence(__ATOMIC_ACQUIRE, "agent");
            asm volatile("s_waitcnt vmcnt(0)" ::: "memory");
        }
    }
    __syncthreads();
}

struct Frame {
    LAS unsigned char* lds;
    char* ldsg;
    volatile LAS unsigned* MISC;
    gu32* ctl;
    int tid, lane, wave, vcu, G;
    const __attribute__((address_space(4))) char* kap;
    float* out; unsigned char* ws;
};
#define FIN(i) (*(const float* const __attribute__((address_space(4)))*)(F.kap + 8 * (i)))
#define PHASE_FENCE() do { unsigned long long k_ = (unsigned long long)F.kap; asm volatile("" : "+s"(k_)); F.kap = (const __attribute__((address_space(4))) char*)k_; \
    int t_ = F.tid; asm volatile("" : "+v"(t_)); F.tid = t_; F.lane = t_ & 63; } while (0)
#define WSP(T, off) ((T*)(F.ws + (off)))
#define GRP(g) (WSP(bf16, WS_PROJ) + (size_t)(g) * GS)
#define QKVG(g) (WSP(bf16, WS_QKV) + (size_t)(g) * GS)

__device__ __forceinline__ void rms_row(const float* xrow, const float* gain, int lane, f32x4 (&v)[4]) {
    const GAS f32x4* xr = (const GAS f32x4*)xrow + lane; float s = 0.f;
#pragma unroll
    for (int j = 0; j < 4; ++j) { v[j] = xr[64 * j]; s += (v[j].x * v[j].x + v[j].y * v[j].y) + (v[j].z * v[j].z + v[j].w * v[j].w); }
    const float rstd = 1.0f / sqrtf(wave_sum(s) * (1.f / DM) + RMS_EPS);
#pragma unroll
    for (int j = 0; j < 4; ++j) { const f32x4 g = ((const GAS f32x4*)gain)[lane + 64 * j]; v[j] = v[j] * rstd * g; }
}
__device__ __forceinline__ void store_row_bf16(bf16* orow, int lane, const f32x4 (&v)[4]) {
    GAS unsigned long long* o8 = (GAS unsigned long long*)orow + lane;
#pragma unroll
    for (int j = 0; j < 4; ++j) o8[64 * j] = (unsigned long long)cvtpk(v[j].x, v[j].y) | ((unsigned long long)cvtpk(v[j].z, v[j].w) << 32);
}
__device__ __forceinline__ void load_row_bf16(const bf16* row, int lane, float (&v)[16]) {
    const v4u a = ((const GAS v4u*)row)[lane], b = ((const GAS v4u*)row)[64 + lane];
#pragma unroll
    for (int q = 0; q < 4; ++q) { v[2 * q] = __uint_as_float(a[q] << 16); v[2 * q + 1] = __uint_as_float(a[q] & 0xffff0000u); v[8 + 2 * q] = __uint_as_float(b[q] << 16); v[8 + 2 * q + 1] = __uint_as_float(b[q] & 0xffff0000u); }
}
__device__ __forceinline__ void store_row16_bf16(bf16* row, int lane, const float (&v)[16]) {
    ((GAS v4u*)row)[lane] = (v4u){cvtpk(v[0], v[1]), cvtpk(v[2], v[3]), cvtpk(v[4], v[5]), cvtpk(v[6], v[7])};
    ((GAS v4u*)row)[64 + lane] = (v4u){cvtpk(v[8], v[9]), cvtpk(v[10], v[11]), cvtpk(v[12], v[13]), cvtpk(v[14], v[15])};
}
__device__ __forceinline__ void rms16(float (&v)[16], const float* gain, int lane) {
    float s = 0.f;
#pragma unroll
    for (int i = 0; i < 16; ++i) s += v[i] * v[i];
    const float rstd = 1.0f / sqrtf(wave_sum(s) * (1.f / DM) + RMS_EPS);
    const f32x4 g0 = ((const GAS f32x4*)gain)[2 * lane], g1 = ((const GAS f32x4*)gain)[2 * lane + 1], g2 = ((const GAS f32x4*)gain)[128 + 2 * lane], g3 = ((const GAS f32x4*)gain)[128 + 2 * lane + 1];
#pragma unroll
    for (int i = 0; i < 4; ++i) { v[i] *= rstd * g0[i]; v[4 + i] *= rstd * g1[i]; v[8 + i] *= rstd * g2[i]; v[12 + i] *= rstd * g3[i]; }
}
__device__ __forceinline__ void norm_phase(Frame& F, const float* srcf, const bf16* srcb, const float* gain) {
    const int gw = F.vcu * NWAVES + F.wave, NGW = F.G * NWAVES;
    if (srcf) { for (int m = gw; m < M; m += 2 * NGW) { f32x4 v[4], w[4]; const int mb = m + NGW;
            const GAS f32x4* xa = (const GAS f32x4*)(srcf + (size_t)m * DM) + F.lane; const GAS f32x4* xb = (const GAS f32x4*)(srcf + (size_t)(mb < M ? mb : m) * DM) + F.lane;
#pragma unroll
            for (int j = 0; j < 4; ++j) { v[j] = xa[64 * j]; w[j] = xb[64 * j]; }
            float sa = 0.f, sb = 0.f;
#pragma unroll
            for (int j = 0; j < 4; ++j) { sa += (v[j].x * v[j].x + v[j].y * v[j].y) + (v[j].z * v[j].z + v[j].w * v[j].w); sb += (w[j].x * w[j].x + w[j].y * w[j].y) + (w[j].z * w[j].z + w[j].w * w[j].w); }
            const float ra = 1.0f / sqrtf(wave_sum(sa) * (1.f / DM) + RMS_EPS), rb = 1.0f / sqrtf(wave_sum(sb) * (1.f / DM) + RMS_EPS);
#pragma unroll
            for (int j = 0; j < 4; ++j) { const f32x4 g = ((const GAS f32x4*)gain)[F.lane + 64 * j]; v[j] = v[j] * ra * g; w[j] = w[j] * rb * g; }
            store_row_bf16(WSP(bf16, WS_XN) + (size_t)m * DM, F.lane, v); if (mb < M) store_row_bf16(WSP(bf16, WS_XN) + (size_t)mb * DM, F.lane, w); } }
    else { for (int m = gw; m < M; m += NGW) { float v[16]; load_row_bf16(srcb + (size_t)m * DM, F.lane, v); rms16(v, gain, F.lane); store_row16_bf16(WSP(bf16, WS_XN) + (size_t)m * DM, F.lane, v); } }
}

struct SrcCol { const float* W; int col; int ldw; };
template <class Fn>
__device__ __forceinline__ void xpose_load(const Fn& fn, int K, const float* kgain, int item, int lane, float (&v)[32]) {
    const int nkb = K / 64, rb = item / nkb, kb = item % nkb, k0 = 64 * kb, r0 = 32 * rb;
    const SrcCol s = fn(r0 + (lane & 31));
#pragma unroll
    for (int i = 0; i < 32; ++i) { const int kk = 2 * i + (lane >> 5); float x = 0.f; if (s.W) { x = s.W[(size_t)(k0 + kk) * s.ldw + s.col]; if (kgain) x *= kgain[k0 + kk]; } v[i] = x; }
}
__device__ __forceinline__ void xpose_store(int K, bf16* WT, LAS float* scr, int item, int lane, const float (&v)[32]) {
    const int nkb = K / 64, rb = item / nkb, kb = item % nkb, k0 = 64 * kb, r0 = 32 * rb;
#pragma unroll
    for (int i = 0; i < 32; ++i) scr[(2 * i + (lane >> 5)) * 33 + (lane & 31)] = v[i];
    LDS_WAIT(); asm volatile("" ::: "memory");
    const int c = lane & 7;
#pragma unroll
    for (int j = 0; j < 4; ++j) { const int n = (lane >> 3) + 8 * j; const LAS float* sp = scr + (8 * c) * 33 + n;
        v4u o; o.x = cvtpk(sp[0 * 33], sp[1 * 33]); o.y = cvtpk(sp[2 * 33], sp[3 * 33]); o.z = cvtpk(sp[4 * 33], sp[5 * 33]); o.w = cvtpk(sp[6 * 33], sp[7 * 33]);
        *(GAS v4u*)(WT + (size_t)(r0 + n) * K + k0 + 8 * c) = o; }
    LDS_WAIT(); asm volatile("" ::: "memory");
}
template <class Fn>
__device__ __forceinline__ void xpose_matrix(const Fn& fn, int K, bf16* WT, const float* kgain, LAS float* scr, int first, int nitems, int stride, int lane) {
    float va[32], vb[32];
    int it = first;
    if (it < nitems) xpose_load(fn, K, kgain, it, lane, va);
    while (it < nitems) {
        const int i1 = it + stride, i2 = i1 + stride;
        if (i1 < nitems) xpose_load(fn, K, kgain, i1, lane, vb);
        xpose_store(K, WT, scr, it, lane, va);
        if (i1 >= nitems) break;
        if (i2 < nitems) xpose_load(fn, K, kgain, i2, lane, va);
        xpose_store(K, WT, scr, i1, lane, vb);
        it = i2;
    }
}
__device__ __forceinline__ int incol(int rho) {
    const int g = rho >> 7, c = rho & 127;
    if (g < 4) return rho;
    if (g < 6) return 512 + (rho - 512);
    if (g < 8) return 768 + (rho - 768);
    if (g < 12) return 1092 + (rho - 1024);
    if (g < 18) return 1604 + (rho - 1536);
    if (g == 18) { if (c < 64) return 1024 + c; if (c < 68) return 1088 + (c - 64); if (c < 80) return 2372 + (c - 68); return -1; }
    return -1;
}
struct FnIn { const float* W; __device__ __forceinline__ SrcCol operator()(int r) const { const int c = incol(r); return SrcCol{c >= 0 ? W : nullptr, c, 2384}; } };
struct FnPlain { const float* W; int ldw; int coff; __device__ __forceinline__ SrcCol operator()(int r) const { return SrcCol{W, r + coff, ldw}; } };
struct FnGU { const float* Wg; const float* Wu; int ldw; __device__ __forceinline__ SrcCol operator()(int r) const { const int pn = r >> 8, c = r & 127;
    const long long d = (r & 128) ? ((const char*)Wu - (const char*)Wg) : 0ll;
    return SrcCol{(const float*)((const char*)Wg + d), pn * 128 + c, ldw}; } };
namespace att {
constexpr int KVBLK = 64, SHM_K = KVBLK * 128 * 2, SHM_V = KVBLK * 128 * 2;
#define KSWZ(row, colB) ((row) * 256 + ((colB) ^ (((row) & 7) << 4)))
__device__ __forceinline__ int v_st(int k, int c) { const int kk = (k & ~0xC) | ((k & 4) << 1) | ((k & 8) >> 1); return ((kk >> 3) * 4 + (c >> 5)) * 512 + ((kk & 7) * 32 + (c & 31)) * 2; }
__device__ __forceinline__ int v_rd_base(int lane) { return ((lane & 3) << 3) | (((lane >> 2) & 3) << 6) | (((lane >> 4) & 1) << 5) | (((lane >> 5) & 1) << 8); }
constexpr int v_rd_off(int d0, int ks, int half) { return d0 * 512 + ks * 4096 + half * 2048; }
__device__ __forceinline__ int crow(int r, int hi) { return (r & 3) + 8 * (r >> 2) + 4 * hi; }
__device__ __forceinline__ void qkt(f32x16& p0, f32x16& p1, const char* K_lds, int r32, int hi, const bf16x8* qr) {
    p0 = f32x16{}; p1 = f32x16{};
    const char* kb[4];
#pragma unroll
    for (int dd = 0; dd < 4; ++dd) kb[dd] = K_lds + KSWZ(r32, (dd * 16 + hi * 8) * 2);
#pragma unroll
    for (int d0 = 0; d0 < 8; ++d0) { const char* a = kb[d0 & 3] + (d0 >> 2) * 128;
        bf16x8 b0 = *reinterpret_cast<const bf16x8*>(a);
        bf16x8 b1 = *reinterpret_cast<const bf16x8*>(a + 32 * 256);
        p0 = __builtin_amdgcn_mfma_f32_32x32x16_bf16(b0, qr[d0], p0, 0, 0, 0);
        p1 = __builtin_amdgcn_mfma_f32_32x32x16_bf16(b1, qr[d0], p1, 0, 0, 0);
        if (d0 == 3) SBAR(); }
}
__device__ __forceinline__ void qkt_lq(f32x16& p0, f32x16& p1, const char* K_lds, const char* Q_lds, int r32, int hi) {
    p0 = f32x16{}; p1 = f32x16{};
    int ko[4];
#pragma unroll
    for (int dd = 0; dd < 4; ++dd) ko[dd] = KSWZ(r32, (dd * 16 + hi * 8) * 2);
#pragma unroll
    for (int d0 = 0; d0 < 8; ++d0) { const int a = ko[d0 & 3] + (d0 >> 2) * 128;
        bf16x8 b0 = *reinterpret_cast<const bf16x8*>(K_lds + a);
        bf16x8 b1 = *reinterpret_cast<const bf16x8*>(K_lds + a + 32 * 256);
        bf16x8 q = *reinterpret_cast<const bf16x8*>(Q_lds + a);
        p0 = __builtin_amdgcn_mfma_f32_32x32x16_bf16(b0, q, p0, 0, 0, 0);
        p1 = __builtin_amdgcn_mfma_f32_32x32x16_bf16(b1, q, p1, 0, 0, 0);
        if (d0 == 3) SBAR(); }
}
__device__ __forceinline__ void pv_tile(f32x16* o, int vb0, bf16x8 pa0, bf16x8 pa1, bf16x8 pa2, bf16x8 pa3) {
#define TRRD(dst, off) asm volatile("ds_read_b64_tr_b16 %0, %1 offset:%2" : "=&v"(dst) : "v"(vb0), "i"(off) : "memory")
#define PV_RD(S, d0) do { constexpr int b_ = v_rd_off(d0, 0, 0); \
        TRRD(S##l0, b_); TRRD(S##h0, b_ + 2048); TRRD(S##l1, b_ + 4096); TRRD(S##h1, b_ + 6144); TRRD(S##l2, b_ + 8192); TRRD(S##h2, b_ + 10240); TRRD(S##l3, b_ + 12288); TRRD(S##h3, b_ + 14336); } while (0)
#define PV_MM(S, d0) do { \
        o[d0] = __builtin_amdgcn_mfma_f32_32x32x16_bf16(pa0, (bf16x8){S##l0[0], S##l0[1], S##l0[2], S##l0[3], S##h0[0], S##h0[1], S##h0[2], S##h0[3]}, o[d0], 0, 0, 0);   \
        o[d0] = __builtin_amdgcn_mfma_f32_32x32x16_bf16(pa1, (bf16x8){S##l1[0], S##l1[1], S##l1[2], S##l1[3], S##h1[0], S##h1[1], S##h1[2], S##h1[3]}, o[d0], 0, 0, 0);   \
        o[d0] = __builtin_amdgcn_mfma_f32_32x32x16_bf16(pa2, (bf16x8){S##l2[0], S##l2[1], S##l2[2], S##l2[3], S##h2[0], S##h2[1], S##h2[2], S##h2[3]}, o[d0], 0, 0, 0);   \
        o[d0] = __builtin_amdgcn_mfma_f32_32x32x16_bf16(pa3, (bf16x8){S##l3[0], S##l3[1], S##l3[2], S##l3[3], S##h3[0], S##h3[1], S##h3[2], S##h3[3]}, o[d0], 0, 0, 0); } while (0)
    s16x4 Al0, Al1, Al2, Al3, Ah0, Ah1, Ah2, Ah3, Bl0, Bl1, Bl2, Bl3, Bh0, Bh1, Bh2, Bh3;
    PV_RD(A, 0); PV_RD(B, 1);
    asm volatile("s_waitcnt lgkmcnt(8)" ::: "memory"); SBAR(); PV_MM(A, 0); SBAR();
    PV_RD(A, 2);
    asm volatile("s_waitcnt lgkmcnt(8)" ::: "memory"); SBAR(); PV_MM(B, 1); SBAR();
    PV_RD(B, 3);
    asm volatile("s_waitcnt lgkmcnt(8)" ::: "memory"); SBAR(); PV_MM(A, 2); SBAR();
    asm volatile("s_waitcnt lgkmcnt(0)" ::: "memory"); SBAR(); PV_MM(B, 3);
#undef PV_RD
#undef PV_MM
#undef TRRD
}
__device__ __forceinline__ void pack_p(const f32x16& p0, const f32x16& p1, bf16x8& pa0, bf16x8& pa1, bf16x8& pa2, bf16x8& pa3) {
#define PK4(P, B_, OUT) do { unsigned a0 = cvtpk(P[B_+0], P[B_+1]), a1 = cvtpk(P[B_+2], P[B_+3]);                          \
        unsigned b0 = cvtpk(P[B_+4], P[B_+5]), b1 = cvtpk(P[B_+6], P[B_+7]);                                             \
        auto r0 = __builtin_amdgcn_permlane32_swap(a0, b0, false, false); auto r1 = __builtin_amdgcn_permlane32_swap(a1, b1, false, false); \
        v4u w = {r0[0], r1[0], r0[1], r1[1]}; OUT = __builtin_bit_cast(bf16x8, w); } while (0)
    PK4(p0, 0, pa0); PK4(p0, 8, pa1); PK4(p1, 0, pa2); PK4(p1, 8, pa3);
#undef PK4
}
__device__ __forceinline__ float xhalf_max(float v) { auto rr = __builtin_amdgcn_permlane32_swap(__float_as_uint(v), __float_as_uint(v), false, false); return fmaxf(__uint_as_float(rr[0]), __uint_as_float(rr[1])); }
__device__ __forceinline__ float xhalf_sum(float v) { auto rr = __builtin_amdgcn_permlane32_swap(__float_as_uint(v), __float_as_uint(v), false, false); return __uint_as_float(rr[0]) + __uint_as_float(rr[1]); }
__device__ __forceinline__ void softmax_step(f32x16& p0, f32x16& p1, float& m_reg, float& l_reg, f32x16* o, float* al_l, int r32, int hi) {
    float pmax = p0[0];
#pragma unroll
    for (int r = 1; r < 16; ++r) pmax = fmaxf(pmax, p0[r]);
#pragma unroll
    for (int r = 0; r < 16; ++r) pmax = fmaxf(pmax, p1[r]);
    pmax = xhalf_max(pmax);
    float mn, alpha;
    if (__all(pmax - m_reg <= 8.f)) { mn = m_reg; alpha = 1.f; }
    else { mn = fmaxf(m_reg, pmax); alpha = __builtin_amdgcn_exp2f(m_reg - mn); m_reg = mn; }
#pragma unroll
    for (int r = 0; r < 16; ++r) { p0[r] = __builtin_amdgcn_exp2f(p0[r] - mn); p1[r] = __builtin_amdgcn_exp2f(p1[r] - mn); }
    float ps = 0.f;
#pragma unroll
    for (int r = 0; r < 16; ++r) ps += p0[r] + p1[r];
    ps = xhalf_sum(ps);
    l_reg = l_reg * alpha + ps;
    if (__any(alpha < 1.f)) { if (hi == 0) al_l[r32] = alpha; asm volatile("s_waitcnt lgkmcnt(0)" ::: "memory");
#pragma unroll
        for (int d_ = 0; d_ < 4; ++d_)
#pragma unroll
            for (int r = 0; r < 16; ++r) o[d_][r] *= al_l[crow(r, hi)];
        asm volatile("s_waitcnt lgkmcnt(0)" ::: "memory"); }
}
struct DmaOff { unsigned k[2], v[2]; };
__device__ __forceinline__ void dma_offsets(DmaOff& d, int tid) {
#pragma unroll
    for (int i = 0; i < 2; ++i) { const int L = i * 8192 + tid * 16;
        const int row = L >> 8, pos = (L >> 4) & 15, c = pos ^ (row & 7); d.k[i] = (unsigned)(row * 256 + c * 16);
        const int sub = L >> 9, within = L & 511, kk = (sub >> 2) * 8 + (within >> 6), ccol = (within & 63) >> 1, cblk = sub & 3;
        const int k = (kk & ~0xC) | ((kk & 4) << 1) | ((kk & 8) >> 1); d.v[i] = (unsigned)(k * 256 + (cblk * 32 + ccol) * 2); }
}
__device__ __forceinline__ void dma_tile(const DmaOff& d, const bf16* Kp, const bf16* Vp, int key0, LAS unsigned char* buf, int wid) {
    const char* kb = (const char*)(Kp + (size_t)key0 * 128); const char* vb = (const char*)(Vp + (size_t)key0 * 128);
#pragma unroll
    for (int i = 0; i < 2; ++i) {
        __builtin_amdgcn_global_load_lds((const unsigned*)(kb + d.k[i]), (LAS unsigned*)(buf + 16384 + i * 8192 + wid * 1024), 16, 0, 0);
        __builtin_amdgcn_global_load_lds((const unsigned*)(vb + d.v[i]), (LAS unsigned*)(buf + i * 8192 + wid * 1024), 16, 0, 0); }
}
}
constexpr int AL_BUF = 0  , AL_Q = 65536  ;
constexpr int AL_WS = MISC_OFF + 2048  , AL_TBL = AL_WS + 2048  , AL_UNI = AL_TBL + 4 * 320 * 4  , AL_TRI = AL_UNI + 256  , AL_GB = AL_TRI + 2048  , AL_TBL132 = MISC_OFF + 12288  ;
static_assert(AL_Q + 65536 <= RING_BYTES && AL_GB + 128 <= AL_TBL132 && AL_TBL132 + 4 * 132 * 4 <= LDS_BYTES, "attention LDS map");

__device__ __forceinline__ void fill_bias_tbl132(Frame& F, float* tbl, int h0) {
    const float* rb = FIN(I_RELB);
    for (int i = F.tid; i < 4 * 132; i += NTHR) { const int h = i / 132, d = i % 132; const int dd = d > 128 ? 128 : d;
        tbl[i] = (rb[rel_bucket_dev(dd) * 8 + h0 + h] - rb[31 * 8 + h0 + h]) * LOG2E; }
}
__device__ __forceinline__ void fill_bias_tbl(Frame& F, float* tbl, int h0) {
    const float* rb = FIN(I_RELB);
    for (int i = F.tid; i < 4 * 320; i += NTHR) { const int h = i / 320, d = i % 320 - 96;
        tbl[i] = (d >= 0 && d < 113) ? (rb[rel_bucket_dev(d) * 8 + h0 + h] - rb[31 * 8 + h0 + h]) * LOG2E : 0.f; }
}

template <int MODE>
__device__ __forceinline__ void attn_unit(Frame& F, int b, int qt) {
    using namespace att;
    char* lds = F.ldsg;
    int tid = F.tid; asm volatile("" : "+v"(tid));
    const int wid = F.wave, lane = tid & 63, r32 = lane & 31, hi = lane >> 5;
    const int hd = wid & 3, qh = wid >> 2, q0 = qt * 64, tw = q0 + 32 * qh, t = tw + r32;
    const size_t rowg = (size_t)b * SEQ;
    float* wsf = (float*)(lds + AL_WS) + wid * 64; float* li_l = wsf; float* al_l = wsf + 32;
    const float* tbl = (const float*)(lds + AL_TBL) + hd * 320;
    const bf16* Qp = GRP((MODE == 0 ? G_QA : G_QB) + hd) + (rowg + t) * 128;
    const bf16* Kp = (MODE == 0 ? WSP(bf16, WS_AK) : MODE == 1 ? GRP(G_SK) : GRP(G_WK)) + rowg * 128;
    const bf16* Vp = (MODE == 0 ? WSP(bf16, WS_AV) : MODE == 1 ? GRP(G_SV) : GRP(G_WV)) + rowg * 128;
    bf16x8 qr[8];
#pragma unroll
    for (int d0 = 0; d0 < 8; ++d0) qr[d0] = *(const bf16x8*)(Qp + d0 * 16 + hi * 8);
    unsigned long long todo = (qt == 63) ? ~0ull : ((2ull << qt) - 1ull);
    unsigned long long bm64 = 0ull;
    if (MODE == 1) {
        bm64 = WSP(unsigned long long, WS_BLK)[rowg + t];
        volatile LAS unsigned* uni = (volatile LAS unsigned*)(F.lds + AL_UNI);
        if (tid < 2) uni[tid] = 0u;
        __syncthreads();
        __hip_atomic_fetch_or((LAS unsigned*)(F.lds + AL_UNI), (unsigned)bm64, __ATOMIC_RELAXED, __HIP_MEMORY_SCOPE_WORKGROUP);
        __hip_atomic_fetch_or((LAS unsigned*)(F.lds + AL_UNI) + 1, (unsigned)(bm64 >> 32), __ATOMIC_RELAXED, __HIP_MEMORY_SCOPE_WORKGROUP);
        __syncthreads();
        const unsigned long long um = (unsigned long long)uni[0] | ((unsigned long long)uni[1] << 32);
        todo &= um;
    }
    if (MODE == 2) { const int jl = q0 >= 511 ? ((q0 - 511) >> 6) : 0; todo &= ~((1ull << jl) - 1ull); }
    todo = ((unsigned long long)__builtin_amdgcn_readfirstlane((unsigned)todo)) | ((unsigned long long)__builtin_amdgcn_readfirstlane((unsigned)(todo >> 32)) << 32);
    const unsigned* bmrow = WSP(unsigned, WS_BM) + (rowg + t) * 128;
    float m_reg = -1e30f, l_reg = 0.f; f32x16 o[4] = {};
    const int vrb = v_rd_base(lane);
    DmaOff dof; dma_offsets(dof, tid);
    int j = __builtin_ctzll(todo); todo &= todo - 1ull;
    int buf = 0;
    v2u wsel = {0u, 0u}, wnx = {0u, 0u};
    if (MODE == 0) wnx = *(const v2u*)(bmrow + 2 * j);
    dma_tile(dof, Kp, Vp, j * 64, F.lds + AL_BUF, wid);
    for (;;) {
        asm volatile("s_waitcnt vmcnt(0)" ::: "memory");
        __syncthreads();
        const int jn = todo ? __builtin_ctzll(todo) : -1;
        if (MODE == 0) { wsel = wnx; if (jn >= 0) wnx = *(const v2u*)(bmrow + 2 * jn); }
        if (jn >= 0) { todo &= todo - 1ull; dma_tile(dof, Kp, Vp, jn * 64, F.lds + AL_BUF + (buf ^ 1) * 32768, wid); }
        const char* V_lds = lds + AL_BUF + buf * 32768; const char* K_lds = V_lds + 16384;
        const int vb0 = (int)(uintptr_t)(lds + AL_BUF + buf * 32768) + vrb;
        const int kb = j * 64;
        bool act = true;
        if (MODE == 1) act = __any((int)((bm64 >> j) & 1ull));
        if (MODE == 2) act = (kb <= tw + 31) && (kb + 63 >= tw - 511);
        if (MODE == 0) act = (kb <= tw + 31);
        if (act) {
            f32x16 p0, p1;
            qkt(p0, p1, K_lds, r32, hi, qr); SBAR();
            const float NEG = -__builtin_inff();
            const int dq = t - kb - 4 * hi;
            if (tw - (kb + 63) < 128) {
                const float* tp = tbl + (dq + 37);
#pragma unroll
                for (int r = 0; r < 16; ++r) { const int c = (r & 3) + 8 * (r >> 2); p0[r] += tp[59 - c]; p1[r] += tp[27 - c]; }
            }
            if (MODE == 0) {
                const unsigned w0 = wsel.x >> (4 * hi), w1 = wsel.y >> (4 * hi);
#pragma unroll
                for (int r = 0; r < 16; ++r) { const int c = (r & 3) + 8 * (r >> 2);
                    const unsigned m0 = (unsigned)__builtin_amdgcn_sbfe((int)w0, c, 1), m1 = (unsigned)__builtin_amdgcn_sbfe((int)w1, c, 1);
                    p0[r] = __uint_as_float((__float_as_uint(p0[r]) & m0) | (0xff800000u & ~m0));
                    p1[r] = __uint_as_float((__float_as_uint(p1[r]) & m1) | (0xff800000u & ~m1)); }
            } else {
                const unsigned W = (MODE == 2) ? 512u : 0x7fffffffu;
                const bool rowsel = (MODE == 1) ? (((bm64 >> j) & 1ull) != 0ull) : true;
#pragma unroll
                for (int r = 0; r < 16; ++r) { const int c = (r & 3) + 8 * (r >> 2);
                    if (!rowsel || (unsigned)(dq - c) >= W) p0[r] = NEG;
                    if (!rowsel || (unsigned)(dq - c - 32) >= W) p1[r] = NEG; }
            }
            SBAR(); softmax_step(p0, p1, m_reg, l_reg, o, al_l, r32, hi); SBAR();
            bf16x8 pa0, pa1, pa2, pa3;
            pack_p(p0, p1, pa0, pa1, pa2, pa3); SBAR();
            pv_tile(o, vb0, pa0, pa1, pa2, pa3); SBAR();
        }
        if (jn < 0) break;
        j = jn; buf ^= 1;
    }
    {
        float fac = l_reg > 0.f ? 1.0f / l_reg : 0.f;
        if (MODE != 0) { const float gl = bf2f(GRP(G_MISC)[(rowg + t) * 128 + 68 + MODE * 4 + hd]); fac *= 1.0f / (1.0f + __expf(-gl)); }
        if (hi == 0) li_l[r32] = fac;
        asm volatile("s_waitcnt lgkmcnt(0)" ::: "memory");
        float rli[16];
#pragma unroll
        for (int r = 0; r < 16; ++r) rli[r] = li_l[crow(r, hi)];
        const size_t row0 = rowg + tw;
        if (MODE == 1) {
            const float* OCp = WSP(float, WS_OC) + row0 * 512 + hd * 128; float* OC2p = WSP(float, WS_OC2) + row0 * 512 + hd * 128;
#pragma unroll
            for (int r = 0; r < 16; ++r) { const int orow = crow(r, hi);
#pragma unroll
                for (int d0 = 0; d0 < 4; ++d0) { const size_t ix = (size_t)orow * 512 + d0 * 32 + r32; OC2p[ix] = OCp[ix] + o[d0][r] * rli[r]; } }
        } else {
            bf16* Op = WSP(bf16, WS_O) + row0 * DM + (MODE == 2 ? 512 : 0) + hd * 128;
            const float* OCp = WSP(float, WS_OC2) + row0 * 512 + hd * 128;
#pragma unroll
            for (int r = 0; r < 16; ++r) { const int orow = crow(r, hi);
#pragma unroll
                for (int d0 = 0; d0 < 4; ++d0) { float v = o[d0][r] * rli[r];
                    if (MODE == 2) v += OCp[(size_t)orow * 512 + d0 * 32 + r32];
                    const float vn = __shfl_xor(v, 1);
                    if ((r32 & 1) == 0) *(unsigned*)(Op + (size_t)orow * DM + d0 * 32 + r32) = cvtpk(v, vn); } }
        }
    }
    __syncthreads();
}
__device__ __forceinline__ float idx_k2f(unsigned k) { return __uint_as_float((k & 0x80000000u) ? (k & 0x7fffffffu) : ~k); }
__device__ __forceinline__ unsigned idx_f2k(float f) { const unsigned u = __float_as_uint(f); return (u >> 31) ? ~u : (u | 0x80000000u); }
__device__ __forceinline__ unsigned half_sum_dpp(unsigned x) {
    x += (unsigned)__builtin_amdgcn_update_dpp(0, (int)x, 0x111, 0xf, 0xf, true);
    x += (unsigned)__builtin_amdgcn_update_dpp(0, (int)x, 0x112, 0xf, 0xf, true);
    x += (unsigned)__builtin_amdgcn_update_dpp(0, (int)x, 0x114, 0xf, 0xf, true);
    x += (unsigned)__builtin_amdgcn_update_dpp(0, (int)x, 0x118, 0xf, 0xf, true);
    x += (unsigned)__builtin_amdgcn_update_dpp(0, (int)x, 0x142, 0xa, 0xf, true);
    return x;
}
constexpr int IL_CAND = MISC_OFF + 2048, IL_HIST = IL_CAND + 4096;
__device__ __forceinline__ unsigned wave_sum_dpp63(unsigned x) {
    x = half_sum_dpp(x); x += (unsigned)__builtin_amdgcn_update_dpp(0, (int)x, 0x143, 0xc, 0xf, true); return (unsigned)__builtin_amdgcn_readlane((int)x, 63); }
__device__ __forceinline__ void idx_unit(Frame& F, int b, int tq, unsigned sub) {
    int tid = F.tid; asm volatile("" : "+v"(tid));
    const int wid = F.wave, lane = tid & 63, r32 = lane & 31, hi = lane >> 5;
    const int t0 = tq * 8; const size_t rowg = (size_t)b * SEQ;
    unsigned* bmrow = WSP(unsigned, WS_BM) + (rowg + t0) * 128;
    const int NT = 2 * (t0 >> 6) + 2;
    if (t0 + 8 <= 256) {
        for (int i = tid; i < 8 * NT; i += NTHR) { const int q = i / NT, wd = i % NT, t = t0 + q, lo = wd * 32;
            const unsigned word = (t >= lo + 31) ? 0xffffffffu : (t < lo ? 0u : ((2u << (t - lo)) - 1u)); bmrow[q * 128 + wd] = word; }
        return;
    }
    LAS unsigned* S = (LAS unsigned*)F.lds;
    const bf16* misc = GRP(G_MISC);
    {
        bf16x8 aq[4];
        { const int ql = r32 >> 2, h = r32 & 3; const bf16* p = GRP(G_IQ + (h >> 1)) + (rowg + t0 + ql) * 128 + (h & 1) * 64 + hi * 8;
#pragma unroll
          for (int c = 0; c < 4; ++c) aq[c] = *(const bf16x8*)(p + c * 16); }
        float wq[4][4];
#pragma unroll
        for (int qj = 0; qj < 4; ++qj) { const v2u w = *(const v2u*)(misc + (rowg + t0 + 2 * qj + hi) * 128 + 64);
            wq[qj][0] = __uint_as_float(w.x << 16); wq[qj][1] = __uint_as_float(w.x & 0xffff0000u); wq[qj][2] = __uint_as_float(w.y << 16); wq[qj][3] = __uint_as_float(w.y & 0xffff0000u); }
#define IDX_LOAD(g, u0) do { _Pragma("unroll") for (int u = (u0); u < (u0) + 2; ++u) { int tile = wid + 8 * (4 * (g) + u); tile = tile < NT ? tile : NT - 1; const bf16* kp = misc + (rowg + tile * 32 + r32) * 128 + hi * 8; \
            _Pragma("unroll") for (int c = 0; c < 4; ++c) bk[u][c] = *(const bf16x8*)(kp + c * 16); } } while (0)
#define IDX_MMA(u0) do { _Pragma("unroll") for (int u = 0; u < 2; ++u) { acc[u] = f32x16{}; \
            _Pragma("unroll") for (int c = 0; c < 4; ++c) acc[u] = __builtin_amdgcn_mfma_f32_32x32x16_bf16(aq[c], bk[(u0) + u][c], acc[u], 0, 0, 0); } } while (0)
#define IDX_COMB(g, u0) do { _Pragma("unroll") for (int u = 0; u < 2; ++u) { const int tile = wid + 8 * (4 * (g) + (u0) + u), kb = tile * 32; \
            if (tile < NT) { _Pragma("unroll") for (int qj = 0; qj < 4; ++qj) { float s = 0.f; \
                _Pragma("unroll") for (int h = 0; h < 4; ++h) s = fmaf(fmaxf(acc[u][4 * qj + h], 0.f), wq[qj][h], s); \
                S[(2 * qj + hi) * 4096 + kb + r32] = (kb + r32 <= t0 + 2 * qj + hi) ? idx_f2k(s) : 0u; } } } } while (0)
#pragma unroll 1
        for (int rk = 0; rk < 1 + (int)(sub & 1u); ++rk) {
            bf16x8 bk[4][4]; f32x16 acc[2];
            IDX_LOAD(0, 0); IDX_LOAD(0, 2);
#pragma unroll
            for (int g = 0; g < 4; ++g) if (wid + 32 * g < NT) { const bool nx = g < 3 && wid + 32 * (g + 1) < NT;
                IDX_MMA(0); SBAR(); if (nx) IDX_LOAD(g + 1, 0); SBAR(); IDX_COMB(g, 0); SBAR();
                IDX_MMA(2); SBAR(); if (nx) IDX_LOAD(g + 1, 2); SBAR(); IDX_COMB(g, 2); SBAR(); }
        }
#undef IDX_LOAD
#undef IDX_MMA
#undef IDX_COMB
    }
    __syncthreads();
    const int t = t0 + wid, NJ = (t >> 6) + 1;
    unsigned kreg[64];
#pragma unroll
    for (int j = 0; j < 64; ++j) { const unsigned v = S[wid * 4096 + 64 * j + lane]; kreg[j] = (j < NJ) ? v : 0u; }
    const int NG = (NJ + 15) >> 4;
    unsigned lo = 1u, hi_ = 0xffffffffu, clo = (unsigned)(t + 1), chi = 0u; float wlo = 0.f, whi = 0.f; int last = 0;
#pragma unroll 1
    for (int rs = 0; rs < 1 + (int)((sub >> 1) & 1u); ++rs) {
    {
        LAS unsigned* hist = (LAS unsigned*)(F.lds + IL_HIST) + wid * 256;
        *(LAS v4u*)(hist + 4 * lane) = (v4u){0u, 0u, 0u, 0u};
        asm volatile("s_waitcnt lgkmcnt(0)" ::: "memory");
#pragma unroll
        for (int g = 0; g < 4; ++g) if (g < NG) {
#pragma unroll
            for (int j = 0; j < 16; ++j) { const unsigned k = kreg[16 * g + j];
                if (k) { int b_ = (int)floorf(idx_k2f(k)) + 128; b_ = b_ < 0 ? 0 : (b_ > 255 ? 255 : b_); __hip_atomic_fetch_add(hist + (255 - b_), 1u, __ATOMIC_RELAXED, __HIP_MEMORY_SCOPE_WAVEFRONT); } } }
        asm volatile("s_waitcnt lgkmcnt(0)" ::: "memory");
        const v4u h4 = *(LAS v4u*)(hist + 4 * lane);
        unsigned pre = h4.x + h4.y + h4.z + h4.w;
        pre += (unsigned)__builtin_amdgcn_update_dpp(0, (int)pre, 0x111, 0xf, 0xf, true);
        pre += (unsigned)__builtin_amdgcn_update_dpp(0, (int)pre, 0x112, 0xf, 0xf, true);
        pre += (unsigned)__builtin_amdgcn_update_dpp(0, (int)pre, 0x114, 0xf, 0xf, true);
        pre += (unsigned)__builtin_amdgcn_update_dpp(0, (int)pre, 0x118, 0xf, 0xf, true);
        pre += (unsigned)__builtin_amdgcn_update_dpp(0, (int)pre, 0x142, 0xa, 0xf, true);
        pre += (unsigned)__builtin_amdgcn_update_dpp(0, (int)pre, 0x143, 0xc, 0xf, true);
        const unsigned long long ge = __ballot(pre >= 256u);
        const int L = __builtin_ctzll(ge);
        const unsigned pL = (unsigned)__builtin_amdgcn_readlane((int)pre, L);
        const unsigned b0 = (unsigned)__builtin_amdgcn_readlane((int)h4.x, L), b1 = (unsigned)__builtin_amdgcn_readlane((int)h4.y, L), b2 = (unsigned)__builtin_amdgcn_readlane((int)h4.z, L), b3 = (unsigned)__builtin_amdgcn_readlane((int)h4.w, L);
        unsigned above = pL - (b0 + b1 + b2 + b3); int bsel = 4 * L; unsigned cb = b0;
        if (above + cb < 256u) { above += cb; cb = b1; bsel = 4 * L + 1; if (above + cb < 256u) { above += cb; cb = b2; bsel = 4 * L + 2; if (above + cb < 256u) { above += cb; cb = b3; bsel = 4 * L + 3; } } }
        const int B = 255 - bsel;
        lo = B == 0 ? 1u : idx_f2k((float)(B - 128)); hi_ = B == 255 ? 0xffffffffu : idx_f2k((float)(B - 127));
        chi = above; clo = above + cb;
    }
    wlo = (float)clo - 255.5f; whi = (float)chi - 255.5f; last = 0;
#pragma unroll 1
    for (int it = 0; it < 72; ++it) {
        if (clo - chi <= 64u || hi_ - lo == 1u) break;
        unsigned mid;
        { const float lf = idx_k2f(lo), hf = idx_k2f(hi_); float mf = lf + (hf - lf) * (wlo / (wlo - whi));
          mid = idx_f2k(mf);
          if (it >= 36 || !(fabsf(lf) < 1e30f && fabsf(hf) < 1e30f)) mid = lo + ((hi_ - lo) >> 1);
          mid = mid <= lo ? lo + 1u : (mid >= hi_ ? hi_ - 1u : mid);
          mid = (unsigned)__builtin_amdgcn_readfirstlane((int)mid); }
        unsigned cnt = 0u;
#pragma unroll
        for (int g = 0; g < 4; ++g) if (g < NG) {
#pragma unroll
            for (int j = 0; j < 16; ++j) cnt += (kreg[16 * g + j] >= mid) ? 1u : 0u; }
        const unsigned tot = wave_sum_dpp63(cnt);
        if (tot >= 256u) { lo = mid; clo = tot; wlo = (float)tot - 255.5f; if (last == 1) whi *= 0.5f; last = 1; }
        else { hi_ = mid; chi = tot; whi = (float)tot - 255.5f; if (last == 2) wlo *= 0.5f; last = 2; }
    }
    }
    unsigned T = lo; int J = 0x7fffffff; bool tie = true;
    const int need = 256 - (int)chi;
    if (clo - chi <= 64u) {
        volatile LAS unsigned* cand = (volatile LAS unsigned*)(F.lds + IL_CAND) + wid * 128;
        int pos = 0;
#pragma unroll
        for (int j = 0; j < 64; ++j) if ((j >> 4) < NG) { const unsigned kq = kreg[j]; const bool inb = kq >= lo && kq < hi_; const unsigned long long bal = __ballot(inb);
            if (bal) { const int slot = pos + __builtin_amdgcn_mbcnt_hi((unsigned)(bal >> 32), __builtin_amdgcn_mbcnt_lo((unsigned)bal, 0u));
                if (inb) { cand[2 * slot] = kreg[j]; cand[2 * slot + 1] = (unsigned)(64 * j + lane); } pos += __popcll(bal); } }
        const int m = pos;
        asm volatile("s_waitcnt lgkmcnt(0)" ::: "memory");
        const unsigned ki = lane < m ? cand[2 * lane] : 0u; const unsigned ii = lane < m ? cand[2 * lane + 1] : 0u;
        int rk = 0;
        for (int jx = 0; jx < m; ++jx) { const unsigned kj = (unsigned)__builtin_amdgcn_readlane((int)ki, jx), ij = (unsigned)__builtin_amdgcn_readlane((int)ii, jx); rk += (kj > ki || (kj == ki && ij < ii)) ? 1 : 0; }
        const unsigned long long hit = __ballot(lane < m && rk == need - 1);
        const int src = hit ? __builtin_ctzll(hit) : 0;
        T = (unsigned)__builtin_amdgcn_readlane((int)ki, src); J = (int)__builtin_amdgcn_readlane((int)ii, src);
        tie = __builtin_popcountll(__ballot(lane < m && ki == T)) != 1;
    } else if (clo > 256u) {
        int ilo = -1, ihi = t;
        for (int it = 0; it < 16 && ihi - ilo > 1; ++it) { const int imid = (ilo + ihi) >> 1; unsigned cnt = 0u;
#pragma unroll
            for (int j = 0; j < 64; ++j) if ((j >> 4) < NG) cnt += (kreg[j] == T && 64 * j + lane <= imid) ? 1u : 0u;
            const int tot = (int)wave_sum_dpp63(cnt);
            if (tot >= need) ihi = imid; else ilo = imid; }
        J = ihi;
    }
    unsigned long long w64 = 0ull;
    if (!tie) {
        int wl = 0, wh = 0;
#pragma unroll
        for (int j = 0; j < 64; ++j) if ((j >> 4) < NG) { const unsigned long long bal = __ballot(kreg[j] >= T); asm volatile("s_nop 4\n\tv_writelane_b32 %0, %2, %4\n\tv_writelane_b32 %1, %3, %4" : "+v"(wl), "+v"(wh) : "s"((unsigned)bal), "s"((unsigned)(bal >> 32)), "n"(j)); }
        w64 = (unsigned long long)(unsigned)wl | ((unsigned long long)(unsigned)wh << 32);
    } else {
#pragma unroll
        for (int j = 0; j < 64; ++j) if ((j >> 4) < NG) { const unsigned k = kreg[j]; const unsigned long long bal = __ballot(k > T || (k == T && 64 * j + lane <= J)); if (lane == j) w64 = bal; }
    }
    if (lane < NJ) *(unsigned long long*)(bmrow + wid * 128 + 2 * lane) = w64;
    __syncthreads();
}

__device__ __forceinline__ float gelu_tanh(float x) { const float y = 0.7978845608028654f * (x + 0.044715f * x * x * x); const float e = __expf(2.0f * y); return 0.5f * x * (2.0f - 2.0f / (1.0f + e)); }
__device__ __forceinline__ void cmp_finalize_item(Frame& F, int b, int j, int rc) {
    float* hid = (float*)F.ldsg + 2048;
    const float* W2 = FIN(I_EV_CW2) + (size_t)j * 128 * 128;
    const float* UV = WSP(float, WS_UV) + ((size_t)j * 2048 + (size_t)b * 256) * 256; const float* UVb = WSP(float, WS_UVB) + ((size_t)j * 2048 + (size_t)b * 256) * 256;
    const float* cbp = WSP(float, WS_TAB) + (size_t)j * 16 * 128;
    const int n0 = rc * 16;
    for (int i = F.tid; i < 16 * 128; i += NTHR) { const int r = i >> 7, c = i & 127, n = n0 + r;
        float cbv = 0.f;
#pragma unroll
        for (int q = 0; q < 16; ++q) cbv += cbp[q * 128 + c];
        float v = 0.f; if (n < 255) v = gelu_tanh((UV[(size_t)n * 256 + c] + UVb[(size_t)n * 256 + c]) + (UV[(size_t)(n + 1) * 256 + 128 + c] + UVb[(size_t)(n + 1) * 256 + 128 + c]) + cbv);
        hid[i] = v; }
    __syncthreads();
    const int c2 = F.tid & 127, rg = F.tid >> 7;
    float acc[4] = {0.f, 0.f, 0.f, 0.f};
#pragma unroll 4
    for (int c = 0; c < 128; ++c) { const float w = W2[c * 128 + c2];
#pragma unroll
        for (int q = 0; q < 4; ++q) acc[q] = fmaf(hid[(rg + 4 * q) * 128 + c], w, acc[q]); }
#pragma unroll
    for (int q = 0; q < 4; ++q) { const int n = n0 + rg + 4 * q; const float a = n >= 255 ? 0.f : acc[q];
        if (j == 0) WSP(bf16, WS_CK)[((size_t)b * 256 + n) * 128 + c2] = (bf16)f2bf(a);
        else WSP(bf16, WS_CV)[((size_t)b * 256 + n) * 128 + c2] = (bf16)f2bf(a); }
    __syncthreads();
}
constexpr int CL_S = 0;
constexpr int CL_P = 64 * 260 * 4;
constexpr int CL_IMP = CL_P + 64 * 264 * 2;
constexpr int CL_TBL = CL_IMP + 16 * 64 * 4;
static_assert(CL_TBL + 4 * 132 * 4 <= RING_BYTES, "cmp LDS map");
__device__ __forceinline__ void cmp_unit(Frame& F, int b, int qt16, unsigned sub) {
    char* lds = F.ldsg;
    float* S = (float*)(lds + CL_S); bf16* Pb = (bf16*)(lds + CL_P); float* impL = (float*)(lds + CL_IMP); const float* tbl = (const float*)(lds + CL_TBL);
    int tid = F.tid; asm volatile("" : "+v"(tid));
    const int wid = F.wave, lane = tid & 63, l15 = lane & 15, l4 = lane >> 4;
    const int q0 = qt16 * 16; const size_t rowg = (size_t)b * SEQ;
#pragma unroll 1
    for (int r1 = 0; r1 < 1 + (int)(sub & 1u); ++r1) {
    {
        const int rb = wid & 3;
        const bf16* qp = GRP(G_QB + rb) + (rowg + q0 + l15) * 128 + l4 * 8;
        bf16x8 qa[4];
#pragma unroll
        for (int c = 0; c < 4; ++c) qa[c] = *(const bf16x8*)(qp + c * 32);
        const bf16* ckb = WSP(bf16, WS_CK) + (size_t)b * 256 * 128;
#pragma unroll
        for (int i = 0; i < 8; ++i) { const int kb = (wid >> 2) * 8 + i;
            const bf16* kp = ckb + (size_t)(kb * 16 + l15) * 128 + l4 * 8;
            f32x4 acc = {0.f, 0.f, 0.f, 0.f};
#pragma unroll
            for (int c = 0; c < 4; ++c) { const bf16x8 bk = *(const bf16x8*)(kp + c * 32); acc = __builtin_amdgcn_mfma_f32_16x16x32_bf16(qa[c], bk, acc, 0, 0, 0); }
            const int n = kb * 16 + l15, kend = 16 * n + 31;
#pragma unroll
            for (int jj = 0; jj < 4; ++jj) { const int ql = l4 * 4 + jj, t = q0 + ql; int d = t - kend; const bool valid = (d >= 0) && (n < 255); d = d < 0 ? 0 : (d > 128 ? 128 : d);
                S[(rb * 16 + ql) * 260 + n] = valid ? acc[jj] + tbl[rb * 132 + d] : -__builtin_inff(); } }
    }
    __syncthreads();
#pragma unroll 1
    for (int rr = 0; rr < 8; ++rr) { const int row = wid * 8 + rr;
        f32x4 v = *(const f32x4*)(S + row * 260 + lane * 4);
        const float mx = wave_max(fmaxf(fmaxf(v[0], v[1]), fmaxf(v[2], v[3])));
        f32x4 p = {0.f, 0.f, 0.f, 0.f};
        if (mx > -1e37f) { p[0] = __builtin_amdgcn_exp2f(v[0] - mx); p[1] = __builtin_amdgcn_exp2f(v[1] - mx); p[2] = __builtin_amdgcn_exp2f(v[2] - mx); p[3] = __builtin_amdgcn_exp2f(v[3] - mx);
            const float inv = 1.0f / wave_sum((p[0] + p[1]) + (p[2] + p[3])); p = p * inv; }
        *(f32x4*)(S + row * 260 + lane * 4) = p;
        *(v2u*)(Pb + row * 264 + lane * 4) = (v2u){cvtpk(p[0], p[1]), cvtpk(p[2], p[3])}; }
    __syncthreads();
    }
#pragma unroll 1
    for (int r3 = 0; r3 < 1 + (int)((sub >> 1) & 1u); ++r3) {
    for (int i = tid; i < 16 * 64; i += NTHR) { const int q = i >> 6, m = i & 63; float s = 0.f;
#pragma unroll
        for (int h = 0; h < 4; ++h)
#pragma unroll
            for (int dn = -1; dn <= 3; ++dn) { const int n = 4 * m + dn; if (n >= 0 && n < 255) s += S[(h * 16 + q) * 260 + n]; }
        impL[i] = s; }
    __syncthreads();
#pragma unroll 1
    for (int qq = 0; qq < 2; ++qq) { const int q = wid * 2 + qq, t = q0 + q, cur = t >> 6, m = lane;
        const bool forced = (m == 0) || (m == cur) || (m == cur - 1);
        const bool cand = !forced && (m < cur);
        float val = cand ? impL[q * 64 + m] : -__builtin_inff();
        bool sel = forced;
        const int picks = 8 - __popcll(__ballot(forced));
        for (int p = 0; p < picks; ++p) { const float vm = wave_max(val); if (!(vm > -__builtin_inff())) break;
            const unsigned long long win = __ballot(val == vm); const int first = __builtin_ctzll(win);
            if (lane == first) { sel = true; val = -__builtin_inff(); } }
        const unsigned long long msk = __ballot(sel);
        if (lane == 0) WSP(unsigned long long, WS_BLK)[rowg + t] = msk; }
    }
#pragma unroll 1
    for (int r5 = 0; r5 < 1 + (int)((sub >> 2) & 1u); ++r5)
    {
        const int rb = wid & 3;
        const bf16* cvt = WSP(bf16, WS_CVT) + (size_t)b * 128 * 256;
        float g0[4];
#pragma unroll
        for (int jj = 0; jj < 4; ++jj) { const float gl = bf2f(GRP(G_MISC)[(rowg + q0 + l4 * 4 + jj) * 128 + 68 + rb]); g0[jj] = 1.0f / (1.0f + __expf(-gl)); }
#pragma unroll
        for (int i = 0; i < 4; ++i) { const int db = (wid >> 2) * 4 + i;
            f32x4 acc = {0.f, 0.f, 0.f, 0.f};
#pragma unroll
            for (int kc = 0; kc < 8; ++kc) { const bf16x8 pa = *(const bf16x8*)(Pb + (rb * 16 + l15) * 264 + kc * 32 + l4 * 8);
                const bf16x8 vb = *(const bf16x8*)(cvt + (size_t)(db * 16 + l15) * 256 + kc * 32 + l4 * 8);
                acc = __builtin_amdgcn_mfma_f32_16x16x32_bf16(pa, vb, acc, 0, 0, 0); }
#pragma unroll
            for (int jj = 0; jj < 4; ++jj) WSP(float, WS_OC)[(rowg + q0 + l4 * 4 + jj) * 512 + rb * 128 + db * 16 + l15] = acc[jj] * g0[jj]; }
    }
    __syncthreads();
}

constexpr int CL2_IMP = 65536;
__device__ __forceinline__ void cmp_unit64(Frame& F, int b, int qt) {
    using namespace att;
    char* lds = F.ldsg;
    int tid = F.tid; asm volatile("" : "+v"(tid));
    const int wid = F.wave, lane = tid & 63, r32 = lane & 31, hi = lane >> 5;
    const int hd = wid & 3, qh = wid >> 2, q0 = qt * 64, tw = q0 + 32 * qh, t = tw + r32;
    const size_t rowg = (size_t)b * SEQ;
    float* wsf = (float*)(lds + AL_WS) + wid * 64; float* li_l = wsf;
    const float* tbl = (const float*)(lds + AL_TBL132) + hd * 132;
    float* impW = (float*)(lds + CL2_IMP);
    const bf16* Qp = GRP(G_QB + hd) + (rowg + t) * 128;
    const bf16* Kp = WSP(bf16, WS_CK) + (size_t)b * 256 * 128; const bf16* Vp = WSP(bf16, WS_CV) + (size_t)b * 256 * 128;
    bf16x8 qr[8];
#pragma unroll
    for (int d0 = 0; d0 < 8; ++d0) qr[d0] = *(const bf16x8*)(Qp + d0 * 16 + hi * 8);
    const int vrb = v_rd_base(lane);
    DmaOff dof; dma_offsets(dof, tid);
    float m_reg = -1e30f, l_reg = 0.f;
    const float NEG = -__builtin_inff();
#define CMP_SCORES(j) \
            const char* V_lds = lds + AL_BUF + buf * 32768; const char* K_lds = V_lds + 16384; \
            f32x16 p0, p1; \
            qkt(p0, p1, K_lds, r32, hi, qr); SBAR(); \
            if (16 * (64 * (j) + 63) + 31 + 128 > tw) {            \
                _Pragma("unroll") for (int rq = 0; rq < 4; ++rq) { \
                    _Pragma("unroll") for (int ri = 0; ri < 4; ++ri) { const int r = 4 * rq + ri; const int n0 = 64 * (j) + (r & 3) + 8 * (r >> 2) + 4 * hi, n1 = n0 + 32; \
                        int d0 = t - (16 * n0 + 31), d1 = t - (16 * n1 + 31); \
                        const bool v0 = d0 >= 0, v1 = d1 >= 0 && n1 < 255; \
                        d0 = d0 < 0 ? 0 : (d0 > 128 ? 128 : d0); d1 = d1 < 0 ? 0 : (d1 > 128 ? 128 : d1); \
                        p0[r] = v0 ? p0[r] + tbl[d0] : NEG; p1[r] = v1 ? p1[r] + tbl[d1] : NEG; } \
                    SBAR(); } \
            } else if ((j) == 3) { if (hi == 1) p1[15] = NEG; }    \
            SBAR();
    {
        int buf = 0;
        dma_tile(dof, Kp, Vp, 0, F.lds + AL_BUF, wid);
#pragma unroll 1
        for (int j = 0; j < 4; ++j) {
            asm volatile("s_waitcnt vmcnt(0)" ::: "memory");
            __syncthreads();
            dma_tile(dof, Kp, Vp, ((j + 1) & 3) * 64, F.lds + AL_BUF + (buf ^ 1) * 32768, wid);
            CMP_SCORES(j)
            float pmax = p0[0];
#pragma unroll
            for (int r = 1; r < 16; ++r) pmax = fmaxf(pmax, p0[r]);
#pragma unroll
            for (int r = 0; r < 16; ++r) pmax = fmaxf(pmax, p1[r]);
            pmax = xhalf_max(pmax);
            const float mn = fmaxf(m_reg, pmax); float ps = 0.f;
#pragma unroll
            for (int r = 0; r < 16; ++r) ps += __builtin_amdgcn_exp2f(p0[r] - mn) + __builtin_amdgcn_exp2f(p1[r] - mn);
            ps = xhalf_sum(ps);
            l_reg = l_reg * __builtin_amdgcn_exp2f(m_reg - mn) + ps; m_reg = mn;
            buf ^= 1;
        }
    }
    const float inv_l = l_reg > 0.f ? 1.0f / l_reg : 0.f;
    float carry = 0.f; f32x16 o[4] = {};
    {
        int buf = 0;
#pragma unroll 1
        for (int j = 0; j < 4; ++j) {
            asm volatile("s_waitcnt vmcnt(0)" ::: "memory");
            __syncthreads();
            if (j < 3) dma_tile(dof, Kp, Vp, (j + 1) * 64, F.lds + AL_BUF + (buf ^ 1) * 32768, wid);
            CMP_SCORES(j)
            const int vb0 = (int)(uintptr_t)(lds + AL_BUF + buf * 32768) + vrb;
#pragma unroll
            for (int r = 0; r < 16; ++r) { p0[r] = __builtin_amdgcn_exp2f(p0[r] - m_reg) * inv_l; p1[r] = __builtin_amdgcn_exp2f(p1[r] - m_reg) * inv_l; }
            float oa[4], ob[4];
#pragma unroll
            for (int g = 0; g < 4; ++g) { auto ra = __builtin_amdgcn_permlane32_swap(__float_as_uint(p0[4 * g + 3]), __float_as_uint(p0[4 * g + 3]), false, false);
                auto rb = __builtin_amdgcn_permlane32_swap(__float_as_uint(p1[4 * g + 3]), __float_as_uint(p1[4 * g + 3]), false, false);
                oa[g] = __uint_as_float(hi ? ra[0] : ra[1]); ob[g] = __uint_as_float(hi ? rb[0] : rb[1]); }
            float* iw = impW + ((size_t)hd * 64 + 32 * qh + r32) * 64 + 16 * j + hi;
#pragma unroll
            for (int g = 0; g < 4; ++g) {
                const float pla = hi ? oa[g] : (g > 0 ? oa[g - 1] : carry);
                const float plb = hi ? ob[g] : (g > 0 ? ob[g - 1] : oa[3]);
                iw[2 * g] = ((p0[4 * g] + p0[4 * g + 1]) + (p0[4 * g + 2] + p0[4 * g + 3])) + pla;
                iw[8 + 2 * g] = ((p1[4 * g] + p1[4 * g + 1]) + (p1[4 * g + 2] + p1[4 * g + 3])) + plb; }
            carry = ob[3];
            bf16x8 pa0, pa1, pa2, pa3;
            pack_p(p0, p1, pa0, pa1, pa2, pa3); SBAR();
            pv_tile(o, vb0, pa0, pa1, pa2, pa3); SBAR();
            buf ^= 1;
        }
    }
#undef CMP_SCORES
    __syncthreads();
#pragma unroll 1
    for (int qq = 0; qq < 8; ++qq) { const int q = wid * 8 + qq, tq = q0 + q, cur = tq >> 6, m = lane;
        const bool forced = (m == 0) || (m == cur) || (m == cur - 1);
        const bool cand = !forced && (m < cur);
        float val = cand ? ((impW[(0 * 64 + q) * 64 + m] + impW[(1 * 64 + q) * 64 + m]) + (impW[(2 * 64 + q) * 64 + m] + impW[(3 * 64 + q) * 64 + m])) : -__builtin_inff();
        bool sel = forced;
        const int picks = 8 - __popcll(__ballot(forced));
        for (int p = 0; p < picks; ++p) { const float vm = wave_max(val); if (!(vm > -__builtin_inff())) break;
            const unsigned long long win = __ballot(val == vm); const int first = __builtin_ctzll(win);
            if (lane == first) { sel = true; val = -__builtin_inff(); } }
        const unsigned long long msk = __ballot(sel);
        if (lane == 0) WSP(unsigned long long, WS_BLK)[rowg + tq] = msk; }
    {
        const float gl = bf2f(GRP(G_MISC)[(rowg + t) * 128 + 68 + hd]);
        if (hi == 0) li_l[r32] = 1.0f / (1.0f + __expf(-gl));
        asm volatile("s_waitcnt lgkmcnt(0)" ::: "memory");
        float* OCp = WSP(float, WS_OC) + (rowg + tw) * 512 + hd * 128;
#pragma unroll
        for (int r = 0; r < 16; ++r) { const int orow = crow(r, hi); const float g0 = li_l[orow];
#pragma unroll
            for (int d0 = 0; d0 < 4; ++d0) OCp[(size_t)orow * 512 + d0 * 32 + r32] = o[d0][r] * g0; }
    }
    __syncthreads();
}
__device__ __forceinline__ void stick_unit(Frame& F, int b, int h, int qb) {
    using namespace att;
    char* lds = F.ldsg;
    int tid = F.tid; asm volatile("" : "+v"(tid));
    const int wid = F.wave, lane = tid & 63, r32 = lane & 31, hi = lane >> 5;
    const size_t rowg = (size_t)b * SEQ;
    const int tw = qb * 256 + wid * 32, t = tw + r32;
    const bf16* Qp = QKVG(h) + (rowg + t) * 128;
    const bf16* Kp = QKVG(8 + h) + rowg * 128;
    const bf16* Vp = QKVG(16 + h) + rowg * 128;
    char* Qw = lds + AL_Q + wid * 8192;
#pragma unroll
    for (int d0 = 0; d0 < 8; ++d0) { const bf16x8 v = *(const bf16x8*)(Qp + d0 * 16 + hi * 8); *(bf16x8*)(Qw + KSWZ(r32, (d0 * 16 + hi * 8) * 2)) = v; }
    asm volatile("s_waitcnt lgkmcnt(0)" ::: "memory");
    {
        bf16x8 trd0, trd1;
#pragma unroll
        for (int jj = 0; jj < 8; ++jj) { const int k0 = 8 * (jj >> 2) + 4 * hi + (jj & 3);
            trd0[jj] = (short)((k0 >= r32) ? 0x3F80 : 0); trd1[jj] = (short)((16 + k0 >= r32) ? 0x3F80 : 0); }
        if (wid == 0) { *(bf16x8*)(lds + AL_TRI + lane * 32) = trd0; *(bf16x8*)(lds + AL_TRI + lane * 32 + 16) = trd1; }
    }
    const bf16x8 ones = {(short)0x3F80, (short)0x3F80, (short)0x3F80, (short)0x3F80, (short)0x3F80, (short)0x3F80, (short)0x3F80, (short)0x3F80};
    f32x16 o[4] = {};
    float carry = 0.f;
    const int vrb = v_rd_base(lane);
    DmaOff dof; dma_offsets(dof, tid);
    int j = qb * 4 + 3, buf = 0;
    bool wdone = false; int par = 0;
    volatile LAS unsigned* fl = (volatile LAS unsigned*)(F.lds + AL_UNI + 64);
    dma_tile(dof, Kp, Vp, j * 64, F.lds + AL_BUF, wid);
    for (;;) {
        if (lane == 0) fl[par * 8 + wid] = wdone ? 1u : 0u;
        asm volatile("s_waitcnt vmcnt(0)" ::: "memory");
        __syncthreads();
        { unsigned a = 1u;
#pragma unroll
          for (int w = 0; w < 8; ++w) a &= fl[par * 8 + w];
          par ^= 1; if (a) break; }
        if (j > 0) dma_tile(dof, Kp, Vp, (j - 1) * 64, F.lds + AL_BUF + (buf ^ 1) * 32768, wid);
        const char* K_lds = lds + AL_BUF + buf * 32768 + 16384;
        const int vb0 = (int)(uintptr_t)(lds + AL_BUF + buf * 32768) + vrb;
        const int kb = j * 64;
        if (!wdone && kb < tw + 32) {
            f32x16 s0, s1;
            qkt_lq(s0, s1, K_lds, Qw, r32, hi);
            const int dq = t - kb - 4 * hi;
            const bool diag = (kb + 63 >= tw);
            bf16x8 cb0, cb1, cb2, cb3; float csum = 0.f;
#define ST_C(ZV, OFF, R) ({ const int c_ = ((R) & 3) + 8 * ((R) >> 2); float z_ = ZV[R]; \
                float a_ = -__builtin_amdgcn_logf(1.0f + __builtin_amdgcn_exp2f(fminf(z_, 126.f))); a_ = fminf(a_, -z_); \
                if (diag && (dq - c_ - (OFF) < 1)) { a_ = 0.f; z_ = -__builtin_inff(); } \
                csum += a_; ZV[R] = z_ + carry; a_; })
#define ST_PK(ZV, OFF, B_) ({ v4u w_; { const float e0 = ST_C(ZV, OFF, B_ + 0), e1 = ST_C(ZV, OFF, B_ + 1), e2 = ST_C(ZV, OFF, B_ + 2), e3 = ST_C(ZV, OFF, B_ + 3); w_.x = cvtpk(e0, e1); w_.y = cvtpk(e2, e3); } SBAR(); \
                { const float e4 = ST_C(ZV, OFF, B_ + 4), e5 = ST_C(ZV, OFF, B_ + 5), e6 = ST_C(ZV, OFF, B_ + 6), e7 = ST_C(ZV, OFF, B_ + 7); w_.z = cvtpk(e4, e5); w_.w = cvtpk(e6, e7); } __builtin_bit_cast(bf16x8, w_); })
            SBAR(); cb0 = ST_PK(s0, 0, 0); SBAR(); cb1 = ST_PK(s0, 0, 8); SBAR(); cb2 = ST_PK(s1, 32, 0); SBAR(); cb3 = ST_PK(s1, 32, 8); SBAR();
#undef ST_PK
#undef ST_C
            const bf16x8 trd0 = *(const bf16x8*)(lds + AL_TRI + lane * 32), trd1 = *(const bf16x8*)(lds + AL_TRI + lane * 32 + 16);
            s1 = __builtin_amdgcn_mfma_f32_32x32x16_bf16(trd0, cb2, s1, 0, 0, 0);
            s1 = __builtin_amdgcn_mfma_f32_32x32x16_bf16(trd1, cb3, s1, 0, 0, 0);
            s0 = __builtin_amdgcn_mfma_f32_32x32x16_bf16(trd0, cb0, s0, 0, 0, 0);
            s0 = __builtin_amdgcn_mfma_f32_32x32x16_bf16(trd1, cb1, s0, 0, 0, 0);
            s0 = __builtin_amdgcn_mfma_f32_32x32x16_bf16(ones, cb2, s0, 0, 0, 0);
            s0 = __builtin_amdgcn_mfma_f32_32x32x16_bf16(ones, cb3, s0, 0, 0, 0);
            carry += xhalf_sum(csum);
#pragma unroll
            for (int r = 0; r < 16; ++r) { s0[r] = __builtin_amdgcn_exp2f(s0[r]); s1[r] = __builtin_amdgcn_exp2f(s1[r]); }
            bf16x8 pa0, pa1, pa2, pa3;
            pack_p(s0, s1, pa0, pa1, pa2, pa3);
            pv_tile(o, vb0, pa0, pa1, pa2, pa3);
            if (__all(carry < -160.f)) wdone = true;
        }
        if (j == 0) wdone = true;
        j = j > 0 ? j - 1 : 0; buf ^= 1;
    }
    asm volatile("s_waitcnt vmcnt(0)" ::: "memory");
    bf16* Op = WSP(bf16, WS_O) + (rowg + tw) * DM + h * 128;
#pragma unroll
    for (int r = 0; r < 16; ++r) { const int orow = crow(r, hi);
#pragma unroll
        for (int d0 = 0; d0 < 4; ++d0) { const float v = o[d0][r]; const float vn = __shfl_xor(v, 1);
            if ((r32 & 1) == 0) *(unsigned*)(Op + (size_t)orow * DM + d0 * 32 + r32) = cvtpk(v, vn); } }
    __syncthreads();
}
__device__ __forceinline__ void router_phase(Frame& F) {
    const int lane = F.lane;
    const float* wr = FIN(I_OD_WR);
    int* list = WSP(int, WS_LIST); float* gwt = WSP(float, WS_GW);
    volatile LAS unsigned* lcnt = (volatile LAS unsigned*)(F.lds);
    volatile LAS unsigned* rec = (volatile LAS unsigned*)(F.lds + 256);
    const int nper = (M + F.G - 1) / F.G, m0 = (int)blockIdx.x * nper, m1 = (m0 + nper < M) ? m0 + nper : M;
    if (F.tid < 32) lcnt[F.tid] = 0u;
    __syncthreads();
    f32x4 wq[16][2];
#pragma unroll
    for (int i = 0; i < 16; ++i) { const int k = (i < 8 ? 0 : 512) + 8 * lane + (i & 7); wq[i][0] = *(const f32x4*)(wr + (size_t)k * 8); wq[i][1] = *(const f32x4*)(wr + (size_t)k * 8 + 4); }
    for (int m = m0 + F.wave; m < m1; m += NWAVES) {
        float v[16]; load_row_bf16(WSP(bf16, WS_XB3) + (size_t)m * DM, lane, v); rms16(v, FIN(I_OD_NFFN), lane);
        float lg[8];
#pragma unroll
        for (int e = 0; e < 8; ++e) lg[e] = 0.f;
#pragma unroll
        for (int i = 0; i < 16; ++i) { const f32x4 w0 = wq[i][0], w1 = wq[i][1]; const float x = v[i];
            lg[0] = fmaf(x, w0[0], lg[0]); lg[1] = fmaf(x, w0[1], lg[1]); lg[2] = fmaf(x, w0[2], lg[2]); lg[3] = fmaf(x, w0[3], lg[3]);
            lg[4] = fmaf(x, w1[0], lg[4]); lg[5] = fmaf(x, w1[1], lg[5]); lg[6] = fmaf(x, w1[2], lg[6]); lg[7] = fmaf(x, w1[3], lg[7]); }
#pragma unroll
        for (int e = 0; e < 8; ++e) lg[e] = wave_sum(lg[e]);
        int i0 = 0; float v0 = lg[0];
#pragma unroll
        for (int e = 1; e < 8; ++e) if (lg[e] > v0) { v0 = lg[e]; i0 = e; }
        int i1 = -1; float v1 = -__builtin_inff();
#pragma unroll
        for (int e = 0; e < 8; ++e) if (e != i0 && lg[e] > v1) { v1 = lg[e]; i1 = e; }
        const float e1 = __expf(v1 - v0), w0 = 1.0f / (1.0f + e1), w1 = e1 * w0;
        if (lane == 0) {
            const unsigned s0 = __hip_atomic_fetch_add((LAS unsigned*)F.lds + i0, 1u, __ATOMIC_RELAXED, __HIP_MEMORY_SCOPE_WORKGROUP);
            const unsigned s1 = __hip_atomic_fetch_add((LAS unsigned*)F.lds + 8 + i1, 1u, __ATOMIC_RELAXED, __HIP_MEMORY_SCOPE_WORKGROUP);
            rec[2 * (m - m0)] = (unsigned)i0 | (s0 << 8); rec[2 * (m - m0) + 1] = (unsigned)i1 | (s1 << 8);
            gwt[m] = w0; gwt[M + m] = w1;
        }
    }
    __syncthreads();
    if (F.tid < 16) lcnt[16 + F.tid] = atomicAdd((unsigned*)(F.ctl + CW_CNT) + F.tid, lcnt[F.tid]);
    __syncthreads();
    for (int i = F.tid; i < m1 - m0; i += NTHR) { const unsigned r0 = rec[2 * i], r1 = rec[2 * i + 1]; const int i0 = r0 & 255, i1 = r1 & 255;
        list[(size_t)i0 * M + lcnt[16 + i0] + (r0 >> 8)] = m0 + i; list[(size_t)(8 + i1) * M + lcnt[24 + i1] + (r1 >> 8)] = m0 + i; }
    __syncthreads();
}
struct MoeLayout { int off[17]; };
__device__ __forceinline__ void moe_layout(Frame& F, MoeLayout& L) {
    int o = 0;
#pragma unroll
    for (int l = 0; l < 16; ++l) { L.off[l] = o; const int c = (int)__hip_atomic_load(F.ctl + CW_CNT + l, RLX_AGENT); o += (c + 255) & ~255; }
    L.off[16] = o;
}
__device__ __forceinline__ void gather_phase(Frame& F) {
    const int gw = F.vcu * NWAVES + F.wave, NGW = F.G * NWAVES, lane = F.lane;
    MoeLayout L; moe_layout(F, L);
    const int* list = WSP(int, WS_LIST); int* inv = WSP(int, WS_INV); float* gws = WSP(float, WS_GWS); const float* gwt = WSP(float, WS_GW);
    bf16* XS = WSP(bf16, WS_XS);
    for (int s = gw; s < L.off[16]; s += NGW) {
        int l = 0, offl = 0;
#pragma unroll
        for (int q = 1; q < 16; ++q) if (s >= L.off[q]) { l = q; offl = L.off[q]; }
        const int idx = s - offl; const int c = (int)__hip_atomic_load(F.ctl + CW_CNT + l, RLX_AGENT);
        const int t = idx < c ? list[(size_t)l * M + idx] : -1;
        float v[16];
        if (t >= 0) { load_row_bf16(WSP(bf16, WS_XB3) + (size_t)t * DM, lane, v); rms16(v, FIN(I_OD_NFFN), lane); }
        else {
#pragma unroll
            for (int i = 0; i < 16; ++i) v[i] = 0.f; }
        store_row16_bf16(XS + (size_t)s * DM, lane, v);
        if (lane == 0) { const int k = l >> 3; gws[s] = t >= 0 ? gwt[(size_t)k * M + t] : 0.f; if (t >= 0) inv[(size_t)k * M + t] = s; }
    }
}
struct MoeSched {
    pg8::GridOrder o; int t0; const char* A; size_t tstepA; const char* W; size_t tstepB; int off[17]; bool a_local; const char* A2;
    __device__ __forceinline__ bool next(int i, pg8::Unit& u) const {
        int pm, pn; if (!o.at(i, pm, pn)) return false; pm += t0; u.pm = pm; u.pn = pn;
        int l = 0;
#pragma unroll
        for (int q = 1; q < 16; ++q) if (pm * 256 >= off[q]) l = q;
        const int lt = pm - t0;
        u.aux = l; u.A = !a_local ? A + (size_t)pm * tstepA : (lt >= HM_SPLIT ? A2 + (size_t)(lt - HM_SPLIT) * tstepA : A + (size_t)lt * tstepA); u.B = W + (size_t)(l & 7) * MW_E + (size_t)pn * tstepB; return true;
    }
};

struct MoeSplitSched {
    pg8::GridOrder o; int t0; const char* A; size_t tstepA; const char* W; size_t tstepB; int off[17];
    __device__ __forceinline__ bool next(int i, pg8::Unit& u) const {
        int pm, pn; if (!o.at(i, pm, pn)) return false; pm += t0; u.pm = pm; u.pn = pn;
        int l = 0;
#pragma unroll
        for (int q = 1; q < 16; ++q) if (pm * 256 >= off[q]) l = q;
        u.aux = l; const size_t ko = (size_t)(pn >> 2) * (EFF / MOE_SPLITS) * 2;
        u.A = A + (size_t)(pm - t0) * tstepA + ko; u.B = W + (size_t)(l & 7) * MW_E + (size_t)(pn & 3) * tstepB + ko; return true;
    }
};

constexpr int N_PHASES = 27;
struct Args { const float* in[N_IN]; float* out; unsigned char* ws; int ph_lo, ph_hi; unsigned rep_mask, pad; };
__global__ void __launch_bounds__(NTHR, 2) fwd(Args args) {
    extern __shared__ __attribute__((aligned(16))) unsigned char lds[];
    Frame F;
    F.lds = (LAS unsigned char*)lds; F.ldsg = (char*)lds;
    F.MISC = (volatile LAS unsigned*)(F.lds + MISC_OFF);
    F.tid = threadIdx.x; F.lane = F.tid & 63; F.wave = __builtin_amdgcn_readfirstlane(F.tid >> 6);
    F.G = gridDim.x; { const int bx = blockIdx.x; F.vcu = (F.G % 8 == 0) ? (bx % 8) * (F.G / 8) + bx / 8 : bx; }
    F.ws = args.ws; F.ctl = (gu32*)(args.ws + WS_CTL); F.out = args.out;
    F.kap = (const __attribute__((address_space(4))) char*)__builtin_amdgcn_kernarg_segment_ptr();
    static_assert(offsetof(Args, in) == 0, "FIN() reads the input pointers at the start of the kernarg segment");
    for (int u = F.tid; u < 64; u += NTHR) ((LAS unsigned*)(F.lds + MISC_OFF))[u] = 0u;
    __syncthreads();
    const int lo = args.ph_lo, hi = args.ph_hi;
    const bool multi = (hi - lo) > 1;
    XcdBarrier bar; bar.bar = (unsigned*)(F.ctl + CW_BAR); bar.x = 0; bar.st = nullptr;
    if (multi) bar = xcd_barrier_post((unsigned*)(F.ctl + CW_BAR), F.MISC + 8);
#ifdef PHASE_ONLY
#define IN(k) ((k) == PHASE_ONLY && lo <= (k) && (k) < hi)
#else
#define IN(k) (lo <= (k) && (k) < hi)
#endif
#ifndef PROBE_BUILD
#define PROBE_BUILD 0
#endif
#if PROBE_BUILD
    const unsigned repmask = args.rep_mask;
#define REPLOOP(k) _Pragma("unroll 1") for (int rep_ = 0, nrep_ = 1 + (int)((repmask >> (k)) & 1u); rep_ < nrep_; ++rep_)
#else
    const unsigned repmask = 0u;
#define REPLOOP(k)
#endif
#define SEAM(k) do { if (IN(k) && IN((k) + 1)) xcd_barrier(bar); PHASE_FENCE(); } while (0)
    const int gwv = F.vcu * NWAVES + F.wave, NGW = F.G * NWAVES;
    const int bx = blockIdx.x;

    REPLOOP(0) {
    if (IN(0)) {
        LAS float* scr = (LAS float*)(F.lds + F.wave * 16384);
        int ibase = 0;
#define XPOSE_MAT(fn, destrows, K, WT, kgain) do { const int _n = ((destrows) / 32) * ((K) / 64); const int _s = (gwv + NGW - (ibase % NGW)) % NGW; \
            xpose_matrix(fn, K, WT, kgain, scr, _s, _n, NGW, F.lane); ibase += _n; } while (0)
        { FnIn f{FIN(I_EV_WIN)}; XPOSE_MAT(f, NPROJ, 1024, WSP(bf16, WS_WIN), (const float*)nullptr); }
        { FnPlain f{FIN(I_EV_WUK), 128, 0}; XPOSE_MAT(f, 128, 256, WSP(bf16, WS_WUKV), FIN(I_EV_KVN)); }
        { FnPlain f{FIN(I_EV_WUV), 128, 0}; XPOSE_MAT(f, 128, 256, WSP(bf16, WS_WUKV) + 128 * 256, FIN(I_EV_KVN)); }
#pragma unroll 1
        for (int j = 0; j < 2; ++j) { const float* W1 = FIN(I_EV_CW1) + (size_t)j * 4096 * 128; bf16* d = WSP(bf16, WS_WC1) + (size_t)j * 256 * 2048;
            { FnPlain f{W1, 128, 0}; XPOSE_MAT(f, 128, 2048, d, (const float*)nullptr); }
            { FnPlain f{W1 + (size_t)2048 * 128, 128, 0}; XPOSE_MAT(f, 128, 2048, d + (size_t)128 * 2048, (const float*)nullptr); } }
        { FnPlain f{FIN(I_EV_WOUT), 1024, 0}; XPOSE_MAT(f, 1024, 1024, WSP(bf16, WS_WOUT0), (const float*)nullptr); }
        { FnGU f{FIN(I_EV_WG), FIN(I_EV_WU), DFF}; XPOSE_MAT(f, 2 * DFF, 1024, WSP(bf16, WS_WGU0), FIN(I_EV_NFFN)); }
        { FnPlain f{FIN(I_EV_WD), 1024, 0}; XPOSE_MAT(f, 1024, DFF, WSP(bf16, WS_WDN0), (const float*)nullptr); }
        { FnPlain f{FIN(I_OD_WQKV), 3072, 0}; XPOSE_MAT(f, 3072, 1024, WSP(bf16, WS_WQKV), FIN(I_OD_NMIX)); }
        { FnPlain f{FIN(I_OD_WOUT), 1024, 0}; XPOSE_MAT(f, 1024, 1024, WSP(bf16, WS_WOUT1), (const float*)nullptr); }
        norm_phase(F, FIN(I_X), nullptr, FIN(I_EV_NMIX));
        for (int oi = gwv; oi < 32; oi += NGW) { const int j = oi >> 4, part = oi & 15; const float* pos = FIN(I_EV_CPOS) + (size_t)j * 4096 + part * 256; const float* W1 = FIN(I_EV_CW1) + ((size_t)j * 4096 + part * 256) * 128;
            float s0 = 0.f, s1 = 0.f;
#pragma unroll 8
            for (int i = 0; i < 256; ++i) { const float pv_ = pos[i]; s0 = fmaf(pv_, W1[(size_t)i * 128 + F.lane], s0); s1 = fmaf(pv_, W1[(size_t)i * 128 + 64 + F.lane], s1); }
            WSP(float, WS_TAB)[(size_t)oi * 128 + F.lane] = s0; WSP(float, WS_TAB)[(size_t)oi * 128 + 64 + F.lane] = s1; }
    }
    }
    SEAM(0);
    REPLOOP(1) {
    if (IN(1)) {
        pg8::PlainSched S; S.init(M, NPROJ, F.G, bx, WSP(bf16, WS_XN), 2048, WSP(bf16, WS_WIN), 2048);
        pg8::EpiGroups E{WSP(bf16, WS_PROJ), GS, 0x0F0Fu, QSCALE, G_PAD, nullptr};
        pg8::gemm_phase<pg8::EpiGroups, pg8::PlainSched>(F.lds, pg8::GemmK{1024, 2048u, 2048u, 30, 0u}, S, E);
    }
    }
    SEAM(1);
    REPLOOP(2) {
    if (IN(2)) {
        if (bx < 128) {
            LAS float* rstd = (LAS float*)(F.lds + MISC_OFF + 1024);
            { const int r = F.tid >> 1, g = F.tid & 1; const bf16* p = GRP(G_LAT + g) + ((size_t)bx * 256 + r) * 128; float s = 0.f;
#pragma unroll
              for (int i = 0; i < 16; ++i) { const v4u w = *(const v4u*)(p + i * 8);
#pragma unroll
                  for (int q = 0; q < 4; ++q) { const float a = __builtin_bit_cast(float, w[q] << 16), c = __builtin_bit_cast(float, w[q] & 0xffff0000u); s += a * a + c * c; } }
              s += __shfl_xor(s, 1);
              if (g == 0) rstd[r] = 1.0f / sqrtf(s * (1.f / 256.f) + RMS_EPS); }
            __syncthreads();
            pg8::OneSched S;
            S.u.pm = bx; S.u.pn = 0; S.u.aux = 0; S.u.A = (const char*)(GRP(G_LAT) + (size_t)bx * 256 * 128); S.u.B = (const char*)WSP(bf16, WS_WUKV);
            pg8::EpiAkv E{WSP(bf16, WS_AK), WSP(bf16, WS_AV), rstd};
            pg8::gemm_phase<pg8::EpiAkv, pg8::OneSched>(F.lds, pg8::GemmK{256, 256u, 512u, 1, (unsigned)(GS * 2)}, S, E);
        } else if (bx < 160) {
            const int u = bx - 128, j = u >> 4, pm = (u >> 1) & 7, kh = u & 1;
            pg8::OneSched S;
            S.u.pm = pm; S.u.pn = 0; S.u.aux = 0; S.u.A = (const char*)(GRP(j == 0 ? G_CKR : G_CVR) + (size_t)pm * 256 * 2048 + (size_t)kh * 1024); S.u.B = (const char*)(WSP(bf16, WS_WC1) + (size_t)j * 256 * 2048 + (size_t)kh * 1024);
            pg8::EpiF32 E{nullptr, (kh ? WSP(float, WS_UVB) : WSP(float, WS_UV)) + (size_t)j * 2048 * 256, 256, 1.f};
            pg8::gemm_phase<pg8::EpiF32, pg8::OneSched>(F.lds, pg8::GemmK{1024, 4096u, 4096u, 30, 0u}, S, E);
        }
    }
    }
    SEAM(2);
    REPLOOP(3) {
    if (IN(3)) {
        for (int it = bx; it < 256; it += F.G) cmp_finalize_item(F, it >> 5, (it >> 4) & 1, it & 15);
        for (int r = 0; r < 4096 / 256 + 1; ++r) { const int cc = (r & 1) ? (F.G - 1 - bx) : bx; const int ui = r * F.G + cc; if (ui >= 4096) break;
            const int tq = 511 - (ui >> 3), b = ui & 7; idx_unit(F, b, tq, repmask >> 24); }
    }
    }
    SEAM(3);
    PHASE_FENCE();
    REPLOOP(5) {
    if (IN(5)) {
        fill_bias_tbl(F, (float*)(F.ldsg + AL_TBL), 0); __syncthreads();
#pragma unroll 1
        for (int p2 = 2 * bx; p2 < 512; p2 += 2 * F.G) {
#pragma unroll 1
            for (int u = 0; u < 2; ++u) { const int p = p2 >> 1, b = p >> 5, q = p & 31; attn_unit<0>(F, b, u ? q : 63 - q); } }
        __syncthreads();
        fill_bias_tbl(F, (float*)(F.ldsg + AL_TBL), 4); fill_bias_tbl132(F, (float*)(F.ldsg + AL_TBL132), 4); __syncthreads();
#pragma unroll 1
        for (int p2 = 2 * bx; p2 < 512; p2 += 2 * F.G) {
#pragma unroll 1
            for (int u = 0; u < 2; ++u) { const int p = p2 >> 1, b = p >> 5, q = p & 31, qt = u ? q : 63 - q;
                cmp_unit64(F, b, qt); asm volatile("s_waitcnt vmcnt(0)" ::: "memory"); __syncthreads();
                attn_unit<1>(F, b, qt); attn_unit<2>(F, b, qt); } }
    }
    }
    SEAM(5);
    REPLOOP(6) {
    if (IN(6)) {
        pg8::PlainSched S; S.init(M, DM, F.G, bx, WSP(bf16, WS_O), 2048, WSP(bf16, WS_WOUT0), 2048);
        pg8::EpiRes E{FIN(I_X), nullptr, WSP(bf16, WS_XB), WSP(float, WS_RS0), 1.f};
        pg8::gemm_phase<pg8::EpiRes, pg8::PlainSched>(F.lds, pg8::GemmK{1024, 2048u, 2048u, 30, 0u}, S, E);
    }
    }
    if (IN(6) && IN(8)) xcd_barrier(bar); PHASE_FENCE();
    REPLOOP(8) {
    if (IN(8)) {
        pg8::PlainSched S; S.init(M, 2 * DFF, F.G, bx, WSP(bf16, WS_XB), 2048, WSP(bf16, WS_WGU0), 2048);
        pg8::EpiSwiglu E{WSP(bf16, WS_H0), DFF, 0, WSP(float, WS_RS0), nullptr, 0};
        pg8::gemm_phase<pg8::EpiSwiglu, pg8::PlainSched>(F.lds, pg8::GemmK{1024, 2048u, 2048u, 30, 0u}, S, E);
    }
    }
    SEAM(8);
    if (IN(9)) {
        pg8::PlainSched S; S.init(M, DM, F.G, bx, WSP(bf16, WS_H0), DFF * 2, WSP(bf16, WS_WDN0), DFF * 2);
        pg8::EpiRes E{nullptr, WSP(bf16, WS_XB), WSP(bf16, WS_XB), WSP(float, WS_RS1), ((repmask >> 10) & 1u) ? 0.5f : 1.f};
        REPLOOP(10) pg8::gemm_phase<pg8::EpiRes, pg8::PlainSched>(F.lds, pg8::GemmK{DFF, DFF * 2u, DFF * 2u, 30, 0u}, S, E);
    }
    if (IN(9) && IN(11)) xcd_barrier(bar); PHASE_FENCE();
    REPLOOP(11) {
    if (IN(11)) {
        pg8::PlainSched S; S.init(M, 3072, F.G, bx, WSP(bf16, WS_XB), 2048, WSP(bf16, WS_WQKV), 2048);
        pg8::EpiGroups E{WSP(bf16, WS_QKV), GS, 0xFFu, QSCALE, 1000, WSP(float, WS_RS1)};
        pg8::gemm_phase<pg8::EpiGroups, pg8::PlainSched>(F.lds, pg8::GemmK{1024, 2048u, 2048u, 30, 0u}, S, E);
    }
    }
    SEAM(11);
    REPLOOP(12) {
    if (IN(12)) {
        for (int ui = bx; ui < 1024; ui += F.G) { const int qb = 15 - (ui >> 6), bh = ui & 63; stick_unit(F, bh >> 3, bh & 7, qb); }
    }
    }
    SEAM(12);
    if (IN(13)) {
        pg8::PlainSched S; S.init(M, DM, F.G, bx, WSP(bf16, WS_O), 2048, WSP(bf16, WS_WOUT1), 2048);
        pg8::EpiRes E{nullptr, WSP(bf16, WS_XB), WSP(bf16, WS_XB3), WSP(float, WS_RS0), 1.f};
        REPLOOP(14) pg8::gemm_phase<pg8::EpiRes, pg8::PlainSched>(F.lds, pg8::GemmK{1024, 2048u, 2048u, 30, 0u}, S, E);
        LAS float* scr = (LAS float*)(F.lds + F.wave * 16384);
        REPLOOP(13) {
        int ibase = 0;
#pragma unroll 1
        for (int e = 0; e < NEXP; ++e) {
            { FnGU f{FIN(I_OD_WG) + (size_t)e * 1024 * EFF, FIN(I_OD_WU) + (size_t)e * 1024 * EFF, EFF}; XPOSE_MAT(f, 2 * EFF, 1024, (bf16*)(F.ws + WS_MW + (size_t)e * MW_E), (const float*)nullptr); }
            { FnPlain f{FIN(I_OD_WD) + (size_t)e * EFF * 1024, 1024, 0}; XPOSE_MAT(f, 1024, EFF, (bf16*)(F.ws + WS_MW + (size_t)e * MW_E + MW_DN), (const float*)nullptr); }
        }
        }
    }
    SEAM(13);
    if (IN(14)) router_phase(F);
    SEAM(14);
    REPLOOP(15) { if (IN(15)) gather_phase(F); }
    SEAM(15);
#pragma unroll 1
    for (int ch = 0; ch < 3; ++ch) {
        const int t0 = ch * HM_TILES, ph = 16 + 2 * ch;
        MoeLayout L; moe_layout(F, L);
        const int ntile = L.off[16] >> 8;
        const int nt = (ntile - t0) < HM_TILES ? (ntile - t0) : HM_TILES;
        if (IN(ph) && nt > 0) {
            MoeSched S; S.o.init(nt, 2 * EFF / 256, F.G, bx); S.t0 = t0; S.A = (const char*)WSP(bf16, WS_XS); S.tstepA = 256 * 2048; S.W = (const char*)(F.ws + WS_MW); S.tstepB = 256 * 2048; S.a_local = false; S.A2 = nullptr;
#pragma unroll
            for (int q = 0; q < 17; ++q) S.off[q] = L.off[q];
            pg8::EpiSwiglu E{WSP(bf16, WS_HM), EFF, t0, nullptr, (bf16*)F.out, HM_SPLIT};
            REPLOOP(16) pg8::gemm_phase<pg8::EpiSwiglu, MoeSched>(F.lds, pg8::GemmK{1024, 2048u, 2048u, 30, 0u}, S, E);
        }
        SEAM(ph);
        const bool split = ch == 2 && nt > 0 && nt <= MOE_SPLIT_TILES;
        if (IN(ph + 1) && split) {
            MoeSplitSched S; S.o.init(nt, 4 * MOE_SPLITS, F.G, bx); S.t0 = t0; S.A = (const char*)WSP(bf16, WS_HM); S.tstepA = (size_t)256 * EFF * 2; S.W = (const char*)(F.ws + WS_MW + MW_DN); S.tstepB = (size_t)256 * EFF * 2;
#pragma unroll
            for (int q = 0; q < 17; ++q) S.off[q] = L.off[q];
            pg8::EpiMoeYp E{WSP(bf16, WS_YP), WSP(float, WS_GWS), t0, (size_t)MOE_SPLIT_TILES * 256 * DM};
            pg8::gemm_phase<pg8::EpiMoeYp, MoeSplitSched>(F.lds, pg8::GemmK{EFF / MOE_SPLITS, EFF * 2u, EFF * 2u, 30, 0u}, S, E);
        }
        if (IN(ph + 1) && nt > 0 && !split) {
            MoeSched S; S.o.init(nt, DM / 256, F.G, bx); S.t0 = t0; S.A = (const char*)WSP(bf16, WS_HM); S.tstepA = (size_t)256 * EFF * 2; S.W = (const char*)(F.ws + WS_MW + MW_DN); S.tstepB = (size_t)256 * EFF * 2; S.a_local = true; S.A2 = (const char*)F.out;
#pragma unroll
            for (int q = 0; q < 17; ++q) S.off[q] = L.off[q];
            pg8::EpiMoeY E{WSP(bf16, WS_XS), WSP(float, WS_GWS)};
            REPLOOP(17) pg8::gemm_phase<pg8::EpiMoeY, MoeSched>(F.lds, pg8::GemmK{EFF, EFF * 2u, EFF * 2u, 30, 0u}, S, E);
        }
        SEAM(ph + 1);
    }
    REPLOOP(18)
    if (IN(26)) {
        const bf16* XS0 = WSP(bf16, WS_XS); const int* inv = WSP(int, WS_INV);
        MoeLayout L; moe_layout(F, L);
        const int ntl = (L.off[16] >> 8) - 2 * HM_TILES; const int srow = (ntl > 0 && ntl <= MOE_SPLIT_TILES) ? 2 * HM_TILES * 256 : 0x7fffffff;
#define FIN_ROW(m_, v_) do { load_row_bf16(WSP(bf16, WS_XB3) + (size_t)(m_) * DM, F.lane, v_); \
            _Pragma("unroll 1") for (int k = 0; k < 2; ++k) { const int s = inv[(size_t)k * M + (m_)]; float y[16]; \
                if (s < srow) { load_row_bf16(XS0 + (size_t)s * DM, F.lane, y); _Pragma("unroll") for (int i = 0; i < 16; ++i) v_[i] += y[i]; } \
                else { _Pragma("unroll 1") for (int sp = 0; sp < MOE_SPLITS; ++sp) { load_row_bf16(WSP(bf16, WS_YP) + ((size_t)sp * MOE_SPLIT_TILES * 256 + (s - srow)) * DM, F.lane, y); \
                        _Pragma("unroll") for (int i = 0; i < 16; ++i) v_[i] += y[i]; } } } } while (0)
#define FIN_OUT(m_, v_) do { rms16(v_, FIN(I_FNORM), F.lane); GAS f32x4* o = (GAS f32x4*)(F.out + (size_t)(m_) * DM); \
            o[2 * F.lane] = (f32x4){v_[0], v_[1], v_[2], v_[3]}; o[2 * F.lane + 1] = (f32x4){v_[4], v_[5], v_[6], v_[7]}; \
            o[128 + 2 * F.lane] = (f32x4){v_[8], v_[9], v_[10], v_[11]}; o[128 + 2 * F.lane + 1] = (f32x4){v_[12], v_[13], v_[14], v_[15]}; } while (0)
        for (int m = gwv; m < M; m += 2 * NGW) { float va[16], vb[16]; const int mb = m + NGW;
            FIN_ROW(m, va); if (mb < M) FIN_ROW(mb, vb);
            FIN_OUT(m, va); if (mb < M) FIN_OUT(mb, vb); }
#undef FIN_ROW
#undef FIN_OUT
    }
#undef IN
#undef SEAM
#undef XPOSE_MAT
}

#ifndef PROBE_REP
#define PROBE_REP 0u
#endif
#ifndef MK_FUSED
#define MK_FUSED 1
#endif
extern "C" void kernel_launch(void* const* d_in, const int* in_sizes, int n_in, void* d_out, int out_size, void* d_ws, size_t ws_size, hipStream_t stream) {
    static int grid = 0;
    if (grid == 0) {
        if (n_in != N_IN || in_sizes[0] != M * DM || out_size != M * DM || ws_size < WS_END) {
            fprintf(stderr, "kernel_launch: built for %d inputs, x/out of %d floats, >= %zu bytes of workspace; got n_in %d, in0 %d, out %d, ws %zu; nothing launched\n", N_IN, M * DM, (size_t)WS_END, n_in, n_in > 0 ? in_sizes[0] : -1, out_size, ws_size);
            grid = -1; return; }
        int dev = 0, cus = 0, per_cu = 0;
        if (hipGetDevice(&dev) != hipSuccess || hipDeviceGetAttribute(&cus, hipDeviceAttributeMultiprocessorCount, dev) != hipSuccess) { fprintf(stderr, "kernel_launch: device query failed\n"); grid = -1; return; }
        if (hipFuncSetAttribute((const void*)fwd, hipFuncAttributeMaxDynamicSharedMemorySize, LDS_BYTES) != hipSuccess) { fprintf(stderr, "kernel_launch: hipFuncSetAttribute failed\n"); grid = -1; return; }
        if (hipOccupancyMaxActiveBlocksPerMultiprocessor(&per_cu, (const void*)fwd, NTHR, LDS_BYTES) != hipSuccess || per_cu < 1)
            fprintf(stderr, "kernel_launch: note: occupancy query reports %d workgroups per CU\n", per_cu);
        (void)hipGetLastError();
        grid = cus;
    }
    if (grid < 0) return;
    if (hipMemsetAsync((char*)d_ws + WS_CTL, 0, CTL_ZERO_BYTES, stream) != hipSuccess) { fprintf(stderr, "kernel_launch: memset failed\n"); return; }
    Args a{};
    for (int i = 0; i < N_IN; ++i) a.in[i] = (const float*)d_in[i];
    a.out = (float*)d_out; a.ws = (unsigned char*)d_ws; a.rep_mask = PROBE_REP; a.pad = 0u;
#if MK_FUSED
    a.ph_lo = 0; a.ph_hi = N_PHASES;
    hipLaunchKernelGGL(fwd, dim3(grid), dim3(NTHR), LDS_BYTES, stream, a);
#else
    for (int p = 0; p < N_PHASES; ++p) { a.ph_lo = p; a.ph_hi = p + 1; hipLaunchKernelGGL(fwd, dim3(grid), dim3(NTHR), LDS_BYTES, stream, a); }
#endif
    const hipError_t le = hipPeekAtLastError();
    if (le != hipSuccess) fprintf(stderr, "kernel_launch: launch failed: %s\n", hipGetErrorName(le));
}
```

```cpp
#include <hip/hip_runtime.h>
#include <cstdio>
#include <cstdint>

#define GAS __attribute__((address_space(1)))
#define LAS __attribute__((address_space(3)))
typedef unsigned short bf16;
typedef unsigned v4u __attribute__((ext_vector_type(4)));
typedef unsigned v2u __attribute__((ext_vector_type(2)));
typedef float f32x2 __attribute__((ext_vector_type(2)));
typedef float f32x4 __attribute__((ext_vector_type(4)));
typedef float f32x16 __attribute__((ext_vector_type(16)));
typedef short bf16x8 __attribute__((ext_vector_type(8)));
typedef short s16x4 __attribute__((ext_vector_type(4)));
typedef GAS unsigned gu32;
#define RLX_AGENT __ATOMIC_RELAXED, __HIP_MEMORY_SCOPE_AGENT
#define LDS_WAIT() asm volatile("s_waitcnt lgkmcnt(0)" ::: "memory")
#define VM_WAIT() asm volatile("s_waitcnt vmcnt(0)" ::: "memory")
#define SBAR() __builtin_amdgcn_sched_barrier(0)

constexpr int BATCH = 8, SEQ = 4096, DM = 1024, M = BATCH * SEQ, HD = 128;
constexpr int NPROJ = 2560;
constexpr int DFF = 2816, NEXP = 8, EFF = 3584;
constexpr float RMS_EPS = 1e-6f;
constexpr float LOG2E = 1.4426950408889634f;
constexpr float QSCALE = 0.08838834764831845f * LOG2E;
enum { I_X = 0, I_RELB, I_EV_NMIX, I_EV_WIN, I_EV_KVN, I_EV_WUK, I_EV_WUV, I_EV_CPOS, I_EV_CW1, I_EV_CW2, I_EV_WOUT, I_EV_NFFN, I_EV_WG, I_EV_WU, I_EV_WD,
       I_OD_NMIX, I_OD_WQKV, I_OD_WOUT, I_OD_NFFN, I_OD_WR, I_OD_WG, I_OD_WU, I_OD_WD, I_FNORM, N_IN };

enum { G_QA = 0  , G_LAT = 4  , G_IQ = 6  , G_QB = 8  , G_CKR = 12, G_CVR = 13, G_SK = 14, G_SV = 15, G_WK = 16, G_WV = 17, G_MISC = 18, G_PAD = 19 };
constexpr size_t GS = (size_t)M * 128;

constexpr size_t MiB = 1u << 20;
constexpr size_t WS_CTL = 0, CTL_ZERO_BYTES = 1 * MiB;
constexpr size_t WS_TAB = 1 * MiB;
constexpr size_t WS_WIN = 2 * MiB;
constexpr size_t WS_WUKV = 7 * MiB;
constexpr size_t WS_WC1 = 7 * MiB + 256 * 1024;
constexpr size_t WS_WOUT0 = 10 * MiB;
constexpr size_t WS_WGU0 = 12 * MiB;
constexpr size_t WS_WDN0 = 23 * MiB;
constexpr size_t WS_WQKV = 29 * MiB;
constexpr size_t WS_WOUT1 = 35 * MiB;
constexpr size_t WS_XN = 40 * MiB;
constexpr size_t WS_PROJ = 104 * MiB;
constexpr size_t WS_AK = 264 * MiB, WS_AV = 272 * MiB;
constexpr size_t WS_BM = 280 * MiB;
constexpr size_t WS_UV = 296 * MiB;
constexpr size_t WS_UVB = 432 * MiB;
constexpr size_t WS_CK = 300 * MiB;
constexpr size_t WS_CVT = 300 * MiB + 512 * 1024;
constexpr size_t WS_CV = 300 * MiB + 512 * 1024;
constexpr size_t WS_BLK = 301 * MiB;
constexpr size_t WS_RS0 = 302 * MiB;
constexpr size_t WS_RS1 = 296 * MiB;
constexpr size_t WS_OC = 304 * MiB;
constexpr size_t WS_O = 368 * MiB;
constexpr size_t WS_OC2 = 432 * MiB;
constexpr size_t WS_XB = 432 * MiB;
constexpr size_t WS_XB3 = 40 * MiB;
constexpr size_t WS_H0 = 104 * MiB;
constexpr size_t WS_QKV = 104 * MiB;
constexpr size_t WS_MW = 104 * MiB;
constexpr size_t MW_E = 21 * MiB, MW_DN = 14 * MiB;
constexpr size_t WS_LIST = 272 * MiB;
constexpr size_t WS_GW = WS_LIST + 2 * MiB;
constexpr size_t WS_TOK = WS_GW + 256 * 1024;
constexpr size_t WS_INV = WS_TOK + 512 * 1024;
constexpr size_t WS_GWS = WS_INV + 256 * 1024;
constexpr int XS_ROWS = M + 8 * 256;
constexpr size_t WS_XS = 276 * MiB;
constexpr int HM_TILES = 128, HM_SPLIT = 64;
constexpr int MOE_SPLITS = 4, MOE_SPLIT_TILES = 16;
constexpr size_t WS_YP = 2 * MiB;
constexpr size_t WS_HM = 412 * MiB;
constexpr size_t WS_END = 524 * MiB;
static_assert(WS_WIN + (size_t)NPROJ * DM * 2 <= WS_WUKV && WS_WC1 + 2ull * 256 * 2048 * 2 <= WS_WOUT0 && WS_WGU0 + 5632ull * 1024 * 2 <= WS_WDN0 && WS_WDN0 + 1024ull * 2816 * 2 <= WS_WQKV && WS_WQKV + 3072ull * 1024 * 2 <= WS_WOUT1 && WS_WOUT1 + 2 * MiB <= WS_XN, "weights map");
static_assert(WS_XN + (size_t)M * DM * 2 <= WS_PROJ && WS_PROJ + 20 * GS * 2 <= WS_AK && WS_BM + (size_t)M * 128 * 4 <= WS_UV && WS_UV + 4 * MiB <= WS_CK && WS_BLK + (size_t)M * 8 <= WS_OC && WS_OC + (size_t)M * 512 * 4 <= WS_O && WS_O + (size_t)M * DM * 2 <= 432 * MiB, "even map");
static_assert(WS_YP + (size_t)MOE_SPLITS * MOE_SPLIT_TILES * 256 * DM * 2 <= WS_XB3, "split partials fit under the residual stream copy");
static_assert(WS_H0 + (size_t)M * DFF * 2 <= WS_OC && WS_QKV + 24 * GS * 2 <= WS_O && WS_MW + 8 * MW_E <= WS_LIST && WS_GWS + 2ull * XS_ROWS * 4 <= WS_XS && WS_XS + 2ull * XS_ROWS * DM * 2 <= WS_HM && WS_HM + (size_t)HM_SPLIT * 256 * EFF * 2 <= WS_END && (size_t)(HM_TILES - HM_SPLIT) * 256 * EFF * 2 <= (size_t)M * DM * 4, "late map");
constexpr int CW_TMO = 0, CW_CODE = 1;
constexpr int CW_BAR = 4096;
constexpr int CW_CNT = 16384;

constexpr int RING_BYTES = 131072;
constexpr int MISC_OFF = RING_BYTES;
constexpr int LDS_BYTES = 147456;
constexpr int NWAVES = 8, NTHR = 512;

__device__ __forceinline__ unsigned f2bf(float f) { unsigned u = __builtin_bit_cast(unsigned, f); return (u + 0x7fffu + ((u >> 16) & 1u)) >> 16; }
__device__ __forceinline__ unsigned pk2(float lo, float hi) { return f2bf(lo) | (f2bf(hi) << 16); }
__device__ __forceinline__ float bf2f(bf16 b) { return __builtin_bit_cast(float, (unsigned)b << 16); }
__device__ __forceinline__ unsigned cvtpk(float lo, float hi) { unsigned r; asm volatile("v_cvt_pk_bf16_f32 %0, %1, %2" : "=v"(r) : "v"(lo), "v"(hi)); return r; }
__device__ __forceinline__ bf16x8 pack8(f32x4 a, f32x4 b) { v4u w = {cvtpk(a[0], a[1]), cvtpk(a[2], a[3]), cvtpk(b[0], b[1]), cvtpk(b[2], b[3])}; return __builtin_bit_cast(bf16x8, w); }
__device__ __forceinline__ float wave_sum(float v) {
#define WS_STEP(ctrl, rmask) v += __int_as_float(__builtin_amdgcn_update_dpp(0, __float_as_int(v), ctrl, rmask, 0xf, true))
    WS_STEP(0x111, 0xf); WS_STEP(0x112, 0xf); WS_STEP(0x114, 0xf); WS_STEP(0x118, 0xf); WS_STEP(0x142, 0xa); WS_STEP(0x143, 0xc);
#undef WS_STEP
    return __int_as_float(__builtin_amdgcn_readlane(__float_as_int(v), 63));
}
__device__ __forceinline__ float wave_max(float v) {
#define WM_STEP(ctrl, rmask) v = fmaxf(v, __int_as_float(__builtin_amdgcn_update_dpp(__float_as_int(v), __float_as_int(v), ctrl, rmask, 0xf, false)))
    WM_STEP(0x111, 0xf); WM_STEP(0x112, 0xf); WM_STEP(0x114, 0xf); WM_STEP(0x118, 0xf); WM_STEP(0x142, 0xa); WM_STEP(0x143, 0xc);
#undef WM_STEP
    return __int_as_float(__builtin_amdgcn_readlane(__float_as_int(v), 63));
}
__device__ __forceinline__ int rel_bucket_dev(int d) {
    if (d < 16) return d;
    if (d >= 113) return 31;
    int v = 16 + (int)(__log2f((float)d * 0.0625f) * (16.0f / 3.0f));
    return v > 31 ? 31 : v;
}
namespace pg8 {
constexpr int BM = 256, BK = 64, HALF = 128, HTB = HALF * BK * 2, STAGE_BYTES = 8 * HTB, NXCD = 8, WGM = 8;
__host__ __device__ __forceinline__ int lds_byte(int r, int c) { const int st = (r >> 4) * 2 + (c >> 5), rr = r & 15, cc = c & 31, ob = rr * 64 + cc * 2; return st * 1024 + (ob ^ (((ob >> 9) & 1) << 5)); }
__host__ __device__ __forceinline__ void stage_rc(int b, int& R, int& C) { const int st = b / 1024, sb = b % 1024, swz = sb ^ (((sb >> 9) & 1) << 5); R = (st >> 1) * 16 + swz / 64; C = (st & 1) * 32 + (swz % 64) / 2; }
__host__ __device__ __forceinline__ int perm32(int rho) { const int n = rho >> 4, i = rho & 15; return 8 * (i >> 2) + 4 * n + (i & 3); }

struct Unit { int pm, pn, aux; const char* A; const char* B; };
struct GemmK { int K; unsigned pitchA, pitchB; int kshA; unsigned gstrA; };

struct GridOrder {
    int nM, nN, nwg, G, c;
    __device__ __forceinline__ void init(int nM_, int nN_, int G_, int c_) { nM = nM_; nN = nN_; nwg = nM * nN; G = G_; c = c_; }
    __device__ __forceinline__ bool at(int i, int& pm, int& pn) const {
        const long L = (long)i * G + c; if (L >= nwg) return false;
        int wgid = (int)L; { const int q = nwg / NXCD, r = nwg % NXCD, xcd = wgid % NXCD, off = wgid / NXCD; wgid = (xcd < r ? xcd * (q + 1) : r * (q + 1) + (xcd - r) * q) + off; }
        const int nig = WGM * nN, gid = wgid / nig, fm = gid * WGM, gsz = (nM - fm) < WGM ? (nM - fm) : WGM;
        pm = fm + ((wgid % nig) % gsz); pn = (wgid % nig) / gsz; return true;
    }
};
struct PlainSched {
    GridOrder o; const char* A; const char* B; size_t tstepA, tstepB;
    __device__ __forceinline__ void init(int Mr, int Nc, int G, int c, const void* A_, size_t pitchA, const void* B_, size_t pitchB) { o.init(Mr / BM, Nc / BM, G, c); A = (const char*)A_; B = (const char*)B_; tstepA = 256 * pitchA; tstepB = 256 * pitchB; }
    __device__ __forceinline__ bool next(int i, Unit& u) const { if (!o.at(i, u.pm, u.pn)) return false; u.aux = 0; u.A = A + (size_t)u.pm * tstepA; u.B = B + (size_t)u.pn * tstepB; return true; }
};

__device__ __forceinline__ unsigned cvt_pk_bf16(float lo, float hi) { unsigned r; asm volatile("v_cvt_pk_bf16_f32 %0, %1, %2" : "=v"(r) : "v"(lo), "v"(hi)); return r; }

typedef float f32x8 __attribute__((ext_vector_type(8)));
__device__ __forceinline__ f32x8 row_rstd8(const float* rs, int row0, int fq) {
    f32x8 r = {1.f, 1.f, 1.f, 1.f, 1.f, 1.f, 1.f, 1.f};
    if (rs) {
#pragma unroll
        for (int i = 0; i < 8; ++i) { const f32x4 p = *(const f32x4*)(rs + (size_t)(row0 + (i >> 2) * HALF + (i & 3) * 16) * 16 + 4 * fq); float s = (p[0] + p[1]) + (p[2] + p[3]);
            s += __shfl_xor(s, 16); s += __shfl_xor(s, 32); r[i] = 1.0f / sqrtf(s * (1.0f / DM) + RMS_EPS); } }
    return r;
}
struct EpiGroups {
    static constexpr bool PERM = true;
    bf16* O; size_t gstride; unsigned scalemask; float scale; int gskip; const float* rs;
    __device__ __forceinline__ void operator()(const f32x4 (&acc)[2][2][4][2], const Unit& u, int wr, int wc, int fr, int fq) const {
        const int row0 = u.pm * BM + wr * 64 + fr, col0 = wc * 32 + 8 * fq;
        const f32x8 rstd = row_rstd8(rs, row0, fq);
#pragma unroll
        for (int bj = 0; bj < 2; ++bj) { const int g = 2 * u.pn + bj; if (g >= gskip) continue; const float sc = ((scalemask >> g) & 1u) ? scale : 1.f; bf16* base = O + (size_t)g * gstride;
#pragma unroll
            for (int ai = 0; ai < 2; ++ai)
#pragma unroll
                for (int m = 0; m < 4; ++m) { const float s2 = sc * rstd[ai * 4 + m]; const f32x4 v0 = acc[ai][bj][m][0] * s2, v1 = acc[ai][bj][m][1] * s2;
                    v4u w; w.x = cvt_pk_bf16(v0[0], v0[1]); w.y = cvt_pk_bf16(v0[2], v0[3]); w.z = cvt_pk_bf16(v1[0], v1[1]); w.w = cvt_pk_bf16(v1[2], v1[3]);
                    *(v4u*)(base + (size_t)(row0 + ai * HALF + m * 16) * 128 + col0) = w; } }
    }
};
struct OneSched { Unit u; __device__ __forceinline__ bool next(int i, Unit& o) const { if (i) return false; o = u; return true; } };
struct EpiAkv {
    static constexpr bool PERM = true;
    bf16* AK; bf16* AV; const LAS float* rstd;
    __device__ __forceinline__ void operator()(const f32x4 (&acc)[2][2][4][2], const Unit& u, int wr, int wc, int fr, int fq) const {
        const int col0 = wc * 32 + 8 * fq;
#pragma unroll
        for (int ai = 0; ai < 2; ++ai)
#pragma unroll
            for (int m = 0; m < 4; ++m) { const int rl = ai * HALF + wr * 64 + m * 16 + fr; const float rs = rstd[rl]; const size_t row = (size_t)u.pm * BM + rl;
#pragma unroll
                for (int bj = 0; bj < 2; ++bj) { const f32x4 v0 = acc[ai][bj][m][0] * rs, v1 = acc[ai][bj][m][1] * rs;
                    v4u w; w.x = cvt_pk_bf16(v0[0], v0[1]); w.y = cvt_pk_bf16(v0[2], v0[3]); w.z = cvt_pk_bf16(v1[0], v1[1]); w.w = cvt_pk_bf16(v1[2], v1[3]);
                    *(v4u*)((bj ? AV : AK) + row * 128 + col0) = w; } }
    }
};
struct EpiF32 {
    static constexpr bool PERM = false;
    const float* base; float* C; int ldc; float scale;
    __device__ __forceinline__ void operator()(const f32x4 (&acc)[2][2][4][2], const Unit& u, int wr, int wc, int fr, int fq) const {
        const int row0 = u.pm * BM + wr * 64 + fr, col0 = u.pn * BM + wc * 32 + 4 * fq;
#pragma unroll
        for (int ai = 0; ai < 2; ++ai)
#pragma unroll
            for (int m = 0; m < 4; ++m) { const size_t off = (size_t)(row0 + ai * HALF + m * 16) * ldc + col0;
#pragma unroll
                for (int bj = 0; bj < 2; ++bj)
#pragma unroll
                    for (int n = 0; n < 2; ++n) { f32x4 v = acc[ai][bj][m][n] * scale; if (base) v += *(const f32x4*)(base + off + bj * HALF + n * 16); *(f32x4*)(C + off + bj * HALF + n * 16) = v; } }
    }
};
struct EpiRes {
    static constexpr bool PERM = true;
    const float* basef; const bf16* baseb; bf16* out; float* rs; float scale;
    __device__ __forceinline__ void operator()(const f32x4 (&acc)[2][2][4][2], const Unit& u, int wr, int wc, int fr, int fq) const {
        const int row0 = u.pm * BM + wr * 64 + fr, col0 = u.pn * BM + wc * 32 + 8 * fq;
#pragma unroll
        for (int ai = 0; ai < 2; ++ai)
#pragma unroll
            for (int m = 0; m < 4; ++m) { const size_t off = (size_t)(row0 + ai * HALF + m * 16) * DM + col0; float ss = 0.f;
#pragma unroll
                for (int bj = 0; bj < 2; ++bj) { f32x4 v0 = acc[ai][bj][m][0] * scale, v1 = acc[ai][bj][m][1] * scale;
                    if (basef) { v0 += *(const f32x4*)(basef + off + bj * HALF); v1 += *(const f32x4*)(basef + off + bj * HALF + 4); }
                    else { const v4u w = *(const v4u*)(baseb + off + bj * HALF);
                        v0 += (f32x4){__uint_as_float(w.x << 16), __uint_as_float(w.x & 0xffff0000u), __uint_as_float(w.y << 16), __uint_as_float(w.y & 0xffff0000u)};
                        v1 += (f32x4){__uint_as_float(w.z << 16), __uint_as_float(w.z & 0xffff0000u), __uint_as_float(w.w << 16), __uint_as_float(w.w & 0xffff0000u)}; }
                    v4u o; o.x = cvt_pk_bf16(v0[0], v0[1]); o.y = cvt_pk_bf16(v0[2], v0[3]); o.z = cvt_pk_bf16(v1[0], v1[1]); o.w = cvt_pk_bf16(v1[2], v1[3]);
                    *(v4u*)(out + off + bj * HALF) = o;
#define RS_ACC(w) { const float a_ = __uint_as_float((w) << 16), c_ = __uint_as_float((w) & 0xffff0000u); ss = fmaf(a_, a_, fmaf(c_, c_, ss)); }
                    RS_ACC(o.x) RS_ACC(o.y) RS_ACC(o.z) RS_ACC(o.w)
#undef RS_ACC
                }
                { ss += __shfl_xor(ss, 16); ss += __shfl_xor(ss, 32); if (fq == 0) rs[(size_t)(row0 + ai * HALF + m * 16) * 16 + 4 * u.pn + wc] = ss; } }
    }
};
struct EpiMoeY {
    static constexpr bool PERM = true;
    bf16* Y; const float* gws;
    __device__ __forceinline__ void operator()(const f32x4 (&acc)[2][2][4][2], const Unit& u, int wr, int wc, int fr, int fq) const {
        const int col0 = u.pn * BM + wc * 32 + 8 * fq;
#pragma unroll
        for (int ai = 0; ai < 2; ++ai)
#pragma unroll
            for (int m = 0; m < 4; ++m) { const int slot = u.pm * BM + ai * HALF + wr * 64 + m * 16 + fr; const float g = gws[slot];
#pragma unroll
                for (int bj = 0; bj < 2; ++bj) { const f32x4 v0 = acc[ai][bj][m][0] * g, v1 = acc[ai][bj][m][1] * g;
                    v4u o; o.x = cvt_pk_bf16(v0[0], v0[1]); o.y = cvt_pk_bf16(v0[2], v0[3]); o.z = cvt_pk_bf16(v1[0], v1[1]); o.w = cvt_pk_bf16(v1[2], v1[3]);
                    *(v4u*)(Y + (size_t)slot * DM + col0 + bj * HALF) = o; } }
    }
};
struct EpiMoeYp {
    static constexpr bool PERM = true;
    bf16* YP; const float* gws; int pm0; size_t split_stride;
    __device__ __forceinline__ void operator()(const f32x4 (&acc)[2][2][4][2], const Unit& u, int wr, int wc, int fr, int fq) const {
        const int col0 = (u.pn & 3) * BM + wc * 32 + 8 * fq; bf16* base = YP + (size_t)(u.pn >> 2) * split_stride;
#pragma unroll
        for (int ai = 0; ai < 2; ++ai)
#pragma unroll
            for (int m = 0; m < 4; ++m) { const int rl = ai * HALF + wr * 64 + m * 16 + fr; const float g = gws[u.pm * BM + rl];
#pragma unroll
                for (int bj = 0; bj < 2; ++bj) { const f32x4 v0 = acc[ai][bj][m][0] * g, v1 = acc[ai][bj][m][1] * g;
                    v4u o; o.x = cvt_pk_bf16(v0[0], v0[1]); o.y = cvt_pk_bf16(v0[2], v0[3]); o.z = cvt_pk_bf16(v1[0], v1[1]); o.w = cvt_pk_bf16(v1[2], v1[3]);
                    *(v4u*)(base + (size_t)((u.pm - pm0) * BM + rl) * DM + col0 + bj * HALF) = o; } }
    }
};
struct EpiSwiglu {
    static constexpr bool PERM = true;
    bf16* H; int ldh; int pm0; const float* rs; bf16* H2; int hsplit;
    __device__ __forceinline__ void operator()(const f32x4 (&acc)[2][2][4][2], const Unit& u, int wr, int wc, int fr, int fq) const {
        const int lt = u.pm - pm0; bf16* Hb = (H2 && lt >= hsplit) ? H2 : H;
        const int row0 = ((H2 && lt >= hsplit) ? lt - hsplit : lt) * BM + wr * 64 + fr, col0 = u.pn * HALF + wc * 32 + 8 * fq;
        const f32x8 rstd = row_rstd8(rs, u.pm * BM + wr * 64 + fr, fq);
#pragma unroll
        for (int ai = 0; ai < 2; ++ai)
#pragma unroll
            for (int m = 0; m < 4; ++m) { float h[8];
#pragma unroll
                for (int n = 0; n < 2; ++n)
#pragma unroll
                    for (int j = 0; j < 4; ++j) { const float g = acc[ai][0][m][n][j] * rstd[ai * 4 + m], up = acc[ai][1][m][n][j] * rstd[ai * 4 + m]; h[n * 4 + j] = g * up * __builtin_amdgcn_rcpf(1.0f + __builtin_amdgcn_exp2f(-g * LOG2E)); }
                v4u w; w.x = cvt_pk_bf16(h[0], h[1]); w.y = cvt_pk_bf16(h[2], h[3]); w.z = cvt_pk_bf16(h[4], h[5]); w.w = cvt_pk_bf16(h[6], h[7]);
                *(v4u*)(Hb + (size_t)(row0 + ai * HALF + m * 16) * ldh + col0) = w; }
    }
};
struct EpiMoeDown {
    static constexpr bool PERM = false;
    float* out; const int* tok; const float* gw; int pm0; float scale;
    __device__ __forceinline__ void operator()(const f32x4 (&acc)[2][2][4][2], const Unit& u, int wr, int wc, int fr, int fq) const {
        const int col0 = u.pn * BM + wc * 32 + 4 * fq;
#pragma unroll
        for (int ai = 0; ai < 2; ++ai)
#pragma unroll
            for (int m = 0; m < 4; ++m) { const int slot = u.pm * BM + ai * HALF + wr * 64 + m * 16 + fr; const int t = tok[slot];
                if (t >= 0) { const float g = gw[t] * scale; float* rowp = out + (size_t)t * DM + col0;
#pragma unroll
                    for (int bj = 0; bj < 2; ++bj)
#pragma unroll
                        for (int n = 0; n < 2; ++n) { f32x4* p = (f32x4*)(rowp + bj * HALF + n * 16); *p = *p + acc[ai][bj][m][n] * g; } } }
    }
};

template <class Epi, class Sched, bool ALIGN_EPI = true>
__device__ __forceinline__ void gemm_phase(LAS unsigned char* lds, const GemmK gk, const Sched& S, const Epi& E) {
    int tid = threadIdx.x; asm volatile("" : "+v"(tid));
    const int wid = __builtin_amdgcn_readfirstlane(tid >> 6), lane = tid & 63, wr = wid >> 2, wc = wid & 3, fr = lane & 15, fq = lane >> 4;
    int nt = gk.K / BK; asm volatile("" : "+s"(nt));
    unsigned voffA[2], voffB[2];
#pragma unroll
    for (int i = 0; i < 2; ++i) { int R, C; stage_rc(tid * 16 + i * 8192, R, C); const int Rb = Epi::PERM ? ((R & ~31) + perm32(R & 31)) : R;
        voffA[i] = (unsigned)R * gk.pitchA + (unsigned)C * 2u; voffB[i] = (unsigned)Rb * gk.pitchB + (unsigned)C * 2u; }
    const size_t hstepA = (size_t)HALF * gk.pitchA, hstepB = (size_t)HALF * gk.pitchB;
    const int ksh = gk.kshA; const unsigned kmask = (1u << ksh) - 1u; const size_t gstr = gk.gstrA;
#define PG8_KOA(t) ((size_t)((unsigned)(t) >> ksh) * gstr + (size_t)((unsigned)(t) & kmask) * 128u)
    const unsigned ldsw = (unsigned)wid * 1024u;
    const int aoff = lds_byte(wr * 64 + fr, fq * 8), boff = lds_byte(wc * 32 + fr, fq * 8);
#define PG8_SA(b, h) (((b) * 2 + (h)) * HTB)
#define PG8_SB(b, h) ((4 + (b) * 2 + (h)) * HTB)
#define PG8_STAGE(bufoff, gbase, voff) do { _Pragma("unroll") for (int _i = 0; _i < 2; ++_i) \
        __builtin_amdgcn_global_load_lds((const unsigned*)((const char*)(gbase) + (voff)[_i]), (LAS unsigned*)(lds + (bufoff) + ldsw + _i * 8192), 16, 0, 0); } while (0)
#define PG8_LDA(dst, b, h) do { _Pragma("unroll") for (int m = 0; m < 4; ++m) _Pragma("unroll") for (int k = 0; k < 2; ++k) dst[m][k] = *(const LAS bf16x8*)(lds + PG8_SA(b, h) + aoff + m * 2048 + k * 1024); } while (0)
#define PG8_LDB(dst, b, h) do { _Pragma("unroll") for (int n = 0; n < 2; ++n) _Pragma("unroll") for (int k = 0; k < 2; ++k) dst[n][k] = *(const LAS bf16x8*)(lds + PG8_SB(b, h) + boff + n * 2048 + k * 1024); } while (0)
#define PG8_MMA(ai, bj, At, Bt) do { __builtin_amdgcn_s_setprio(1); _Pragma("unroll") for (int m = 0; m < 4; ++m) _Pragma("unroll") for (int n = 0; n < 2; ++n) _Pragma("unroll") for (int k = 0; k < 2; ++k) \
        acc[ai][bj][m][n] = __builtin_amdgcn_mfma_f32_16x16x32_bf16(Bt[n][k], At[m][k], acc[ai][bj][m][n], 0, 0, 0); __builtin_amdgcn_s_setprio(0); } while (0)
#define PG8_WAIT_V(n) asm volatile("s_waitcnt vmcnt(" #n ")" ::: "memory")
#define PG8_WAIT_L(n) asm volatile("s_waitcnt lgkmcnt(" #n ")" ::: "memory")
#define PG8_BAR __builtin_amdgcn_s_barrier()
#define PG8_SCHED __builtin_amdgcn_sched_barrier(0)
    Unit cur, nxt; int ui = 0;
    if (!S.next(0, cur)) return;
    f32x4 acc[2][2][4][2];
#pragma unroll
    for (int a = 0; a < 2; ++a)
#pragma unroll
        for (int b = 0; b < 2; ++b)
#pragma unroll
            for (int m = 0; m < 4; ++m)
#pragma unroll
                for (int n = 0; n < 2; ++n) acc[a][b][m][n] = (f32x4){0.f, 0.f, 0.f, 0.f};
    bf16x8 At[4][2], B0[2][2], B1[2][2];
    const char* cA = cur.A; const char* cB = cur.B;
    PG8_STAGE(PG8_SB(0, 0), cB, voffB); PG8_STAGE(PG8_SB(0, 1), cB + hstepB, voffB); PG8_STAGE(PG8_SA(0, 0), cA, voffA); PG8_STAGE(PG8_SA(0, 1), cA + hstepA, voffA);
    if (wr == 1) PG8_BAR;
    PG8_WAIT_V(2); PG8_BAR;
    PG8_STAGE(PG8_SB(1, 0), cB + 128, voffB); PG8_STAGE(PG8_SA(1, 0), cA + 128, voffA); PG8_STAGE(PG8_SB(1, 1), cB + hstepB + 128, voffB);
    PG8_WAIT_V(6); PG8_BAR;
    for (;;) {
        const bool has_next = S.next(ui + 1, nxt);
        const char* nA = has_next ? nxt.A : cA; const char* nB = has_next ? nxt.B : cB;
        for (int t = 0; t < nt; t += 2) {
            const bool last = (t == nt - 2);
            const char* a1 = cA + PG8_KOA(t + 1);
            const char* a2 = last ? nA : cA + PG8_KOA(t + 2); const char* b2 = last ? nB : cB + (size_t)(t + 2) * 128u;
            const char* a3 = a2 + 128; const char* b3 = b2 + 128;
            PG8_LDB(B0, 0, 0); PG8_LDB(B1, 0, 1); PG8_SCHED; PG8_LDA(At, 0, 0); PG8_STAGE(PG8_SA(1, 1), a1 + hstepA, voffA);
            PG8_WAIT_V(8); PG8_WAIT_L(0); PG8_BAR; PG8_MMA(0, 0, At, B0); PG8_MMA(0, 1, At, B1); PG8_BAR; PG8_SCHED;
            PG8_LDA(At, 0, 1); PG8_STAGE(PG8_SB(0, 0), b2, voffB); PG8_STAGE(PG8_SB(0, 1), b2 + hstepB, voffB); PG8_STAGE(PG8_SA(0, 0), a2, voffA);
            PG8_WAIT_V(8); PG8_WAIT_L(0); PG8_BAR; PG8_MMA(1, 0, At, B0); PG8_MMA(1, 1, At, B1); PG8_BAR; PG8_SCHED;
            PG8_LDB(B0, 1, 0); PG8_LDB(B1, 1, 1); PG8_SCHED; PG8_LDA(At, 1, 0); PG8_STAGE(PG8_SA(0, 1), a2 + hstepA, voffA);
            PG8_WAIT_V(8); PG8_WAIT_L(0); PG8_BAR; PG8_MMA(0, 0, At, B0); PG8_MMA(0, 1, At, B1); PG8_BAR; PG8_SCHED;
            PG8_LDA(At, 1, 1); PG8_STAGE(PG8_SB(1, 0), b3, voffB); PG8_STAGE(PG8_SB(1, 1), b3 + hstepB, voffB); PG8_STAGE(PG8_SA(1, 0), a3, voffA);
            PG8_WAIT_V(8); PG8_WAIT_L(0); PG8_BAR; PG8_MMA(1, 0, At, B0); PG8_MMA(1, 1, At, B1); PG8_BAR; PG8_SCHED;
        }
        if constexpr (ALIGN_EPI) { if (wr == 0) PG8_BAR; }
        E(acc, cur, wr, wc, fr, fq);
        if (!has_next) break;
#pragma unroll
        for (int a = 0; a < 2; ++a)
#pragma unroll
            for (int b = 0; b < 2; ++b)
#pragma unroll
                for (int m = 0; m < 4; ++m)
#pragma unroll
                    for (int n = 0; n < 2; ++n) acc[a][b][m][n] = (f32x4){0.f, 0.f, 0.f, 0.f};
        cur = nxt; cA = nA; cB = nB; ++ui;
        if constexpr (ALIGN_EPI) { if (wr == 1) PG8_BAR; }
    }
    PG8_WAIT_V(0);
    if constexpr (!ALIGN_EPI) { if (wr == 0) PG8_BAR; }
    PG8_BAR;
#undef PG8_KOA
#undef PG8_SA
#undef PG8_SB
#undef PG8_STAGE
#undef PG8_LDA
#undef PG8_LDB
#undef PG8_MMA
#undef PG8_WAIT_V
#undef PG8_WAIT_L
#undef PG8_BAR
#undef PG8_SCHED
}
}
#define XB_TMO      128
#define XB_XCNT(j)  (256  + 64 * (j))
#define XB_XSUB(j)  (1280 + 64 * (j))
#define XB_XGEN(j)  (2304 + 64 * (j))
#define XB_TOP      3328
#define XB_TOPGEN   3392
#define XCD_BAR_WORDS 3456
#define XB_SPIN_CAP (1u << 22)

__device__ __forceinline__ unsigned xb_ld(unsigned* p)              { return __hip_atomic_load(p, __ATOMIC_RELAXED, __HIP_MEMORY_SCOPE_AGENT); }
__device__ __forceinline__ unsigned xb_add(unsigned* p, unsigned v) { return __hip_atomic_fetch_add(p, v, __ATOMIC_RELAXED, __HIP_MEMORY_SCOPE_AGENT); }
__device__ __forceinline__ unsigned xb_xcc_id() { return (unsigned)__builtin_amdgcn_s_getreg((3 << 11) | 20) & 0xFu; }
#define XB_SPIN(cond, bar) do { unsigned _sp = 0; while (cond) { __builtin_amdgcn_s_sleep(1); \
    if ((++_sp & 255u) == 0u) { if (xb_ld(&(bar)[XB_TMO])) break; if (_sp > XB_SPIN_CAP) { atomicAdd(&(bar)[XB_TMO], 1u); break; } } } } while (0)

struct XcdBarrier { unsigned* bar; unsigned x; volatile LAS unsigned* st; };

__device__ __forceinline__ XcdBarrier xcd_barrier_post(unsigned* bar, volatile LAS unsigned* st) {
    XcdBarrier b; b.bar = bar; b.x = xb_xcc_id(); b.st = st;
    if (threadIdx.x == 0) (void)xb_add(&bar[XB_XCNT(b.x)], 1u);
    return b;
}
__device__ __forceinline__ void xcd_barrier_complete(unsigned* bar, unsigned x, unsigned& nloc, unsigned& nx) {
    const unsigned G = gridDim.x * gridDim.y * gridDim.z;
    unsigned sum, cnt, mine, sp = 0u;
    for (;;) {
        sum = 0u; cnt = 0u; mine = 0u;
#pragma unroll
        for (unsigned j = 0; j < 16; ++j) { const unsigned c = xb_ld(&bar[XB_XCNT(j)]); sum += c; cnt += (c > 0u) ? 1u : 0u; mine = (j == x) ? c : mine; }
        if (sum == G) break;
        __builtin_amdgcn_s_sleep(1);
        if ((++sp & 255u) == 0u) { if (xb_ld(&bar[XB_TMO])) break; if (sp > XB_SPIN_CAP) { atomicAdd(&bar[XB_TMO], 1u); break; } }
    }
    nloc = mine > 0u ? mine : 1u; nx = cnt > 0u ? cnt : 1u;
}
__device__ __forceinline__ void xcd_barrier(const XcdBarrier& b) {
    asm volatile("s_waitcnt vmcnt(0)" ::: "memory");
    __syncthreads();
    if (threadIdx.x == 0) {
        unsigned* bar = b.bar;
        __builtin_amdgcn_s_waitcnt(0);
        unsigned nloc = b.st[0], nx = b.st[1];
        if (nloc == 0u) { xcd_barrier_complete(bar, b.x, nloc, nx); b.st[0] = nloc; b.st[1] = nx; }
        const unsigned old = xb_add(&bar[XB_XSUB(b.x)], 1u);
        const unsigned gen = old / nloc;
        if (old + 1u == (gen + 1u) * nloc) {
            __builtin_amdgcn_fence(__ATOMIC_RELEASE, "agent");
            asm volatile("s_waitcnt vmcnt(0)" ::: "memory");
            const unsigned og = xb_add(&bar[XB_TOP], 1u);
            const unsigned tg = og / nx;
            if (og + 1u == (tg + 1u) * nx) xb_add(&bar[XB_TOPGEN], 1u);
            else XB_SPIN(xb_ld(&bar[XB_TOPGEN]) == tg, bar);
            __builtin_amdgcn_fence(__ATOMIC_ACQUIRE, "agent");
            xb_add(&bar[XB_XGEN(b.x)], 1u);
            asm volatile("s_waitcnt vmcnt(0)" ::: "memory");
        } else {
            XB_SPIN(xb_ld(&bar[XB_XGEN(b.x)]) == gen, bar);
            __builtin_amdgcn_fence(__ATOMIC_ACQUIRE, "agent");
            asm volatile("s_waitcnt vmcnt(0)" ::: "memory");
        }
    }
    __syncthreads();
}

struct Frame {
    LAS unsigned char* lds;
    char* ldsg;
    volatile LAS unsigned* MISC;
    gu32* ctl;
    int tid, lane, wave, vcu, G;
    const __attribute__((address_space(4))) char* kap;
    float* out; unsigned char* ws;
};
#define FIN(i) (*(const float* const __attribute__((address_space(4)))*)(F.kap + 8 * (i)))
#define PHASE_FENCE() do { unsigned long long k_ = (unsigned long long)F.kap; asm volatile("" : "+s"(k_)); F.kap = (const __attribute__((address_space(4))) char*)k_; \
    int t_ = F.tid; asm volatile("" : "+v"(t_)); F.tid = t_; F.lane = t_ & 63; } while (0)
#define WSP(T, off) ((T*)(F.ws + (off)))
#define GRP(g) (WSP(bf16, WS_PROJ) + (size_t)(g) * GS)
#define QKVG(g) (WSP(bf16, WS_QKV) + (size_t)(g) * GS)

__device__ __forceinline__ void rms_row(const float* xrow, const float* gain, int lane, f32x4 (&v)[4]) {
    const GAS f32x4* xr = (const GAS f32x4*)xrow + lane; float s = 0.f;
#pragma unroll
    for (int j = 0; j < 4; ++j) { v[j] = xr[64 * j]; s += (v[j].x * v[j].x + v[j].y * v[j].y) + (v[j].z * v[j].z + v[j].w * v[j].w); }
    const float rstd = 1.0f / sqrtf(wave_sum(s) * (1.f / DM) + RMS_EPS);
#pragma unroll
    for (int j = 0; j < 4; ++j) { const f32x4 g = ((const GAS f32x4*)gain)[lane + 64 * j]; v[j] = v[j] * rstd * g; }
}
__device__ __forceinline__ void store_row_bf16(bf16* orow, int lane, const f32x4 (&v)[4]) {
    GAS unsigned long long* o8 = (GAS unsigned long long*)orow + lane;
#pragma unroll
    for (int j = 0; j < 4; ++j) o8[64 * j] = (unsigned long long)cvtpk(v[j].x, v[j].y) | ((unsigned long long)cvtpk(v[j].z, v[j].w) << 32);
}
__device__ __forceinline__ void load_row_bf16(const bf16* row, int lane, float (&v)[16]) {
    const v4u a = ((const GAS v4u*)row)[lane], b = ((const GAS v4u*)row)[64 + lane];
#pragma unroll
    for (int q = 0; q < 4; ++q) { v[2 * q] = __uint_as_float(a[q] << 16); v[2 * q + 1] = __uint_as_float(a[q] & 0xffff0000u); v[8 + 2 * q] = __uint_as_float(b[q] << 16); v[8 + 2 * q + 1] = __uint_as_float(b[q] & 0xffff0000u); }
}
__device__ __forceinline__ void store_row16_bf16(bf16* row, int lane, const float (&v)[16]) {
    ((GAS v4u*)row)[lane] = (v4u){cvtpk(v[0], v[1]), cvtpk(v[2], v[3]), cvtpk(v[4], v[5]), cvtpk(v[6], v[7])};
    ((GAS v4u*)row)[64 + lane] = (v4u){cvtpk(v[8], v[9]), cvtpk(v[10], v[11]), cvtpk(v[12], v[13]), cvtpk(v[14], v[15])};
}
__device__ __forceinline__ void rms16(float (&v)[16], const float* gain, int lane) {
    float s = 0.f;
#pragma unroll
    for (int i = 0; i < 16; ++i) s += v[i] * v[i];
    const float rstd = 1.0f / sqrtf(wave_sum(s) * (1.f / DM) + RMS_EPS);
    const f32x4 g0 = ((const GAS f32x4*)gain)[2 * lane], g1 = ((const GAS f32x4*)gain)[2 * lane + 1], g2 = ((const GAS f32x4*)gain)[128 + 2 * lane], g3 = ((const GAS f32x4*)gain)[128 + 2 * lane + 1];
#pragma unroll
    for (int i = 0; i < 4; ++i) { v[i] *= rstd * g0[i]; v[4 + i] *= rstd * g1[i]; v[8 + i] *= rstd * g2[i]; v[12 + i] *= rstd * g3[i]; }
}
__device__ __forceinline__ void norm_phase(Frame& F, const float* srcf, const bf16* srcb, const float* gain) {
    const int gw = F.vcu * NWAVES + F.wave, NGW = F.G * NWAVES;
    if (srcf) { for (int m = gw; m < M; m += 2 * NGW) { f32x4 v[4], w[4]; const int mb = m + NGW;
            const GAS f32x4* xa = (const GAS f32x4*)(srcf + (size_t)m * DM) + F.lane; const GAS f32x4* xb = (const GAS f32x4*)(srcf + (size_t)(mb < M ? mb : m) * DM) + F.lane;
#pragma unroll
            for (int j = 0; j < 4; ++j) { v[j] = xa[64 * j]; w[j] = xb[64 * j]; }
            float sa = 0.f, sb = 0.f;
#pragma unroll
            for (int j = 0; j < 4; ++j) { sa += (v[j].x * v[j].x + v[j].y * v[j].y) + (v[j].z * v[j].z + v[j].w * v[j].w); sb += (w[j].x * w[j].x + w[j].y * w[j].y) + (w[j].z * w[j].z + w[j].w * w[j].w); }
            const float ra = 1.0f / sqrtf(wave_sum(sa) * (1.f / DM) + RMS_EPS), rb = 1.0f / sqrtf(wave_sum(sb) * (1.f / DM) + RMS_EPS);
#pragma unroll
            for (int j = 0; j < 4; ++j) { const f32x4 g = ((const GAS f32x4*)gain)[F.lane + 64 * j]; v[j] = v[j] * ra * g; w[j] = w[j] * rb * g; }
            store_row_bf16(WSP(bf16, WS_XN) + (size_t)m * DM, F.lane, v); if (mb < M) store_row_bf16(WSP(bf16, WS_XN) + (size_t)mb * DM, F.lane, w); } }
    else { for (int m = gw; m < M; m += NGW) { float v[16]; load_row_bf16(srcb + (size_t)m * DM, F.lane, v); rms16(v, gain, F.lane); store_row16_bf16(WSP(bf16, WS_XN) + (size_t)m * DM, F.lane, v); } }
}

struct SrcCol { const float* W; int col; int ldw; };
template <class Fn>
__device__ __forceinline__ void xpose_load(const Fn& fn, int K, const float* kgain, int item, int lane, float (&v)[32]) {
    const int nkb = K / 64, rb = item / nkb, kb = item % nkb, k0 = 64 * kb, r0 = 32 * rb;
    const SrcCol s = fn(r0 + (lane & 31));
#pragma unroll
    for (int i = 0; i < 32; ++i) { const int kk = 2 * i + (lane >> 5); float x = 0.f; if (s.W) { x = s.W[(size_t)(k0 + kk) * s.ldw + s.col]; if (kgain) x *= kgain[k0 + kk]; } v[i] = x; }
}
__device__ __forceinline__ void xpose_store(int K, bf16* WT, LAS float* scr, int item, int lane, const float (&v)[32]) {
    const int nkb = K / 64, rb = item / nkb, kb = item % nkb, k0 = 64 * kb, r0 = 32 * rb;
#pragma unroll
    for (int i = 0; i < 32; ++i) scr[(2 * i + (lane >> 5)) * 33 + (lane & 31)] = v[i];
    LDS_WAIT(); asm volatile("" ::: "memory");
    const int c = lane & 7;
#pragma unroll
    for (int j = 0; j < 4; ++j) { const int n = (lane >> 3) + 8 * j; const LAS float* sp = scr + (8 * c) * 33 + n;
        v4u o; o.x = cvtpk(sp[0 * 33], sp[1 * 33]); o.y = cvtpk(sp[2 * 33], sp[3 * 33]); o.z = cvtpk(sp[4 * 33], sp[5 * 33]); o.w = cvtpk(sp[6 * 33], sp[7 * 33]);
        *(GAS v4u*)(WT + (size_t)(r0 + n) * K + k0 + 8 * c) = o; }
    LDS_WAIT(); asm volatile("" ::: "memory");
}
template <class Fn>
__device__ __forceinline__ void xpose_matrix(const Fn& fn, int K, bf16* WT, const float* kgain, LAS float* scr, int first, int nitems, int stride, int lane) {
    float va[32], vb[32];
    int it = first;
    if (it < nitems) xpose_load(fn, K, kgain, it, lane, va);
    while (it < nitems) {
        const int i1 = it + stride, i2 = i1 + stride;
        if (i1 < nitems) xpose_load(fn, K, kgain, i1, lane, vb);
        xpose_store(K, WT, scr, it, lane, va);
        if (i1 >= nitems) break;
        if (i2 < nitems) xpose_load(fn, K, kgain, i2, lane, va);
        xpose_store(K, WT, scr, i1, lane, vb);
        it = i2;
    }
}
__device__ __forceinline__ int incol(int rho) {
    const int g = rho >> 7, c = rho & 127;
    if (g < 4) return rho;
    if (g < 6) return 512 + (rho - 512);
    if (g < 8) return 768 + (rho - 768);
    if (g < 12) return 1092 + (rho - 1024);
    if (g < 18) return 1604 + (rho - 1536);
    if (g == 18) { if (c < 64) return 1024 + c; if (c < 68) return 1088 + (c - 64); if (c < 80) return 2372 + (c - 68); return -1; }
    return -1;
}
struct FnIn { const float* W; __device__ __forceinline__ SrcCol operator()(int r) const { const int c = incol(r); return SrcCol{c >= 0 ? W : nullptr, c, 2384}; } };
struct FnPlain { const float* W; int ldw; int coff; __device__ __forceinline__ SrcCol operator()(int r) const { return SrcCol{W, r + coff, ldw}; } };
struct FnGU { const float* Wg; const float* Wu; int ldw; __device__ __forceinline__ SrcCol operator()(int r) const { const int pn = r >> 8, c = r & 127;
    const long long d = (r & 128) ? ((const char*)Wu - (const char*)Wg) : 0ll;
    return SrcCol{(const float*)((const char*)Wg + d), pn * 128 + c, ldw}; } };
namespace att {
constexpr int KVBLK = 64, SHM_K = KVBLK * 128 * 2, SHM_V = KVBLK * 128 * 2;
#define KSWZ(row, colB) ((row) * 256 + ((colB) ^ (((row) & 7) << 4)))
__device__ __forceinline__ int v_st(int k, int c) { const int kk = (k & ~0xC) | ((k & 4) << 1) | ((k & 8) >> 1); return ((kk >> 3) * 4 + (c >> 5)) * 512 + ((kk & 7) * 32 + (c & 31)) * 2; }
__device__ __forceinline__ int v_rd_base(int lane) { return ((lane & 3) << 3) | (((lane >> 2) & 3) << 6) | (((lane >> 4) & 1) << 5) | (((lane >> 5) & 1) << 8); }
constexpr int v_rd_off(int d0, int ks, int half) { return d0 * 512 + ks * 4096 + half * 2048; }
__device__ __forceinline__ int crow(int r, int hi) { return (r & 3) + 8 * (r >> 2) + 4 * hi; }
__device__ __forceinline__ void qkt(f32x16& p0, f32x16& p1, const char* K_lds, int r32, int hi, const bf16x8* qr) {
    p0 = f32x16{}; p1 = f32x16{};
    const char* kb[4];
#pragma unroll
    for (int dd = 0; dd < 4; ++dd) kb[dd] = K_lds + KSWZ(r32, (dd * 16 + hi * 8) * 2);
#pragma unroll
    for (int d0 = 0; d0 < 8; ++d0) { const char* a = kb[d0 & 3] + (d0 >> 2) * 128;
        bf16x8 b0 = *reinterpret_cast<const bf16x8*>(a);
        bf16x8 b1 = *reinterpret_cast<const bf16x8*>(a + 32 * 256);
        p0 = __builtin_amdgcn_mfma_f32_32x32x16_bf16(b0, qr[d0], p0, 0, 0, 0);
        p1 = __builtin_amdgcn_mfma_f32_32x32x16_bf16(b1, qr[d0], p1, 0, 0, 0);
        if (d0 == 3) SBAR(); }
}
__device__ __forceinline__ void qkt_lq(f32x16& p0, f32x16& p1, const char* K_lds, const char* Q_lds, int r32, int hi) {
    p0 = f32x16{}; p1 = f32x16{};
    int ko[4];
#pragma unroll
    for (int dd = 0; dd < 4; ++dd) ko[dd] = KSWZ(r32, (dd * 16 + hi * 8) * 2);
#pragma unroll
    for (int d0 = 0; d0 < 8; ++d0) { const int a = ko[d0 & 3] + (d0 >> 2) * 128;
        bf16x8 b0 = *reinterpret_cast<const bf16x8*>(K_lds + a);
        bf16x8 b1 = *reinterpret_cast<const bf16x8*>(K_lds + a + 32 * 256);
        bf16x8 q = *reinterpret_cast<const bf16x8*>(Q_lds + a);
        p0 = __builtin_amdgcn_mfma_f32_32x32x16_bf16(b0, q, p0, 0, 0, 0);
        p1 = __builtin_amdgcn_mfma_f32_32x32x16_bf16(b1, q, p1, 0, 0, 0);
        if (d0 == 3) SBAR(); }
}
__device__ __forceinline__ void pv_tile(f32x16* o, int vb0, bf16x8 pa0, bf16x8 pa1, bf16x8 pa2, bf16x8 pa3) {
#define TRRD(dst, off) asm volatile("ds_read_b64_tr_b16 %0, %1 offset:%2" : "=&v"(dst) : "v"(vb0), "i"(off) : "memory")
#define PV_RD(S, d0) do { constexpr int b_ = v_rd_off(d0, 0, 0); \
        TRRD(S##l0, b_); TRRD(S##h0, b_ + 2048); TRRD(S##l1, b_ + 4096); TRRD(S##h1, b_ + 6144); TRRD(S##l2, b_ + 8192); TRRD(S##h2, b_ + 10240); TRRD(S##l3, b_ + 12288); TRRD(S##h3, b_ + 14336); } while (0)
#define PV_MM(S, d0) do { \
        o[d0] = __builtin_amdgcn_mfma_f32_32x32x16_bf16(pa0, (bf16x8){S##l0[0], S##l0[1], S##l0[2], S##l0[3], S##h0[0], S##h0[1], S##h0[2], S##h0[3]}, o[d0], 0, 0, 0);   \
        o[d0] = __builtin_amdgcn_mfma_f32_32x32x16_bf16(pa1, (bf16x8){S##l1[0], S##l1[1], S##l1[2], S##l1[3], S##h1[0], S##h1[1], S##h1[2], S##h1[3]}, o[d0], 0, 0, 0);   \
        o[d0] = __builtin_amdgcn_mfma_f32_32x32x16_bf16(pa2, (bf16x8){S##l2[0], S##l2[1], S##l2[2], S##l2[3], S##h2[0], S##h2[1], S##h2[2], S##h2[3]}, o[d0], 0, 0, 0);   \
        o[d0] = __builtin_amdgcn_mfma_f32_32x32x16_bf16(pa3, (bf16x8){S##l3[0], S##l3[1], S##l3[2], S##l3[3], S##h3[0], S##h3[1], S##h3[2], S##h3[3]}, o[d0], 0, 0, 0); } while (0)
    s16x4 Al0, Al1, Al2, Al3, Ah0, Ah1, Ah2, Ah3, Bl0, Bl1, Bl2, Bl3, Bh0, Bh1, Bh2, Bh3;
    PV_RD(A, 0); PV_RD(B, 1);
    asm volatile("s_waitcnt lgkmcnt(8)" ::: "memory"); SBAR(); PV_MM(A, 0); SBAR();
    PV_RD(A, 2);
    asm volatile("s_waitcnt lgkmcnt(8)" ::: "memory"); SBAR(); PV_MM(B, 1); SBAR();
    PV_RD(B, 3);
    asm volatile("s_waitcnt lgkmcnt(8)" ::: "memory"); SBAR(); PV_MM(A, 2); SBAR();
    asm volatile("s_waitcnt lgkmcnt(0)" ::: "memory"); SBAR(); PV_MM(B, 3);
#undef PV_RD
#undef PV_MM
#undef TRRD
}
__device__ __forceinline__ void pack_p(const f32x16& p0, const f32x16& p1, bf16x8& pa0, bf16x8& pa1, bf16x8& pa2, bf16x8& pa3) {
#define PK4(P, B_, OUT) do { unsigned a0 = cvtpk(P[B_+0], P[B_+1]), a1 = cvtpk(P[B_+2], P[B_+3]);                          \
        unsigned b0 = cvtpk(P[B_+4], P[B_+5]), b1 = cvtpk(P[B_+6], P[B_+7]);                                             \
        auto r0 = __builtin_amdgcn_permlane32_swap(a0, b0, false, false); auto r1 = __builtin_amdgcn_permlane32_swap(a1, b1, false, false); \
        v4u w = {r0[0], r1[0], r0[1], r1[1]}; OUT = __builtin_bit_cast(bf16x8, w); } while (0)
    PK4(p0, 0, pa0); PK4(p0, 8, pa1); PK4(p1, 0, pa2); PK4(p1, 8, pa3);
#undef PK4
}
__device__ __forceinline__ float xhalf_max(float v) { auto rr = __builtin_amdgcn_permlane32_swap(__float_as_uint(v), __float_as_uint(v), false, false); return fmaxf(__uint_as_float(rr[0]), __uint_as_float(rr[1])); }
__device__ __forceinline__ float xhalf_sum(float v) { auto rr = __builtin_amdgcn_permlane32_swap(__float_as_uint(v), __float_as_uint(v), false, false); return __uint_as_float(rr[0]) + __uint_as_float(rr[1]); }
__device__ __forceinline__ void softmax_step(f32x16& p0, f32x16& p1, float& m_reg, float& l_reg, f32x16* o, float* al_l, int r32, int hi) {
    float pmax = p0[0];
#pragma unroll
    for (int r = 1; r < 16; ++r) pmax = fmaxf(pmax, p0[r]);
#pragma unroll
    for (int r = 0; r < 16; ++r) pmax = fmaxf(pmax, p1[r]);
    pmax = xhalf_max(pmax);
    float mn, alpha;
    if (__all(pmax - m_reg <= 8.f)) { mn = m_reg; alpha = 1.f; }
    else { mn = fmaxf(m_reg, pmax); alpha = __builtin_amdgcn_exp2f(m_reg - mn); m_reg = mn; }
#pragma unroll
    for (int r = 0; r < 16; ++r) { p0[r] = __builtin_amdgcn_exp2f(p0[r] - mn); p1[r] = __builtin_amdgcn_exp2f(p1[r] - mn); }
    float ps = 0.f;
#pragma unroll
    for (int r = 0; r < 16; ++r) ps += p0[r] + p1[r];
    ps = xhalf_sum(ps);
    l_reg = l_reg * alpha + ps;
    if (__any(alpha < 1.f)) { if (hi == 0) al_l[r32] = alpha; asm volatile("s_waitcnt lgkmcnt(0)" ::: "memory");
#pragma unroll
        for (int d_ = 0; d_ < 4; ++d_)
#pragma unroll
            for (int r = 0; r < 16; ++r) o[d_][r] *= al_l[crow(r, hi)];
        asm volatile("s_waitcnt lgkmcnt(0)" ::: "memory"); }
}
__device__ __forceinline__ void softmax_step_row(f32x16& p0, f32x16& p1, bool on, float& m_reg, float& l_reg, f32x16* o, float* al_l, int r32, int hi) {
    float pmax = p0[0];
#pragma unroll
    for (int r = 1; r < 16; ++r) pmax = fmaxf(pmax, p0[r]);
#pragma unroll
    for (int r = 0; r < 16; ++r) pmax = fmaxf(pmax, p1[r]);
    pmax = on ? pmax : -__builtin_inff();
    pmax = xhalf_max(pmax);
    float mn, alpha;
    if (__all(pmax - m_reg <= 8.f)) { mn = m_reg; alpha = 1.f; }
    else { mn = fmaxf(m_reg, pmax); alpha = __builtin_amdgcn_exp2f(m_reg - mn); m_reg = mn; }
    const float me = on ? mn : __builtin_inff();
#pragma unroll
    for (int r = 0; r < 16; ++r) { p0[r] = __builtin_amdgcn_exp2f(p0[r] - me); p1[r] = __builtin_amdgcn_exp2f(p1[r] - me); }
    float ps = 0.f;
#pragma unroll
    for (int r = 0; r < 16; ++r) ps += p0[r] + p1[r];
    ps = xhalf_sum(ps);
    l_reg = l_reg * alpha + ps;
    if (__any(alpha < 1.f)) { if (hi == 0) al_l[r32] = alpha; asm volatile("s_waitcnt lgkmcnt(0)" ::: "memory");
#pragma unroll
        for (int d_ = 0; d_ < 4; ++d_)
#pragma unroll
            for (int r = 0; r < 16; ++r) o[d_][r] *= al_l[crow(r, hi)];
        asm volatile("s_waitcnt lgkmcnt(0)" ::: "memory"); }
}
struct DmaOff { unsigned k[2], v[2]; };
__device__ __forceinline__ void dma_offsets(DmaOff& d, int tid) {
#pragma unroll
    for (int i = 0; i < 2; ++i) { const int L = i * 8192 + tid * 16;
        const int row = L >> 8, pos = (L >> 4) & 15, c = pos ^ (row & 7); d.k[i] = (unsigned)(row * 256 + c * 16);
        const int sub = L >> 9, within = L & 511, kk = (sub >> 2) * 8 + (within >> 6), ccol = (within & 63) >> 1, cblk = sub & 3;
        const int k = (kk & ~0xC) | ((kk & 4) << 1) | ((kk & 8) >> 1); d.v[i] = (unsigned)(k * 256 + (cblk * 32 + ccol) * 2); }
}
__device__ __forceinline__ void dma_tile(const DmaOff& d, const bf16* Kp, const bf16* Vp, int key0, LAS unsigned char* buf, int wid) {
    const char* kb = (const char*)(Kp + (size_t)key0 * 128); const char* vb = (const char*)(Vp + (size_t)key0 * 128);
#pragma unroll
    for (int i = 0; i < 2; ++i) {
        __builtin_amdgcn_global_load_lds((const unsigned*)(kb + d.k[i]), (LAS unsigned*)(buf + 16384 + i * 8192 + wid * 1024), 16, 0, 0);
        __builtin_amdgcn_global_load_lds((const unsigned*)(vb + d.v[i]), (LAS unsigned*)(buf + i * 8192 + wid * 1024), 16, 0, 0); }
}
}
constexpr int AL_BUF = 0  , AL_Q = 65536  ;
constexpr int AL_WS = MISC_OFF + 2048  , AL_TBL = AL_WS + 2048  , AL_UNI = AL_TBL + 4 * 320 * 4  , AL_TRI = AL_UNI + 256  , AL_GB = AL_TRI + 2048  , AL_TBL132 = MISC_OFF + 12288  ;
static_assert(AL_Q + 65536 <= RING_BYTES && AL_GB + 128 <= AL_TBL132 && AL_TBL132 + 4 * 132 * 4 <= LDS_BYTES, "attention LDS map");

__device__ __forceinline__ void fill_bias_tbl132(Frame& F, float* tbl, int h0) {
    const float* rb = FIN(I_RELB);
    for (int i = F.tid; i < 4 * 132; i += NTHR) { const int h = i / 132, d = i % 132; const int dd = d > 128 ? 128 : d;
        tbl[i] = (rb[rel_bucket_dev(dd) * 8 + h0 + h] - rb[31 * 8 + h0 + h]) * LOG2E; }
}
__device__ __forceinline__ void fill_bias_tbl(Frame& F, float* tbl, int h0) {
    const float* rb = FIN(I_RELB);
    for (int i = F.tid; i < 4 * 320; i += NTHR) { const int h = i / 320, d = i % 320 - 96;
        tbl[i] = (d >= 0 && d < 113) ? (rb[rel_bucket_dev(d) * 8 + h0 + h] - rb[31 * 8 + h0 + h]) * LOG2E : 0.f; }
}

template <int MODE>
__device__ __forceinline__ void attn_unit(Frame& F, int b, int qt) {
    using namespace att;
    char* lds = F.ldsg;
    int tid = F.tid; asm volatile("" : "+v"(tid));
    const int wid = F.wave, lane = tid & 63, r32 = lane & 31, hi = lane >> 5;
    const int hd = wid & 3, qh = wid >> 2, q0 = qt * 64, tw = q0 + 32 * qh, t = tw + r32;
    const size_t rowg = (size_t)b * SEQ;
    float* wsf = (float*)(lds + AL_WS) + wid * 64; float* li_l = wsf; float* al_l = wsf + 32;
    const float* tbl = (const float*)(lds + AL_TBL) + hd * 320;
    const bf16* Qp = GRP((MODE == 0 ? G_QA : G_QB) + hd) + (rowg + t) * 128;
    const bf16* Kp = (MODE == 0 ? WSP(bf16, WS_AK) : MODE == 1 ? GRP(G_SK) : GRP(G_WK)) + rowg * 128;
    const bf16* Vp = (MODE == 0 ? WSP(bf16, WS_AV) : MODE == 1 ? GRP(G_SV) : GRP(G_WV)) + rowg * 128;
    bf16x8 qr[8];
#pragma unroll
    for (int d0 = 0; d0 < 8; ++d0) qr[d0] = *(const bf16x8*)(Qp + d0 * 16 + hi * 8);
    unsigned long long todo = (qt == 63) ? ~0ull : ((2ull << qt) - 1ull);
    unsigned long long bm64 = 0ull;
    if (MODE == 1) {
        bm64 = WSP(unsigned long long, WS_BLK)[rowg + t];
        volatile LAS unsigned* uni = (volatile LAS unsigned*)(F.lds + AL_UNI);
        if (tid < 2) uni[tid] = 0u;
        __syncthreads();
        __hip_atomic_fetch_or((LAS unsigned*)(F.lds + AL_UNI), (unsigned)bm64, __ATOMIC_RELAXED, __HIP_MEMORY_SCOPE_WORKGROUP);
        __hip_atomic_fetch_or((LAS unsigned*)(F.lds + AL_UNI) + 1, (unsigned)(bm64 >> 32), __ATOMIC_RELAXED, __HIP_MEMORY_SCOPE_WORKGROUP);
        __syncthreads();
        const unsigned long long um = (unsigned long long)uni[0] | ((unsigned long long)uni[1] << 32);
        todo &= um;
    }
    if (MODE == 2) { const int jl = q0 >= 511 ? ((q0 - 511) >> 6) : 0; todo &= ~((1ull << jl) - 1ull); }
    todo = ((unsigned long long)__builtin_amdgcn_readfirstlane((unsigned)todo)) | ((unsigned long long)__builtin_amdgcn_readfirstlane((unsigned)(todo >> 32)) << 32);
    const unsigned* bmrow = WSP(unsigned, WS_BM) + (rowg + t) * 128;
    float m_reg = -1e30f, l_reg = 0.f; f32x16 o[4] = {};
    const int vrb = v_rd_base(lane);
    DmaOff dof; dma_offsets(dof, tid);
    int j = __builtin_ctzll(todo); todo &= todo - 1ull;
    int buf = 0;
    v2u wsel = {0u, 0u}, wnx = {0u, 0u};
    if (MODE == 0) wnx = *(const v2u*)(bmrow + 2 * j);
    dma_tile(dof, Kp, Vp, j * 64, F.lds + AL_BUF, wid);
    for (;;) {
        asm volatile("s_waitcnt vmcnt(0)" ::: "memory");
        __syncthreads();
        const int jn = todo ? __builtin_ctzll(todo) : -1;
        if (MODE == 0) { wsel = wnx; if (jn >= 0) wnx = *(const v2u*)(bmrow + 2 * jn); }
        if (jn >= 0) { todo &= todo - 1ull; dma_tile(dof, Kp, Vp, jn * 64, F.lds + AL_BUF + (buf ^ 1) * 32768, wid); }
        const char* V_lds = lds + AL_BUF + buf * 32768; const char* K_lds = V_lds + 16384;
        const int vb0 = (int)(uintptr_t)(lds + AL_BUF + buf * 32768) + vrb;
        const int kb = j * 64;
        bool act = true;
        if (MODE == 1) act = __any((int)((bm64 >> j) & 1ull));
        if (MODE == 2) act = (kb <= tw + 31) && (kb + 63 >= tw - 511);
        if (MODE == 0) act = (kb <= tw + 31);
        if (act) {
            f32x16 p0, p1;
            qkt(p0, p1, K_lds, r32, hi, qr); SBAR();
            const float NEG = -__builtin_inff(); bool rowon = true;
            const int dq = t - kb - 4 * hi;
            if (tw - (kb + 63) < 128) {
                const float* tp = tbl + (dq + 37);
#pragma unroll
                for (int r = 0; r < 16; ++r) { const int c = (r & 3) + 8 * (r >> 2); p0[r] += tp[59 - c]; p1[r] += tp[27 - c]; }
            }
            if (MODE == 0) {
                const unsigned w0 = wsel.x >> (4 * hi), w1 = wsel.y >> (4 * hi);
#pragma unroll
                for (int r = 0; r < 16; ++r) { const int c = (r & 3) + 8 * (r >> 2);
                    const unsigned m0 = (unsigned)__builtin_amdgcn_sbfe((int)w0, c, 1), m1 = (unsigned)__builtin_amdgcn_sbfe((int)w1, c, 1);
                    p0[r] = __uint_as_float((__float_as_uint(p0[r]) & m0) | (0xff800000u & ~m0));
                    p1[r] = __uint_as_float((__float_as_uint(p1[r]) & m1) | (0xff800000u & ~m1)); }
            } else {
                if (MODE == 1) {
                    if (kb + 63 > tw) {
                        const int dqs = ((bm64 >> j) & 1ull) ? dq : -0x40000000;
#pragma unroll
                        for (int r = 0; r < 16; ++r) { const int c = (r & 3) + 8 * (r >> 2);
                            if (dqs < c) p0[r] = NEG;
                            if (dqs < c + 32) p1[r] = NEG; }
                    } else rowon = ((bm64 >> j) & 1ull) != 0ull;
                } else if (tw - (kb + 63) < 0 || tw + 31 - kb >= 512) {
#pragma unroll
                    for (int r = 0; r < 16; ++r) { const int c = (r & 3) + 8 * (r >> 2);
                        if ((unsigned)(dq - c) >= 512u) p0[r] = NEG;
                        if ((unsigned)(dq - c - 32) >= 512u) p1[r] = NEG; }
                }
            }
            SBAR(); if (MODE == 1) softmax_step_row(p0, p1, rowon, m_reg, l_reg, o, al_l, r32, hi); else softmax_step(p0, p1, m_reg, l_reg, o, al_l, r32, hi); SBAR();
            bf16x8 pa0, pa1, pa2, pa3;
            pack_p(p0, p1, pa0, pa1, pa2, pa3); SBAR();
            pv_tile(o, vb0, pa0, pa1, pa2, pa3); SBAR();
        }
        if (jn < 0) break;
        j = jn; buf ^= 1;
    }
    {
        float fac = l_reg > 0.f ? 1.0f / l_reg : 0.f;
        if (MODE != 0) { const float gl = bf2f(GRP(G_MISC)[(rowg + t) * 128 + 68 + MODE * 4 + hd]); fac *= 1.0f / (1.0f + __expf(-gl)); }
        if (hi == 0) li_l[r32] = fac;
        asm volatile("s_waitcnt lgkmcnt(0)" ::: "memory");
        float rli[16];
#pragma unroll
        for (int r = 0; r < 16; ++r) rli[r] = li_l[crow(r, hi)];
        const size_t row0 = rowg + tw;
        if (MODE == 1) {
            const float* OCp = WSP(float, WS_OC) + row0 * 512 + hd * 128; float* OC2p = WSP(float, WS_OC2) + row0 * 512 + hd * 128;
#pragma unroll
            for (int r = 0; r < 16; ++r) { const int orow = crow(r, hi);
#pragma unroll
                for (int d0 = 0; d0 < 4; ++d0) { const size_t ix = (size_t)orow * 512 + d0 * 32 + r32; OC2p[ix] = OCp[ix] + o[d0][r] * rli[r]; } }
        } else {
            bf16* Op = WSP(bf16, WS_O) + row0 * DM + (MODE == 2 ? 512 : 0) + hd * 128;
            const float* OCp = WSP(float, WS_OC2) + row0 * 512 + hd * 128;
#pragma unroll
            for (int r = 0; r < 16; ++r) { const int orow = crow(r, hi);
#pragma unroll
                for (int d0 = 0; d0 < 4; ++d0) { float v = o[d0][r] * rli[r];
                    if (MODE == 2) v += OCp[(size_t)orow * 512 + d0 * 32 + r32];
                    const float vn = __shfl_xor(v, 1);
                    if ((r32 & 1) == 0) *(unsigned*)(Op + (size_t)orow * DM + d0 * 32 + r32) = cvtpk(v, vn); } }
        }
    }
    __syncthreads();
}
__device__ __forceinline__ float idx_k2f(unsigned k) { return __uint_as_float((k & 0x80000000u) ? (k & 0x7fffffffu) : ~k); }
__device__ __forceinline__ unsigned idx_f2k(float f) { const unsigned u = __float_as_uint(f); return (u >> 31) ? ~u : (u | 0x80000000u); }
__device__ __forceinline__ unsigned half_sum_dpp(unsigned x) {
    x += (unsigned)__builtin_amdgcn_update_dpp(0, (int)x, 0x111, 0xf, 0xf, true);
    x += (unsigned)__builtin_amdgcn_update_dpp(0, (int)x, 0x112, 0xf, 0xf, true);
    x += (unsigned)__builtin_amdgcn_update_dpp(0, (int)x, 0x114, 0xf, 0xf, true);
    x += (unsigned)__builtin_amdgcn_update_dpp(0, (int)x, 0x118, 0xf, 0xf, true);
    x += (unsigned)__builtin_amdgcn_update_dpp(0, (int)x, 0x142, 0xa, 0xf, true);
    return x;
}
constexpr int IL_CAND = MISC_OFF + 2048, IL_HIST = IL_CAND + 4096;
__device__ __forceinline__ unsigned wave_sum_dpp63(unsigned x) {
    x = half_sum_dpp(x); x += (unsigned)__builtin_amdgcn_update_dpp(0, (int)x, 0x143, 0xc, 0xf, true); return (unsigned)__builtin_amdgcn_readlane((int)x, 63); }
__device__ __forceinline__ void idx_unit(Frame& F, int b, int tq, unsigned sub) {
    int tid = F.tid; asm volatile("" : "+v"(tid));
    const int wid = F.wave, lane = tid & 63, r32 = lane & 31, hi = lane >> 5;
    const int t0 = tq * 8; const size_t rowg = (size_t)b * SEQ;
    unsigned* bmrow = WSP(unsigned, WS_BM) + (rowg + t0) * 128;
    const int NT = 2 * (t0 >> 6) + 2;
    if (t0 + 8 <= 256) {
        for (int i = tid; i < 8 * NT; i += NTHR) { const int q = i / NT, wd = i % NT, t = t0 + q, lo = wd * 32;
            const unsigned word = (t >= lo + 31) ? 0xffffffffu : (t < lo ? 0u : ((2u << (t - lo)) - 1u)); bmrow[q * 128 + wd] = word; }
        return;
    }
    LAS unsigned* S = (LAS unsigned*)F.lds;
    const bf16* misc = GRP(G_MISC);
    {
        bf16x8 aq[4];
        { const int ql = r32 >> 2, h = r32 & 3; const bf16* p = GRP(G_IQ + (h >> 1)) + (rowg + t0 + ql) * 128 + (h & 1) * 64 + hi * 8;
#pragma unroll
          for (int c = 0; c < 4; ++c) aq[c] = *(const bf16x8*)(p + c * 16); }
        float wq[4][4];
#pragma unroll
        for (int qj = 0; qj < 4; ++qj) { const v2u w = *(const v2u*)(misc + (rowg + t0 + 2 * qj + hi) * 128 + 64);
            wq[qj][0] = __uint_as_float(w.x << 16); wq[qj][1] = __uint_as_float(w.x & 0xffff0000u); wq[qj][2] = __uint_as_float(w.y << 16); wq[qj][3] = __uint_as_float(w.y & 0xffff0000u); }
#define IDX_LOAD(g, u0) do { _Pragma("unroll") for (int u = (u0); u < (u0) + 2; ++u) { int tile = wid + 8 * (4 * (g) + u); tile = tile < NT ? tile : NT - 1; const bf16* kp = misc + (rowg + tile * 32 + r32) * 128 + hi * 8; \
            _Pragma("unroll") for (int c = 0; c < 4; ++c) bk[u][c] = *(const bf16x8*)(kp + c * 16); } } while (0)
#define IDX_MMA(u0) do { _Pragma("unroll") for (int u = 0; u < 2; ++u) { acc[u] = f32x16{}; \
            _Pragma("unroll") for (int c = 0; c < 4; ++c) acc[u] = __builtin_amdgcn_mfma_f32_32x32x16_bf16(aq[c], bk[(u0) + u][c], acc[u], 0, 0, 0); } } while (0)
#define IDX_COMB(g, u0) do { _Pragma("unroll") for (int u = 0; u < 2; ++u) { const int tile = wid + 8 * (4 * (g) + (u0) + u), kb = tile * 32; \
            if (tile < NT) { _Pragma("unroll") for (int qj = 0; qj < 4; ++qj) { float s = 0.f; \
                _Pragma("unroll") for (int h = 0; h < 4; ++h) s = fmaf(fmaxf(acc[u][4 * qj + h], 0.f), wq[qj][h], s); \
                S[(2 * qj + hi) * 4096 + kb + r32] = (kb + r32 <= t0 + 2 * qj + hi) ? idx_f2k(s) : 0u; } } } } while (0)
#pragma unroll 1
        for (int rk = 0; rk < 1 + (int)(sub & 1u); ++rk) {
            bf16x8 bk[4][4]; f32x16 acc[2];
            IDX_LOAD(0, 0); IDX_LOAD(0, 2);
#pragma unroll
            for (int g = 0; g < 4; ++g) if (wid + 32 * g < NT) { const bool nx = g < 3 && wid + 32 * (g + 1) < NT;
                IDX_MMA(0); SBAR(); if (nx) IDX_LOAD(g + 1, 0); SBAR(); IDX_COMB(g, 0); SBAR();
                IDX_MMA(2); SBAR(); if (nx) IDX_LOAD(g + 1, 2); SBAR(); IDX_COMB(g, 2); SBAR(); }
        }
#undef IDX_LOAD
#undef IDX_MMA
#undef IDX_COMB
    }
    __syncthreads();
    const int t = t0 + wid, NJ = (t >> 6) + 1;
    unsigned kreg[64];
#pragma unroll
    for (int j = 0; j < 64; ++j) { const unsigned v = S[wid * 4096 + 64 * j + lane]; kreg[j] = (j < NJ) ? v : 0u; }
    const int NG = (NJ + 15) >> 4;
    unsigned lo = 1u, hi_ = 0xffffffffu, clo = (unsigned)(t + 1), chi = 0u; float wlo = 0.f, whi = 0.f; int last = 0;
#pragma unroll 1
    for (int rs = 0; rs < 1 + (int)((sub >> 1) & 1u); ++rs) {
    {
        LAS unsigned* hist = (LAS unsigned*)(F.lds + IL_HIST) + wid * 256;
        *(LAS v4u*)(hist + 4 * lane) = (v4u){0u, 0u, 0u, 0u};
        asm volatile("s_waitcnt lgkmcnt(0)" ::: "memory");
#pragma unroll
        for (int g = 0; g < 4; ++g) if (g < NG) {
#pragma unroll
            for (int j = 0; j < 16; ++j) { const unsigned k = kreg[16 * g + j];
                if (k) { int b_ = (int)floorf(idx_k2f(k)) + 128; b_ = b_ < 0 ? 0 : (b_ > 255 ? 255 : b_); __hip_atomic_fetch_add(hist + (255 - b_), 1u, __ATOMIC_RELAXED, __HIP_MEMORY_SCOPE_WAVEFRONT); } } }
        asm volatile("s_waitcnt lgkmcnt(0)" ::: "memory");
        const v4u h4 = *(LAS v4u*)(hist + 4 * lane);
        unsigned pre = h4.x + h4.y + h4.z + h4.w;
        pre += (unsigned)__builtin_amdgcn_update_dpp(0, (int)pre, 0x111, 0xf, 0xf, true);
        pre += (unsigned)__builtin_amdgcn_update_dpp(0, (int)pre, 0x112, 0xf, 0xf, true);
        pre += (unsigned)__builtin_amdgcn_update_dpp(0, (int)pre, 0x114, 0xf, 0xf, true);
        pre += (unsigned)__builtin_amdgcn_update_dpp(0, (int)pre, 0x118, 0xf, 0xf, true);
        pre += (unsigned)__builtin_amdgcn_update_dpp(0, (int)pre, 0x142, 0xa, 0xf, true);
        pre += (unsigned)__builtin_amdgcn_update_dpp(0, (int)pre, 0x143, 0xc, 0xf, true);
        const unsigned long long ge = __ballot(pre >= 256u);
        const int L = __builtin_ctzll(ge);
        const unsigned pL = (unsigned)__builtin_amdgcn_readlane((int)pre, L);
        const unsigned b0 = (unsigned)__builtin_amdgcn_readlane((int)h4.x, L), b1 = (unsigned)__builtin_amdgcn_readlane((int)h4.y, L), b2 = (unsigned)__builtin_amdgcn_readlane((int)h4.z, L), b3 = (unsigned)__builtin_amdgcn_readlane((int)h4.w, L);
        unsigned above = pL - (b0 + b1 + b2 + b3); int bsel = 4 * L; unsigned cb = b0;
        if (above + cb < 256u) { above += cb; cb = b1; bsel = 4 * L + 1; if (above + cb < 256u) { above += cb; cb = b2; bsel = 4 * L + 2; if (above + cb < 256u) { above += cb; cb = b3; bsel = 4 * L + 3; } } }
        const int B = 255 - bsel;
        lo = B == 0 ? 1u : idx_f2k((float)(B - 128)); hi_ = B == 255 ? 0xffffffffu : idx_f2k((float)(B - 127));
        chi = above; clo = above + cb;
    }
    wlo = (float)clo - 255.5f; whi = (float)chi - 255.5f; last = 0;
#pragma unroll 1
    for (int it = 0; it < 72; ++it) {
        if (clo - chi <= 64u || hi_ - lo == 1u) break;
        unsigned mid;
        { const float lf = idx_k2f(lo), hf = idx_k2f(hi_); float mf = lf + (hf - lf) * (wlo / (wlo - whi));
          mid = idx_f2k(mf);
          if (it >= 36 || !(fabsf(lf) < 1e30f && fabsf(hf) < 1e30f)) mid = lo + ((hi_ - lo) >> 1);
          mid = mid <= lo ? lo + 1u : (mid >= hi_ ? hi_ - 1u : mid);
          mid = (unsigned)__builtin_amdgcn_readfirstlane((int)mid); }
        unsigned cnt = 0u;
#pragma unroll
        for (int g = 0; g < 4; ++g) if (g < NG) {
#pragma unroll
            for (int j = 0; j < 16; ++j) cnt += (kreg[16 * g + j] >= mid) ? 1u : 0u; }
        const unsigned tot = wave_sum_dpp63(cnt);
        if (tot >= 256u) { lo = mid; clo = tot; wlo = (float)tot - 255.5f; if (last == 1) whi *= 0.5f; last = 1; }
        else { hi_ = mid; chi = tot; whi = (float)tot - 255.5f; if (last == 2) wlo *= 0.5f; last = 2; }
    }
    }
    unsigned T = lo; int J = 0x7fffffff; bool tie = true;
    const int need = 256 - (int)chi;
    if (clo - chi <= 64u) {
        volatile LAS unsigned* cand = (volatile LAS unsigned*)(F.lds + IL_CAND) + wid * 128;
        int pos = 0;
#pragma unroll
        for (int j = 0; j < 64; ++j) if ((j >> 4) < NG) { const unsigned kq = kreg[j]; const bool inb = kq >= lo && kq < hi_; const unsigned long long bal = __ballot(inb);
            if (bal) { const int slot = pos + __builtin_amdgcn_mbcnt_hi((unsigned)(bal >> 32), __builtin_amdgcn_mbcnt_lo((unsigned)bal, 0u));
                if (inb) { cand[2 * slot] = kreg[j]; cand[2 * slot + 1] = (unsigned)(64 * j + lane); } pos += __popcll(bal); } }
        const int m = pos;
        asm volatile("s_waitcnt lgkmcnt(0)" ::: "memory");
        const unsigned ki = lane < m ? cand[2 * lane] : 0u; const unsigned ii = lane < m ? cand[2 * lane + 1] : 0u;
        int rk = 0;
        for (int jx = 0; jx < m; ++jx) { const unsigned kj = (unsigned)__builtin_amdgcn_readlane((int)ki, jx), ij = (unsigned)__builtin_amdgcn_readlane((int)ii, jx); rk += (kj > ki || (kj == ki && ij < ii)) ? 1 : 0; }
        const unsigned long long hit = __ballot(lane < m && rk == need - 1);
        const int src = hit ? __builtin_ctzll(hit) : 0;
        T = (unsigned)__builtin_amdgcn_readlane((int)ki, src); J = (int)__builtin_amdgcn_readlane((int)ii, src);
        tie = __builtin_popcountll(__ballot(lane < m && ki == T)) != 1;
    } else if (clo > 256u) {
        int ilo = -1, ihi = t;
        for (int it = 0; it < 16 && ihi - ilo > 1; ++it) { const int imid = (ilo + ihi) >> 1; unsigned cnt = 0u;
#pragma unroll
            for (int j = 0; j < 64; ++j) if ((j >> 4) < NG) cnt += (kreg[j] == T && 64 * j + lane <= imid) ? 1u : 0u;
            const int tot = (int)wave_sum_dpp63(cnt);
            if (tot >= need) ihi = imid; else ilo = imid; }
        J = ihi;
    }
    unsigned long long w64 = 0ull;
    if (!tie) {
        int wl = 0, wh = 0;
#pragma unroll
        for (int j = 0; j < 64; ++j) if ((j >> 4) < NG) { const unsigned long long bal = __ballot(kreg[j] >= T); asm volatile("s_nop 4\n\tv_writelane_b32 %0, %2, %4\n\tv_writelane_b32 %1, %3, %4" : "+v"(wl), "+v"(wh) : "s"((unsigned)bal), "s"((unsigned)(bal >> 32)), "n"(j)); }
        w64 = (unsigned long long)(unsigned)wl | ((unsigned long long)(unsigned)wh << 32);
    } else {
#pragma unroll
        for (int j = 0; j < 64; ++j) if ((j >> 4) < NG) { const unsigned k = kreg[j]; const unsigned long long bal = __ballot(k > T || (k == T && 64 * j + lane <= J)); if (lane == j) w64 = bal; }
    }
    if (lane < NJ) *(unsigned long long*)(bmrow + wid * 128 + 2 * lane) = w64;
    __syncthreads();
}

__device__ __forceinline__ float gelu_tanh(float x) { const float y = 0.7978845608028654f * (x + 0.044715f * x * x * x); const float e = __expf(2.0f * y); return 0.5f * x * (2.0f - 2.0f / (1.0f + e)); }
__device__ __forceinline__ void cmp_finalize_item(Frame& F, int b, int j, int rc) {
    float* hid = (float*)F.ldsg + 2048;
    const float* W2 = FIN(I_EV_CW2) + (size_t)j * 128 * 128;
    const float* UV = WSP(float, WS_UV) + ((size_t)j * 2048 + (size_t)b * 256) * 256; const float* UVb = WSP(float, WS_UVB) + ((size_t)j * 2048 + (size_t)b * 256) * 256;
    const float* cbp = WSP(float, WS_TAB) + (size_t)j * 16 * 128;
    const int n0 = rc * 16;
    for (int i = F.tid; i < 16 * 128; i += NTHR) { const int r = i >> 7, c = i & 127, n = n0 + r;
        float cbv = 0.f;
#pragma unroll
        for (int q = 0; q < 16; ++q) cbv += cbp[q * 128 + c];
        float v = 0.f; if (n < 255) v = gelu_tanh((UV[(size_t)n * 256 + c] + UVb[(size_t)n * 256 + c]) + (UV[(size_t)(n + 1) * 256 + 128 + c] + UVb[(size_t)(n + 1) * 256 + 128 + c]) + cbv);
        hid[i] = v; }
    __syncthreads();
    const int c2 = F.tid & 127, rg = F.tid >> 7;
    float acc[4] = {0.f, 0.f, 0.f, 0.f};
#pragma unroll 4
    for (int c = 0; c < 128; ++c) { const float w = W2[c * 128 + c2];
#pragma unroll
        for (int q = 0; q < 4; ++q) acc[q] = fmaf(hid[(rg + 4 * q) * 128 + c], w, acc[q]); }
#pragma unroll
    for (int q = 0; q < 4; ++q) { const int n = n0 + rg + 4 * q; const float a = n >= 255 ? 0.f : acc[q];
        if (j == 0) WSP(bf16, WS_CK)[((size_t)b * 256 + n) * 128 + c2] = (bf16)f2bf(a);
        else WSP(bf16, WS_CV)[((size_t)b * 256 + n) * 128 + c2] = (bf16)f2bf(a); }
    __syncthreads();
}
constexpr int CL_S = 0;
constexpr int CL_P = 64 * 260 * 4;
constexpr int CL_IMP = CL_P + 64 * 264 * 2;
constexpr int CL_TBL = CL_IMP + 16 * 64 * 4;
static_assert(CL_TBL + 4 * 132 * 4 <= RING_BYTES, "cmp LDS map");
__device__ __forceinline__ void cmp_unit(Frame& F, int b, int qt16, unsigned sub) {
    char* lds = F.ldsg;
    float* S = (float*)(lds + CL_S); bf16* Pb = (bf16*)(lds + CL_P); float* impL = (float*)(lds + CL_IMP); const float* tbl = (const float*)(lds + CL_TBL);
    int tid = F.tid; asm volatile("" : "+v"(tid));
    const int wid = F.wave, lane = tid & 63, l15 = lane & 15, l4 = lane >> 4;
    const int q0 = qt16 * 16; const size_t rowg = (size_t)b * SEQ;
#pragma unroll 1
    for (int r1 = 0; r1 < 1 + (int)(sub & 1u); ++r1) {
    {
        const int rb = wid & 3;
        const bf16* qp = GRP(G_QB + rb) + (rowg + q0 + l15) * 128 + l4 * 8;
        bf16x8 qa[4];
#pragma unroll
        for (int c = 0; c < 4; ++c) qa[c] = *(const bf16x8*)(qp + c * 32);
        const bf16* ckb = WSP(bf16, WS_CK) + (size_t)b * 256 * 128;
#pragma unroll
        for (int i = 0; i < 8; ++i) { const int kb = (wid >> 2) * 8 + i;
            const bf16* kp = ckb + (size_t)(kb * 16 + l15) * 128 + l4 * 8;
            f32x4 acc = {0.f, 0.f, 0.f, 0.f};
#pragma unroll
            for (int c = 0; c < 4; ++c) { const bf16x8 bk = *(const bf16x8*)(kp + c * 32); acc = __builtin_amdgcn_mfma_f32_16x16x32_bf16(qa[c], bk, acc, 0, 0, 0); }
            const int n = kb * 16 + l15, kend = 16 * n + 31;
#pragma unroll
            for (int jj = 0; jj < 4; ++jj) { const int ql = l4 * 4 + jj, t = q0 + ql; int d = t - kend; const bool valid = (d >= 0) && (n < 255); d = d < 0 ? 0 : (d > 128 ? 128 : d);
                S[(rb * 16 + ql) * 260 + n] = valid ? acc[jj] + tbl[rb * 132 + d] : -__builtin_inff(); } }
    }
    __syncthreads();
#pragma unroll 1
    for (int rr = 0; rr < 8; ++rr) { const int row = wid * 8 + rr;
        f32x4 v = *(const f32x4*)(S + row * 260 + lane * 4);
        const float mx = wave_max(fmaxf(fmaxf(v[0], v[1]), fmaxf(v[2], v[3])));
        f32x4 p = {0.f, 0.f, 0.f, 0.f};
        if (mx > -1e37f) { p[0] = __builtin_amdgcn_exp2f(v[0] - mx); p[1] = __builtin_amdgcn_exp2f(v[1] - mx); p[2] = __builtin_amdgcn_exp2f(v[2] - mx); p[3] = __builtin_amdgcn_exp2f(v[3] - mx);
            const float inv = 1.0f / wave_sum((p[0] + p[1]) + (p[2] + p[3])); p = p * inv; }
        *(f32x4*)(S + row * 260 + lane * 4) = p;
        *(v2u*)(Pb + row * 264 + lane * 4) = (v2u){cvtpk(p[0], p[1]), cvtpk(p[2], p[3])}; }
    __syncthreads();
    }
#pragma unroll 1
    for (int r3 = 0; r3 < 1 + (int)((sub >> 1) & 1u); ++r3) {
    for (int i = tid; i < 16 * 64; i += NTHR) { const int q = i >> 6, m = i & 63; float s = 0.f;
#pragma unroll
        for (int h = 0; h < 4; ++h)
#pragma unroll
            for (int dn = -1; dn <= 3; ++dn) { const int n = 4 * m + dn; if (n >= 0 && n < 255) s += S[(h * 16 + q) * 260 + n]; }
        impL[i] = s; }
    __syncthreads();
#pragma unroll 1
    for (int qq = 0; qq < 2; ++qq) { const int q = wid * 2 + qq, t = q0 + q, cur = t >> 6, m = lane;
        const bool forced = (m == 0) || (m == cur) || (m == cur - 1);
        const bool cand = !forced && (m < cur);
        float val = cand ? impL[q * 64 + m] : -__builtin_inff();
        bool sel = forced;
        const int picks = 8 - __popcll(__ballot(forced));
        for (int p = 0; p < picks; ++p) { const float vm = wave_max(val); if (!(vm > -__builtin_inff())) break;
            const unsigned long long win = __ballot(val == vm); const int first = __builtin_ctzll(win);
            if (lane == first) { sel = true; val = -__builtin_inff(); } }
        const unsigned long long msk = __ballot(sel);
        if (lane == 0) WSP(unsigned long long, WS_BLK)[rowg + t] = msk; }
    }
#pragma unroll 1
    for (int r5 = 0; r5 < 1 + (int)((sub >> 2) & 1u); ++r5)
    {
        const int rb = wid & 3;
        const bf16* cvt = WSP(bf16, WS_CVT) + (size_t)b * 128 * 256;
        float g0[4];
#pragma unroll
        for (int jj = 0; jj < 4; ++jj) { const float gl = bf2f(GRP(G_MISC)[(rowg + q0 + l4 * 4 + jj) * 128 + 68 + rb]); g0[jj] = 1.0f / (1.0f + __expf(-gl)); }
#pragma unroll
        for (int i = 0; i < 4; ++i) { const int db = (wid >> 2) * 4 + i;
            f32x4 acc = {0.f, 0.f, 0.f, 0.f};
#pragma unroll
            for (int kc = 0; kc < 8; ++kc) { const bf16x8 pa = *(const bf16x8*)(Pb + (rb * 16 + l15) * 264 + kc * 32 + l4 * 8);
                const bf16x8 vb = *(const bf16x8*)(cvt + (size_t)(db * 16 + l15) * 256 + kc * 32 + l4 * 8);
                acc = __builtin_amdgcn_mfma_f32_16x16x32_bf16(pa, vb, acc, 0, 0, 0); }
#pragma unroll
            for (int jj = 0; jj < 4; ++jj) WSP(float, WS_OC)[(rowg + q0 + l4 * 4 + jj) * 512 + rb * 128 + db * 16 + l15] = acc[jj] * g0[jj]; }
    }
    __syncthreads();
}

constexpr int CL2_IMP = 65536;
__device__ __forceinline__ void cmp_unit64(Frame& F, int b, int qt) {
    using namespace att;
    char* lds = F.ldsg;
    int tid = F.tid; asm volatile("" : "+v"(tid));
    const int wid = F.wave, lane = tid & 63, r32 = lane & 31, hi = lane >> 5;
    const int hd = wid & 3, qh = wid >> 2, q0 = qt * 64, tw = q0 + 32 * qh, t = tw + r32;
    const size_t rowg = (size_t)b * SEQ;
    float* wsf = (float*)(lds + AL_WS) + wid * 64; float* li_l = wsf;
    const float* tbl = (const float*)(lds + AL_TBL132) + hd * 132;
    float* impW = (float*)(lds + CL2_IMP);
    const bf16* Qp = GRP(G_QB + hd) + (rowg + t) * 128;
    const bf16* Kp = WSP(bf16, WS_CK) + (size_t)b * 256 * 128; const bf16* Vp = WSP(bf16, WS_CV) + (size_t)b * 256 * 128;
    bf16x8 qr[8];
#pragma unroll
    for (int d0 = 0; d0 < 8; ++d0) qr[d0] = *(const bf16x8*)(Qp + d0 * 16 + hi * 8);
    const int vrb = v_rd_base(lane);
    DmaOff dof; dma_offsets(dof, tid);
    float m_reg = -1e30f, l_reg = 0.f;
    const float NEG = -__builtin_inff();
#define CMP_SCORES(j) \
            const char* V_lds = lds + AL_BUF + buf * 32768; const char* K_lds = V_lds + 16384; \
            f32x16 p0, p1; \
            qkt(p0, p1, K_lds, r32, hi, qr); SBAR(); \
            if (16 * (64 * (j) + 63) + 31 + 128 > tw) {            \
                _Pragma("unroll") for (int rq = 0; rq < 4; ++rq) { \
                    _Pragma("unroll") for (int ri = 0; ri < 4; ++ri) { const int r = 4 * rq + ri; const int n0 = 64 * (j) + (r & 3) + 8 * (r >> 2) + 4 * hi, n1 = n0 + 32; \
                        int d0 = t - (16 * n0 + 31), d1 = t - (16 * n1 + 31); \
                        const bool v0 = d0 >= 0, v1 = d1 >= 0 && n1 < 255; \
                        d0 = d0 < 0 ? 0 : (d0 > 128 ? 128 : d0); d1 = d1 < 0 ? 0 : (d1 > 128 ? 128 : d1); \
                        p0[r] = v0 ? p0[r] + tbl[d0] : NEG; p1[r] = v1 ? p1[r] + tbl[d1] : NEG; } \
                    SBAR(); } \
            } else if ((j) == 3) { if (hi == 1) p1[15] = NEG; }    \
            SBAR();
    {
        int buf = 0;
        dma_tile(dof, Kp, Vp, 0, F.lds + AL_BUF, wid);
#pragma unroll 1
        for (int j = 0; j < 4; ++j) {
            asm volatile("s_waitcnt vmcnt(0)" ::: "memory");
            __syncthreads();
            dma_tile(dof, Kp, Vp, ((j + 1) & 3) * 64, F.lds + AL_BUF + (buf ^ 1) * 32768, wid);
            CMP_SCORES(j)
            float pmax = p0[0];
#pragma unroll
            for (int r = 1; r < 16; ++r) pmax = fmaxf(pmax, p0[r]);
#pragma unroll
            for (int r = 0; r < 16; ++r) pmax = fmaxf(pmax, p1[r]);
            pmax = xhalf_max(pmax);
            const float mn = fmaxf(m_reg, pmax); float ps = 0.f;
#pragma unroll
            for (int r = 0; r < 16; ++r) ps += __builtin_amdgcn_exp2f(p0[r] - mn) + __builtin_amdgcn_exp2f(p1[r] - mn);
            ps = xhalf_sum(ps);
            l_reg = l_reg * __builtin_amdgcn_exp2f(m_reg - mn) + ps; m_reg = mn;
            buf ^= 1;
        }
    }
    const float inv_l = l_reg > 0.f ? 1.0f / l_reg : 0.f;
    float carry = 0.f; f32x16 o[4] = {};
    {
        int buf = 0;
#pragma unroll 1
        for (int j = 0; j < 4; ++j) {
            asm volatile("s_waitcnt vmcnt(0)" ::: "memory");
            __syncthreads();
            if (j < 3) dma_tile(dof, Kp, Vp, (j + 1) * 64, F.lds + AL_BUF + (buf ^ 1) * 32768, wid);
            CMP_SCORES(j)
            const int vb0 = (int)(uintptr_t)(lds + AL_BUF + buf * 32768) + vrb;
#pragma unroll
            for (int r = 0; r < 16; ++r) { p0[r] = __builtin_amdgcn_exp2f(p0[r] - m_reg) * inv_l; p1[r] = __builtin_amdgcn_exp2f(p1[r] - m_reg) * inv_l; }
            float oa[4], ob[4];
#pragma unroll
            for (int g = 0; g < 4; ++g) { auto ra = __builtin_amdgcn_permlane32_swap(__float_as_uint(p0[4 * g + 3]), __float_as_uint(p0[4 * g + 3]), false, false);
                auto rb = __builtin_amdgcn_permlane32_swap(__float_as_uint(p1[4 * g + 3]), __float_as_uint(p1[4 * g + 3]), false, false);
                oa[g] = __uint_as_float(hi ? ra[0] : ra[1]); ob[g] = __uint_as_float(hi ? rb[0] : rb[1]); }
            float* iw = impW + ((size_t)hd * 64 + 32 * qh + r32) * 64 + 16 * j + hi;
#pragma unroll
            for (int g = 0; g < 4; ++g) {
                const float pla = hi ? oa[g] : (g > 0 ? oa[g - 1] : carry);
                const float plb = hi ? ob[g] : (g > 0 ? ob[g - 1] : oa[3]);
                iw[2 * g] = ((p0[4 * g] + p0[4 * g + 1]) + (p0[4 * g + 2] + p0[4 * g + 3])) + pla;
                iw[8 + 2 * g] = ((p1[4 * g] + p1[4 * g + 1]) + (p1[4 * g + 2] + p1[4 * g + 3])) + plb; }
            carry = ob[3];
            bf16x8 pa0, pa1, pa2, pa3;
            pack_p(p0, p1, pa0, pa1, pa2, pa3); SBAR();
            pv_tile(o, vb0, pa0, pa1, pa2, pa3); SBAR();
            buf ^= 1;
        }
    }
#undef CMP_SCORES
    __syncthreads();
#pragma unroll 1
    for (int qq = 0; qq < 8; ++qq) { const int q = wid * 8 + qq, tq = q0 + q, cur = tq >> 6, m = lane;
        const bool forced = (m == 0) || (m == cur) || (m == cur - 1);
        const bool cand = !forced && (m < cur);
        float val = cand ? ((impW[(0 * 64 + q) * 64 + m] + impW[(1 * 64 + q) * 64 + m]) + (impW[(2 * 64 + q) * 64 + m] + impW[(3 * 64 + q) * 64 + m])) : -__builtin_inff();
        bool sel = forced;
        const int picks = 8 - __popcll(__ballot(forced));
        for (int p = 0; p < picks; ++p) { const float vm = wave_max(val); if (!(vm > -__builtin_inff())) break;
            const unsigned long long win = __ballot(val == vm); const int first = __builtin_ctzll(win);
            if (lane == first) { sel = true; val = -__builtin_inff(); } }
        const unsigned long long msk = __ballot(sel);
        if (lane == 0) WSP(unsigned long long, WS_BLK)[rowg + tq] = msk; }
    {
        const float gl = bf2f(GRP(G_MISC)[(rowg + t) * 128 + 68 + hd]);
        if (hi == 0) li_l[r32] = 1.0f / (1.0f + __expf(-gl));
        asm volatile("s_waitcnt lgkmcnt(0)" ::: "memory");
        float* OCp = WSP(float, WS_OC) + (rowg + tw) * 512 + hd * 128;
#pragma unroll
        for (int r = 0; r < 16; ++r) { const int orow = crow(r, hi); const float g0 = li_l[orow];
#pragma unroll
            for (int d0 = 0; d0 < 4; ++d0) OCp[(size_t)orow * 512 + d0 * 32 + r32] = o[d0][r] * g0; }
    }
    __syncthreads();
}
__device__ __forceinline__ void stick_unit(Frame& F, int b, int h, int qb) {
    using namespace att;
    char* lds = F.ldsg;
    int tid = F.tid; asm volatile("" : "+v"(tid));
    const int wid = F.wave, lane = tid & 63, r32 = lane & 31, hi = lane >> 5;
    const size_t rowg = (size_t)b * SEQ;
    const int tw = qb * 256 + wid * 32, t = tw + r32;
    const bf16* Qp = QKVG(h) + (rowg + t) * 128;
    const bf16* Kp = QKVG(8 + h) + rowg * 128;
    const bf16* Vp = QKVG(16 + h) + rowg * 128;
    char* Qw = lds + AL_Q + wid * 8192;
#pragma unroll
    for (int d0 = 0; d0 < 8; ++d0) { const bf16x8 v = *(const bf16x8*)(Qp + d0 * 16 + hi * 8); *(bf16x8*)(Qw + KSWZ(r32, (d0 * 16 + hi * 8) * 2)) = v; }
    asm volatile("s_waitcnt lgkmcnt(0)" ::: "memory");
    {
        bf16x8 trd0, trd1;
#pragma unroll
        for (int jj = 0; jj < 8; ++jj) { const int k0 = 8 * (jj >> 2) + 4 * hi + (jj & 3);
            trd0[jj] = (short)((k0 >= r32) ? 0x3F80 : 0); trd1[jj] = (short)((16 + k0 >= r32) ? 0x3F80 : 0); }
        if (wid == 0) { *(bf16x8*)(lds + AL_TRI + lane * 32) = trd0; *(bf16x8*)(lds + AL_TRI + lane * 32 + 16) = trd1; }
    }
    const bf16x8 ones = {(short)0x3F80, (short)0x3F80, (short)0x3F80, (short)0x3F80, (short)0x3F80, (short)0x3F80, (short)0x3F80, (short)0x3F80};
    f32x16 o[4] = {};
    float carry = 0.f;
    const int vrb = v_rd_base(lane);
    DmaOff dof; dma_offsets(dof, tid);
    int j = qb * 4 + 3, buf = 0;
    bool wdone = false; int par = 0;
    volatile LAS unsigned* fl = (volatile LAS unsigned*)(F.lds + AL_UNI + 64);
    dma_tile(dof, Kp, Vp, j * 64, F.lds + AL_BUF, wid);
    for (;;) {
        if (lane == 0) fl[par * 8 + wid] = wdone ? 1u : 0u;
        asm volatile("s_waitcnt vmcnt(0)" ::: "memory");
        __syncthreads();
        { unsigned a = 1u;
#pragma unroll
          for (int w = 0; w < 8; ++w) a &= fl[par * 8 + w];
          par ^= 1; if (a) break; }
        if (j > 0) dma_tile(dof, Kp, Vp, (j - 1) * 64, F.lds + AL_BUF + (buf ^ 1) * 32768, wid);
        const char* K_lds = lds + AL_BUF + buf * 32768 + 16384;
        const int vb0 = (int)(uintptr_t)(lds + AL_BUF + buf * 32768) + vrb;
        const int kb = j * 64;
        if (!wdone && kb < tw + 32) {
            f32x16 s0, s1;
            qkt_lq(s0, s1, K_lds, Qw, r32, hi);
            const int dq = t - kb - 4 * hi;
            const bool diag = (kb + 63 >= tw);
            bf16x8 cb0, cb1, cb2, cb3; float csum = 0.f;
#define ST_C(ZV, OFF, R) ({ const int c_ = ((R) & 3) + 8 * ((R) >> 2); float z_ = ZV[R]; \
                float a_ = -__builtin_amdgcn_logf(1.0f + __builtin_amdgcn_exp2f(fminf(z_, 126.f))); a_ = fminf(a_, -z_); \
                if (diag && (dq - c_ - (OFF) < 1)) { a_ = 0.f; z_ = -__builtin_inff(); } \
                csum += a_; ZV[R] = z_ + carry; a_; })
#define ST_PK(ZV, OFF, B_) ({ v4u w_; { const float e0 = ST_C(ZV, OFF, B_ + 0), e1 = ST_C(ZV, OFF, B_ + 1), e2 = ST_C(ZV, OFF, B_ + 2), e3 = ST_C(ZV, OFF, B_ + 3); w_.x = cvtpk(e0, e1); w_.y = cvtpk(e2, e3); } SBAR(); \
                { const float e4 = ST_C(ZV, OFF, B_ + 4), e5 = ST_C(ZV, OFF, B_ + 5), e6 = ST_C(ZV, OFF, B_ + 6), e7 = ST_C(ZV, OFF, B_ + 7); w_.z = cvtpk(e4, e5); w_.w = cvtpk(e6, e7); } __builtin_bit_cast(bf16x8, w_); })
            SBAR(); cb0 = ST_PK(s0, 0, 0); SBAR(); cb1 = ST_PK(s0, 0, 8); SBAR(); cb2 = ST_PK(s1, 32, 0); SBAR(); cb3 = ST_PK(s1, 32, 8); SBAR();
#undef ST_PK
#undef ST_C
            const bf16x8 trd0 = *(const bf16x8*)(lds + AL_TRI + lane * 32), trd1 = *(const bf16x8*)(lds + AL_TRI + lane * 32 + 16);
            s1 = __builtin_amdgcn_mfma_f32_32x32x16_bf16(trd0, cb2, s1, 0, 0, 0);
            s1 = __builtin_amdgcn_mfma_f32_32x32x16_bf16(trd1, cb3, s1, 0, 0, 0);
            s0 = __builtin_amdgcn_mfma_f32_32x32x16_bf16(trd0, cb0, s0, 0, 0, 0);
            s0 = __builtin_amdgcn_mfma_f32_32x32x16_bf16(trd1, cb1, s0, 0, 0, 0);
            s0 = __builtin_amdgcn_mfma_f32_32x32x16_bf16(ones, cb2, s0, 0, 0, 0);
            s0 = __builtin_amdgcn_mfma_f32_32x32x16_bf16(ones, cb3, s0, 0, 0, 0);
            carry += xhalf_sum(csum);
#pragma unroll
            for (int r = 0; r < 16; ++r) { s0[r] = __builtin_amdgcn_exp2f(s0[r]); s1[r] = __builtin_amdgcn_exp2f(s1[r]); }
            bf16x8 pa0, pa1, pa2, pa3;
            pack_p(s0, s1, pa0, pa1, pa2, pa3);
            pv_tile(o, vb0, pa0, pa1, pa2, pa3);
            if (__all(carry < -160.f)) wdone = true;
        }
        if (j == 0) wdone = true;
        j = j > 0 ? j - 1 : 0; buf ^= 1;
    }
    asm volatile("s_waitcnt vmcnt(0)" ::: "memory");
    bf16* Op = WSP(bf16, WS_O) + (rowg + tw) * DM + h * 128;
#pragma unroll
    for (int r = 0; r < 16; ++r) { const int orow = crow(r, hi);
#pragma unroll
        for (int d0 = 0; d0 < 4; ++d0) { const float v = o[d0][r]; const float vn = __shfl_xor(v, 1);
            if ((r32 & 1) == 0) *(unsigned*)(Op + (size_t)orow * DM + d0 * 32 + r32) = cvtpk(v, vn); } }
    __syncthreads();
}
__device__ __forceinline__ void router_phase(Frame& F) {
    const int lane = F.lane;
    const float* wr = FIN(I_OD_WR);
    int* list = WSP(int, WS_LIST); float* gwt = WSP(float, WS_GW);
    volatile LAS unsigned* lcnt = (volatile LAS unsigned*)(F.lds);
    volatile LAS unsigned* rec = (volatile LAS unsigned*)(F.lds + 256);
    const int nper = (M + F.G - 1) / F.G, m0 = (int)blockIdx.x * nper, m1 = (m0 + nper < M) ? m0 + nper : M;
    if (F.tid < 32) lcnt[F.tid] = 0u;
    __syncthreads();
    f32x4 wq[16][2];
#pragma unroll
    for (int i = 0; i < 16; ++i) { const int k = (i < 8 ? 0 : 512) + 8 * lane + (i & 7); wq[i][0] = *(const f32x4*)(wr + (size_t)k * 8); wq[i][1] = *(const f32x4*)(wr + (size_t)k * 8 + 4); }
    for (int m = m0 + F.wave; m < m1; m += NWAVES) {
        float v[16]; load_row_bf16(WSP(bf16, WS_XB3) + (size_t)m * DM, lane, v); rms16(v, FIN(I_OD_NFFN), lane);
        float lg[8];
#pragma unroll
        for (int e = 0; e < 8; ++e) lg[e] = 0.f;
#pragma unroll
        for (int i = 0; i < 16; ++i) { const f32x4 w0 = wq[i][0], w1 = wq[i][1]; const float x = v[i];
            lg[0] = fmaf(x, w0[0], lg[0]); lg[1] = fmaf(x, w0[1], lg[1]); lg[2] = fmaf(x, w0[2], lg[2]); lg[3] = fmaf(x, w0[3], lg[3]);
            lg[4] = fmaf(x, w1[0], lg[4]); lg[5] = fmaf(x, w1[1], lg[5]); lg[6] = fmaf(x, w1[2], lg[6]); lg[7] = fmaf(x, w1[3], lg[7]); }
#pragma unroll
        for (int e = 0; e < 8; ++e) lg[e] = wave_sum(lg[e]);
        int i0 = 0; float v0 = lg[0];
#pragma unroll
        for (int e = 1; e < 8; ++e) if (lg[e] > v0) { v0 = lg[e]; i0 = e; }
        int i1 = -1; float v1 = -__builtin_inff();
#pragma unroll
        for (int e = 0; e < 8; ++e) if (e != i0 && lg[e] > v1) { v1 = lg[e]; i1 = e; }
        const float e1 = __expf(v1 - v0), w0 = 1.0f / (1.0f + e1), w1 = e1 * w0;
        if (lane == 0) {
            const unsigned s0 = __hip_atomic_fetch_add((LAS unsigned*)F.lds + i0, 1u, __ATOMIC_RELAXED, __HIP_MEMORY_SCOPE_WORKGROUP);
            const unsigned s1 = __hip_atomic_fetch_add((LAS unsigned*)F.lds + 8 + i1, 1u, __ATOMIC_RELAXED, __HIP_MEMORY_SCOPE_WORKGROUP);
            rec[2 * (m - m0)] = (unsigned)i0 | (s0 << 8); rec[2 * (m - m0) + 1] = (unsigned)i1 | (s1 << 8);
            gwt[m] = w0; gwt[M + m] = w1;
        }
    }
    __syncthreads();
    if (F.tid < 16) lcnt[16 + F.tid] = atomicAdd((unsigned*)(F.ctl + CW_CNT) + F.tid, lcnt[F.tid]);
    __syncthreads();
    for (int i = F.tid; i < m1 - m0; i += NTHR) { const unsigned r0 = rec[2 * i], r1 = rec[2 * i + 1]; const int i0 = r0 & 255, i1 = r1 & 255;
        list[(size_t)i0 * M + lcnt[16 + i0] + (r0 >> 8)] = m0 + i; list[(size_t)(8 + i1) * M + lcnt[24 + i1] + (r1 >> 8)] = m0 + i; }
    __syncthreads();
}
struct MoeLayout { int off[17]; };
__device__ __forceinline__ void moe_layout(Frame& F, MoeLayout& L) {
    int o = 0;
#pragma unroll
    for (int l = 0; l < 16; ++l) { L.off[l] = o; const int c = (int)__hip_atomic_load(F.ctl + CW_CNT + l, RLX_AGENT); o += (c + 255) & ~255; }
    L.off[16] = o;
}
__device__ __forceinline__ void gather_phase(Frame& F) {
    const int gw = F.vcu * NWAVES + F.wave, NGW = F.G * NWAVES, lane = F.lane;
    MoeLayout L; moe_layout(F, L);
    const int* list = WSP(int, WS_LIST); int* inv = WSP(int, WS_INV); float* gws = WSP(float, WS_GWS); const float* gwt = WSP(float, WS_GW);
    bf16* XS = WSP(bf16, WS_XS);
    for (int s = gw; s < L.off[16]; s += NGW) {
        int l = 0, offl = 0;
#pragma unroll
        for (int q = 1; q < 16; ++q) if (s >= L.off[q]) { l = q; offl = L.off[q]; }
        const int idx = s - offl; const int c = (int)__hip_atomic_load(F.ctl + CW_CNT + l, RLX_AGENT);
        const int t = idx < c ? list[(size_t)l * M + idx] : -1;
        float v[16];
        if (t >= 0) { load_row_bf16(WSP(bf16, WS_XB3) + (size_t)t * DM, lane, v); rms16(v, FIN(I_OD_NFFN), lane); }
        else {
#pragma unroll
            for (int i = 0; i < 16; ++i) v[i] = 0.f; }
        store_row16_bf16(XS + (size_t)s * DM, lane, v);
        if (lane == 0) { const int k = l >> 3; gws[s] = t >= 0 ? gwt[(size_t)k * M + t] : 0.f; if (t >= 0) inv[(size_t)k * M + t] = s; }
    }
}
struct MoeSched {
    pg8::GridOrder o; int t0; const char* A; size_t tstepA; const char* W; size_t tstepB; int off[17]; bool a_local; const char* A2;
    __device__ __forceinline__ bool next(int i, pg8::Unit& u) const {
        int pm, pn; if (!o.at(i, pm, pn)) return false; pm += t0; u.pm = pm; u.pn = pn;
        int l = 0;
#pragma unroll
        for (int q = 1; q < 16; ++q) if (pm * 256 >= off[q]) l = q;
        const int lt = pm - t0;
        u.aux = l; u.A = !a_local ? A + (size_t)pm * tstepA : (lt >= HM_SPLIT ? A2 + (size_t)(lt - HM_SPLIT) * tstepA : A + (size_t)lt * tstepA); u.B = W + (size_t)(l & 7) * MW_E + (size_t)pn * tstepB; return true;
    }
};

struct MoeSplitSched {
    pg8::GridOrder o; int t0; const char* A; size_t tstepA; const char* W; size_t tstepB; int off[17];
    __device__ __forceinline__ bool next(int i, pg8::Unit& u) const {
        int pm, pn; if (!o.at(i, pm, pn)) return false; pm += t0; u.pm = pm; u.pn = pn;
        int l = 0;
#pragma unroll
        for (int q = 1; q < 16; ++q) if (pm * 256 >= off[q]) l = q;
        u.aux = l; const size_t ko = (size_t)(pn >> 2) * (EFF / MOE_SPLITS) * 2;
        u.A = A + (size_t)(pm - t0) * tstepA + ko; u.B = W + (size_t)(l & 7) * MW_E + (size_t)(pn & 3) * tstepB + ko; return true;
    }
};

constexpr int N_PHASES = 27;
struct Args { const float* in[N_IN]; float* out; unsigned char* ws; int ph_lo, ph_hi; unsigned rep_mask, pad; };
__global__ void __launch_bounds__(NTHR, 2) fwd(Args args) {
    extern __shared__ __attribute__((aligned(16))) unsigned char lds[];
    Frame F;
    F.lds = (LAS unsigned char*)lds; F.ldsg = (char*)lds;
    F.MISC = (volatile LAS unsigned*)(F.lds + MISC_OFF);
    F.tid = threadIdx.x; F.lane = F.tid & 63; F.wave = __builtin_amdgcn_readfirstlane(F.tid >> 6);
    F.G = gridDim.x; { const int bx = blockIdx.x; F.vcu = (F.G % 8 == 0) ? (bx % 8) * (F.G / 8) + bx / 8 : bx; }
    F.ws = args.ws; F.ctl = (gu32*)(args.ws + WS_CTL); F.out = args.out;
    F.kap = (const __attribute__((address_space(4))) char*)__builtin_amdgcn_kernarg_segment_ptr();
    static_assert(offsetof(Args, in) == 0, "FIN() reads the input pointers at the start of the kernarg segment");
    for (int u = F.tid; u < 64; u += NTHR) ((LAS unsigned*)(F.lds + MISC_OFF))[u] = 0u;
    __syncthreads();
    const int lo = args.ph_lo, hi = args.ph_hi;
    const bool multi = (hi - lo) > 1;
    XcdBarrier bar; bar.bar = (unsigned*)(F.ctl + CW_BAR); bar.x = 0; bar.st = nullptr;
    if (multi) bar = xcd_barrier_post((unsigned*)(F.ctl + CW_BAR), F.MISC + 8);
#ifdef PHASE_ONLY
#define IN(k) ((k) == PHASE_ONLY && lo <= (k) && (k) < hi)
#else
#define IN(k) (lo <= (k) && (k) < hi)
#endif
#ifndef PROBE_BUILD
#define PROBE_BUILD 0
#endif
#if PROBE_BUILD
    const unsigned repmask = args.rep_mask;
#define REPLOOP(k) _Pragma("unroll 1") for (int rep_ = 0, nrep_ = 1 + (int)((repmask >> (k)) & 1u); rep_ < nrep_; ++rep_)
#else
    const unsigned repmask = 0u;
#define REPLOOP(k)
#endif
#define SEAM(k) do { if (IN(k) && IN((k) + 1)) xcd_barrier(bar); PHASE_FENCE(); } while (0)
    const int gwv = F.vcu * NWAVES + F.wave, NGW = F.G * NWAVES;
    const int bx = blockIdx.x;

    REPLOOP(0) {
    if (IN(0)) {
        LAS float* scr = (LAS float*)(F.lds + F.wave * 16384);
        int ibase = 0;
#define XPOSE_MAT(fn, destrows, K, WT, kgain) do { const int _n = ((destrows) / 32) * ((K) / 64); const int _s = (gwv + NGW - (ibase % NGW)) % NGW; \
            xpose_matrix(fn, K, WT, kgain, scr, _s, _n, NGW, F.lane); ibase += _n; } while (0)
        { FnIn f{FIN(I_EV_WIN)}; XPOSE_MAT(f, NPROJ, 1024, WSP(bf16, WS_WIN), (const float*)nullptr); }
        { FnPlain f{FIN(I_EV_WUK), 128, 0}; XPOSE_MAT(f, 128, 256, WSP(bf16, WS_WUKV), FIN(I_EV_KVN)); }
        { FnPlain f{FIN(I_EV_WUV), 128, 0}; XPOSE_MAT(f, 128, 256, WSP(bf16, WS_WUKV) + 128 * 256, FIN(I_EV_KVN)); }
#pragma unroll 1
        for (int j = 0; j < 2; ++j) { const float* W1 = FIN(I_EV_CW1) + (size_t)j * 4096 * 128; bf16* d = WSP(bf16, WS_WC1) + (size_t)j * 256 * 2048;
            { FnPlain f{W1, 128, 0}; XPOSE_MAT(f, 128, 2048, d, (const float*)nullptr); }
            { FnPlain f{W1 + (size_t)2048 * 128, 128, 0}; XPOSE_MAT(f, 128, 2048, d + (size_t)128 * 2048, (const float*)nullptr); } }
        { FnPlain f{FIN(I_EV_WOUT), 1024, 0}; XPOSE_MAT(f, 1024, 1024, WSP(bf16, WS_WOUT0), (const float*)nullptr); }
        { FnGU f{FIN(I_EV_WG), FIN(I_EV_WU), DFF}; XPOSE_MAT(f, 2 * DFF, 1024, WSP(bf16, WS_WGU0), FIN(I_EV_NFFN)); }
        { FnPlain f{FIN(I_EV_WD), 1024, 0}; XPOSE_MAT(f, 1024, DFF, WSP(bf16, WS_WDN0), (const float*)nullptr); }
        { FnPlain f{FIN(I_OD_WQKV), 3072, 0}; XPOSE_MAT(f, 3072, 1024, WSP(bf16, WS_WQKV), FIN(I_OD_NMIX)); }
        { FnPlain f{FIN(I_OD_WOUT), 1024, 0}; XPOSE_MAT(f, 1024, 1024, WSP(bf16, WS_WOUT1), (const float*)nullptr); }
        norm_phase(F, FIN(I_X), nullptr, FIN(I_EV_NMIX));
        for (int oi = gwv; oi < 32; oi += NGW) { const int j = oi >> 4, part = oi & 15; const float* pos = FIN(I_EV_CPOS) + (size_t)j * 4096 + part * 256; const float* W1 = FIN(I_EV_CW1) + ((size_t)j * 4096 + part * 256) * 128;
            float s0 = 0.f, s1 = 0.f;
#pragma unroll 8
            for (int i = 0; i < 256; ++i) { const float pv_ = pos[i]; s0 = fmaf(pv_, W1[(size_t)i * 128 + F.lane], s0); s1 = fmaf(pv_, W1[(size_t)i * 128 + 64 + F.lane], s1); }
            WSP(float, WS_TAB)[(size_t)oi * 128 + F.lane] = s0; WSP(float, WS_TAB)[(size_t)oi * 128 + 64 + F.lane] = s1; }
    }
    }
    SEAM(0);
    REPLOOP(1) {
    if (IN(1)) {
        pg8::PlainSched S; S.init(M, NPROJ, F.G, bx, WSP(bf16, WS_XN), 2048, WSP(bf16, WS_WIN), 2048);
        pg8::EpiGroups E{WSP(bf16, WS_PROJ), GS, 0x0F0Fu, QSCALE, G_PAD, nullptr};
        pg8::gemm_phase<pg8::EpiGroups, pg8::PlainSched>(F.lds, pg8::GemmK{1024, 2048u, 2048u, 30, 0u}, S, E);
    }
    }
    SEAM(1);
    REPLOOP(2) {
    if (IN(2)) {
        if (bx < 128) {
            LAS float* rstd = (LAS float*)(F.lds + MISC_OFF + 1024);
            { const int r = F.tid >> 1, g = F.tid & 1; const bf16* p = GRP(G_LAT + g) + ((size_t)bx * 256 + r) * 128; float s = 0.f;
#pragma unroll
              for (int i = 0; i < 16; ++i) { const v4u w = *(const v4u*)(p + i * 8);
#pragma unroll
                  for (int q = 0; q < 4; ++q) { const float a = __builtin_bit_cast(float, w[q] << 16), c = __builtin_bit_cast(float, w[q] & 0xffff0000u); s += a * a + c * c; } }
              s += __shfl_xor(s, 1);
              if (g == 0) rstd[r] = 1.0f / sqrtf(s * (1.f / 256.f) + RMS_EPS); }
            __syncthreads();
            pg8::OneSched S;
            S.u.pm = bx; S.u.pn = 0; S.u.aux = 0; S.u.A = (const char*)(GRP(G_LAT) + (size_t)bx * 256 * 128); S.u.B = (const char*)WSP(bf16, WS_WUKV);
            pg8::EpiAkv E{WSP(bf16, WS_AK), WSP(bf16, WS_AV), rstd};
            pg8::gemm_phase<pg8::EpiAkv, pg8::OneSched>(F.lds, pg8::GemmK{256, 256u, 512u, 1, (unsigned)(GS * 2)}, S, E);
        } else if (bx < 160) {
            const int u = bx - 128, j = u >> 4, pm = (u >> 1) & 7, kh = u & 1;
            pg8::OneSched S;
            S.u.pm = pm; S.u.pn = 0; S.u.aux = 0; S.u.A = (const char*)(GRP(j == 0 ? G_CKR : G_CVR) + (size_t)pm * 256 * 2048 + (size_t)kh * 1024); S.u.B = (const char*)(WSP(bf16, WS_WC1) + (size_t)j * 256 * 2048 + (size_t)kh * 1024);
            pg8::EpiF32 E{nullptr, (kh ? WSP(float, WS_UVB) : WSP(float, WS_UV)) + (size_t)j * 2048 * 256, 256, 1.f};
            pg8::gemm_phase<pg8::EpiF32, pg8::OneSched>(F.lds, pg8::GemmK{1024, 4096u, 4096u, 30, 0u}, S, E);
        }
    }
    }
    SEAM(2);
    REPLOOP(3) {
    if (IN(3)) {
        for (int it = bx; it < 256; it += F.G) cmp_finalize_item(F, it >> 5, (it >> 4) & 1, it & 15);
        for (int r = 0; r < 4096 / 256 + 1; ++r) { const int cc = (r & 1) ? (F.G - 1 - bx) : bx; const int ui = r * F.G + cc; if (ui >= 4096) break;
            const int tq = 511 - (ui >> 3), b = ui & 7; idx_unit(F, b, tq, repmask >> 24); }
    }
    }
    SEAM(3);
    PHASE_FENCE();
    REPLOOP(5) {
    if (IN(5)) {
        fill_bias_tbl(F, (float*)(F.ldsg + AL_TBL), 0); __syncthreads();
#pragma unroll 1
        for (int p2 = 2 * bx; p2 < 512; p2 += 2 * F.G) {
#pragma unroll 1
            for (int u = 0; u < 2; ++u) { const int p = p2 >> 1, b = p >> 5, q = p & 31; attn_unit<0>(F, b, u ? q : 63 - q); } }
        __syncthreads();
        fill_bias_tbl(F, (float*)(F.ldsg + AL_TBL), 4); fill_bias_tbl132(F, (float*)(F.ldsg + AL_TBL132), 4); __syncthreads();
#pragma unroll 1
        for (int p2 = 2 * bx; p2 < 512; p2 += 2 * F.G) {
#pragma unroll 1
            for (int u = 0; u < 2; ++u) { const int p = p2 >> 1, b = p >> 5, q = p & 31, qt = u ? q : 63 - q;
                cmp_unit64(F, b, qt); asm volatile("s_waitcnt vmcnt(0)" ::: "memory"); __syncthreads();
                attn_unit<1>(F, b, qt); attn_unit<2>(F, b, qt); } }
    }
    }
    SEAM(5);
    REPLOOP(6) {
    if (IN(6)) {
        pg8::PlainSched S; S.init(M, DM, F.G, bx, WSP(bf16, WS_O), 2048, WSP(bf16, WS_WOUT0), 2048);
        pg8::EpiRes E{FIN(I_X), nullptr, WSP(bf16, WS_XB), WSP(float, WS_RS0), 1.f};
        pg8::gemm_phase<pg8::EpiRes, pg8::PlainSched>(F.lds, pg8::GemmK{1024, 2048u, 2048u, 30, 0u}, S, E);
    }
    }
    if (IN(6) && IN(8)) xcd_barrier(bar); PHASE_FENCE();
    REPLOOP(8) {
    if (IN(8)) {
        pg8::PlainSched S; S.init(M, 2 * DFF, F.G, bx, WSP(bf16, WS_XB), 2048, WSP(bf16, WS_WGU0), 2048);
        pg8::EpiSwiglu E{WSP(bf16, WS_H0), DFF, 0, WSP(float, WS_RS0), nullptr, 0};
        pg8::gemm_phase<pg8::EpiSwiglu, pg8::PlainSched>(F.lds, pg8::GemmK{1024, 2048u, 2048u, 30, 0u}, S, E);
    }
    }
    SEAM(8);
    if (IN(9)) {
        pg8::PlainSched S; S.init(M, DM, F.G, bx, WSP(bf16, WS_H0), DFF * 2, WSP(bf16, WS_WDN0), DFF * 2);
        pg8::EpiRes E{nullptr, WSP(bf16, WS_XB), WSP(bf16, WS_XB), WSP(float, WS_RS1), ((repmask >> 10) & 1u) ? 0.5f : 1.f};
        REPLOOP(10) pg8::gemm_phase<pg8::EpiRes, pg8::PlainSched>(F.lds, pg8::GemmK{DFF, DFF * 2u, DFF * 2u, 30, 0u}, S, E);
    }
    if (IN(9) && IN(11)) xcd_barrier(bar); PHASE_FENCE();
    REPLOOP(11) {
    if (IN(11)) {
        pg8::PlainSched S; S.init(M, 3072, F.G, bx, WSP(bf16, WS_XB), 2048, WSP(bf16, WS_WQKV), 2048);
        pg8::EpiGroups E{WSP(bf16, WS_QKV), GS, 0xFFu, QSCALE, 1000, WSP(float, WS_RS1)};
        pg8::gemm_phase<pg8::EpiGroups, pg8::PlainSched>(F.lds, pg8::GemmK{1024, 2048u, 2048u, 30, 0u}, S, E);
    }
    }
    SEAM(11);
    REPLOOP(12) {
    if (IN(12)) {
        for (int ui = bx; ui < 1024; ui += F.G) { const int qb = 15 - (ui >> 6), bh = ui & 63; stick_unit(F, bh >> 3, bh & 7, qb); }
    }
    }
    SEAM(12);
    if (IN(13)) {
        pg8::PlainSched S; S.init(M, DM, F.G, bx, WSP(bf16, WS_O), 2048, WSP(bf16, WS_WOUT1), 2048);
        pg8::EpiRes E{nullptr, WSP(bf16, WS_XB), WSP(bf16, WS_XB3), WSP(float, WS_RS0), 1.f};
        REPLOOP(14) pg8::gemm_phase<pg8::EpiRes, pg8::PlainSched>(F.lds, pg8::GemmK{1024, 2048u, 2048u, 30, 0u}, S, E);
        LAS float* scr = (LAS float*)(F.lds + F.wave * 16384);
        REPLOOP(13) {
        int ibase = 0;
#pragma unroll 1
        for (int e = 0; e < NEXP; ++e) {
            { FnGU f{FIN(I_OD_WG) + (size_t)e * 1024 * EFF, FIN(I_OD_WU) + (size_t)e * 1024 * EFF, EFF}; XPOSE_MAT(f, 2 * EFF, 1024, (bf16*)(F.ws + WS_MW + (size_t)e * MW_E), (const float*)nullptr); }
            { FnPlain f{FIN(I_OD_WD) + (size_t)e * EFF * 1024, 1024, 0}; XPOSE_MAT(f, 1024, EFF, (bf16*)(F.ws + WS_MW + (size_t)e * MW_E + MW_DN), (const float*)nullptr); }
        }
        }
    }
    SEAM(13);
    if (IN(14)) router_phase(F);
    SEAM(14);
    REPLOOP(15) { if (IN(15)) gather_phase(F); }
    SEAM(15);
#pragma unroll 1
    for (int ch = 0; ch < 3; ++ch) {
        const int t0 = ch * HM_TILES, ph = 16 + 2 * ch;
        MoeLayout L; moe_layout(F, L);
        const int ntile = L.off[16] >> 8;
        const int nt = (ntile - t0) < HM_TILES ? (ntile - t0) : HM_TILES;
        if (IN(ph) && nt > 0) {
            MoeSched S; S.o.init(nt, 2 * EFF / 256, F.G, bx); S.t0 = t0; S.A = (const char*)WSP(bf16, WS_XS); S.tstepA = 256 * 2048; S.W = (const char*)(F.ws + WS_MW); S.tstepB = 256 * 2048; S.a_local = false; S.A2 = nullptr;
#pragma unroll
            for (int q = 0; q < 17; ++q) S.off[q] = L.off[q];
            pg8::EpiSwiglu E{WSP(bf16, WS_HM), EFF, t0, nullptr, (bf16*)F.out, HM_SPLIT};
            REPLOOP(16) pg8::gemm_phase<pg8::EpiSwiglu, MoeSched>(F.lds, pg8::GemmK{1024, 2048u, 2048u, 30, 0u}, S, E);
        }
        SEAM(ph);
        const bool split = ch == 2 && nt > 0 && nt <= MOE_SPLIT_TILES;
        if (IN(ph + 1) && split) {
            MoeSplitSched S; S.o.init(nt, 4 * MOE_SPLITS, F.G, bx); S.t0 = t0; S.A = (const char*)WSP(bf16, WS_HM); S.tstepA = (size_t)256 * EFF * 2; S.W = (const char*)(F.ws + WS_MW + MW_DN); S.tstepB = (size_t)256 * EFF * 2;
#pragma unroll
            for (int q = 0; q < 17; ++q) S.off[q] = L.off[q];
            pg8::EpiMoeYp E{WSP(bf16, WS_YP), WSP(float, WS_GWS), t0, (size_t)MOE_SPLIT_TILES * 256 * DM};
            pg8::gemm_phase<pg8::EpiMoeYp, MoeSplitSched>(F.lds, pg8::GemmK{EFF / MOE_SPLITS, EFF * 2u, EFF * 2u, 30, 0u}, S, E);
        }
        if (IN(ph + 1) && nt > 0 && !split) {
            MoeSched S; S.o.init(nt, DM / 256, F.G, bx); S.t0 = t0; S.A = (const char*)WSP(bf16, WS_HM); S.tstepA = (size_t)256 * EFF * 2; S.W = (const char*)(F.ws + WS_MW + MW_DN); S.tstepB = (size_t)256 * EFF * 2; S.a_local = true; S.A2 = (const char*)F.out;
#pragma unroll
            for (int q = 0; q < 17; ++q) S.off[q] = L.off[q];
            pg8::EpiMoeY E{WSP(bf16, WS_XS), WSP(float, WS_GWS)};
            REPLOOP(17) pg8::gemm_phase<pg8::EpiMoeY, MoeSched>(F.lds, pg8::GemmK{EFF, EFF * 2u, EFF * 2u, 30, 0u}, S, E);
        }
        SEAM(ph + 1);
    }
    REPLOOP(18)
    if (IN(26)) {
        const bf16* XS0 = WSP(bf16, WS_XS); const int* inv = WSP(int, WS_INV);
        MoeLayout L; moe_layout(F, L);
        const int ntl = (L.off[16] >> 8) - 2 * HM_TILES; const int srow = (ntl > 0 && ntl <= MOE_SPLIT_TILES) ? 2 * HM_TILES * 256 : 0x7fffffff;
#define FIN_ROW(m_, v_) do { load_row_bf16(WSP(bf16, WS_XB3) + (size_t)(m_) * DM, F.lane, v_); \
            _Pragma("unroll 1") for (int k = 0; k < 2; ++k) { const int s = inv[(size_t)k * M + (m_)]; float y[16]; \
                if (s < srow) { load_row_bf16(XS0 + (size_t)s * DM, F.lane, y); _Pragma("unroll") for (int i = 0; i < 16; ++i) v_[i] += y[i]; } \
                else { _Pragma("unroll 1") for (int sp = 0; sp < MOE_SPLITS; ++sp) { load_row_bf16(WSP(bf16, WS_YP) + ((size_t)sp * MOE_SPLIT_TILES * 256 + (s - srow)) * DM, F.lane, y); \
                        _Pragma("unroll") for (int i = 0; i < 16; ++i) v_[i] += y[i]; } } } } while (0)
#define FIN_OUT(m_, v_) do { rms16(v_, FIN(I_FNORM), F.lane); GAS f32x4* o = (GAS f32x4*)(F.out + (size_t)(m_) * DM); \
            o[2 * F.lane] = (f32x4){v_[0], v_[1], v_[2], v_[3]}; o[2 * F.lane + 1] = (f32x4){v_[4], v_[5], v_[6], v_[7]}; \
            o[128 + 2 * F.lane] = (f32x4){v_[8], v_[9], v_[10], v_[11]}; o[128 + 2 * F.lane + 1] = (f32x4){v_[12], v_[13], v_[14], v_[15]}; } while (0)
        for (int m = gwv; m < M; m += 2 * NGW) { float va[16], vb[16]; const int mb = m + NGW;
            FIN_ROW(m, va); if (mb < M) FIN_ROW(mb, vb);
            FIN_OUT(m, va); if (mb < M) FIN_OUT(mb, vb); }
#undef FIN_ROW
#undef FIN_OUT
    }
#undef IN
#undef SEAM
#undef XPOSE_MAT
}

#ifndef PROBE_REP
#define PROBE_REP 0u
#endif
#ifndef MK_FUSED
#define MK_FUSED 1
#endif
extern "C" void kernel_launch(void* const* d_in, const int* in_sizes, int n_in, void* d_out, int out_size, void* d_ws, size_t ws_size, hipStream_t stream) {
    static int grid = 0;
    if (grid == 0) {
        if (n_in != N_IN || in_sizes[0] != M * DM || out_size != M * DM || ws_size < WS_END) {
            fprintf(stderr, "kernel_launch: built for %d inputs, x/out of %d floats, >= %zu bytes of workspace; got n_in %d, in0 %d, out %d, ws %zu; nothing launched\n", N_IN, M * DM, (size_t)WS_END, n_in, n_in > 0 ? in_sizes[0] : -1, out_size, ws_size);
            grid = -1; return; }
        int dev = 0, cus = 0, per_cu = 0;
        if (hipGetDevice(&dev) != hipSuccess || hipDeviceGetAttribute(&cus, hipDeviceAttributeMultiprocessorCount, dev) != hipSuccess) { fprintf(stderr, "kernel_launch: device query failed\n"); grid = -1; return; }
        if (hipFuncSetAttribute((const void*)fwd, hipFuncAttributeMaxDynamicSharedMemorySize, LDS_BYTES) != hipSuccess) { fprintf(stderr, "kernel_launch: hipFuncSetAttribute failed\n"); grid = -1; return; }
        if (hipOccupancyMaxActiveBlocksPerMultiprocessor(&per_cu, (const void*)fwd, NTHR, LDS_BYTES) != hipSuccess || per_cu < 1)
            fprintf(stderr, "kernel_launch: note: occupancy query reports %d workgroups per CU\n", per_cu);
        (void)hipGetLastError();
        grid = cus;
    }
    if (grid < 0) return;
    if (hipMemsetAsync((char*)d_ws + WS_CTL, 0, CTL_ZERO_BYTES, stream) != hipSuccess) { fprintf(stderr, "kernel_launch: memset failed\n"); return; }
    Args a{};
    for (int i = 0; i < N_IN; ++i) a.in[i] = (const float*)d_in[i];
    a.out = (float*)d_out; a.ws = (unsigned char*)d_ws; a.rep_mask = PROBE_REP; a.pad = 0u;
#if MK_FUSED
    a.ph_lo = 0; a.ph_hi = N_PHASES;
    hipLaunchKernelGGL(fwd, dim3(grid), dim3(NTHR), LDS_BYTES, stream, a);
#else
    for (int p = 0; p < N_PHASES; ++p) { a.ph_lo = p; a.ph_hi = p + 1; hipLaunchKernelGGL(fwd, dim3(grid), dim3(NTHR), LDS_BYTES, stream, a); }
#endif
    const hipError_t le = hipPeekAtLastError();
    if (le != hipSuccess) fprintf(stderr, "kernel_launch: launch failed: %s\n", hipGetErrorName(le));
}
```

```cpp
#include <hip/hip_runtime.h>
#include <cstdio>
#include <cstdint>

#define GAS __attribute__((address_space(1)))
#define LAS __attribute__((address_space(3)))
typedef unsigned short bf16;
typedef unsigned v4u __attribute__((ext_vector_type(4)));
typedef unsigned v2u __attribute__((ext_vector_type(2)));
typedef float f32x2 __attribute__((ext_vector_type(2)));
typedef float f32x4 __attribute__((ext_vector_type(4)));
typedef float f32x16 __attribute__((ext_vector_type(16)));
typedef short bf16x8 __attribute__((ext_vector_type(8)));
typedef short s16x4 __attribute__((ext_vector_type(4)));
typedef GAS unsigned gu32;
#define RLX_AGENT __ATOMIC_RELAXED, __HIP_MEMORY_SCOPE_AGENT
#define LDS_WAIT() asm volatile("s_waitcnt lgkmcnt(0)" ::: "memory")
#define VM_WAIT() asm volatile("s_waitcnt vmcnt(0)" ::: "memory")
#define SBAR() __builtin_amdgcn_sched_barrier(0)

constexpr int BATCH = 8, SEQ = 4096, DM = 1024, M = BATCH * SEQ, HD = 128;
constexpr int NPROJ = 2560;
constexpr int DFF = 2816, NEXP = 8, EFF = 3584;
constexpr float RMS_EPS = 1e-6f;
constexpr float LOG2E = 1.4426950408889634f;
constexpr float QSCALE = 0.08838834764831845f * LOG2E;
enum { I_X = 0, I_RELB, I_EV_NMIX, I_EV_WIN, I_EV_KVN, I_EV_WUK, I_EV_WUV, I_EV_CPOS, I_EV_CW1, I_EV_CW2, I_EV_WOUT, I_EV_NFFN, I_EV_WG, I_EV_WU, I_EV_WD,
       I_OD_NMIX, I_OD_WQKV, I_OD_WOUT, I_OD_NFFN, I_OD_WR, I_OD_WG, I_OD_WU, I_OD_WD, I_FNORM, N_IN };

enum { G_QA = 0  , G_LAT = 4  , G_IQ = 6  , G_QB = 8  , G_CKR = 12, G_CVR = 13, G_SK = 14, G_SV = 15, G_WK = 16, G_WV = 17, G_MISC = 18, G_PAD = 19 };
constexpr size_t GS = (size_t)M * 128;

constexpr size_t MiB = 1u << 20;
constexpr size_t WS_CTL = 0, CTL_ZERO_BYTES = 1 * MiB;
constexpr size_t WS_TAB = 1 * MiB;
constexpr size_t WS_WIN = 2 * MiB;
constexpr size_t WS_WUKV = 7 * MiB;
constexpr size_t WS_WC1 = 7 * MiB + 256 * 1024;
constexpr size_t WS_WOUT0 = 10 * MiB;
constexpr size_t WS_WGU0 = 12 * MiB;
constexpr size_t WS_WDN0 = 23 * MiB;
constexpr size_t WS_WQKV = 29 * MiB;
constexpr size_t WS_WOUT1 = 35 * MiB;
constexpr size_t WS_XN = 40 * MiB;
constexpr size_t WS_PROJ = 104 * MiB;
constexpr size_t WS_AK = 264 * MiB, WS_AV = 272 * MiB;
constexpr size_t WS_BM = 280 * MiB;
constexpr size_t WS_UV = 296 * MiB;
constexpr size_t WS_UVB = 432 * MiB;
constexpr size_t WS_CK = 300 * MiB;
constexpr size_t WS_CVT = 300 * MiB + 512 * 1024;
constexpr size_t WS_CV = 300 * MiB + 512 * 1024;
constexpr size_t WS_BLK = 301 * MiB;
constexpr size_t WS_RS0 = 302 * MiB;
constexpr size_t WS_RS1 = 296 * MiB;
constexpr size_t WS_OC = 304 * MiB;
constexpr size_t WS_O = 368 * MiB;
constexpr size_t WS_OC2 = 432 * MiB;
constexpr size_t WS_XB = 432 * MiB;
constexpr size_t WS_XB3 = 40 * MiB;
constexpr size_t WS_H0 = 104 * MiB;
constexpr size_t WS_QKV = 104 * MiB;
constexpr size_t WS_MW = 104 * MiB;
constexpr size_t MW_E = 21 * MiB, MW_DN = 14 * MiB;
constexpr size_t WS_LIST = 272 * MiB;
constexpr size_t WS_GW = WS_LIST + 2 * MiB;
constexpr size_t WS_TOK = WS_GW + 256 * 1024;
constexpr size_t WS_INV = WS_TOK + 512 * 1024;
constexpr size_t WS_GWS = WS_INV + 256 * 1024;
constexpr int XS_ROWS = M + 8 * 256;
constexpr size_t WS_XS = 276 * MiB;
constexpr int HM_TILES = 128, HM_SPLIT = 64;
constexpr int MOE_SPLITS = 4, MOE_SPLIT_TILES = 16;
constexpr size_t WS_YP = 2 * MiB;
constexpr size_t WS_HM = 412 * MiB;
constexpr size_t WS_END = 524 * MiB;
static_assert(WS_WIN + (size_t)NPROJ * DM * 2 <= WS_WUKV && WS_WC1 + 2ull * 256 * 2048 * 2 <= WS_WOUT0 && WS_WGU0 + 5632ull * 1024 * 2 <= WS_WDN0 && WS_WDN0 + 1024ull * 2816 * 2 <= WS_WQKV && WS_WQKV + 3072ull * 1024 * 2 <= WS_WOUT1 && WS_WOUT1 + 2 * MiB <= WS_XN, "weights map");
static_assert(WS_XN + (size_t)M * DM * 2 <= WS_PROJ && WS_PROJ + 20 * GS * 2 <= WS_AK && WS_BM + (size_t)M * 128 * 4 <= WS_UV && WS_UV + 4 * MiB <= WS_CK && WS_BLK + (size_t)M * 8 <= WS_OC && WS_OC + (size_t)M * 512 * 4 <= WS_O && WS_O + (size_t)M * DM * 2 <= 432 * MiB, "even map");
static_assert(WS_YP + (size_t)MOE_SPLITS * MOE_SPLIT_TILES * 256 * DM * 2 <= WS_XB3, "split partials fit under the residual stream copy");
static_assert(WS_H0 + (size_t)M * DFF * 2 <= WS_OC && WS_QKV + 24 * GS * 2 <= WS_O && WS_MW + 8 * MW_E <= WS_LIST && WS_GWS + 2ull * XS_ROWS * 4 <= WS_XS && WS_XS + 2ull * XS_ROWS * DM * 2 <= WS_HM && WS_HM + (size_t)HM_SPLIT * 256 * EFF * 2 <= WS_END && (size_t)(HM_TILES - HM_SPLIT) * 256 * EFF * 2 <= (size_t)M * DM * 4, "late map");
constexpr int CW_TMO = 0, CW_CODE = 1;
constexpr int CW_BAR = 4096;
constexpr int CW_CNT = 16384;

constexpr int RING_BYTES = 131072;
constexpr int MISC_OFF = RING_BYTES;
constexpr int LDS_BYTES = 147456;
constexpr int NWAVES = 8, NTHR = 512;

__device__ __forceinline__ unsigned f2bf(float f) { unsigned u = __builtin_bit_cast(unsigned, f); return (u + 0x7fffu + ((u >> 16) & 1u)) >> 16; }
__device__ __forceinline__ unsigned pk2(float lo, float hi) { return f2bf(lo) | (f2bf(hi) << 16); }
__device__ __forceinline__ float bf2f(bf16 b) { return __builtin_bit_cast(float, (unsigned)b << 16); }
__device__ __forceinline__ unsigned cvtpk(float lo, float hi) { unsigned r; asm volatile("v_cvt_pk_bf16_f32 %0, %1, %2" : "=v"(r) : "v"(lo), "v"(hi)); return r; }
__device__ __forceinline__ bf16x8 pack8(f32x4 a, f32x4 b) { v4u w = {cvtpk(a[0], a[1]), cvtpk(a[2], a[3]), cvtpk(b[0], b[1]), cvtpk(b[2], b[3])}; return __builtin_bit_cast(bf16x8, w); }
__device__ __forceinline__ float wave_sum(float v) {
#define WS_STEP(ctrl, rmask) v += __int_as_float(__builtin_amdgcn_update_dpp(0, __float_as_int(v), ctrl, rmask, 0xf, true))
    WS_STEP(0x111, 0xf); WS_STEP(0x112, 0xf); WS_STEP(0x114, 0xf); WS_STEP(0x118, 0xf); WS_STEP(0x142, 0xa); WS_STEP(0x143, 0xc);
#undef WS_STEP
    return __int_as_float(__builtin_amdgcn_readlane(__float_as_int(v), 63));
}
__device__ __forceinline__ float wave_max(float v) {
#define WM_STEP(ctrl, rmask) v = fmaxf(v, __int_as_float(__builtin_amdgcn_update_dpp(__float_as_int(v), __float_as_int(v), ctrl, rmask, 0xf, false)))
    WM_STEP(0x111, 0xf); WM_STEP(0x112, 0xf); WM_STEP(0x114, 0xf); WM_STEP(0x118, 0xf); WM_STEP(0x142, 0xa); WM_STEP(0x143, 0xc);
#undef WM_STEP
    return __int_as_float(__builtin_amdgcn_readlane(__float_as_int(v), 63));
}
__device__ __forceinline__ int rel_bucket_dev(int d) {
    if (d < 16) return d;
    if (d >= 113) return 31;
    int v = 16 + (int)(__log2f((float)d * 0.0625f) * (16.0f / 3.0f));
    return v > 31 ? 31 : v;
}
namespace pg8 {
constexpr int BM = 256, BK = 64, HALF = 128, HTB = HALF * BK * 2, STAGE_BYTES = 8 * HTB, NXCD = 8, WGM = 8;
__host__ __device__ __forceinline__ int lds_byte(int r, int c) { const int st = (r >> 4) * 2 + (c >> 5), rr = r & 15, cc = c & 31, ob = rr * 64 + cc * 2; return st * 1024 + (ob ^ (((ob >> 9) & 1) << 5)); }
__host__ __device__ __forceinline__ void stage_rc(int b, int& R, int& C) { const int st = b / 1024, sb = b % 1024, swz = sb ^ (((sb >> 9) & 1) << 5); R = (st >> 1) * 16 + swz / 64; C = (st & 1) * 32 + (swz % 64) / 2; }
__host__ __device__ __forceinline__ int perm32(int rho) { const int n = rho >> 4, i = rho & 15; return 8 * (i >> 2) + 4 * n + (i & 3); }

struct Unit { int pm, pn, aux; const char* A; const char* B; };
struct GemmK { int K; unsigned pitchA, pitchB; int kshA; unsigned gstrA; };

struct GridOrder {
    int nM, nN, nwg, G, c;
    __device__ __forceinline__ void init(int nM_, int nN_, int G_, int c_) { nM = nM_; nN = nN_; nwg = nM * nN; G = G_; c = c_; }
    __device__ __forceinline__ bool at(int i, int& pm, int& pn) const {
        const long L = (long)i * G + c; if (L >= nwg) return false;
        int wgid = (int)L; { const int q = nwg / NXCD, r = nwg % NXCD, xcd = wgid % NXCD, off = wgid / NXCD; wgid = (xcd < r ? xcd * (q + 1) : r * (q + 1) + (xcd - r) * q) + off; }
        const int nig = WGM * nN, gid = wgid / nig, fm = gid * WGM, gsz = (nM - fm) < WGM ? (nM - fm) : WGM;
        pm = fm + ((wgid % nig) % gsz); pn = (wgid % nig) / gsz; return true;
    }
};
struct PlainSched {
    GridOrder o; const char* A; const char* B; size_t tstepA, tstepB;
    __device__ __forceinline__ void init(int Mr, int Nc, int G, int c, const void* A_, size_t pitchA, const void* B_, size_t pitchB) { o.init(Mr / BM, Nc / BM, G, c); A = (const char*)A_; B = (const char*)B_; tstepA = 256 * pitchA; tstepB = 256 * pitchB; }
    __device__ __forceinline__ bool next(int i, Unit& u) const { if (!o.at(i, u.pm, u.pn)) return false; u.aux = 0; u.A = A + (size_t)u.pm * tstepA; u.B = B + (size_t)u.pn * tstepB; return true; }
};

__device__ __forceinline__ unsigned cvt_pk_bf16(float lo, float hi) { unsigned r; asm volatile("v_cvt_pk_bf16_f32 %0, %1, %2" : "=v"(r) : "v"(lo), "v"(hi)); return r; }

typedef float f32x8 __attribute__((ext_vector_type(8)));
__device__ __forceinline__ f32x8 row_rstd8(const float* rs, int row0, int fq) {
    f32x8 r = {1.f, 1.f, 1.f, 1.f, 1.f, 1.f, 1.f, 1.f};
    if (rs) {
#pragma unroll
        for (int i = 0; i < 8; ++i) { const f32x4 p = *(const f32x4*)(rs + (size_t)(row0 + (i >> 2) * HALF + (i & 3) * 16) * 16 + 4 * fq); float s = (p[0] + p[1]) + (p[2] + p[3]);
            s += __shfl_xor(s, 16); s += __shfl_xor(s, 32); r[i] = 1.0f / sqrtf(s * (1.0f / DM) + RMS_EPS); } }
    return r;
}
struct EpiGroups {
    static constexpr bool PERM = true;
    bf16* O; size_t gstride; unsigned scalemask; float scale; int gskip; const float* rs;
    __device__ __forceinline__ void operator()(const f32x4 (&acc)[2][2][4][2], const Unit& u, int wr, int wc, int fr, int fq) const {
        const int row0 = u.pm * BM + wr * 64 + fr, col0 = wc * 32 + 8 * fq;
        const f32x8 rstd = row_rstd8(rs, row0, fq);
#pragma unroll
        for (int bj = 0; bj < 2; ++bj) { const int g = 2 * u.pn + bj; if (g >= gskip) continue; const float sc = ((scalemask >> g) & 1u) ? scale : 1.f; bf16* base = O + (size_t)g * gstride;
#pragma unroll
            for (int ai = 0; ai < 2; ++ai)
#pragma unroll
                for (int m = 0; m < 4; ++m) { const float s2 = sc * rstd[ai * 4 + m]; const f32x4 v0 = acc[ai][bj][m][0] * s2, v1 = acc[ai][bj][m][1] * s2;
                    v4u w; w.x = cvt_pk_bf16(v0[0], v0[1]); w.y = cvt_pk_bf16(v0[2], v0[3]); w.z = cvt_pk_bf16(v1[0], v1[1]); w.w = cvt_pk_bf16(v1[2], v1[3]);
                    *(v4u*)(base + (size_t)(row0 + ai * HALF + m * 16) * 128 + col0) = w; } }
    }
};
struct OneSched { Unit u; __device__ __forceinline__ bool next(int i, Unit& o) const { if (i) return false; o = u; return true; } };
struct EpiAkv {
    static constexpr bool PERM = true;
    bf16* AK; bf16* AV; const LAS float* rstd;
    __device__ __forceinline__ void operator()(const f32x4 (&acc)[2][2][4][2], const Unit& u, int wr, int wc, int fr, int fq) const {
        const int col0 = wc * 32 + 8 * fq;
#pragma unroll
        for (int ai = 0; ai < 2; ++ai)
#pragma unroll
            for (int m = 0; m < 4; ++m) { const int rl = ai * HALF + wr * 64 + m * 16 + fr; const float rs = rstd[rl]; const size_t row = (size_t)u.pm * BM + rl;
#pragma unroll
                for (int bj = 0; bj < 2; ++bj) { const f32x4 v0 = acc[ai][bj][m][0] * rs, v1 = acc[ai][bj][m][1] * rs;
                    v4u w; w.x = cvt_pk_bf16(v0[0], v0[1]); w.y = cvt_pk_bf16(v0[2], v0[3]); w.z = cvt_pk_bf16(v1[0], v1[1]); w.w = cvt_pk_bf16(v1[2], v1[3]);
                    *(v4u*)((bj ? AV : AK) + row * 128 + col0) = w; } }
    }
};
struct EpiF32 {
    static constexpr bool PERM = false;
    const float* base; float* C; int ldc; float scale;
    __device__ __forceinline__ void operator()(const f32x4 (&acc)[2][2][4][2], const Unit& u, int wr, int wc, int fr, int fq) const {
        const int row0 = u.pm * BM + wr * 64 + fr, col0 = u.pn * BM + wc * 32 + 4 * fq;
#pragma unroll
        for (int ai = 0; ai < 2; ++ai)
#pragma unroll
            for (int m = 0; m < 4; ++m) { const size_t off = (size_t)(row0 + ai * HALF + m * 16) * ldc + col0;
#pragma unroll
                for (int bj = 0; bj < 2; ++bj)
#pragma unroll
                    for (int n = 0; n < 2; ++n) { f32x4 v = acc[ai][bj][m][n] * scale; if (base) v += *(const f32x4*)(base + off + bj * HALF + n * 16); *(f32x4*)(C + off + bj * HALF + n * 16) = v; } }
    }
};
struct EpiRes {
    static constexpr bool PERM = true;
    const float* basef; const bf16* baseb; bf16* out; float* rs; float scale;
    __device__ __forceinline__ void operator()(const f32x4 (&acc)[2][2][4][2], const Unit& u, int wr, int wc, int fr, int fq) const {
        const int row0 = u.pm * BM + wr * 64 + fr, col0 = u.pn * BM + wc * 32 + 8 * fq;
#pragma unroll
        for (int ai = 0; ai < 2; ++ai)
#pragma unroll
            for (int m = 0; m < 4; ++m) { const size_t off = (size_t)(row0 + ai * HALF + m * 16) * DM + col0; float ss = 0.f;
#pragma unroll
                for (int bj = 0; bj < 2; ++bj) { f32x4 v0 = acc[ai][bj][m][0] * scale, v1 = acc[ai][bj][m][1] * scale;
                    if (basef) { v0 += *(const f32x4*)(basef + off + bj * HALF); v1 += *(const f32x4*)(basef + off + bj * HALF + 4); }
                    else { const v4u w = *(const v4u*)(baseb + off + bj * HALF);
                        v0 += (f32x4){__uint_as_float(w.x << 16), __uint_as_float(w.x & 0xffff0000u), __uint_as_float(w.y << 16), __uint_as_float(w.y & 0xffff0000u)};
                        v1 += (f32x4){__uint_as_float(w.z << 16), __uint_as_float(w.z & 0xffff0000u), __uint_as_float(w.w << 16), __uint_as_float(w.w & 0xffff0000u)}; }
                    v4u o; o.x = cvt_pk_bf16(v0[0], v0[1]); o.y = cvt_pk_bf16(v0[2], v0[3]); o.z = cvt_pk_bf16(v1[0], v1[1]); o.w = cvt_pk_bf16(v1[2], v1[3]);
                    *(v4u*)(out + off + bj * HALF) = o;
#define RS_ACC(w) { const float a_ = __uint_as_float((w) << 16), c_ = __uint_as_float((w) & 0xffff0000u); ss = fmaf(a_, a_, fmaf(c_, c_, ss)); }
                    RS_ACC(o.x) RS_ACC(o.y) RS_ACC(o.z) RS_ACC(o.w)
#undef RS_ACC
                }
                { ss += __shfl_xor(ss, 16); ss += __shfl_xor(ss, 32); if (fq == 0) rs[(size_t)(row0 + ai * HALF + m * 16) * 16 + 4 * u.pn + wc] = ss; } }
    }
};
struct EpiMoeY {
    static constexpr bool PERM = true;
    bf16* Y; const float* gws;
    __device__ __forceinline__ void operator()(const f32x4 (&acc)[2][2][4][2], const Unit& u, int wr, int wc, int fr, int fq) const {
        const int col0 = u.pn * BM + wc * 32 + 8 * fq;
#pragma unroll
        for (int ai = 0; ai < 2; ++ai)
#pragma unroll
            for (int m = 0; m < 4; ++m) { const int slot = u.pm * BM + ai * HALF + wr * 64 + m * 16 + fr; const float g = gws[slot];
#pragma unroll
                for (int bj = 0; bj < 2; ++bj) { const f32x4 v0 = acc[ai][bj][m][0] * g, v1 = acc[ai][bj][m][1] * g;
                    v4u o; o.x = cvt_pk_bf16(v0[0], v0[1]); o.y = cvt_pk_bf16(v0[2], v0[3]); o.z = cvt_pk_bf16(v1[0], v1[1]); o.w = cvt_pk_bf16(v1[2], v1[3]);
                    *(v4u*)(Y + (size_t)slot * DM + col0 + bj * HALF) = o; } }
    }
};
struct EpiMoeYp {
    static constexpr bool PERM = true;
    bf16* YP; const float* gws; int pm0; size_t split_stride;
    __device__ __forceinline__ void operator()(const f32x4 (&acc)[2][2][4][2], const Unit& u, int wr, int wc, int fr, int fq) const {
        const int col0 = (u.pn & 3) * BM + wc * 32 + 8 * fq; bf16* base = YP + (size_t)(u.pn >> 2) * split_stride;
#pragma unroll
        for (int ai = 0; ai < 2; ++ai)
#pragma unroll
            for (int m = 0; m < 4; ++m) { const int rl = ai * HALF + wr * 64 + m * 16 + fr; const float g = gws[u.pm * BM + rl];
#pragma unroll
                for (int bj = 0; bj < 2; ++bj) { const f32x4 v0 = acc[ai][bj][m][0] * g, v1 = acc[ai][bj][m][1] * g;
                    v4u o; o.x = cvt_pk_bf16(v0[0], v0[1]); o.y = cvt_pk_bf16(v0[2], v0[3]); o.z = cvt_pk_bf16(v1[0], v1[1]); o.w = cvt_pk_bf16(v1[2], v1[3]);
                    *(v4u*)(base + (size_t)((u.pm - pm0) * BM + rl) * DM + col0 + bj * HALF) = o; } }
    }
};
struct EpiSwiglu {
    static constexpr bool PERM = true;
    bf16* H; int ldh; int pm0; const float* rs; bf16* H2; int hsplit;
    __device__ __forceinline__ void operator()(const f32x4 (&acc)[2][2][4][2], const Unit& u, int wr, int wc, int fr, int fq) const {
        const int lt = u.pm - pm0; bf16* Hb = (H2 && lt >= hsplit) ? H2 : H;
        const int row0 = ((H2 && lt >= hsplit) ? lt - hsplit : lt) * BM + wr * 64 + fr, col0 = u.pn * HALF + wc * 32 + 8 * fq;
        const f32x8 rstd = row_rstd8(rs, u.pm * BM + wr * 64 + fr, fq);
#pragma unroll
        for (int ai = 0; ai < 2; ++ai)
#pragma unroll
            for (int m = 0; m < 4; ++m) { float h[8];
#pragma unroll
                for (int n = 0; n < 2; ++n)
#pragma unroll
                    for (int j = 0; j < 4; ++j) { const float g = acc[ai][0][m][n][j] * rstd[ai * 4 + m], up = acc[ai][1][m][n][j] * rstd[ai * 4 + m]; h[n * 4 + j] = g * up * __builtin_amdgcn_rcpf(1.0f + __builtin_amdgcn_exp2f(-g * LOG2E)); }
                v4u w; w.x = cvt_pk_bf16(h[0], h[1]); w.y = cvt_pk_bf16(h[2], h[3]); w.z = cvt_pk_bf16(h[4], h[5]); w.w = cvt_pk_bf16(h[6], h[7]);
                *(v4u*)(Hb + (size_t)(row0 + ai * HALF + m * 16) * ldh + col0) = w; }
    }
};
struct EpiMoeDown {
    static constexpr bool PERM = false;
    float* out; const int* tok; const float* gw; int pm0; float scale;
    __device__ __forceinline__ void operator()(const f32x4 (&acc)[2][2][4][2], const Unit& u, int wr, int wc, int fr, int fq) const {
        const int col0 = u.pn * BM + wc * 32 + 4 * fq;
#pragma unroll
        for (int ai = 0; ai < 2; ++ai)
#pragma unroll
            for (int m = 0; m < 4; ++m) { const int slot = u.pm * BM + ai * HALF + wr * 64 + m * 16 + fr; const int t = tok[slot];
                if (t >= 0) { const float g = gw[t] * scale; float* rowp = out + (size_t)t * DM + col0;
#pragma unroll
                    for (int bj = 0; bj < 2; ++bj)
#pragma unroll
                        for (int n = 0; n < 2; ++n) { f32x4* p = (f32x4*)(rowp + bj * HALF + n * 16); *p = *p + acc[ai][bj][m][n] * g; } } }
    }
};

template <class Epi, class Sched, bool ALIGN_EPI = true>
__device__ __forceinline__ void gemm_phase(LAS unsigned char* lds, const GemmK gk, const Sched& S, const Epi& E) {
    int tid = threadIdx.x; asm volatile("" : "+v"(tid));
    const int wid = __builtin_amdgcn_readfirstlane(tid >> 6), lane = tid & 63, wr = wid >> 2, wc = wid & 3, fr = lane & 15, fq = lane >> 4;
    int nt = gk.K / BK; asm volatile("" : "+s"(nt));
    unsigned voffA[2], voffB[2];
#pragma unroll
    for (int i = 0; i < 2; ++i) { int R, C; stage_rc(tid * 16 + i * 8192, R, C); const int Rb = Epi::PERM ? ((R & ~31) + perm32(R & 31)) : R;
        voffA[i] = (unsigned)R * gk.pitchA + (unsigned)C * 2u; voffB[i] = (unsigned)Rb * gk.pitchB + (unsigned)C * 2u; }
    const size_t hstepA = (size_t)HALF * gk.pitchA, hstepB = (size_t)HALF * gk.pitchB;
    const int ksh = gk.kshA; const unsigned kmask = (1u << ksh) - 1u; const size_t gstr = gk.gstrA;
#define PG8_KOA(t) ((size_t)((unsigned)(t) >> ksh) * gstr + (size_t)((unsigned)(t) & kmask) * 128u)
    const unsigned ldsw = (unsigned)wid * 1024u;
    const int aoff = lds_byte(wr * 64 + fr, fq * 8), boff = lds_byte(wc * 32 + fr, fq * 8);
#define PG8_SA(b, h) (((b) * 2 + (h)) * HTB)
#define PG8_SB(b, h) ((4 + (b) * 2 + (h)) * HTB)
#define PG8_STAGE(bufoff, gbase, voff) do { _Pragma("unroll") for (int _i = 0; _i < 2; ++_i) \
        __builtin_amdgcn_global_load_lds((const unsigned*)((const char*)(gbase) + (voff)[_i]), (LAS unsigned*)(lds + (bufoff) + ldsw + _i * 8192), 16, 0, 0); } while (0)
#define PG8_LDA(dst, b, h) do { _Pragma("unroll") for (int m = 0; m < 4; ++m) _Pragma("unroll") for (int k = 0; k < 2; ++k) dst[m][k] = *(const LAS bf16x8*)(lds + PG8_SA(b, h) + aoff + m * 2048 + k * 1024); } while (0)
#define PG8_LDB(dst, b, h) do { _Pragma("unroll") for (int n = 0; n < 2; ++n) _Pragma("unroll") for (int k = 0; k < 2; ++k) dst[n][k] = *(const LAS bf16x8*)(lds + PG8_SB(b, h) + boff + n * 2048 + k * 1024); } while (0)
#define PG8_MMA(ai, bj, At, Bt) do { __builtin_amdgcn_s_setprio(1); _Pragma("unroll") for (int m = 0; m < 4; ++m) _Pragma("unroll") for (int n = 0; n < 2; ++n) _Pragma("unroll") for (int k = 0; k < 2; ++k) \
        acc[ai][bj][m][n] = __builtin_amdgcn_mfma_f32_16x16x32_bf16(Bt[n][k], At[m][k], acc[ai][bj][m][n], 0, 0, 0); __builtin_amdgcn_s_setprio(0); } while (0)
#define PG8_WAIT_V(n) asm volatile("s_waitcnt vmcnt(" #n ")" ::: "memory")
#define PG8_WAIT_L(n) asm volatile("s_waitcnt lgkmcnt(" #n ")" ::: "memory")
#define PG8_BAR __builtin_amdgcn_s_barrier()
#define PG8_SCHED __builtin_amdgcn_sched_barrier(0)
    Unit cur, nxt; int ui = 0;
    if (!S.next(0, cur)) return;
    f32x4 acc[2][2][4][2];
#pragma unroll
    for (int a = 0; a < 2; ++a)
#pragma unroll
        for (int b = 0; b < 2; ++b)
#pragma unroll
            for (int m = 0; m < 4; ++m)
#pragma unroll
                for (int n = 0; n < 2; ++n) acc[a][b][m][n] = (f32x4){0.f, 0.f, 0.f, 0.f};
    bf16x8 At[4][2], B0[2][2], B1[2][2];
    const char* cA = cur.A; const char* cB = cur.B;
    PG8_STAGE(PG8_SB(0, 0), cB, voffB); PG8_STAGE(PG8_SB(0, 1), cB + hstepB, voffB); PG8_STAGE(PG8_SA(0, 0), cA, voffA); PG8_STAGE(PG8_SA(0, 1), cA + hstepA, voffA);
    if (wr == 1) PG8_BAR;
    PG8_WAIT_V(2); PG8_BAR;
    PG8_STAGE(PG8_SB(1, 0), cB + 128, voffB); PG8_STAGE(PG8_SA(1, 0), cA + 128, voffA); PG8_STAGE(PG8_SB(1, 1), cB + hstepB + 128, voffB);
    PG8_WAIT_V(6); PG8_BAR;
    for (;;) {
        const bool has_next = S.next(ui + 1, nxt);
        const char* nA = has_next ? nxt.A : cA; const char* nB = has_next ? nxt.B : cB;
        for (int t = 0; t < nt; t += 2) {
            const bool last = (t == nt - 2);
            const char* a1 = cA + PG8_KOA(t + 1);
            const char* a2 = last ? nA : cA + PG8_KOA(t + 2); const char* b2 = last ? nB : cB + (size_t)(t + 2) * 128u;
            const char* a3 = a2 + 128; const char* b3 = b2 + 128;
            PG8_LDB(B0, 0, 0); PG8_LDB(B1, 0, 1); PG8_SCHED; PG8_LDA(At, 0, 0); PG8_STAGE(PG8_SA(1, 1), a1 + hstepA, voffA);
            PG8_WAIT_V(8); PG8_WAIT_L(0); PG8_BAR; PG8_MMA(0, 0, At, B0); PG8_MMA(0, 1, At, B1); PG8_BAR; PG8_SCHED;
            PG8_LDA(At, 0, 1); PG8_STAGE(PG8_SB(0, 0), b2, voffB); PG8_STAGE(PG8_SB(0, 1), b2 + hstepB, voffB); PG8_STAGE(PG8_SA(0, 0), a2, voffA);
            PG8_WAIT_V(8); PG8_WAIT_L(0); PG8_BAR; PG8_MMA(1, 0, At, B0); PG8_MMA(1, 1, At, B1); PG8_BAR; PG8_SCHED;
            PG8_LDB(B0, 1, 0); PG8_LDB(B1, 1, 1); PG8_SCHED; PG8_LDA(At, 1, 0); PG8_STAGE(PG8_SA(0, 1), a2 + hstepA, voffA);
            PG8_WAIT_V(8); PG8_WAIT_L(0); PG8_BAR; PG8_MMA(0, 0, At, B0); PG8_MMA(0, 1, At, B1); PG8_BAR; PG8_SCHED;
            PG8_LDA(At, 1, 1); PG8_STAGE(PG8_SB(1, 0), b3, voffB); PG8_STAGE(PG8_SB(1, 1), b3 + hstepB, voffB); PG8_STAGE(PG8_SA(1, 0), a3, voffA);
            PG8_WAIT_V(8); PG8_WAIT_L(0); PG8_BAR; PG8_MMA(1, 0, At, B0); PG8_MMA(1, 1, At, B1); PG8_BAR; PG8_SCHED;
        }
        if constexpr (ALIGN_EPI) { if (wr == 0) PG8_BAR; }
        E(acc, cur, wr, wc, fr, fq);
        if (!has_next) break;
#pragma unroll
        for (int a = 0; a < 2; ++a)
#pragma unroll
            for (int b = 0; b < 2; ++b)
#pragma unroll
                for (int m = 0; m < 4; ++m)
#pragma unroll
                    for (int n = 0; n < 2; ++n) acc[a][b][m][n] = (f32x4){0.f, 0.f, 0.f, 0.f};
        cur = nxt; cA = nA; cB = nB; ++ui;
        if constexpr (ALIGN_EPI) { if (wr == 1) PG8_BAR; }
    }
    PG8_WAIT_V(0);
    if constexpr (!ALIGN_EPI) { if (wr == 0) PG8_BAR; }
    PG8_BAR;
#undef PG8_KOA
#undef PG8_SA
#undef PG8_SB
#undef PG8_STAGE
#undef PG8_LDA
#undef PG8_LDB
#undef PG8_MMA
#undef PG8_WAIT_V
#undef PG8_WAIT_L
#undef PG8_BAR
#undef PG8_SCHED
}
}
#define XB_TMO      128
#define XB_XCNT(j)  (256  + 64 * (j))
#define XB_XSUB(j)  (1280 + 64 * (j))
#define XB_XGEN(j)  (2304 + 64 * (j))
#define XB_TOP      3328
#define XB_TOPGEN   3392
#define XCD_BAR_WORDS 3456
#define XB_SPIN_CAP (1u << 22)

__device__ __forceinline__ unsigned xb_ld(unsigned* p)              { return __hip_atomic_load(p, __ATOMIC_RELAXED, __HIP_MEMORY_SCOPE_AGENT); }
__device__ __forceinline__ unsigned xb_add(unsigned* p, unsigned v) { return __hip_atomic_fetch_add(p, v, __ATOMIC_RELAXED, __HIP_MEMORY_SCOPE_AGENT); }
__device__ __forceinline__ unsigned xb_xcc_id() { return (unsigned)__builtin_amdgcn_s_getreg((3 << 11) | 20) & 0xFu; }
#define XB_SPIN(cond, bar) do { unsigned _sp = 0; while (cond) { __builtin_amdgcn_s_sleep(1); \
    if ((++_sp & 255u) == 0u) { if (xb_ld(&(bar)[XB_TMO])) break; if (_sp > XB_SPIN_CAP) { atomicAdd(&(bar)[XB_TMO], 1u); break; } } } } while (0)

struct XcdBarrier { unsigned* bar; unsigned x; volatile LAS unsigned* st; };

__device__ __forceinline__ XcdBarrier xcd_barrier_post(unsigned* bar, volatile LAS unsigned* st) {
    XcdBarrier b; b.bar = bar; b.x = xb_xcc_id(); b.st = st;
    if (threadIdx.x == 0) (void)xb_add(&bar[XB_XCNT(b.x)], 1u);
    return b;
}
__device__ __forceinline__ void xcd_barrier_complete(unsigned* bar, unsigned x, unsigned& nloc, unsigned& nx) {
    const unsigned G = gridDim.x * gridDim.y * gridDim.z;
    unsigned sum, cnt, mine, sp = 0u;
    for (;;) {
        sum = 0u; cnt = 0u; mine = 0u;
#pragma unroll
        for (unsigned j = 0; j < 16; ++j) { const unsigned c = xb_ld(&bar[XB_XCNT(j)]); sum += c; cnt += (c > 0u) ? 1u : 0u; mine = (j == x) ? c : mine; }
        if (sum == G) break;
        __builtin_amdgcn_s_sleep(1);
        if ((++sp & 255u) == 0u) { if (xb_ld(&bar[XB_TMO])) break; if (sp > XB_SPIN_CAP) { atomicAdd(&bar[XB_TMO], 1u); break; } }
    }
    nloc = mine > 0u ? mine : 1u; nx = cnt > 0u ? cnt : 1u;
}
__device__ __forceinline__ void xcd_barrier(const XcdBarrier& b) {
    asm volatile("s_waitcnt vmcnt(0)" ::: "memory");
    __syncthreads();
    if (threadIdx.x == 0) {
        unsigned* bar = b.bar;
        __builtin_amdgcn_s_waitcnt(0);
        unsigned nloc = b.st[0], nx = b.st[1];
        if (nloc == 0u) { xcd_barrier_complete(bar, b.x, nloc, nx); b.st[0] = nloc; b.st[1] = nx; }
        const unsigned old = xb_add(&bar[XB_XSUB(b.x)], 1u);
        const unsigned gen = old / nloc;
        if (old + 1u == (gen + 1u) * nloc) {
            __builtin_amdgcn_fence(__ATOMIC_RELEASE, "agent");
            asm volatile("s_waitcnt vmcnt(0)" ::: "memory");
            const unsigned og = xb_add(&bar[XB_TOP], 1u);
            const unsigned tg = og / nx;
            if (og + 1u == (tg + 1u) * nx) xb_add(&bar[XB_TOPGEN], 1u);
            else XB_SPIN(xb_ld(&bar[XB_TOPGEN]) == tg, bar);
            __builtin_amdgcn_fence(__ATOMIC_ACQUIRE, "agent");
            xb_add(&bar[XB_XGEN(b.x)], 1u);
            asm volatile("s_waitcnt vmcnt(0)" ::: "memory");
        } else {
            XB_SPIN(xb_ld(&bar[XB_XGEN(b.x)]) == gen, bar);
            __builtin_amdgcn_fence(__ATOMIC_ACQUIRE, "agent");
            asm volatile("s_waitcnt vmcnt(0)" ::: "memory");
        }
    }
    __syncthreads();
}

struct Frame {
    LAS unsigned char* lds;
    char* ldsg;
    volatile LAS unsigned* MISC;
    gu32* ctl;
    int tid, lane, wave, vcu, G;
    const __attribute__((address_space(4))) char* kap;
    float* out; unsigned char* ws;
};
#define FIN(i) (*(const float* const __attribute__((address_space(4)))*)(F.kap + 8 * (i)))
#define PHASE_FENCE() do { unsigned long long k_ = (unsigned long long)F.kap; asm volatile("" : "+s"(k_)); F.kap = (const __attribute__((address_space(4))) char*)k_; \
    int t_ = F.tid; asm volatile("" : "+v"(t_)); F.tid = t_; F.lane = t_ & 63; } while (0)
#define WSP(T, off) ((T*)(F.ws + (off)))
#define GRP(g) (WSP(bf16, WS_PROJ) + (size_t)(g) * GS)
#define QKVG(g) (WSP(bf16, WS_QKV) + (size_t)(g) * GS)

__device__ __forceinline__ void rms_row(const float* xrow, const float* gain, int lane, f32x4 (&v)[4]) {
    const GAS f32x4* xr = (const GAS f32x4*)xrow + lane; float s = 0.f;
#pragma unroll
    for (int j = 0; j < 4; ++j) { v[j] = xr[64 * j]; s += (v[j].x * v[j].x + v[j].y * v[j].y) + (v[j].z * v[j].z + v[j].w * v[j].w); }
    const float rstd = 1.0f / sqrtf(wave_sum(s) * (1.f / DM) + RMS_EPS);
#pragma unroll
    for (int j = 0; j < 4; ++j) { const f32x4 g = ((const GAS f32x4*)gain)[lane + 64 * j]; v[j] = v[j] * rstd * g; }
}
__device__ __forceinline__ void store_row_bf16(bf16* orow, int lane, const f32x4 (&v)[4]) {
    GAS unsigned long long* o8 = (GAS unsigned long long*)orow + lane;
#pragma unroll
    for (int j = 0; j < 4; ++j) o8[64 * j] = (unsigned long long)cvtpk(v[j].x, v[j].y) | ((unsigned long long)cvtpk(v[j].z, v[j].w) << 32);
}
__device__ __forceinline__ void load_row_bf16(const bf16* row, int lane, float (&v)[16]) {
    const v4u a = ((const GAS v4u*)row)[lane], b = ((const GAS v4u*)row)[64 + lane];
#pragma unroll
    for (int q = 0; q < 4; ++q) { v[2 * q] = __uint_as_float(a[q] << 16); v[2 * q + 1] = __uint_as_float(a[q] & 0xffff0000u); v[8 + 2 * q] = __uint_as_float(b[q] << 16); v[8 + 2 * q + 1] = __uint_as_float(b[q] & 0xffff0000u); }
}
__device__ __forceinline__ void store_row16_bf16(bf16* row, int lane, const float (&v)[16]) {
    ((GAS v4u*)row)[lane] = (v4u){cvtpk(v[0], v[1]), cvtpk(v[2], v[3]), cvtpk(v[4], v[5]), cvtpk(v[6], v[7])};
    ((GAS v4u*)row)[64 + lane] = (v4u){cvtpk(v[8], v[9]), cvtpk(v[10], v[11]), cvtpk(v[12], v[13]), cvtpk(v[14], v[15])};
}
__device__ __forceinline__ void rms16(float (&v)[16], const float* gain, int lane) {
    float s = 0.f;
#pragma unroll
    for (int i = 0; i < 16; ++i) s += v[i] * v[i];
    const float rstd = 1.0f / sqrtf(wave_sum(s) * (1.f / DM) + RMS_EPS);
    const f32x4 g0 = ((const GAS f32x4*)gain)[2 * lane], g1 = ((const GAS f32x4*)gain)[2 * lane + 1], g2 = ((const GAS f32x4*)gain)[128 + 2 * lane], g3 = ((const GAS f32x4*)gain)[128 + 2 * lane + 1];
#pragma unroll
    for (int i = 0; i < 4; ++i) { v[i] *= rstd * g0[i]; v[4 + i] *= rstd * g1[i]; v[8 + i] *= rstd * g2[i]; v[12 + i] *= rstd * g3[i]; }
}
__device__ __forceinline__ void norm_phase(Frame& F, const float* srcf, const bf16* srcb, const float* gain) {
    const int gw = F.vcu * NWAVES + F.wave, NGW = F.G * NWAVES;
    if (srcf) { for (int m = gw; m < M; m += 2 * NGW) { f32x4 v[4], w[4]; const int mb = m + NGW;
            const GAS f32x4* xa = (const GAS f32x4*)(srcf + (size_t)m * DM) + F.lane; const GAS f32x4* xb = (const GAS f32x4*)(srcf + (size_t)(mb < M ? mb : m) * DM) + F.lane;
#pragma unroll
            for (int j = 0; j < 4; ++j) { v[j] = xa[64 * j]; w[j] = xb[64 * j]; }
            float sa = 0.f, sb = 0.f;
#pragma unroll
            for (int j = 0; j < 4; ++j) { sa += (v[j].x * v[j].x + v[j].y * v[j].y) + (v[j].z * v[j].z + v[j].w * v[j].w); sb += (w[j].x * w[j].x + w[j].y * w[j].y) + (w[j].z * w[j].z + w[j].w * w[j].w); }
            const float ra = 1.0f / sqrtf(wave_sum(sa) * (1.f / DM) + RMS_EPS), rb = 1.0f / sqrtf(wave_sum(sb) * (1.f / DM) + RMS_EPS);
#pragma unroll
            for (int j = 0; j < 4; ++j) { const f32x4 g = ((const GAS f32x4*)gain)[F.lane + 64 * j]; v[j] = v[j] * ra * g; w[j] = w[j] * rb * g; }
            store_row_bf16(WSP(bf16, WS_XN) + (size_t)m * DM, F.lane, v); if (mb < M) store_row_bf16(WSP(bf16, WS_XN) + (size_t)mb * DM, F.lane, w); } }
    else { for (int m = gw; m < M; m += NGW) { float v[16]; load_row_bf16(srcb + (size_t)m * DM, F.lane, v); rms16(v, gain, F.lane); store_row16_bf16(WSP(bf16, WS_XN) + (size_t)m * DM, F.lane, v); } }
}

struct SrcCol { const float* W; int col; int ldw; };
template <class Fn>
__device__ __forceinline__ void xpose_load(const Fn& fn, int K, const float* kgain, int item, int lane, float (&v)[32]) {
    const int nkb = K / 64, rb = item / nkb, kb = item % nkb, k0 = 64 * kb, r0 = 32 * rb;
    const SrcCol s = fn(r0 + (lane & 31));
#pragma unroll
    for (int i = 0; i < 32; ++i) { const int kk = 2 * i + (lane >> 5); float x = 0.f; if (s.W) { x = s.W[(size_t)(k0 + kk) * s.ldw + s.col]; if (kgain) x *= kgain[k0 + kk]; } v[i] = x; }
}
__device__ __forceinline__ void xpose_store(int K, bf16* WT, LAS float* scr, int item, int lane, const float (&v)[32]) {
    const int nkb = K / 64, rb = item / nkb, kb = item % nkb, k0 = 64 * kb, r0 = 32 * rb;
#pragma unroll
    for (int i = 0; i < 32; ++i) scr[(2 * i + (lane >> 5)) * 33 + (lane & 31)] = v[i];
    LDS_WAIT(); asm volatile("" ::: "memory");
    const int c = lane & 7;
#pragma unroll
    for (int j = 0; j < 4; ++j) { const int n = (lane >> 3) + 8 * j; const LAS float* sp = scr + (8 * c) * 33 + n;
        v4u o; o.x = cvtpk(sp[0 * 33], sp[1 * 33]); o.y = cvtpk(sp[2 * 33], sp[3 * 33]); o.z = cvtpk(sp[4 * 33], sp[5 * 33]); o.w = cvtpk(sp[6 * 33], sp[7 * 33]);
        *(GAS v4u*)(WT + (size_t)(r0 + n) * K + k0 + 8 * c) = o; }
    LDS_WAIT(); asm volatile("" ::: "memory");
}
template <class Fn>
__device__ __forceinline__ void xpose_matrix(const Fn& fn, int K, bf16* WT, const float* kgain, LAS float* scr, int first, int nitems, int stride, int lane) {
    float va[32], vb[32];
    int it = first;
    if (it < nitems) xpose_load(fn, K, kgain, it, lane, va);
    while (it < nitems) {
        const int i1 = it + stride, i2 = i1 + stride;
        if (i1 < nitems) xpose_load(fn, K, kgain, i1, lane, vb);
        xpose_store(K, WT, scr, it, lane, va);
        if (i1 >= nitems) break;
        if (i2 < nitems) xpose_load(fn, K, kgain, i2, lane, va);
        xpose_store(K, WT, scr, i1, lane, vb);
        it = i2;
    }
}
__device__ __forceinline__ int incol(int rho) {
    const int g = rho >> 7, c = rho & 127;
    if (g < 4) return rho;
    if (g < 6) return 512 + (rho - 512);
    if (g < 8) return 768 + (rho - 768);
    if (g < 12) return 1092 + (rho - 1024);
    if (g < 18) return 1604 + (rho - 1536);
    if (g == 18) { if (c < 64) return 1024 + c; if (c < 68) return 1088 + (c - 64); if (c < 80) return 2372 + (c - 68); return -1; }
    return -1;
}
struct FnIn { const float* W; __device__ __forceinline__ SrcCol operator()(int r) const { const int c = incol(r); return SrcCol{c >= 0 ? W : nullptr, c, 2384}; } };
struct FnPlain { const float* W; int ldw; int coff; __device__ __forceinline__ SrcCol operator()(int r) const { return SrcCol{W, r + coff, ldw}; } };
struct FnGU { const float* Wg; const float* Wu; int ldw; __device__ __forceinline__ SrcCol operator()(int r) const { const int pn = r >> 8, c = r & 127;
    const long long d = (r & 128) ? ((const char*)Wu - (const char*)Wg) : 0ll;
    return SrcCol{(const float*)((const char*)Wg + d), pn * 128 + c, ldw}; } };
namespace att {
constexpr int KVBLK = 64, SHM_K = KVBLK * 128 * 2, SHM_V = KVBLK * 128 * 2;
#define KSWZ(row, colB) ((row) * 256 + ((colB) ^ (((row) & 7) << 4)))
__device__ __forceinline__ int v_st(int k, int c) { const int kk = (k & ~0xC) | ((k & 4) << 1) | ((k & 8) >> 1); return ((kk >> 3) * 4 + (c >> 5)) * 512 + ((kk & 7) * 32 + (c & 31)) * 2; }
__device__ __forceinline__ int v_rd_base(int lane) { return ((lane & 3) << 3) | (((lane >> 2) & 3) << 6) | (((lane >> 4) & 1) << 5) | (((lane >> 5) & 1) << 8); }
constexpr int v_rd_off(int d0, int ks, int half) { return d0 * 512 + ks * 4096 + half * 2048; }
__device__ __forceinline__ int crow(int r, int hi) { return (r & 3) + 8 * (r >> 2) + 4 * hi; }
__device__ __forceinline__ void qkt(f32x16& p0, f32x16& p1, const char* K_lds, int r32, int hi, const bf16x8* qr) {
    p0 = f32x16{}; p1 = f32x16{};
    const char* kb[4];
#pragma unroll
    for (int dd = 0; dd < 4; ++dd) kb[dd] = K_lds + KSWZ(r32, (dd * 16 + hi * 8) * 2);
#pragma unroll
    for (int d0 = 0; d0 < 8; ++d0) { const char* a = kb[d0 & 3] + (d0 >> 2) * 128;
        bf16x8 b0 = *reinterpret_cast<const bf16x8*>(a);
        bf16x8 b1 = *reinterpret_cast<const bf16x8*>(a + 32 * 256);
        p0 = __builtin_amdgcn_mfma_f32_32x32x16_bf16(b0, qr[d0], p0, 0, 0, 0);
        p1 = __builtin_amdgcn_mfma_f32_32x32x16_bf16(b1, qr[d0], p1, 0, 0, 0);
        if (d0 == 3) SBAR(); }
}
__device__ __forceinline__ void qkt_lq(f32x16& p0, f32x16& p1, const char* K_lds, const char* Q_lds, int r32, int hi) {
    p0 = f32x16{}; p1 = f32x16{};
    int ko[4];
#pragma unroll
    for (int dd = 0; dd < 4; ++dd) ko[dd] = KSWZ(r32, (dd * 16 + hi * 8) * 2);
#pragma unroll
    for (int d0 = 0; d0 < 8; ++d0) { const int a = ko[d0 & 3] + (d0 >> 2) * 128;
        bf16x8 b0 = *reinterpret_cast<const bf16x8*>(K_lds + a);
        bf16x8 b1 = *reinterpret_cast<const bf16x8*>(K_lds + a + 32 * 256);
        bf16x8 q = *reinterpret_cast<const bf16x8*>(Q_lds + a);
        p0 = __builtin_amdgcn_mfma_f32_32x32x16_bf16(b0, q, p0, 0, 0, 0);
        p1 = __builtin_amdgcn_mfma_f32_32x32x16_bf16(b1, q, p1, 0, 0, 0);
        if (d0 == 3) SBAR(); }
}
__device__ __forceinline__ void pv_tile(f32x16* o, int vb0, bf16x8 pa0, bf16x8 pa1, bf16x8 pa2, bf16x8 pa3) {
#define TRRD(dst, off) asm volatile("ds_read_b64_tr_b16 %0, %1 offset:%2" : "=&v"(dst) : "v"(vb0), "i"(off) : "memory")
#define PV_RD(S, d0) do { constexpr int b_ = v_rd_off(d0, 0, 0); \
        TRRD(S##l0, b_); TRRD(S##h0, b_ + 2048); TRRD(S##l1, b_ + 4096); TRRD(S##h1, b_ + 6144); TRRD(S##l2, b_ + 8192); TRRD(S##h2, b_ + 10240); TRRD(S##l3, b_ + 12288); TRRD(S##h3, b_ + 14336); } while (0)
#define PV_MM(S, d0) do { \
        o[d0] = __builtin_amdgcn_mfma_f32_32x32x16_bf16(pa0, (bf16x8){S##l0[0], S##l0[1], S##l0[2], S##l0[3], S##h0[0], S##h0[1], S##h0[2], S##h0[3]}, o[d0], 0, 0, 0);   \
        o[d0] = __builtin_amdgcn_mfma_f32_32x32x16_bf16(pa1, (bf16x8){S##l1[0], S##l1[1], S##l1[2], S##l1[3], S##h1[0], S##h1[1], S##h1[2], S##h1[3]}, o[d0], 0, 0, 0);   \
        o[d0] = __builtin_amdgcn_mfma_f32_32x32x16_bf16(pa2, (bf16x8){S##l2[0], S##l2[1], S##l2[2], S##l2[3], S##h2[0], S##h2[1], S##h2[2], S##h2[3]}, o[d0], 0, 0, 0);   \
        o[d0] = __builtin_amdgcn_mfma_f32_32x32x16_bf16(pa3, (bf16x8){S##l3[0], S##l3[1], S##l3[2], S##l3[3], S##h3[0], S##h3[1], S##h3[2], S##h3[3]}, o[d0], 0, 0, 0); } while (0)
    s16x4 Al0, Al1, Al2, Al3, Ah0, Ah1, Ah2, Ah3, Bl0, Bl1, Bl2, Bl3, Bh0, Bh1, Bh2, Bh3;
    PV_RD(A, 0); PV_RD(B, 1);
    asm volatile("s_waitcnt lgkmcnt(8)" ::: "memory"); SBAR(); PV_MM(A, 0); SBAR();
    PV_RD(A, 2);
    asm volatile("s_waitcnt lgkmcnt(8)" ::: "memory"); SBAR(); PV_MM(B, 1); SBAR();
    PV_RD(B, 3);
    asm volatile("s_waitcnt lgkmcnt(8)" ::: "memory"); SBAR(); PV_MM(A, 2); SBAR();
    asm volatile("s_waitcnt lgkmcnt(0)" ::: "memory"); SBAR(); PV_MM(B, 3);
#undef PV_RD
#undef PV_MM
#undef TRRD
}
__device__ __forceinline__ void pack_p(const f32x16& p0, const f32x16& p1, bf16x8& pa0, bf16x8& pa1, bf16x8& pa2, bf16x8& pa3) {
#define PK4(P, B_, OUT) do { unsigned a0 = cvtpk(P[B_+0], P[B_+1]), a1 = cvtpk(P[B_+2], P[B_+3]);                          \
        unsigned b0 = cvtpk(P[B_+4], P[B_+5]), b1 = cvtpk(P[B_+6], P[B_+7]);                                             \
        auto r0 = __builtin_amdgcn_permlane32_swap(a0, b0, false, false); auto r1 = __builtin_amdgcn_permlane32_swap(a1, b1, false, false); \
        v4u w = {r0[0], r1[0], r0[1], r1[1]}; OUT = __builtin_bit_cast(bf16x8, w); } while (0)
    PK4(p0, 0, pa0); PK4(p0, 8, pa1); PK4(p1, 0, pa2); PK4(p1, 8, pa3);
#undef PK4
}
__device__ __forceinline__ float xhalf_max(float v) { auto rr = __builtin_amdgcn_permlane32_swap(__float_as_uint(v), __float_as_uint(v), false, false); return fmaxf(__uint_as_float(rr[0]), __uint_as_float(rr[1])); }
__device__ __forceinline__ float xhalf_sum(float v) { auto rr = __builtin_amdgcn_permlane32_swap(__float_as_uint(v), __float_as_uint(v), false, false); return __uint_as_float(rr[0]) + __uint_as_float(rr[1]); }
typedef float f32x8v __attribute__((ext_vector_type(8)));
typedef float f32x4v __attribute__((ext_vector_type(4)));
typedef float f32x2v __attribute__((ext_vector_type(2)));
__device__ __forceinline__ float sum32(const f32x16& a, const f32x16& b) {
    const f32x16 s = a + b;
    const f32x8v h = __builtin_shufflevector(s, s, 0, 1, 2, 3, 4, 5, 6, 7) + __builtin_shufflevector(s, s, 8, 9, 10, 11, 12, 13, 14, 15);
    const f32x4v f = __builtin_shufflevector(h, h, 0, 1, 2, 3) + __builtin_shufflevector(h, h, 4, 5, 6, 7);
    const f32x2v t = __builtin_shufflevector(f, f, 0, 1) + __builtin_shufflevector(f, f, 2, 3);
    return t[0] + t[1];
}
__device__ __forceinline__ void softmax_step(f32x16& p0, f32x16& p1, float& m_reg, float& l_reg, f32x16* o, float* al_l, int r32, int hi) {
    float pmax = p0[0];
#pragma unroll
    for (int r = 1; r < 16; ++r) pmax = fmaxf(pmax, p0[r]);
#pragma unroll
    for (int r = 0; r < 16; ++r) pmax = fmaxf(pmax, p1[r]);
    pmax = xhalf_max(pmax);
    float mn, alpha;
    if (__all(pmax - m_reg <= 8.f)) { mn = m_reg; alpha = 1.f; }
    else { mn = fmaxf(m_reg, pmax); alpha = __builtin_amdgcn_exp2f(m_reg - mn); m_reg = mn; }
    { const float nm = -mn; p0 = p0 + nm; p1 = p1 + nm; }
#pragma unroll
    for (int r = 0; r < 16; ++r) { p0[r] = __builtin_amdgcn_exp2f(p0[r]); p1[r] = __builtin_amdgcn_exp2f(p1[r]); }
    float ps = sum32(p0, p1);
    ps = xhalf_sum(ps);
    l_reg = l_reg * alpha + ps;
    if (__any(alpha < 1.f)) { if (hi == 0) al_l[r32] = alpha; asm volatile("s_waitcnt lgkmcnt(0)" ::: "memory");
#pragma unroll
        for (int d_ = 0; d_ < 4; ++d_)
#pragma unroll
            for (int r = 0; r < 16; ++r) o[d_][r] *= al_l[crow(r, hi)];
        asm volatile("s_waitcnt lgkmcnt(0)" ::: "memory"); }
}
__device__ __forceinline__ void softmax_step_row(f32x16& p0, f32x16& p1, bool on, float& m_reg, float& l_reg, f32x16* o, float* al_l, int r32, int hi) {
    float pmax = p0[0];
#pragma unroll
    for (int r = 1; r < 16; ++r) pmax = fmaxf(pmax, p0[r]);
#pragma unroll
    for (int r = 0; r < 16; ++r) pmax = fmaxf(pmax, p1[r]);
    pmax = on ? pmax : -__builtin_inff();
    pmax = xhalf_max(pmax);
    float mn, alpha;
    if (__all(pmax - m_reg <= 8.f)) { mn = m_reg; alpha = 1.f; }
    else { mn = fmaxf(m_reg, pmax); alpha = __builtin_amdgcn_exp2f(m_reg - mn); m_reg = mn; }
    const float me = on ? mn : __builtin_inff();
    { const float nm = -me; p0 = p0 + nm; p1 = p1 + nm; }
#pragma unroll
    for (int r = 0; r < 16; ++r) { p0[r] = __builtin_amdgcn_exp2f(p0[r]); p1[r] = __builtin_amdgcn_exp2f(p1[r]); }
    float ps = sum32(p0, p1);
    ps = xhalf_sum(ps);
    l_reg = l_reg * alpha + ps;
    if (__any(alpha < 1.f)) { if (hi == 0) al_l[r32] = alpha; asm volatile("s_waitcnt lgkmcnt(0)" ::: "memory");
#pragma unroll
        for (int d_ = 0; d_ < 4; ++d_)
#pragma unroll
            for (int r = 0; r < 16; ++r) o[d_][r] *= al_l[crow(r, hi)];
        asm volatile("s_waitcnt lgkmcnt(0)" ::: "memory"); }
}
struct DmaOff { unsigned k[2], v[2]; };
__device__ __forceinline__ void dma_offsets(DmaOff& d, int tid) {
#pragma unroll
    for (int i = 0; i < 2; ++i) { const int L = i * 8192 + tid * 16;
        const int row = L >> 8, pos = (L >> 4) & 15, c = pos ^ (row & 7); d.k[i] = (unsigned)(row * 256 + c * 16);
        const int sub = L >> 9, within = L & 511, kk = (sub >> 2) * 8 + (within >> 6), ccol = (within & 63) >> 1, cblk = sub & 3;
        const int k = (kk & ~0xC) | ((kk & 4) << 1) | ((kk & 8) >> 1); d.v[i] = (unsigned)(k * 256 + (cblk * 32 + ccol) * 2); }
}
__device__ __forceinline__ void dma_tile(const DmaOff& d, const bf16* Kp, const bf16* Vp, int key0, LAS unsigned char* buf, int wid) {
    const char* kb = (const char*)(Kp + (size_t)key0 * 128); const char* vb = (const char*)(Vp + (size_t)key0 * 128);
#pragma unroll
    for (int i = 0; i < 2; ++i) {
        __builtin_amdgcn_global_load_lds((const unsigned*)(kb + d.k[i]), (LAS unsigned*)(buf + 16384 + i * 8192 + wid * 1024), 16, 0, 0);
        __builtin_amdgcn_global_load_lds((const unsigned*)(vb + d.v[i]), (LAS unsigned*)(buf + i * 8192 + wid * 1024), 16, 0, 0); }
}
}
constexpr int AL_BUF = 0  , AL_Q = 65536  ;
constexpr int AL_WS = MISC_OFF + 2048  , AL_TBL = AL_WS + 2048  , AL_UNI = AL_TBL + 4 * 320 * 4  , AL_TRI = AL_UNI + 256  , AL_GB = AL_TRI + 2048  , AL_TBL132 = MISC_OFF + 12288  ;
static_assert(AL_Q + 65536 <= RING_BYTES && AL_GB + 128 <= AL_TBL132 && AL_TBL132 + 4 * 132 * 4 <= LDS_BYTES, "attention LDS map");

__device__ __forceinline__ void fill_bias_tbl132(Frame& F, float* tbl, int h0) {
    const float* rb = FIN(I_RELB);
    for (int i = F.tid; i < 4 * 132; i += NTHR) { const int h = i / 132, d = i % 132; const int dd = d > 128 ? 128 : d;
        tbl[i] = (rb[rel_bucket_dev(dd) * 8 + h0 + h] - rb[31 * 8 + h0 + h]) * LOG2E; }
}
__device__ __forceinline__ void fill_bias_tbl(Frame& F, float* tbl, int h0) {
    const float* rb = FIN(I_RELB);
    for (int i = F.tid; i < 4 * 320; i += NTHR) { const int h = i / 320, d = i % 320 - 96;
        tbl[i] = (d >= 0 && d < 113) ? (rb[rel_bucket_dev(d) * 8 + h0 + h] - rb[31 * 8 + h0 + h]) * LOG2E : 0.f; }
}

template <int MODE>
__device__ __forceinline__ void attn_unit(Frame& F, int b, int qt) {
    using namespace att;
    char* lds = F.ldsg;
    int tid = F.tid; asm volatile("" : "+v"(tid));
    const int wid = F.wave, lane = tid & 63, r32 = lane & 31, hi = lane >> 5;
    const int hd = wid & 3, qh = wid >> 2, q0 = qt * 64, tw = q0 + 32 * qh, t = tw + r32;
    const size_t rowg = (size_t)b * SEQ;
    float* wsf = (float*)(lds + AL_WS) + wid * 64; float* li_l = wsf; float* al_l = wsf + 32;
    const float* tbl = (const float*)(lds + AL_TBL) + hd * 320;
    const bf16* Qp = GRP((MODE == 0 ? G_QA : G_QB) + hd) + (rowg + t) * 128;
    const bf16* Kp = (MODE == 0 ? WSP(bf16, WS_AK) : MODE == 1 ? GRP(G_SK) : GRP(G_WK)) + rowg * 128;
    const bf16* Vp = (MODE == 0 ? WSP(bf16, WS_AV) : MODE == 1 ? GRP(G_SV) : GRP(G_WV)) + rowg * 128;
    bf16x8 qr[8];
#pragma unroll
    for (int d0 = 0; d0 < 8; ++d0) qr[d0] = *(const bf16x8*)(Qp + d0 * 16 + hi * 8);
    unsigned long long todo = (qt == 63) ? ~0ull : ((2ull << qt) - 1ull);
    unsigned long long bm64 = 0ull;
    if (MODE == 1) {
        bm64 = WSP(unsigned long long, WS_BLK)[rowg + t];
        volatile LAS unsigned* uni = (volatile LAS unsigned*)(F.lds + AL_UNI);
        if (tid < 2) uni[tid] = 0u;
        __syncthreads();
        __hip_atomic_fetch_or((LAS unsigned*)(F.lds + AL_UNI), (unsigned)bm64, __ATOMIC_RELAXED, __HIP_MEMORY_SCOPE_WORKGROUP);
        __hip_atomic_fetch_or((LAS unsigned*)(F.lds + AL_UNI) + 1, (unsigned)(bm64 >> 32), __ATOMIC_RELAXED, __HIP_MEMORY_SCOPE_WORKGROUP);
        __syncthreads();
        const unsigned long long um = (unsigned long long)uni[0] | ((unsigned long long)uni[1] << 32);
        todo &= um;
    }
    if (MODE == 2) { const int jl = q0 >= 511 ? ((q0 - 511) >> 6) : 0; todo &= ~((1ull << jl) - 1ull); }
    todo = ((unsigned long long)__builtin_amdgcn_readfirstlane((unsigned)todo)) | ((unsigned long long)__builtin_amdgcn_readfirstlane((unsigned)(todo >> 32)) << 32);
    const unsigned* bmrow = WSP(unsigned, WS_BM) + (rowg + t) * 128;
    float m_reg = -1e30f, l_reg = 0.f; f32x16 o[4] = {};
    const int vrb = v_rd_base(lane);
    DmaOff dof; dma_offsets(dof, tid);
    int j = __builtin_ctzll(todo); todo &= todo - 1ull;
    int buf = 0;
    v2u wsel = {0u, 0u}, wnx = {0u, 0u};
    if (MODE == 0) wnx = *(const v2u*)(bmrow + 2 * j);
    dma_tile(dof, Kp, Vp, j * 64, F.lds + AL_BUF, wid);
    for (;;) {
        asm volatile("s_waitcnt vmcnt(0)" ::: "memory");
        __syncthreads();
        const int jn = todo ? __builtin_ctzll(todo) : -1;
        if (MODE == 0) { wsel = wnx; if (jn >= 0) wnx = *(const v2u*)(bmrow + 2 * jn); }
        if (jn >= 0) { todo &= todo - 1ull; dma_tile(dof, Kp, Vp, jn * 64, F.lds + AL_BUF + (buf ^ 1) * 32768, wid); }
        const char* V_lds = lds + AL_BUF + buf * 32768; const char* K_lds = V_lds + 16384;
        const int vb0 = (int)(uintptr_t)(lds + AL_BUF + buf * 32768) + vrb;
        const int kb = j * 64;
        bool act = true;
        if (MODE == 1) act = __any((int)((bm64 >> j) & 1ull));
        if (MODE == 2) act = (kb <= tw + 31) && (kb + 63 >= tw - 511);
        if (MODE == 0) act = (kb <= tw + 31);
        if (act) {
            f32x16 p0, p1;
            qkt(p0, p1, K_lds, r32, hi, qr); SBAR();
            const float NEG = -__builtin_inff(); bool rowon = true;
            const int dq = t - kb - 4 * hi;
            if (tw - (kb + 63) < 128) {
                const float* tp = tbl + (dq + 37);
#pragma unroll
                for (int r = 0; r < 16; ++r) { const int c = (r & 3) + 8 * (r >> 2); p0[r] += tp[59 - c]; p1[r] += tp[27 - c]; }
            }
            if (MODE == 0) {
                const unsigned w0 = wsel.x >> (4 * hi), w1 = wsel.y >> (4 * hi);
#pragma unroll
                for (int r = 0; r < 16; ++r) { const int c = (r & 3) + 8 * (r >> 2);
                    const unsigned m0 = (unsigned)__builtin_amdgcn_sbfe((int)w0, c, 1), m1 = (unsigned)__builtin_amdgcn_sbfe((int)w1, c, 1);
                    p0[r] = __uint_as_float((__float_as_uint(p0[r]) & m0) | (0xff800000u & ~m0));
                    p1[r] = __uint_as_float((__float_as_uint(p1[r]) & m1) | (0xff800000u & ~m1)); }
            } else {
                if (MODE == 1) {
                    if (kb + 63 > tw) {
                        const int dqs = ((bm64 >> j) & 1ull) ? dq : -0x40000000;
#pragma unroll
                        for (int r = 0; r < 16; ++r) { const int c = (r & 3) + 8 * (r >> 2);
                            if (dqs < c) p0[r] = NEG;
                            if (dqs < c + 32) p1[r] = NEG; }
                    } else rowon = ((bm64 >> j) & 1ull) != 0ull;
                } else if (tw - (kb + 63) < 0 || tw + 31 - kb >= 512) {
#pragma unroll
                    for (int r = 0; r < 16; ++r) { const int c = (r & 3) + 8 * (r >> 2);
                        if ((unsigned)(dq - c) >= 512u) p0[r] = NEG;
                        if ((unsigned)(dq - c - 32) >= 512u) p1[r] = NEG; }
                }
            }
            SBAR(); if (MODE == 1) softmax_step_row(p0, p1, rowon, m_reg, l_reg, o, al_l, r32, hi); else softmax_step(p0, p1, m_reg, l_reg, o, al_l, r32, hi); SBAR();
            bf16x8 pa0, pa1, pa2, pa3;
            pack_p(p0, p1, pa0, pa1, pa2, pa3); SBAR();
            pv_tile(o, vb0, pa0, pa1, pa2, pa3); SBAR();
        }
        if (jn < 0) break;
        j = jn; buf ^= 1;
    }
    {
        float fac = l_reg > 0.f ? 1.0f / l_reg : 0.f;
        if (MODE != 0) { const float gl = bf2f(GRP(G_MISC)[(rowg + t) * 128 + 68 + MODE * 4 + hd]); fac *= 1.0f / (1.0f + __expf(-gl)); }
        if (hi == 0) li_l[r32] = fac;
        asm volatile("s_waitcnt lgkmcnt(0)" ::: "memory");
        float rli[16];
#pragma unroll
        for (int r = 0; r < 16; ++r) rli[r] = li_l[crow(r, hi)];
        const size_t row0 = rowg + tw;
        if (MODE == 1) {
            const float* OCp = WSP(float, WS_OC) + row0 * 512 + hd * 128; float* OC2p = WSP(float, WS_OC2) + row0 * 512 + hd * 128;
#pragma unroll
            for (int r = 0; r < 16; ++r) { const int orow = crow(r, hi);
#pragma unroll
                for (int d0 = 0; d0 < 4; ++d0) { const size_t ix = (size_t)orow * 512 + d0 * 32 + r32; OC2p[ix] = OCp[ix] + o[d0][r] * rli[r]; } }
        } else {
            bf16* Op = WSP(bf16, WS_O) + row0 * DM + (MODE == 2 ? 512 : 0) + hd * 128;
            const float* OCp = WSP(float, WS_OC2) + row0 * 512 + hd * 128;
#pragma unroll
            for (int r = 0; r < 16; ++r) { const int orow = crow(r, hi);
#pragma unroll
                for (int d0 = 0; d0 < 4; ++d0) { float v = o[d0][r] * rli[r];
                    if (MODE == 2) v += OCp[(size_t)orow * 512 + d0 * 32 + r32];
                    const float vn = __shfl_xor(v, 1);
                    if ((r32 & 1) == 0) *(unsigned*)(Op + (size_t)orow * DM + d0 * 32 + r32) = cvtpk(v, vn); } }
        }
    }
    __syncthreads();
}
__device__ __forceinline__ float idx_k2f(unsigned k) { return __uint_as_float((k & 0x80000000u) ? (k & 0x7fffffffu) : ~k); }
__device__ __forceinline__ unsigned idx_f2k(float f) { const unsigned u = __float_as_uint(f); return (u >> 31) ? ~u : (u | 0x80000000u); }
__device__ __forceinline__ unsigned half_sum_dpp(unsigned x) {
    x += (unsigned)__builtin_amdgcn_update_dpp(0, (int)x, 0x111, 0xf, 0xf, true);
    x += (unsigned)__builtin_amdgcn_update_dpp(0, (int)x, 0x112, 0xf, 0xf, true);
    x += (unsigned)__builtin_amdgcn_update_dpp(0, (int)x, 0x114, 0xf, 0xf, true);
    x += (unsigned)__builtin_amdgcn_update_dpp(0, (int)x, 0x118, 0xf, 0xf, true);
    x += (unsigned)__builtin_amdgcn_update_dpp(0, (int)x, 0x142, 0xa, 0xf, true);
    return x;
}
constexpr int IL_CAND = MISC_OFF + 2048, IL_HIST = IL_CAND + 4096;
__device__ __forceinline__ unsigned wave_sum_dpp63(unsigned x) {
    x = half_sum_dpp(x); x += (unsigned)__builtin_amdgcn_update_dpp(0, (int)x, 0x143, 0xc, 0xf, true); return (unsigned)__builtin_amdgcn_readlane((int)x, 63); }
__device__ __forceinline__ void idx_unit(Frame& F, int b, int tq, unsigned sub) {
    int tid = F.tid; asm volatile("" : "+v"(tid));
    const int wid = F.wave, lane = tid & 63, r32 = lane & 31, hi = lane >> 5;
    const int t0 = tq * 8; const size_t rowg = (size_t)b * SEQ;
    unsigned* bmrow = WSP(unsigned, WS_BM) + (rowg + t0) * 128;
    const int NT = 2 * (t0 >> 6) + 2;
    if (t0 + 8 <= 256) {
        for (int i = tid; i < 8 * NT; i += NTHR) { const int q = i / NT, wd = i % NT, t = t0 + q, lo = wd * 32;
            const unsigned word = (t >= lo + 31) ? 0xffffffffu : (t < lo ? 0u : ((2u << (t - lo)) - 1u)); bmrow[q * 128 + wd] = word; }
        return;
    }
    LAS unsigned* S = (LAS unsigned*)F.lds;
    const bf16* misc = GRP(G_MISC);
    {
        bf16x8 aq[4];
        { const int ql = r32 >> 2, h = r32 & 3; const bf16* p = GRP(G_IQ + (h >> 1)) + (rowg + t0 + ql) * 128 + (h & 1) * 64 + hi * 8;
#pragma unroll
          for (int c = 0; c < 4; ++c) aq[c] = *(const bf16x8*)(p + c * 16); }
        float wq[4][4];
#pragma unroll
        for (int qj = 0; qj < 4; ++qj) { const v2u w = *(const v2u*)(misc + (rowg + t0 + 2 * qj + hi) * 128 + 64);
            wq[qj][0] = __uint_as_float(w.x << 16); wq[qj][1] = __uint_as_float(w.x & 0xffff0000u); wq[qj][2] = __uint_as_float(w.y << 16); wq[qj][3] = __uint_as_float(w.y & 0xffff0000u); }
#define IDX_LOAD(g, u0) do { _Pragma("unroll") for (int u = (u0); u < (u0) + 2; ++u) { int tile = wid + 8 * (4 * (g) + u); tile = tile < NT ? tile : NT - 1; const bf16* kp = misc + (rowg + tile * 32 + r32) * 128 + hi * 8; \
            _Pragma("unroll") for (int c = 0; c < 4; ++c) bk[u][c] = *(const bf16x8*)(kp + c * 16); } } while (0)
#define IDX_MMA(u0) do { _Pragma("unroll") for (int u = 0; u < 2; ++u) { acc[u] = f32x16{}; \
            _Pragma("unroll") for (int c = 0; c < 4; ++c) acc[u] = __builtin_amdgcn_mfma_f32_32x32x16_bf16(aq[c], bk[(u0) + u][c], acc[u], 0, 0, 0); } } while (0)
#define IDX_COMB(g, u0) do { _Pragma("unroll") for (int u = 0; u < 2; ++u) { const int tile = wid + 8 * (4 * (g) + (u0) + u), kb = tile * 32; \
            if (tile < NT) { _Pragma("unroll") for (int qj = 0; qj < 4; ++qj) { float s = 0.f; \
                _Pragma("unroll") for (int h = 0; h < 4; ++h) s = fmaf(fmaxf(acc[u][4 * qj + h], 0.f), wq[qj][h], s); \
                S[(2 * qj + hi) * 4096 + kb + r32] = (kb + r32 <= t0 + 2 * qj + hi) ? idx_f2k(s) : 0u; } } } } while (0)
#pragma unroll 1
        for (int rk = 0; rk < 1 + (int)(sub & 1u); ++rk) {
            bf16x8 bk[4][4]; f32x16 acc[2];
            IDX_LOAD(0, 0); IDX_LOAD(0, 2);
#pragma unroll
            for (int g = 0; g < 4; ++g) if (wid + 32 * g < NT) { const bool nx = g < 3 && wid + 32 * (g + 1) < NT;
                IDX_MMA(0); SBAR(); if (nx) IDX_LOAD(g + 1, 0); SBAR(); IDX_COMB(g, 0); SBAR();
                IDX_MMA(2); SBAR(); if (nx) IDX_LOAD(g + 1, 2); SBAR(); IDX_COMB(g, 2); SBAR(); }
        }
#undef IDX_LOAD
#undef IDX_MMA
#undef IDX_COMB
    }
    __syncthreads();
    const int t = t0 + wid, NJ = (t >> 6) + 1;
    unsigned kreg[64];
#pragma unroll
    for (int j = 0; j < 64; ++j) { const unsigned v = S[wid * 4096 + 64 * j + lane]; kreg[j] = (j < NJ) ? v : 0u; }
    const int NG = (NJ + 15) >> 4;
    unsigned lo = 1u, hi_ = 0xffffffffu, clo = (unsigned)(t + 1), chi = 0u; float wlo = 0.f, whi = 0.f; int last = 0;
#pragma unroll 1
    for (int rs = 0; rs < 1 + (int)((sub >> 1) & 1u); ++rs) {
    {
        LAS unsigned* hist = (LAS unsigned*)(F.lds + IL_HIST) + wid * 256;
        *(LAS v4u*)(hist + 4 * lane) = (v4u){0u, 0u, 0u, 0u};
        asm volatile("s_waitcnt lgkmcnt(0)" ::: "memory");
#pragma unroll
        for (int g = 0; g < 4; ++g) if (g < NG) {
#pragma unroll
            for (int j = 0; j < 16; ++j) { const unsigned k = kreg[16 * g + j];
                if (k) { int b_ = (int)floorf(idx_k2f(k)) + 128; b_ = b_ < 0 ? 0 : (b_ > 255 ? 255 : b_); __hip_atomic_fetch_add(hist + (255 - b_), 1u, __ATOMIC_RELAXED, __HIP_MEMORY_SCOPE_WAVEFRONT); } } }
        asm volatile("s_waitcnt lgkmcnt(0)" ::: "memory");
        const v4u h4 = *(LAS v4u*)(hist + 4 * lane);
        unsigned pre = h4.x + h4.y + h4.z + h4.w;
        pre += (unsigned)__builtin_amdgcn_update_dpp(0, (int)pre, 0x111, 0xf, 0xf, true);
        pre += (unsigned)__builtin_amdgcn_update_dpp(0, (int)pre, 0x112, 0xf, 0xf, true);
        pre += (unsigned)__builtin_amdgcn_update_dpp(0, (int)pre, 0x114, 0xf, 0xf, true);
        pre += (unsigned)__builtin_amdgcn_update_dpp(0, (int)pre, 0x118, 0xf, 0xf, true);
        pre += (unsigned)__builtin_amdgcn_update_dpp(0, (int)pre, 0x142, 0xa, 0xf, true);
        pre += (unsigned)__builtin_amdgcn_update_dpp(0, (int)pre, 0x143, 0xc, 0xf, true);
        const unsigned long long ge = __ballot(pre >= 256u);
        const int L = __builtin_ctzll(ge);
        const unsigned pL = (unsigned)__builtin_amdgcn_readlane((int)pre, L);
        const unsigned b0 = (unsigned)__builtin_amdgcn_readlane((int)h4.x, L), b1 = (unsigned)__builtin_amdgcn_readlane((int)h4.y, L), b2 = (unsigned)__builtin_amdgcn_readlane((int)h4.z, L), b3 = (unsigned)__builtin_amdgcn_readlane((int)h4.w, L);
        unsigned above = pL - (b0 + b1 + b2 + b3); int bsel = 4 * L; unsigned cb = b0;
        if (above + cb < 256u) { above += cb; cb = b1; bsel = 4 * L + 1; if (above + cb < 256u) { above += cb; cb = b2; bsel = 4 * L + 2; if (above + cb < 256u) { above += cb; cb = b3; bsel = 4 * L + 3; } } }
        const int B = 255 - bsel;
        lo = B == 0 ? 1u : idx_f2k((float)(B - 128)); hi_ = B == 255 ? 0xffffffffu : idx_f2k((float)(B - 127));
        chi = above; clo = above + cb;
    }
    wlo = (float)clo - 255.5f; whi = (float)chi - 255.5f; last = 0;
#pragma unroll 1
    for (int it = 0; it < 72; ++it) {
        if (clo - chi <= 64u || hi_ - lo == 1u) break;
        unsigned mid;
        { const float lf = idx_k2f(lo), hf = idx_k2f(hi_); float mf = lf + (hf - lf) * (wlo / (wlo - whi));
          mid = idx_f2k(mf);
          if (it >= 36 || !(fabsf(lf) < 1e30f && fabsf(hf) < 1e30f)) mid = lo + ((hi_ - lo) >> 1);
          mid = mid <= lo ? lo + 1u : (mid >= hi_ ? hi_ - 1u : mid);
          mid = (unsigned)__builtin_amdgcn_readfirstlane((int)mid); }
        unsigned cnt = 0u;
#pragma unroll
        for (int g = 0; g < 4; ++g) if (g < NG) {
#pragma unroll
            for (int j = 0; j < 16; ++j) cnt += (kreg[16 * g + j] >= mid) ? 1u : 0u; }
        const unsigned tot = wave_sum_dpp63(cnt);
        if (tot >= 256u) { lo = mid; clo = tot; wlo = (float)tot - 255.5f; if (last == 1) whi *= 0.5f; last = 1; }
        else { hi_ = mid; chi = tot; whi = (float)tot - 255.5f; if (last == 2) wlo *= 0.5f; last = 2; }
    }
    }
    unsigned T = lo; int J = 0x7fffffff; bool tie = true;
    const int need = 256 - (int)chi;
    if (clo - chi <= 64u) {
        volatile LAS unsigned* cand = (volatile LAS unsigned*)(F.lds + IL_CAND) + wid * 128;
        int pos = 0;
#pragma unroll
        for (int j = 0; j < 64; ++j) if ((j >> 4) < NG) { const unsigned kq = kreg[j]; const bool inb = kq >= lo && kq < hi_; const unsigned long long bal = __ballot(inb);
            if (bal) { const int slot = pos + __builtin_amdgcn_mbcnt_hi((unsigned)(bal >> 32), __builtin_amdgcn_mbcnt_lo((unsigned)bal, 0u));
                if (inb) { cand[2 * slot] = kreg[j]; cand[2 * slot + 1] = (unsigned)(64 * j + lane); } pos += __popcll(bal); } }
        const int m = pos;
        asm volatile("s_waitcnt lgkmcnt(0)" ::: "memory");
        const unsigned ki = lane < m ? cand[2 * lane] : 0u; const unsigned ii = lane < m ? cand[2 * lane + 1] : 0u;
        int rk = 0;
        for (int jx = 0; jx < m; ++jx) { const unsigned kj = (unsigned)__builtin_amdgcn_readlane((int)ki, jx), ij = (unsigned)__builtin_amdgcn_readlane((int)ii, jx); rk += (kj > ki || (kj == ki && ij < ii)) ? 1 : 0; }
        const unsigned long long hit = __ballot(lane < m && rk == need - 1);
        const int src = hit ? __builtin_ctzll(hit) : 0;
        T = (unsigned)__builtin_amdgcn_readlane((int)ki, src); J = (int)__builtin_amdgcn_readlane((int)ii, src);
        tie = __builtin_popcountll(__ballot(lane < m && ki == T)) != 1;
    } else if (clo > 256u) {
        int ilo = -1, ihi = t;
        for (int it = 0; it < 16 && ihi - ilo > 1; ++it) { const int imid = (ilo + ihi) >> 1; unsigned cnt = 0u;
#pragma unroll
            for (int j = 0; j < 64; ++j) if ((j >> 4) < NG) cnt += (kreg[j] == T && 64 * j + lane <= imid) ? 1u : 0u;
            const int tot = (int)wave_sum_dpp63(cnt);
            if (tot >= need) ihi = imid; else ilo = imid; }
        J = ihi;
    }
    unsigned long long w64 = 0ull;
    if (!tie) {
        int wl = 0, wh = 0;
#pragma unroll
        for (int j = 0; j < 64; ++j) if ((j >> 4) < NG) { const unsigned long long bal = __ballot(kreg[j] >= T); asm volatile("s_nop 4\n\tv_writelane_b32 %0, %2, %4\n\tv_writelane_b32 %1, %3, %4" : "+v"(wl), "+v"(wh) : "s"((unsigned)bal), "s"((unsigned)(bal >> 32)), "n"(j)); }
        w64 = (unsigned long long)(unsigned)wl | ((unsigned long long)(unsigned)wh << 32);
    } else {
#pragma unroll
        for (int j = 0; j < 64; ++j) if ((j >> 4) < NG) { const unsigned k = kreg[j]; const unsigned long long bal = __ballot(k > T || (k == T && 64 * j + lane <= J)); if (lane == j) w64 = bal; }
    }
    if (lane < NJ) *(unsigned long long*)(bmrow + wid * 128 + 2 * lane) = w64;
    __syncthreads();
}

__device__ __forceinline__ float gelu_tanh(float x) { const float y = 0.7978845608028654f * (x + 0.044715f * x * x * x); const float e = __expf(2.0f * y); return 0.5f * x * (2.0f - 2.0f / (1.0f + e)); }
__device__ __forceinline__ void cmp_finalize_item(Frame& F, int b, int j, int rc) {
    float* hid = (float*)F.ldsg + 2048;
    const float* W2 = FIN(I_EV_CW2) + (size_t)j * 128 * 128;
    const float* UV = WSP(float, WS_UV) + ((size_t)j * 2048 + (size_t)b * 256) * 256; const float* UVb = WSP(float, WS_UVB) + ((size_t)j * 2048 + (size_t)b * 256) * 256;
    const float* cbp = WSP(float, WS_TAB) + (size_t)j * 16 * 128;
    const int n0 = rc * 16;
    for (int i = F.tid; i < 16 * 128; i += NTHR) { const int r = i >> 7, c = i & 127, n = n0 + r;
        float cbv = 0.f;
#pragma unroll
        for (int q = 0; q < 16; ++q) cbv += cbp[q * 128 + c];
        float v = 0.f; if (n < 255) v = gelu_tanh((UV[(size_t)n * 256 + c] + UVb[(size_t)n * 256 + c]) + (UV[(size_t)(n + 1) * 256 + 128 + c] + UVb[(size_t)(n + 1) * 256 + 128 + c]) + cbv);
        hid[i] = v; }
    __syncthreads();
    const int c2 = F.tid & 127, rg = F.tid >> 7;
    float acc[4] = {0.f, 0.f, 0.f, 0.f};
#pragma unroll 4
    for (int c = 0; c < 128; ++c) { const float w = W2[c * 128 + c2];
#pragma unroll
        for (int q = 0; q < 4; ++q) acc[q] = fmaf(hid[(rg + 4 * q) * 128 + c], w, acc[q]); }
#pragma unroll
    for (int q = 0; q < 4; ++q) { const int n = n0 + rg + 4 * q; const float a = n >= 255 ? 0.f : acc[q];
        if (j == 0) WSP(bf16, WS_CK)[((size_t)b * 256 + n) * 128 + c2] = (bf16)f2bf(a);
        else WSP(bf16, WS_CV)[((size_t)b * 256 + n) * 128 + c2] = (bf16)f2bf(a); }
    __syncthreads();
}
constexpr int CL_S = 0;
constexpr int CL_P = 64 * 260 * 4;
constexpr int CL_IMP = CL_P + 64 * 264 * 2;
constexpr int CL_TBL = CL_IMP + 16 * 64 * 4;
static_assert(CL_TBL + 4 * 132 * 4 <= RING_BYTES, "cmp LDS map");
__device__ __forceinline__ void cmp_unit(Frame& F, int b, int qt16, unsigned sub) {
    char* lds = F.ldsg;
    float* S = (float*)(lds + CL_S); bf16* Pb = (bf16*)(lds + CL_P); float* impL = (float*)(lds + CL_IMP); const float* tbl = (const float*)(lds + CL_TBL);
    int tid = F.tid; asm volatile("" : "+v"(tid));
    const int wid = F.wave, lane = tid & 63, l15 = lane & 15, l4 = lane >> 4;
    const int q0 = qt16 * 16; const size_t rowg = (size_t)b * SEQ;
#pragma unroll 1
    for (int r1 = 0; r1 < 1 + (int)(sub & 1u); ++r1) {
    {
        const int rb = wid & 3;
        const bf16* qp = GRP(G_QB + rb) + (rowg + q0 + l15) * 128 + l4 * 8;
        bf16x8 qa[4];
#pragma unroll
        for (int c = 0; c < 4; ++c) qa[c] = *(const bf16x8*)(qp + c * 32);
        const bf16* ckb = WSP(bf16, WS_CK) + (size_t)b * 256 * 128;
#pragma unroll
        for (int i = 0; i < 8; ++i) { const int kb = (wid >> 2) * 8 + i;
            const bf16* kp = ckb + (size_t)(kb * 16 + l15) * 128 + l4 * 8;
            f32x4 acc = {0.f, 0.f, 0.f, 0.f};
#pragma unroll
            for (int c = 0; c < 4; ++c) { const bf16x8 bk = *(const bf16x8*)(kp + c * 32); acc = __builtin_amdgcn_mfma_f32_16x16x32_bf16(qa[c], bk, acc, 0, 0, 0); }
            const int n = kb * 16 + l15, kend = 16 * n + 31;
#pragma unroll
            for (int jj = 0; jj < 4; ++jj) { const int ql = l4 * 4 + jj, t = q0 + ql; int d = t - kend; const bool valid = (d >= 0) && (n < 255); d = d < 0 ? 0 : (d > 128 ? 128 : d);
                S[(rb * 16 + ql) * 260 + n] = valid ? acc[jj] + tbl[rb * 132 + d] : -__builtin_inff(); } }
    }
    __syncthreads();
#pragma unroll 1
    for (int rr = 0; rr < 8; ++rr) { const int row = wid * 8 + rr;
        f32x4 v = *(const f32x4*)(S + row * 260 + lane * 4);
        const float mx = wave_max(fmaxf(fmaxf(v[0], v[1]), fmaxf(v[2], v[3])));
        f32x4 p = {0.f, 0.f, 0.f, 0.f};
        if (mx > -1e37f) { p[0] = __builtin_amdgcn_exp2f(v[0] - mx); p[1] = __builtin_amdgcn_exp2f(v[1] - mx); p[2] = __builtin_amdgcn_exp2f(v[2] - mx); p[3] = __builtin_amdgcn_exp2f(v[3] - mx);
            const float inv = 1.0f / wave_sum((p[0] + p[1]) + (p[2] + p[3])); p = p * inv; }
        *(f32x4*)(S + row * 260 + lane * 4) = p;
        *(v2u*)(Pb + row * 264 + lane * 4) = (v2u){cvtpk(p[0], p[1]), cvtpk(p[2], p[3])}; }
    __syncthreads();
    }
#pragma unroll 1
    for (int r3 = 0; r3 < 1 + (int)((sub >> 1) & 1u); ++r3) {
    for (int i = tid; i < 16 * 64; i += NTHR) { const int q = i >> 6, m = i & 63; float s = 0.f;
#pragma unroll
        for (int h = 0; h < 4; ++h)
#pragma unroll
            for (int dn = -1; dn <= 3; ++dn) { const int n = 4 * m + dn; if (n >= 0 && n < 255) s += S[(h * 16 + q) * 260 + n]; }
        impL[i] = s; }
    __syncthreads();
#pragma unroll 1
    for (int qq = 0; qq < 2; ++qq) { const int q = wid * 2 + qq, t = q0 + q, cur = t >> 6, m = lane;
        const bool forced = (m == 0) || (m == cur) || (m == cur - 1);
        const bool cand = !forced && (m < cur);
        float val = cand ? impL[q * 64 + m] : -__builtin_inff();
        bool sel = forced;
        const int picks = 8 - __popcll(__ballot(forced));
        for (int p = 0; p < picks; ++p) { const float vm = wave_max(val); if (!(vm > -__builtin_inff())) break;
            const unsigned long long win = __ballot(val == vm); const int first = __builtin_ctzll(win);
            if (lane == first) { sel = true; val = -__builtin_inff(); } }
        const unsigned long long msk = __ballot(sel);
        if (lane == 0) WSP(unsigned long long, WS_BLK)[rowg + t] = msk; }
    }
#pragma unroll 1
    for (int r5 = 0; r5 < 1 + (int)((sub >> 2) & 1u); ++r5)
    {
        const int rb = wid & 3;
        const bf16* cvt = WSP(bf16, WS_CVT) + (size_t)b * 128 * 256;
        float g0[4];
#pragma unroll
        for (int jj = 0; jj < 4; ++jj) { const float gl = bf2f(GRP(G_MISC)[(rowg + q0 + l4 * 4 + jj) * 128 + 68 + rb]); g0[jj] = 1.0f / (1.0f + __expf(-gl)); }
#pragma unroll
        for (int i = 0; i < 4; ++i) { const int db = (wid >> 2) * 4 + i;
            f32x4 acc = {0.f, 0.f, 0.f, 0.f};
#pragma unroll
            for (int kc = 0; kc < 8; ++kc) { const bf16x8 pa = *(const bf16x8*)(Pb + (rb * 16 + l15) * 264 + kc * 32 + l4 * 8);
                const bf16x8 vb = *(const bf16x8*)(cvt + (size_t)(db * 16 + l15) * 256 + kc * 32 + l4 * 8);
                acc = __builtin_amdgcn_mfma_f32_16x16x32_bf16(pa, vb, acc, 0, 0, 0); }
#pragma unroll
            for (int jj = 0; jj < 4; ++jj) WSP(float, WS_OC)[(rowg + q0 + l4 * 4 + jj) * 512 + rb * 128 + db * 16 + l15] = acc[jj] * g0[jj]; }
    }
    __syncthreads();
}

constexpr int CL2_IMP = 65536;
__device__ __forceinline__ void cmp_unit64(Frame& F, int b, int qt) {
    using namespace att;
    char* lds = F.ldsg;
    int tid = F.tid; asm volatile("" : "+v"(tid));
    const int wid = F.wave, lane = tid & 63, r32 = lane & 31, hi = lane >> 5;
    const int hd = wid & 3, qh = wid >> 2, q0 = qt * 64, tw = q0 + 32 * qh, t = tw + r32;
    const size_t rowg = (size_t)b * SEQ;
    float* wsf = (float*)(lds + AL_WS) + wid * 64; float* li_l = wsf;
    const float* tbl = (const float*)(lds + AL_TBL132) + hd * 132;
    float* impW = (float*)(lds + CL2_IMP);
    const bf16* Qp = GRP(G_QB + hd) + (rowg + t) * 128;
    const bf16* Kp = WSP(bf16, WS_CK) + (size_t)b * 256 * 128; const bf16* Vp = WSP(bf16, WS_CV) + (size_t)b * 256 * 128;
    bf16x8 qr[8];
#pragma unroll
    for (int d0 = 0; d0 < 8; ++d0) qr[d0] = *(const bf16x8*)(Qp + d0 * 16 + hi * 8);
    const int vrb = v_rd_base(lane);
    DmaOff dof; dma_offsets(dof, tid);
    float m_reg = -1e30f, l_reg = 0.f;
    const float NEG = -__builtin_inff();
#define CMP_SCORES(j) \
            const char* V_lds = lds + AL_BUF + buf * 32768; const char* K_lds = V_lds + 16384; \
            f32x16 p0, p1; \
            qkt(p0, p1, K_lds, r32, hi, qr); SBAR(); \
            if (16 * (64 * (j) + 63) + 31 + 128 > tw) {            \
                _Pragma("unroll") for (int rq = 0; rq < 4; ++rq) { \
                    _Pragma("unroll") for (int ri = 0; ri < 4; ++ri) { const int r = 4 * rq + ri; const int n0 = 64 * (j) + (r & 3) + 8 * (r >> 2) + 4 * hi, n1 = n0 + 32; \
                        int d0 = t - (16 * n0 + 31), d1 = t - (16 * n1 + 31); \
                        const bool v0 = d0 >= 0, v1 = d1 >= 0 && n1 < 255; \
                        d0 = d0 < 0 ? 0 : (d0 > 128 ? 128 : d0); d1 = d1 < 0 ? 0 : (d1 > 128 ? 128 : d1); \
                        p0[r] = v0 ? p0[r] + tbl[d0] : NEG; p1[r] = v1 ? p1[r] + tbl[d1] : NEG; } \
                    SBAR(); } \
            } else if ((j) == 3) { if (hi == 1) p1[15] = NEG; }    \
            SBAR();
    {
        int buf = 0;
        dma_tile(dof, Kp, Vp, 0, F.lds + AL_BUF, wid);
#pragma unroll 1
        for (int j = 0; j < 4; ++j) {
            asm volatile("s_waitcnt vmcnt(0)" ::: "memory");
            __syncthreads();
            dma_tile(dof, Kp, Vp, ((j + 1) & 3) * 64, F.lds + AL_BUF + (buf ^ 1) * 32768, wid);
            CMP_SCORES(j)
            float pmax = p0[0];
#pragma unroll
            for (int r = 1; r < 16; ++r) pmax = fmaxf(pmax, p0[r]);
#pragma unroll
            for (int r = 0; r < 16; ++r) pmax = fmaxf(pmax, p1[r]);
            pmax = xhalf_max(pmax);
            const float mn = fmaxf(m_reg, pmax); float ps = 0.f;
#pragma unroll
            for (int r = 0; r < 16; ++r) ps += __builtin_amdgcn_exp2f(p0[r] - mn) + __builtin_amdgcn_exp2f(p1[r] - mn);
            ps = xhalf_sum(ps);
            l_reg = l_reg * __builtin_amdgcn_exp2f(m_reg - mn) + ps; m_reg = mn;
            buf ^= 1;
        }
    }
    const float inv_l = l_reg > 0.f ? 1.0f / l_reg : 0.f;
    float carry = 0.f; f32x16 o[4] = {};
    {
        int buf = 0;
#pragma unroll 1
        for (int j = 0; j < 4; ++j) {
            asm volatile("s_waitcnt vmcnt(0)" ::: "memory");
            __syncthreads();
            if (j < 3) dma_tile(dof, Kp, Vp, (j + 1) * 64, F.lds + AL_BUF + (buf ^ 1) * 32768, wid);
            CMP_SCORES(j)
            const int vb0 = (int)(uintptr_t)(lds + AL_BUF + buf * 32768) + vrb;
#pragma unroll
            for (int r = 0; r < 16; ++r) { p0[r] = __builtin_amdgcn_exp2f(p0[r] - m_reg) * inv_l; p1[r] = __builtin_amdgcn_exp2f(p1[r] - m_reg) * inv_l; }
            float oa[4], ob[4];
#pragma unroll
            for (int g = 0; g < 4; ++g) { auto ra = __builtin_amdgcn_permlane32_swap(__float_as_uint(p0[4 * g + 3]), __float_as_uint(p0[4 * g + 3]), false, false);
                auto rb = __builtin_amdgcn_permlane32_swap(__float_as_uint(p1[4 * g + 3]), __float_as_uint(p1[4 * g + 3]), false, false);
                oa[g] = __uint_as_float(hi ? ra[0] : ra[1]); ob[g] = __uint_as_float(hi ? rb[0] : rb[1]); }
            float* iw = impW + ((size_t)hd * 64 + 32 * qh + r32) * 64 + 16 * j + hi;
#pragma unroll
            for (int g = 0; g < 4; ++g) {
                const float pla = hi ? oa[g] : (g > 0 ? oa[g - 1] : carry);
                const float plb = hi ? ob[g] : (g > 0 ? ob[g - 1] : oa[3]);
                iw[2 * g] = ((p0[4 * g] + p0[4 * g + 1]) + (p0[4 * g + 2] + p0[4 * g + 3])) + pla;
                iw[8 + 2 * g] = ((p1[4 * g] + p1[4 * g + 1]) + (p1[4 * g + 2] + p1[4 * g + 3])) + plb; }
            carry = ob[3];
            bf16x8 pa0, pa1, pa2, pa3;
            pack_p(p0, p1, pa0, pa1, pa2, pa3); SBAR();
            pv_tile(o, vb0, pa0, pa1, pa2, pa3); SBAR();
            buf ^= 1;
        }
    }
#undef CMP_SCORES
    __syncthreads();
#pragma unroll 1
    for (int qq = 0; qq < 8; ++qq) { const int q = wid * 8 + qq, tq = q0 + q, cur = tq >> 6, m = lane;
        const bool forced = (m == 0) || (m == cur) || (m == cur - 1);
        const bool cand = !forced && (m < cur);
        float val = cand ? ((impW[(0 * 64 + q) * 64 + m] + impW[(1 * 64 + q) * 64 + m]) + (impW[(2 * 64 + q) * 64 + m] + impW[(3 * 64 + q) * 64 + m])) : -__builtin_inff();
        bool sel = forced;
        const int picks = 8 - __popcll(__ballot(forced));
        for (int p = 0; p < picks; ++p) { const float vm = wave_max(val); if (!(vm > -__builtin_inff())) break;
            const unsigned long long win = __ballot(val == vm); const int first = __builtin_ctzll(win);
            if (lane == first) { sel = true; val = -__builtin_inff(); } }
        const unsigned long long msk = __ballot(sel);
        if (lane == 0) WSP(unsigned long long, WS_BLK)[rowg + tq] = msk; }
    {
        const float gl = bf2f(GRP(G_MISC)[(rowg + t) * 128 + 68 + hd]);
        if (hi == 0) li_l[r32] = 1.0f / (1.0f + __expf(-gl));
        asm volatile("s_waitcnt lgkmcnt(0)" ::: "memory");
        float* OCp = WSP(float, WS_OC) + (rowg + tw) * 512 + hd * 128;
#pragma unroll
        for (int r = 0; r < 16; ++r) { const int orow = crow(r, hi); const float g0 = li_l[orow];
#pragma unroll
            for (int d0 = 0; d0 < 4; ++d0) OCp[(size_t)orow * 512 + d0 * 32 + r32] = o[d0][r] * g0; }
    }
    __syncthreads();
}
__device__ __forceinline__ void stick_unit(Frame& F, int b, int h, int qb) {
    using namespace att;
    char* lds = F.ldsg;
    int tid = F.tid; asm volatile("" : "+v"(tid));
    const int wid = F.wave, lane = tid & 63, r32 = lane & 31, hi = lane >> 5;
    const size_t rowg = (size_t)b * SEQ;
    const int tw = qb * 256 + wid * 32, t = tw + r32;
    const bf16* Qp = QKVG(h) + (rowg + t) * 128;
    const bf16* Kp = QKVG(8 + h) + rowg * 128;
    const bf16* Vp = QKVG(16 + h) + rowg * 128;
    char* Qw = lds + AL_Q + wid * 8192;
#pragma unroll
    for (int d0 = 0; d0 < 8; ++d0) { const bf16x8 v = *(const bf16x8*)(Qp + d0 * 16 + hi * 8); *(bf16x8*)(Qw + KSWZ(r32, (d0 * 16 + hi * 8) * 2)) = v; }
    asm volatile("s_waitcnt lgkmcnt(0)" ::: "memory");
    {
        bf16x8 trd0, trd1;
#pragma unroll
        for (int jj = 0; jj < 8; ++jj) { const int k0 = 8 * (jj >> 2) + 4 * hi + (jj & 3);
            trd0[jj] = (short)((k0 >= r32) ? 0x3F80 : 0); trd1[jj] = (short)((16 + k0 >= r32) ? 0x3F80 : 0); }
        if (wid == 0) { *(bf16x8*)(lds + AL_TRI + lane * 32) = trd0; *(bf16x8*)(lds + AL_TRI + lane * 32 + 16) = trd1; }
    }
    const bf16x8 ones = {(short)0x3F80, (short)0x3F80, (short)0x3F80, (short)0x3F80, (short)0x3F80, (short)0x3F80, (short)0x3F80, (short)0x3F80};
    f32x16 o[4] = {};
    float carry = 0.f;
    const int vrb = v_rd_base(lane);
    DmaOff dof; dma_offsets(dof, tid);
    int j = qb * 4 + 3, buf = 0;
    bool wdone = false; int par = 0;
    volatile LAS unsigned* fl = (volatile LAS unsigned*)(F.lds + AL_UNI + 64);
    dma_tile(dof, Kp, Vp, j * 64, F.lds + AL_BUF, wid);
    for (;;) {
        if (lane == 0) fl[par * 8 + wid] = wdone ? 1u : 0u;
        asm volatile("s_waitcnt vmcnt(0)" ::: "memory");
        __syncthreads();
        { unsigned a = 1u;
#pragma unroll
          for (int w = 0; w < 8; ++w) a &= fl[par * 8 + w];
          par ^= 1; if (a) break; }
        if (j > 0) dma_tile(dof, Kp, Vp, (j - 1) * 64, F.lds + AL_BUF + (buf ^ 1) * 32768, wid);
        const char* K_lds = lds + AL_BUF + buf * 32768 + 16384;
        const int vb0 = (int)(uintptr_t)(lds + AL_BUF + buf * 32768) + vrb;
        const int kb = j * 64;
        if (!wdone && kb < tw + 32) {
            f32x16 s0, s1;
            qkt_lq(s0, s1, K_lds, Qw, r32, hi);
            const int dq = t - kb - 4 * hi;
            const bool diag = (kb + 63 >= tw);
            bf16x8 cb0, cb1, cb2, cb3; float csum = 0.f;
#define ST_C(ZV, OFF, R) ({ const int c_ = ((R) & 3) + 8 * ((R) >> 2); float z_ = ZV[R]; \
                float a_ = -__builtin_amdgcn_logf(1.0f + __builtin_amdgcn_exp2f(fminf(z_, 126.f))); a_ = fminf(a_, -z_); \
                if (diag && (dq - c_ - (OFF) < 1)) { a_ = 0.f; z_ = -__builtin_inff(); } \
                csum += a_; ZV[R] = z_ + carry; a_; })
#define ST_PK(ZV, OFF, B_) ({ v4u w_; { const float e0 = ST_C(ZV, OFF, B_ + 0), e1 = ST_C(ZV, OFF, B_ + 1), e2 = ST_C(ZV, OFF, B_ + 2), e3 = ST_C(ZV, OFF, B_ + 3); w_.x = cvtpk(e0, e1); w_.y = cvtpk(e2, e3); } SBAR(); \
                { const float e4 = ST_C(ZV, OFF, B_ + 4), e5 = ST_C(ZV, OFF, B_ + 5), e6 = ST_C(ZV, OFF, B_ + 6), e7 = ST_C(ZV, OFF, B_ + 7); w_.z = cvtpk(e4, e5); w_.w = cvtpk(e6, e7); } __builtin_bit_cast(bf16x8, w_); })
            SBAR(); cb0 = ST_PK(s0, 0, 0); SBAR(); cb1 = ST_PK(s0, 0, 8); SBAR(); cb2 = ST_PK(s1, 32, 0); SBAR(); cb3 = ST_PK(s1, 32, 8); SBAR();
#undef ST_PK
#undef ST_C
            const bf16x8 trd0 = *(const bf16x8*)(lds + AL_TRI + lane * 32), trd1 = *(const bf16x8*)(lds + AL_TRI + lane * 32 + 16);
            s1 = __builtin_amdgcn_mfma_f32_32x32x16_bf16(trd0, cb2, s1, 0, 0, 0);
            s1 = __builtin_amdgcn_mfma_f32_32x32x16_bf16(trd1, cb3, s1, 0, 0, 0);
            s0 = __builtin_amdgcn_mfma_f32_32x32x16_bf16(trd0, cb0, s0, 0, 0, 0);
            s0 = __builtin_amdgcn_mfma_f32_32x32x16_bf16(trd1, cb1, s0, 0, 0, 0);
            s0 = __builtin_amdgcn_mfma_f32_32x32x16_bf16(ones, cb2, s0, 0, 0, 0);
            s0 = __builtin_amdgcn_mfma_f32_32x32x16_bf16(ones, cb3, s0, 0, 0, 0);
            carry += xhalf_sum(csum);
#pragma unroll
            for (int r = 0; r < 16; ++r) { s0[r] = __builtin_amdgcn_exp2f(s0[r]); s1[r] = __builtin_amdgcn_exp2f(s1[r]); }
            bf16x8 pa0, pa1, pa2, pa3;
            pack_p(s0, s1, pa0, pa1, pa2, pa3);
            pv_tile(o, vb0, pa0, pa1, pa2, pa3);
            if (__all(carry < -160.f)) wdone = true;
        }
        if (j == 0) wdone = true;
        j = j > 0 ? j - 1 : 0; buf ^= 1;
    }
    asm volatile("s_waitcnt vmcnt(0)" ::: "memory");
    bf16* Op = WSP(bf16, WS_O) + (rowg + tw) * DM + h * 128;
#pragma unroll
    for (int r = 0; r < 16; ++r) { const int orow = crow(r, hi);
#pragma unroll
        for (int d0 = 0; d0 < 4; ++d0) { const float v = o[d0][r]; const float vn = __shfl_xor(v, 1);
            if ((r32 & 1) == 0) *(unsigned*)(Op + (size_t)orow * DM + d0 * 32 + r32) = cvtpk(v, vn); } }
    __syncthreads();
}
__device__ __forceinline__ void router_phase(Frame& F) {
    const int lane = F.lane;
    const float* wr = FIN(I_OD_WR);
    int* list = WSP(int, WS_LIST); float* gwt = WSP(float, WS_GW);
    volatile LAS unsigned* lcnt = (volatile LAS unsigned*)(F.lds);
    volatile LAS unsigned* rec = (volatile LAS unsigned*)(F.lds + 256);
    const int nper = (M + F.G - 1) / F.G, m0 = (int)blockIdx.x * nper, m1 = (m0 + nper < M) ? m0 + nper : M;
    if (F.tid < 32) lcnt[F.tid] = 0u;
    __syncthreads();
    f32x4 wq[16][2];
#pragma unroll
    for (int i = 0; i < 16; ++i) { const int k = (i < 8 ? 0 : 512) + 8 * lane + (i & 7); wq[i][0] = *(const f32x4*)(wr + (size_t)k * 8); wq[i][1] = *(const f32x4*)(wr + (size_t)k * 8 + 4); }
    for (int m = m0 + F.wave; m < m1; m += NWAVES) {
        float v[16]; load_row_bf16(WSP(bf16, WS_XB3) + (size_t)m * DM, lane, v); rms16(v, FIN(I_OD_NFFN), lane);
        float lg[8];
#pragma unroll
        for (int e = 0; e < 8; ++e) lg[e] = 0.f;
#pragma unroll
        for (int i = 0; i < 16; ++i) { const f32x4 w0 = wq[i][0], w1 = wq[i][1]; const float x = v[i];
            lg[0] = fmaf(x, w0[0], lg[0]); lg[1] = fmaf(x, w0[1], lg[1]); lg[2] = fmaf(x, w0[2], lg[2]); lg[3] = fmaf(x, w0[3], lg[3]);
            lg[4] = fmaf(x, w1[0], lg[4]); lg[5] = fmaf(x, w1[1], lg[5]); lg[6] = fmaf(x, w1[2], lg[6]); lg[7] = fmaf(x, w1[3], lg[7]); }
#pragma unroll
        for (int e = 0; e < 8; ++e) lg[e] = wave_sum(lg[e]);
        int i0 = 0; float v0 = lg[0];
#pragma unroll
        for (int e = 1; e < 8; ++e) if (lg[e] > v0) { v0 = lg[e]; i0 = e; }
        int i1 = -1; float v1 = -__builtin_inff();
#pragma unroll
        for (int e = 0; e < 8; ++e) if (e != i0 && lg[e] > v1) { v1 = lg[e]; i1 = e; }
        const float e1 = __expf(v1 - v0), w0 = 1.0f / (1.0f + e1), w1 = e1 * w0;
        if (lane == 0) {
            const unsigned s0 = __hip_atomic_fetch_add((LAS unsigned*)F.lds + i0, 1u, __ATOMIC_RELAXED, __HIP_MEMORY_SCOPE_WORKGROUP);
            const unsigned s1 = __hip_atomic_fetch_add((LAS unsigned*)F.lds + 8 + i1, 1u, __ATOMIC_RELAXED, __HIP_MEMORY_SCOPE_WORKGROUP);
            rec[2 * (m - m0)] = (unsigned)i0 | (s0 << 8); rec[2 * (m - m0) + 1] = (unsigned)i1 | (s1 << 8);
            gwt[m] = w0; gwt[M + m] = w1;
        }
    }
    __syncthreads();
    if (F.tid < 16) lcnt[16 + F.tid] = atomicAdd((unsigned*)(F.ctl + CW_CNT) + F.tid, lcnt[F.tid]);
    __syncthreads();
    for (int i = F.tid; i < m1 - m0; i += NTHR) { const unsigned r0 = rec[2 * i], r1 = rec[2 * i + 1]; const int i0 = r0 & 255, i1 = r1 & 255;
        list[(size_t)i0 * M + lcnt[16 + i0] + (r0 >> 8)] = m0 + i; list[(size_t)(8 + i1) * M + lcnt[24 + i1] + (r1 >> 8)] = m0 + i; }
    __syncthreads();
}
struct MoeLayout { int off[17]; };
__device__ __forceinline__ void moe_layout(Frame& F, MoeLayout& L) {
    int o = 0;
#pragma unroll
    for (int l = 0; l < 16; ++l) { L.off[l] = o; const int c = (int)__hip_atomic_load(F.ctl + CW_CNT + l, RLX_AGENT); o += (c + 255) & ~255; }
    L.off[16] = o;
}
__device__ __forceinline__ void gather_phase(Frame& F) {
    const int gw = F.vcu * NWAVES + F.wave, NGW = F.G * NWAVES, lane = F.lane;
    MoeLayout L; moe_layout(F, L);
    const int* list = WSP(int, WS_LIST); int* inv = WSP(int, WS_INV); float* gws = WSP(float, WS_GWS); const float* gwt = WSP(float, WS_GW);
    bf16* XS = WSP(bf16, WS_XS);
    for (int s = gw; s < L.off[16]; s += NGW) {
        int l = 0, offl = 0;
#pragma unroll
        for (int q = 1; q < 16; ++q) if (s >= L.off[q]) { l = q; offl = L.off[q]; }
        const int idx = s - offl; const int c = (int)__hip_atomic_load(F.ctl + CW_CNT + l, RLX_AGENT);
        const int t = idx < c ? list[(size_t)l * M + idx] : -1;
        float v[16];
        if (t >= 0) { load_row_bf16(WSP(bf16, WS_XB3) + (size_t)t * DM, lane, v); rms16(v, FIN(I_OD_NFFN), lane); }
        else {
#pragma unroll
            for (int i = 0; i < 16; ++i) v[i] = 0.f; }
        store_row16_bf16(XS + (size_t)s * DM, lane, v);
        if (lane == 0) { const int k = l >> 3; gws[s] = t >= 0 ? gwt[(size_t)k * M + t] : 0.f; if (t >= 0) inv[(size_t)k * M + t] = s; }
    }
}
struct MoeSched {
    pg8::GridOrder o; int t0; const char* A; size_t tstepA; const char* W; size_t tstepB; int off[17]; bool a_local; const char* A2;
    __device__ __forceinline__ bool next(int i, pg8::Unit& u) const {
        int pm, pn; if (!o.at(i, pm, pn)) return false; pm += t0; u.pm = pm; u.pn = pn;
        int l = 0;
#pragma unroll
        for (int q = 1; q < 16; ++q) if (pm * 256 >= off[q]) l = q;
        const int lt = pm - t0;
        u.aux = l; u.A = !a_local ? A + (size_t)pm * tstepA : (lt >= HM_SPLIT ? A2 + (size_t)(lt - HM_SPLIT) * tstepA : A + (size_t)lt * tstepA); u.B = W + (size_t)(l & 7) * MW_E + (size_t)pn * tstepB; return true;
    }
};

struct MoeSplitSched {
    pg8::GridOrder o; int t0; const char* A; size_t tstepA; const char* W; size_t tstepB; int off[17];
    __device__ __forceinline__ bool next(int i, pg8::Unit& u) const {
        int pm, pn; if (!o.at(i, pm, pn)) return false; pm += t0; u.pm = pm; u.pn = pn;
        int l = 0;
#pragma unroll
        for (int q = 1; q < 16; ++q) if (pm * 256 >= off[q]) l = q;
        u.aux = l; const size_t ko = (size_t)(pn >> 2) * (EFF / MOE_SPLITS) * 2;
        u.A = A + (size_t)(pm - t0) * tstepA + ko; u.B = W + (size_t)(l & 7) * MW_E + (size_t)(pn & 3) * tstepB + ko; return true;
    }
};

constexpr int N_PHASES = 27;
struct Args { const float* in[N_IN]; float* out; unsigned char* ws; int ph_lo, ph_hi; unsigned rep_mask, pad; };
__global__ void __launch_bounds__(NTHR, 2) fwd(Args args) {
    extern __shared__ __attribute__((aligned(16))) unsigned char lds[];
    Frame F;
    F.lds = (LAS unsigned char*)lds; F.ldsg = (char*)lds;
    F.MISC = (volatile LAS unsigned*)(F.lds + MISC_OFF);
    F.tid = threadIdx.x; F.lane = F.tid & 63; F.wave = __builtin_amdgcn_readfirstlane(F.tid >> 6);
    F.G = gridDim.x; { const int bx = blockIdx.x; F.vcu = (F.G % 8 == 0) ? (bx % 8) * (F.G / 8) + bx / 8 : bx; }
    F.ws = args.ws; F.ctl = (gu32*)(args.ws + WS_CTL); F.out = args.out;
    F.kap = (const __attribute__((address_space(4))) char*)__builtin_amdgcn_kernarg_segment_ptr();
    static_assert(offsetof(Args, in) == 0, "FIN() reads the input pointers at the start of the kernarg segment");
    for (int u = F.tid; u < 64; u += NTHR) ((LAS unsigned*)(F.lds + MISC_OFF))[u] = 0u;
    __syncthreads();
    const int lo = args.ph_lo, hi = args.ph_hi;
    const bool multi = (hi - lo) > 1;
    XcdBarrier bar; bar.bar = (unsigned*)(F.ctl + CW_BAR); bar.x = 0; bar.st = nullptr;
    if (multi) bar = xcd_barrier_post((unsigned*)(F.ctl + CW_BAR), F.MISC + 8);
#ifdef PHASE_ONLY
#define IN(k) ((k) == PHASE_ONLY && lo <= (k) && (k) < hi)
#else
#define IN(k) (lo <= (k) && (k) < hi)
#endif
#ifndef PROBE_BUILD
#define PROBE_BUILD 0
#endif
#if PROBE_BUILD
    const unsigned repmask = args.rep_mask;
#define REPLOOP(k) _Pragma("unroll 1") for (int rep_ = 0, nrep_ = 1 + (int)((repmask >> (k)) & 1u); rep_ < nrep_; ++rep_)
#else
    const unsigned repmask = 0u;
#define REPLOOP(k)
#endif
#define SEAM(k) do { if (IN(k) && IN((k) + 1)) xcd_barrier(bar); PHASE_FENCE(); } while (0)
    const int gwv = F.vcu * NWAVES + F.wave, NGW = F.G * NWAVES;
    const int bx = blockIdx.x;

    REPLOOP(0) {
    if (IN(0)) {
        LAS float* scr = (LAS float*)(F.lds + F.wave * 16384);
        int ibase = 0;
#define XPOSE_MAT(fn, destrows, K, WT, kgain) do { const int _n = ((destrows) / 32) * ((K) / 64); const int _s = (gwv + NGW - (ibase % NGW)) % NGW; \
            xpose_matrix(fn, K, WT, kgain, scr, _s, _n, NGW, F.lane); ibase += _n; } while (0)
        { FnIn f{FIN(I_EV_WIN)}; XPOSE_MAT(f, NPROJ, 1024, WSP(bf16, WS_WIN), (const float*)nullptr); }
        { FnPlain f{FIN(I_EV_WUK), 128, 0}; XPOSE_MAT(f, 128, 256, WSP(bf16, WS_WUKV), FIN(I_EV_KVN)); }
        { FnPlain f{FIN(I_EV_WUV), 128, 0}; XPOSE_MAT(f, 128, 256, WSP(bf16, WS_WUKV) + 128 * 256, FIN(I_EV_KVN)); }
#pragma unroll 1
        for (int j = 0; j < 2; ++j) { const float* W1 = FIN(I_EV_CW1) + (size_t)j * 4096 * 128; bf16* d = WSP(bf16, WS_WC1) + (size_t)j * 256 * 2048;
            { FnPlain f{W1, 128, 0}; XPOSE_MAT(f, 128, 2048, d, (const float*)nullptr); }
            { FnPlain f{W1 + (size_t)2048 * 128, 128, 0}; XPOSE_MAT(f, 128, 2048, d + (size_t)128 * 2048, (const float*)nullptr); } }
        { FnPlain f{FIN(I_EV_WOUT), 1024, 0}; XPOSE_MAT(f, 1024, 1024, WSP(bf16, WS_WOUT0), (const float*)nullptr); }
        { FnGU f{FIN(I_EV_WG), FIN(I_EV_WU), DFF}; XPOSE_MAT(f, 2 * DFF, 1024, WSP(bf16, WS_WGU0), FIN(I_EV_NFFN)); }
        { FnPlain f{FIN(I_EV_WD), 1024, 0}; XPOSE_MAT(f, 1024, DFF, WSP(bf16, WS_WDN0), (const float*)nullptr); }
        { FnPlain f{FIN(I_OD_WQKV), 3072, 0}; XPOSE_MAT(f, 3072, 1024, WSP(bf16, WS_WQKV), FIN(I_OD_NMIX)); }
        { FnPlain f{FIN(I_OD_WOUT), 1024, 0}; XPOSE_MAT(f, 1024, 1024, WSP(bf16, WS_WOUT1), (const float*)nullptr); }
        norm_phase(F, FIN(I_X), nullptr, FIN(I_EV_NMIX));
        for (int oi = gwv; oi < 32; oi += NGW) { const int j = oi >> 4, part = oi & 15; const float* pos = FIN(I_EV_CPOS) + (size_t)j * 4096 + part * 256; const float* W1 = FIN(I_EV_CW1) + ((size_t)j * 4096 + part * 256) * 128;
            float s0 = 0.f, s1 = 0.f;
#pragma unroll 8
            for (int i = 0; i < 256; ++i) { const float pv_ = pos[i]; s0 = fmaf(pv_, W1[(size_t)i * 128 + F.lane], s0); s1 = fmaf(pv_, W1[(size_t)i * 128 + 64 + F.lane], s1); }
            WSP(float, WS_TAB)[(size_t)oi * 128 + F.lane] = s0; WSP(float, WS_TAB)[(size_t)oi * 128 + 64 + F.lane] = s1; }
    }
    }
    SEAM(0);
    REPLOOP(1) {
    if (IN(1)) {
        pg8::PlainSched S; S.init(M, NPROJ, F.G, bx, WSP(bf16, WS_XN), 2048, WSP(bf16, WS_WIN), 2048);
        pg8::EpiGroups E{WSP(bf16, WS_PROJ), GS, 0x0F0Fu, QSCALE, G_PAD, nullptr};
        pg8::gemm_phase<pg8::EpiGroups, pg8::PlainSched>(F.lds, pg8::GemmK{1024, 2048u, 2048u, 30, 0u}, S, E);
    }
    }
    SEAM(1);
    REPLOOP(2) {
    if (IN(2)) {
        if (bx < 128) {
            LAS float* rstd = (LAS float*)(F.lds + MISC_OFF + 1024);
            { const int r = F.tid >> 1, g = F.tid & 1; const bf16* p = GRP(G_LAT + g) + ((size_t)bx * 256 + r) * 128; float s = 0.f;
#pragma unroll
              for (int i = 0; i < 16; ++i) { const v4u w = *(const v4u*)(p + i * 8);
#pragma unroll
                  for (int q = 0; q < 4; ++q) { const float a = __builtin_bit_cast(float, w[q] << 16), c = __builtin_bit_cast(float, w[q] & 0xffff0000u); s += a * a + c * c; } }
              s += __shfl_xor(s, 1);
              if (g == 0) rstd[r] = 1.0f / sqrtf(s * (1.f / 256.f) + RMS_EPS); }
            __syncthreads();
            pg8::OneSched S;
            S.u.pm = bx; S.u.pn = 0; S.u.aux = 0; S.u.A = (const char*)(GRP(G_LAT) + (size_t)bx * 256 * 128); S.u.B = (const char*)WSP(bf16, WS_WUKV);
            pg8::EpiAkv E{WSP(bf16, WS_AK), WSP(bf16, WS_AV), rstd};
            pg8::gemm_phase<pg8::EpiAkv, pg8::OneSched>(F.lds, pg8::GemmK{256, 256u, 512u, 1, (unsigned)(GS * 2)}, S, E);
        } else if (bx < 160) {
            const int u = bx - 128, j = u >> 4, pm = (u >> 1) & 7, kh = u & 1;
            pg8::OneSched S;
            S.u.pm = pm; S.u.pn = 0; S.u.aux = 0; S.u.A = (const char*)(GRP(j == 0 ? G_CKR : G_CVR) + (size_t)pm * 256 * 2048 + (size_t)kh * 1024); S.u.B = (const char*)(WSP(bf16, WS_WC1) + (size_t)j * 256 * 2048 + (size_t)kh * 1024);
            pg8::EpiF32 E{nullptr, (kh ? WSP(float, WS_UVB) : WSP(float, WS_UV)) + (size_t)j * 2048 * 256, 256, 1.f};
            pg8::gemm_phase<pg8::EpiF32, pg8::OneSched>(F.lds, pg8::GemmK{1024, 4096u, 4096u, 30, 0u}, S, E);
        }
    }
    }
    SEAM(2);
    REPLOOP(3) {
    if (IN(3)) {
        for (int it = bx; it < 256; it += F.G) cmp_finalize_item(F, it >> 5, (it >> 4) & 1, it & 15);
        for (int r = 0; r < 4096 / 256 + 1; ++r) { const int cc = (r & 1) ? (F.G - 1 - bx) : bx; const int ui = r * F.G + cc; if (ui >= 4096) break;
            const int tq = 511 - (ui >> 3), b = ui & 7; idx_unit(F, b, tq, repmask >> 24); }
    }
    }
    SEAM(3);
    PHASE_FENCE();
    REPLOOP(5) {
    if (IN(5)) {
        fill_bias_tbl(F, (float*)(F.ldsg + AL_TBL), 0); __syncthreads();
#pragma unroll 1
        for (int p2 = 2 * bx; p2 < 512; p2 += 2 * F.G) {
#pragma unroll 1
            for (int u = 0; u < 2; ++u) { const int p = p2 >> 1, b = p >> 5, q = p & 31; attn_unit<0>(F, b, u ? q : 63 - q); } }
        __syncthreads();
        fill_bias_tbl(F, (float*)(F.ldsg + AL_TBL), 4); fill_bias_tbl132(F, (float*)(F.ldsg + AL_TBL132), 4); __syncthreads();
#pragma unroll 1
        for (int p2 = 2 * bx; p2 < 512; p2 += 2 * F.G) {
#pragma unroll 1
            for (int u = 0; u < 2; ++u) { const int p = p2 >> 1, b = p >> 5, q = p & 31, qt = u ? q : 63 - q;
                cmp_unit64(F, b, qt); asm volatile("s_waitcnt vmcnt(0)" ::: "memory"); __syncthreads();
                attn_unit<1>(F, b, qt); attn_unit<2>(F, b, qt); } }
    }
    }
    SEAM(5);
    REPLOOP(6) {
    if (IN(6)) {
        pg8::PlainSched S; S.init(M, DM, F.G, bx, WSP(bf16, WS_O), 2048, WSP(bf16, WS_WOUT0), 2048);
        pg8::EpiRes E{FIN(I_X), nullptr, WSP(bf16, WS_XB), WSP(float, WS_RS0), 1.f};
        pg8::gemm_phase<pg8::EpiRes, pg8::PlainSched>(F.lds, pg8::GemmK{1024, 2048u, 2048u, 30, 0u}, S, E);
    }
    }
    if (IN(6) && IN(8)) xcd_barrier(bar); PHASE_FENCE();
    REPLOOP(8) {
    if (IN(8)) {
        pg8::PlainSched S; S.init(M, 2 * DFF, F.G, bx, WSP(bf16, WS_XB), 2048, WSP(bf16, WS_WGU0), 2048);
        pg8::EpiSwiglu E{WSP(bf16, WS_H0), DFF, 0, WSP(float, WS_RS0), nullptr, 0};
        pg8::gemm_phase<pg8::EpiSwiglu, pg8::PlainSched>(F.lds, pg8::GemmK{1024, 2048u, 2048u, 30, 0u}, S, E);
    }
    }
    SEAM(8);
    if (IN(9)) {
        pg8::PlainSched S; S.init(M, DM, F.G, bx, WSP(bf16, WS_H0), DFF * 2, WSP(bf16, WS_WDN0), DFF * 2);
        pg8::EpiRes E{nullptr, WSP(bf16, WS_XB), WSP(bf16, WS_XB), WSP(float, WS_RS1), ((repmask >> 10) & 1u) ? 0.5f : 1.f};
        REPLOOP(10) pg8::gemm_phase<pg8::EpiRes, pg8::PlainSched>(F.lds, pg8::GemmK{DFF, DFF * 2u, DFF * 2u, 30, 0u}, S, E);
    }
    if (IN(9) && IN(11)) xcd_barrier(bar); PHASE_FENCE();
    REPLOOP(11) {
    if (IN(11)) {
        pg8::PlainSched S; S.init(M, 3072, F.G, bx, WSP(bf16, WS_XB), 2048, WSP(bf16, WS_WQKV), 2048);
        pg8::EpiGroups E{WSP(bf16, WS_QKV), GS, 0xFFu, QSCALE, 1000, WSP(float, WS_RS1)};
        pg8::gemm_phase<pg8::EpiGroups, pg8::PlainSched>(F.lds, pg8::GemmK{1024, 2048u, 2048u, 30, 0u}, S, E);
    }
    }
    SEAM(11);
    REPLOOP(12) {
    if (IN(12)) {
        for (int ui = bx; ui < 1024; ui += F.G) { const int qb = 15 - (ui >> 6), bh = ui & 63; stick_unit(F, bh >> 3, bh & 7, qb); }
    }
    }
    SEAM(12);
    if (IN(13)) {
        pg8::PlainSched S; S.init(M, DM, F.G, bx, WSP(bf16, WS_O), 2048, WSP(bf16, WS_WOUT1), 2048);
        pg8::EpiRes E{nullptr, WSP(bf16, WS_XB), WSP(bf16, WS_XB3), WSP(float, WS_RS0), 1.f};
        REPLOOP(14) pg8::gemm_phase<pg8::EpiRes, pg8::PlainSched>(F.lds, pg8::GemmK{1024, 2048u, 2048u, 30, 0u}, S, E);
        LAS float* scr = (LAS float*)(F.lds + F.wave * 16384);
        REPLOOP(13) {
        int ibase = 0;
#pragma unroll 1
        for (int e = 0; e < NEXP; ++e) {
            { FnGU f{FIN(I_OD_WG) + (size_t)e * 1024 * EFF, FIN(I_OD_WU) + (size_t)e * 1024 * EFF, EFF}; XPOSE_MAT(f, 2 * EFF, 1024, (bf16*)(F.ws + WS_MW + (size_t)e * MW_E), (const float*)nullptr); }
            { FnPlain f{FIN(I_OD_WD) + (size_t)e * EFF * 1024, 1024, 0}; XPOSE_MAT(f, 1024, EFF, (bf16*)(F.ws + WS_MW + (size_t)e * MW_E + MW_DN), (const float*)nullptr); }
        }
        }
    }
    SEAM(13);
    if (IN(14)) router_phase(F);
    SEAM(14);
    REPLOOP(15) { if (IN(15)) gather_phase(F); }
    SEAM(15);
#pragma unroll 1
    for (int ch = 0; ch < 3; ++ch) {
        const int t0 = ch * HM_TILES, ph = 16 + 2 * ch;
        MoeLayout L; moe_layout(F, L);
        const int ntile = L.off[16] >> 8;
        const int nt = (ntile - t0) < HM_TILES ? (ntile - t0) : HM_TILES;
        if (IN(ph) && nt > 0) {
            MoeSched S; S.o.init(nt, 2 * EFF / 256, F.G, bx); S.t0 = t0; S.A = (const char*)WSP(bf16, WS_XS); S.tstepA = 256 * 2048; S.W = (const char*)(F.ws + WS_MW); S.tstepB = 256 * 2048; S.a_local = false; S.A2 = nullptr;
#pragma unroll
            for (int q = 0; q < 17; ++q) S.off[q] = L.off[q];
            pg8::EpiSwiglu E{WSP(bf16, WS_HM), EFF, t0, nullptr, (bf16*)F.out, HM_SPLIT};
            REPLOOP(16) pg8::gemm_phase<pg8::EpiSwiglu, MoeSched>(F.lds, pg8::GemmK{1024, 2048u, 2048u, 30, 0u}, S, E);
        }
        SEAM(ph);
        const bool split = ch == 2 && nt > 0 && nt <= MOE_SPLIT_TILES;
        if (IN(ph + 1) && split) {
            MoeSplitSched S; S.o.init(nt, 4 * MOE_SPLITS, F.G, bx); S.t0 = t0; S.A = (const char*)WSP(bf16, WS_HM); S.tstepA = (size_t)256 * EFF * 2; S.W = (const char*)(F.ws + WS_MW + MW_DN); S.tstepB = (size_t)256 * EFF * 2;
#pragma unroll
            for (int q = 0; q < 17; ++q) S.off[q] = L.off[q];
            pg8::EpiMoeYp E{WSP(bf16, WS_YP), WSP(float, WS_GWS), t0, (size_t)MOE_SPLIT_TILES * 256 * DM};
            pg8::gemm_phase<pg8::EpiMoeYp, MoeSplitSched>(F.lds, pg8::GemmK{EFF / MOE_SPLITS, EFF * 2u, EFF * 2u, 30, 0u}, S, E);
        }
        if (IN(ph + 1) && nt > 0 && !split) {
            MoeSched S; S.o.init(nt, DM / 256, F.G, bx); S.t0 = t0; S.A = (const char*)WSP(bf16, WS_HM); S.tstepA = (size_t)256 * EFF * 2; S.W = (const char*)(F.ws + WS_MW + MW_DN); S.tstepB = (size_t)256 * EFF * 2; S.a_local = true; S.A2 = (const char*)F.out;
#pragma unroll
            for (int q = 0; q < 17; ++q) S.off[q] = L.off[q];
            pg8::EpiMoeY E{WSP(bf16, WS_XS), WSP(float, WS_GWS)};
            REPLOOP(17) pg8::gemm_phase<pg8::EpiMoeY, MoeSched>(F.lds, pg8::GemmK{EFF, EFF * 2u, EFF * 2u, 30, 0u}, S, E);
        }
        SEAM(ph + 1);
    }
    REPLOOP(18)
    if (IN(26)) {
        const bf16* XS0 = WSP(bf16, WS_XS); const int* inv = WSP(int, WS_INV);
        MoeLayout L; moe_layout(F, L);
        const int ntl = (L.off[16] >> 8) - 2 * HM_TILES; const int srow = (ntl > 0 && ntl <= MOE_SPLIT_TILES) ? 2 * HM_TILES * 256 : 0x7fffffff;
#define FIN_ROW(m_, v_) do { load_row_bf16(WSP(bf16, WS_XB3) + (size_t)(m_) * DM, F.lane, v_); \
            _Pragma("unroll 1") for (int k = 0; k < 2; ++k) { const int s = inv[(size_t)k * M + (m_)]; float y[16]; \
                if (s < srow) { load_row_bf16(XS0 + (size_t)s * DM, F.lane, y); _Pragma("unroll") for (int i = 0; i < 16; ++i) v_[i] += y[i]; } \
                else { _Pragma("unroll 1") for (int sp = 0; sp < MOE_SPLITS; ++sp) { load_row_bf16(WSP(bf16, WS_YP) + ((size_t)sp * MOE_SPLIT_TILES * 256 + (s - srow)) * DM, F.lane, y); \
                        _Pragma("unroll") for (int i = 0; i < 16; ++i) v_[i] += y[i]; } } } } while (0)
#define FIN_OUT(m_, v_) do { rms16(v_, FIN(I_FNORM), F.lane); GAS f32x4* o = (GAS f32x4*)(F.out + (size_t)(m_) * DM); \
            o[2 * F.lane] = (f32x4){v_[0], v_[1], v_[2], v_[3]}; o[2 * F.lane + 1] = (f32x4){v_[4], v_[5], v_[6], v_[7]}; \
            o[128 + 2 * F.lane] = (f32x4){v_[8], v_[9], v_[10], v_[11]}; o[128 + 2 * F.lane + 1] = (f32x4){v_[12], v_[13], v_[14], v_[15]}; } while (0)
        for (int m = gwv; m < M; m += 2 * NGW) { float va[16], vb[16]; const int mb = m + NGW;
            FIN_ROW(m, va); if (mb < M) FIN_ROW(mb, vb);
            FIN_OUT(m, va); if (mb < M) FIN_OUT(mb, vb); }
#undef FIN_ROW
#undef FIN_OUT
    }
#undef IN
#undef SEAM
#undef XPOSE_MAT
}

#ifndef PROBE_REP
#define PROBE_REP 0u
#endif
#ifndef MK_FUSED
#define MK_FUSED 1
#endif
extern "C" void kernel_launch(void* const* d_in, const int* in_sizes, int n_in, void* d_out, int out_size, void* d_ws, size_t ws_size, hipStream_t stream) {
    static int grid = 0;
    if (grid == 0) {
        if (n_in != N_IN || in_sizes[0] != M * DM || out_size != M * DM || ws_size < WS_END) {
            fprintf(stderr, "kernel_launch: built for %d inputs, x/out of %d floats, >= %zu bytes of workspace; got n_in %d, in0 %d, out %d, ws %zu; nothing launched\n", N_IN, M * DM, (size_t)WS_END, n_in, n_in > 0 ? in_sizes[0] : -1, out_size, ws_size);
            grid = -1; return; }
        int dev = 0, cus = 0, per_cu = 0;
        if (hipGetDevice(&dev) != hipSuccess || hipDeviceGetAttribute(&cus, hipDeviceAttributeMultiprocessorCount, dev) != hipSuccess) { fprintf(stderr, "kernel_launch: device query failed\n"); grid = -1; return; }
        if (hipFuncSetAttribute((const void*)fwd, hipFuncAttributeMaxDynamicSharedMemorySize, LDS_BYTES) != hipSuccess) { fprintf(stderr, "kernel_launch: hipFuncSetAttribute failed\n"); grid = -1; return; }
        if (hipOccupancyMaxActiveBlocksPerMultiprocessor(&per_cu, (const void*)fwd, NTHR, LDS_BYTES) != hipSuccess || per_cu < 1)
            fprintf(stderr, "kernel_launch: note: occupancy query reports %d workgroups per CU\n", per_cu);
        (void)hipGetLastError();
        grid = cus;
    }
    if (grid < 0) return;
    if (hipMemsetAsync((char*)d_ws + WS_CTL, 0, CTL_ZERO_BYTES, stream) != hipSuccess) { fprintf(stderr, "kernel_launch: memset failed\n"); return; }
    Args a{};
    for (int i = 0; i < N_IN; ++i) a.in[i] = (const float*)d_in[i];
    a.out = (float*)d_out; a.ws = (unsigned char*)d_ws; a.rep_mask = PROBE_REP; a.pad = 0u;
#if MK_FUSED
    a.ph_lo = 0; a.ph_hi = N_PHASES;
    hipLaunchKernelGGL(fwd, dim3(grid), dim3(NTHR), LDS_BYTES, stream, a);
#else
    for (int p = 0; p < N_PHASES; ++p) { a.ph_lo = p; a.ph_hi = p + 1; hipLaunchKernelGGL(fwd, dim3(grid), dim3(NTHR), LDS_BYTES, stream, a); }
#endif
    const hipError_t le = hipPeekAtLastError();
    if (le != hipSuccess) fprintf(stderr, "kernel_launch: launch failed: %s\n", hipGetErrorName(le));
}
```

```cpp
#include <hip/hip_runtime.h>
#include <cstdio>
#include <cstdint>

#define GAS __attribute__((address_space(1)))
#define LAS __attribute__((address_space(3)))
typedef unsigned short bf16;
typedef unsigned v4u __attribute__((ext_vector_type(4)));
typedef unsigned v2u __attribute__((ext_vector_type(2)));
typedef float f32x2 __attribute__((ext_vector_type(2)));
typedef float f32x4 __attribute__((ext_vector_type(4)));
typedef float f32x16 __attribute__((ext_vector_type(16)));
typedef short bf16x8 __attribute__((ext_vector_type(8)));
typedef short s16x4 __attribute__((ext_vector_type(4)));
typedef GAS unsigned gu32;
#define RLX_AGENT __ATOMIC_RELAXED, __HIP_MEMORY_SCOPE_AGENT
#define LDS_WAIT() asm volatile("s_waitcnt lgkmcnt(0)" ::: "memory")
#define VM_WAIT() asm volatile("s_waitcnt vmcnt(0)" ::: "memory")
#define SBAR() __builtin_amdgcn_sched_barrier(0)

constexpr int BATCH = 8, SEQ = 4096, DM = 1024, M = BATCH * SEQ, HD = 128;
constexpr int NPROJ = 2560;
constexpr int DFF = 2816, NEXP = 8, EFF = 3584;
constexpr float RMS_EPS = 1e-6f;
constexpr float LOG2E = 1.4426950408889634f;
constexpr float QSCALE = 0.08838834764831845f * LOG2E;
enum { I_X = 0, I_RELB, I_EV_NMIX, I_EV_WIN, I_EV_KVN, I_EV_WUK, I_EV_WUV, I_EV_CPOS, I_EV_CW1, I_EV_CW2, I_EV_WOUT, I_EV_NFFN, I_EV_WG, I_EV_WU, I_EV_WD,
       I_OD_NMIX, I_OD_WQKV, I_OD_WOUT, I_OD_NFFN, I_OD_WR, I_OD_WG, I_OD_WU, I_OD_WD, I_FNORM, N_IN };

enum { G_QA = 0  , G_LAT = 4  , G_IQ = 6  , G_QB = 8  , G_CKR = 12, G_CVR = 13, G_SK = 14, G_SV = 15, G_WK = 16, G_WV = 17, G_MISC = 18, G_PAD = 19 };
constexpr size_t GS = (size_t)M * 128;

constexpr size_t MiB = 1u << 20;
constexpr size_t WS_CTL = 0, CTL_ZERO_BYTES = 1 * MiB;
constexpr size_t WS_TAB = 1 * MiB;
constexpr size_t WS_WIN = 2 * MiB;
constexpr size_t WS_WUKV = 7 * MiB;
constexpr size_t WS_WC1 = 7 * MiB + 256 * 1024;
constexpr size_t WS_WOUT0 = 10 * MiB;
constexpr size_t WS_WGU0 = 12 * MiB;
constexpr size_t WS_WDN0 = 23 * MiB;
constexpr size_t WS_WQKV = 29 * MiB;
constexpr size_t WS_WOUT1 = 35 * MiB;
constexpr size_t WS_XN = 40 * MiB;
constexpr size_t WS_PROJ = 104 * MiB;
constexpr size_t WS_AK = 264 * MiB, WS_AV = 272 * MiB;
constexpr size_t WS_BM = 280 * MiB;
constexpr size_t WS_UV = 296 * MiB;
constexpr size_t WS_UVB = 432 * MiB;
constexpr size_t WS_CK = 300 * MiB;
constexpr size_t WS_CVT = 300 * MiB + 512 * 1024;
constexpr size_t WS_CV = 300 * MiB + 512 * 1024;
constexpr size_t WS_BLK = 301 * MiB;
constexpr size_t WS_RS0 = 302 * MiB;
constexpr size_t WS_RS1 = 296 * MiB;
constexpr size_t WS_OC = 304 * MiB;
constexpr size_t WS_O = 368 * MiB;
constexpr size_t WS_OC2 = 432 * MiB;
constexpr size_t WS_XB = 432 * MiB;
constexpr size_t WS_IKT = 500 * MiB;
constexpr size_t WS_XB3 = 40 * MiB;
constexpr size_t WS_H0 = 104 * MiB;
constexpr size_t WS_QKV = 104 * MiB;
constexpr size_t WS_MW = 104 * MiB;
constexpr size_t MW_E = 21 * MiB, MW_DN = 14 * MiB;
constexpr size_t WS_LIST = 272 * MiB;
constexpr size_t WS_GW = WS_LIST + 2 * MiB;
constexpr size_t WS_TOK = WS_GW + 256 * 1024;
constexpr size_t WS_INV = WS_TOK + 512 * 1024;
constexpr size_t WS_GWS = WS_INV + 256 * 1024;
constexpr int XS_ROWS = M + 8 * 256;
constexpr size_t WS_XS = 276 * MiB;
constexpr int HM_TILES = 128, HM_SPLIT = 64;
constexpr int MOE_SPLITS = 4, MOE_SPLIT_TILES = 16;
constexpr size_t WS_YP = 2 * MiB;
constexpr size_t WS_HM = 412 * MiB;
constexpr size_t WS_END = 524 * MiB;
static_assert(WS_WIN + (size_t)NPROJ * DM * 2 <= WS_WUKV && WS_WC1 + 2ull * 256 * 2048 * 2 <= WS_WOUT0 && WS_WGU0 + 5632ull * 1024 * 2 <= WS_WDN0 && WS_WDN0 + 1024ull * 2816 * 2 <= WS_WQKV && WS_WQKV + 3072ull * 1024 * 2 <= WS_WOUT1 && WS_WOUT1 + 2 * MiB <= WS_XN, "weights map");
static_assert(WS_XN + (size_t)M * DM * 2 <= WS_PROJ && WS_PROJ + 20 * GS * 2 <= WS_AK && WS_BM + (size_t)M * 128 * 4 <= WS_UV && WS_UV + 4 * MiB <= WS_CK && WS_BLK + (size_t)M * 8 <= WS_OC && WS_OC + (size_t)M * 512 * 4 <= WS_O && WS_O + (size_t)M * DM * 2 <= 432 * MiB, "even map");
static_assert(WS_YP + (size_t)MOE_SPLITS * MOE_SPLIT_TILES * 256 * DM * 2 <= WS_XB3, "split partials fit under the residual stream copy");
static_assert(WS_H0 + (size_t)M * DFF * 2 <= WS_OC && WS_QKV + 24 * GS * 2 <= WS_O && WS_MW + 8 * MW_E <= WS_LIST && WS_GWS + 2ull * XS_ROWS * 4 <= WS_XS && WS_XS + 2ull * XS_ROWS * DM * 2 <= WS_HM && WS_HM + (size_t)HM_SPLIT * 256 * EFF * 2 <= WS_END && (size_t)(HM_TILES - HM_SPLIT) * 256 * EFF * 2 <= (size_t)M * DM * 4, "late map");
constexpr int CW_TMO = 0, CW_CODE = 1;
constexpr int CW_BAR = 4096;
constexpr int CW_CNT = 16384;

constexpr int RING_BYTES = 131072;
constexpr int MISC_OFF = RING_BYTES;
constexpr int LDS_BYTES = 147456;
constexpr int NWAVES = 8, NTHR = 512;

__device__ __forceinline__ unsigned f2bf(float f) { unsigned u = __builtin_bit_cast(unsigned, f); return (u + 0x7fffu + ((u >> 16) & 1u)) >> 16; }
__device__ __forceinline__ unsigned pk2(float lo, float hi) { return f2bf(lo) | (f2bf(hi) << 16); }
__device__ __forceinline__ float bf2f(bf16 b) { return __builtin_bit_cast(float, (unsigned)b << 16); }
__device__ __forceinline__ unsigned cvtpk(float lo, float hi) { unsigned r; asm volatile("v_cvt_pk_bf16_f32 %0, %1, %2" : "=v"(r) : "v"(lo), "v"(hi)); return r; }
__device__ __forceinline__ bf16x8 pack8(f32x4 a, f32x4 b) { v4u w = {cvtpk(a[0], a[1]), cvtpk(a[2], a[3]), cvtpk(b[0], b[1]), cvtpk(b[2], b[3])}; return __builtin_bit_cast(bf16x8, w); }
__device__ __forceinline__ float wave_sum(float v) {
#define WS_STEP(ctrl, rmask) v += __int_as_float(__builtin_amdgcn_update_dpp(0, __float_as_int(v), ctrl, rmask, 0xf, true))
    WS_STEP(0x111, 0xf); WS_STEP(0x112, 0xf); WS_STEP(0x114, 0xf); WS_STEP(0x118, 0xf); WS_STEP(0x142, 0xa); WS_STEP(0x143, 0xc);
#undef WS_STEP
    return __int_as_float(__builtin_amdgcn_readlane(__float_as_int(v), 63));
}
__device__ __forceinline__ float wave_max(float v) {
#define WM_STEP(ctrl, rmask) v = fmaxf(v, __int_as_float(__builtin_amdgcn_update_dpp(__float_as_int(v), __float_as_int(v), ctrl, rmask, 0xf, false)))
    WM_STEP(0x111, 0xf); WM_STEP(0x112, 0xf); WM_STEP(0x114, 0xf); WM_STEP(0x118, 0xf); WM_STEP(0x142, 0xa); WM_STEP(0x143, 0xc);
#undef WM_STEP
    return __int_as_float(__builtin_amdgcn_readlane(__float_as_int(v), 63));
}
__device__ __forceinline__ int rel_bucket_dev(int d) {
    if (d < 16) return d;
    if (d >= 113) return 31;
    int v = 16 + (int)(__log2f((float)d * 0.0625f) * (16.0f / 3.0f));
    return v > 31 ? 31 : v;
}
namespace pg8 {
constexpr int BM = 256, BK = 64, HALF = 128, HTB = HALF * BK * 2, STAGE_BYTES = 8 * HTB, NXCD = 8, WGM = 8;
__host__ __device__ __forceinline__ int lds_byte(int r, int c) { const int st = (r >> 4) * 2 + (c >> 5), rr = r & 15, cc = c & 31, ob = rr * 64 + cc * 2; return st * 1024 + (ob ^ (((ob >> 9) & 1) << 5)); }
__host__ __device__ __forceinline__ void stage_rc(int b, int& R, int& C) { const int st = b / 1024, sb = b % 1024, swz = sb ^ (((sb >> 9) & 1) << 5); R = (st >> 1) * 16 + swz / 64; C = (st & 1) * 32 + (swz % 64) / 2; }
__host__ __device__ __forceinline__ int perm32(int rho) { const int n = rho >> 4, i = rho & 15; return 8 * (i >> 2) + 4 * n + (i & 3); }

struct Unit { int pm, pn, aux; const char* A; const char* B; };
struct GemmK { int K; unsigned pitchA, pitchB; int kshA; unsigned gstrA; };

struct GridOrder {
    int nM, nN, nwg, G, c;
    __device__ __forceinline__ void init(int nM_, int nN_, int G_, int c_) { nM = nM_; nN = nN_; nwg = nM * nN; G = G_; c = c_; }
    __device__ __forceinline__ bool at(int i, int& pm, int& pn) const {
        const long L = (long)i * G + c; if (L >= nwg) return false;
        int wgid = (int)L; { const int q = nwg / NXCD, r = nwg % NXCD, xcd = wgid % NXCD, off = wgid / NXCD; wgid = (xcd < r ? xcd * (q + 1) : r * (q + 1) + (xcd - r) * q) + off; }
        const int nig = WGM * nN, gid = wgid / nig, fm = gid * WGM, gsz = (nM - fm) < WGM ? (nM - fm) : WGM;
        pm = fm + ((wgid % nig) % gsz); pn = (wgid % nig) / gsz; return true;
    }
};
struct PlainSched {
    GridOrder o; const char* A; const char* B; size_t tstepA, tstepB;
    __device__ __forceinline__ void init(int Mr, int Nc, int G, int c, const void* A_, size_t pitchA, const void* B_, size_t pitchB) { o.init(Mr / BM, Nc / BM, G, c); A = (const char*)A_; B = (const char*)B_; tstepA = 256 * pitchA; tstepB = 256 * pitchB; }
    __device__ __forceinline__ bool next(int i, Unit& u) const { if (!o.at(i, u.pm, u.pn)) return false; u.aux = 0; u.A = A + (size_t)u.pm * tstepA; u.B = B + (size_t)u.pn * tstepB; return true; }
};

__device__ __forceinline__ unsigned cvt_pk_bf16(float lo, float hi) { unsigned r; asm volatile("v_cvt_pk_bf16_f32 %0, %1, %2" : "=v"(r) : "v"(lo), "v"(hi)); return r; }

typedef float f32x8 __attribute__((ext_vector_type(8)));
__device__ __forceinline__ f32x8 row_rstd8(const float* rs, int row0, int fq) {
    f32x8 r = {1.f, 1.f, 1.f, 1.f, 1.f, 1.f, 1.f, 1.f};
    if (rs) {
#pragma unroll
        for (int i = 0; i < 8; ++i) { const f32x4 p = *(const f32x4*)(rs + (size_t)(row0 + (i >> 2) * HALF + (i & 3) * 16) * 16 + 4 * fq); float s = (p[0] + p[1]) + (p[2] + p[3]);
            s += __shfl_xor(s, 16); s += __shfl_xor(s, 32); r[i] = 1.0f / sqrtf(s * (1.0f / DM) + RMS_EPS); } }
    return r;
}
struct EpiGroups {
    static constexpr bool PERM = true;
    bf16* O; size_t gstride; unsigned scalemask; float scale; int gskip; const float* rs;
    __device__ __forceinline__ void operator()(const f32x4 (&acc)[2][2][4][2], const Unit& u, int wr, int wc, int fr, int fq) const {
        const int row0 = u.pm * BM + wr * 64 + fr, col0 = wc * 32 + 8 * fq;
        const f32x8 rstd = row_rstd8(rs, row0, fq);
#pragma unroll
        for (int bj = 0; bj < 2; ++bj) { const int g = 2 * u.pn + bj; if (g >= gskip) continue; const float sc = ((scalemask >> g) & 1u) ? scale : 1.f; bf16* base = O + (size_t)g * gstride;
#pragma unroll
            for (int ai = 0; ai < 2; ++ai)
#pragma unroll
                for (int m = 0; m < 4; ++m) { const float s2 = sc * rstd[ai * 4 + m]; const f32x4 v0 = acc[ai][bj][m][0] * s2, v1 = acc[ai][bj][m][1] * s2;
                    v4u w; w.x = cvt_pk_bf16(v0[0], v0[1]); w.y = cvt_pk_bf16(v0[2], v0[3]); w.z = cvt_pk_bf16(v1[0], v1[1]); w.w = cvt_pk_bf16(v1[2], v1[3]);
                    *(v4u*)(base + (size_t)(row0 + ai * HALF + m * 16) * 128 + col0) = w; } }
    }
};
struct OneSched { Unit u; __device__ __forceinline__ bool next(int i, Unit& o) const { if (i) return false; o = u; return true; } };
struct EpiAkv {
    static constexpr bool PERM = true;
    bf16* AK; bf16* AV; const LAS float* rstd;
    __device__ __forceinline__ void operator()(const f32x4 (&acc)[2][2][4][2], const Unit& u, int wr, int wc, int fr, int fq) const {
        const int col0 = wc * 32 + 8 * fq;
#pragma unroll
        for (int ai = 0; ai < 2; ++ai)
#pragma unroll
            for (int m = 0; m < 4; ++m) { const int rl = ai * HALF + wr * 64 + m * 16 + fr; const float rs = rstd[rl]; const size_t row = (size_t)u.pm * BM + rl;
#pragma unroll
                for (int bj = 0; bj < 2; ++bj) { const f32x4 v0 = acc[ai][bj][m][0] * rs, v1 = acc[ai][bj][m][1] * rs;
                    v4u w; w.x = cvt_pk_bf16(v0[0], v0[1]); w.y = cvt_pk_bf16(v0[2], v0[3]); w.z = cvt_pk_bf16(v1[0], v1[1]); w.w = cvt_pk_bf16(v1[2], v1[3]);
                    *(v4u*)((bj ? AV : AK) + row * 128 + col0) = w; } }
    }
};
struct EpiF32 {
    static constexpr bool PERM = false;
    const float* base; float* C; int ldc; float scale;
    __device__ __forceinline__ void operator()(const f32x4 (&acc)[2][2][4][2], const Unit& u, int wr, int wc, int fr, int fq) const {
        const int row0 = u.pm * BM + wr * 64 + fr, col0 = u.pn * BM + wc * 32 + 4 * fq;
#pragma unroll
        for (int ai = 0; ai < 2; ++ai)
#pragma unroll
            for (int m = 0; m < 4; ++m) { const size_t off = (size_t)(row0 + ai * HALF + m * 16) * ldc + col0;
#pragma unroll
                for (int bj = 0; bj < 2; ++bj)
#pragma unroll
                    for (int n = 0; n < 2; ++n) { f32x4 v = acc[ai][bj][m][n] * scale; if (base) v += *(const f32x4*)(base + off + bj * HALF + n * 16); *(f32x4*)(C + off + bj * HALF + n * 16) = v; } }
    }
};
struct EpiRes {
    static constexpr bool PERM = true;
    const float* basef; const bf16* baseb; bf16* out; float* rs; float scale;
    __device__ __forceinline__ void operator()(const f32x4 (&acc)[2][2][4][2], const Unit& u, int wr, int wc, int fr, int fq) const {
        const int row0 = u.pm * BM + wr * 64 + fr, col0 = u.pn * BM + wc * 32 + 8 * fq;
#pragma unroll
        for (int ai = 0; ai < 2; ++ai)
#pragma unroll
            for (int m = 0; m < 4; ++m) { const size_t off = (size_t)(row0 + ai * HALF + m * 16) * DM + col0; float ss = 0.f;
#pragma unroll
                for (int bj = 0; bj < 2; ++bj) { f32x4 v0 = acc[ai][bj][m][0] * scale, v1 = acc[ai][bj][m][1] * scale;
                    if (basef) { v0 += *(const f32x4*)(basef + off + bj * HALF); v1 += *(const f32x4*)(basef + off + bj * HALF + 4); }
                    else { const v4u w = *(const v4u*)(baseb + off + bj * HALF);
                        v0 += (f32x4){__uint_as_float(w.x << 16), __uint_as_float(w.x & 0xffff0000u), __uint_as_float(w.y << 16), __uint_as_float(w.y & 0xffff0000u)};
                        v1 += (f32x4){__uint_as_float(w.z << 16), __uint_as_float(w.z & 0xffff0000u), __uint_as_float(w.w << 16), __uint_as_float(w.w & 0xffff0000u)}; }
                    v4u o; o.x = cvt_pk_bf16(v0[0], v0[1]); o.y = cvt_pk_bf16(v0[2], v0[3]); o.z = cvt_pk_bf16(v1[0], v1[1]); o.w = cvt_pk_bf16(v1[2], v1[3]);
                    *(v4u*)(out + off + bj * HALF) = o;
#define RS_ACC(w) { const float a_ = __uint_as_float((w) << 16), c_ = __uint_as_float((w) & 0xffff0000u); ss = fmaf(a_, a_, fmaf(c_, c_, ss)); }
                    RS_ACC(o.x) RS_ACC(o.y) RS_ACC(o.z) RS_ACC(o.w)
#undef RS_ACC
                }
                { ss += __shfl_xor(ss, 16); ss += __shfl_xor(ss, 32); if (fq == 0) rs[(size_t)(row0 + ai * HALF + m * 16) * 16 + 4 * u.pn + wc] = ss; } }
    }
};
struct EpiMoeY {
    static constexpr bool PERM = true;
    bf16* Y; const float* gws;
    __device__ __forceinline__ void operator()(const f32x4 (&acc)[2][2][4][2], const Unit& u, int wr, int wc, int fr, int fq) const {
        const int col0 = u.pn * BM + wc * 32 + 8 * fq;
#pragma unroll
        for (int ai = 0; ai < 2; ++ai)
#pragma unroll
            for (int m = 0; m < 4; ++m) { const int slot = u.pm * BM + ai * HALF + wr * 64 + m * 16 + fr; const float g = gws[slot];
#pragma unroll
                for (int bj = 0; bj < 2; ++bj) { const f32x4 v0 = acc[ai][bj][m][0] * g, v1 = acc[ai][bj][m][1] * g;
                    v4u o; o.x = cvt_pk_bf16(v0[0], v0[1]); o.y = cvt_pk_bf16(v0[2], v0[3]); o.z = cvt_pk_bf16(v1[0], v1[1]); o.w = cvt_pk_bf16(v1[2], v1[3]);
                    *(v4u*)(Y + (size_t)slot * DM + col0 + bj * HALF) = o; } }
    }
};
struct EpiMoeYp {
    static constexpr bool PERM = true;
    bf16* YP; const float* gws; int pm0; size_t split_stride;
    __device__ __forceinline__ void operator()(const f32x4 (&acc)[2][2][4][2], const Unit& u, int wr, int wc, int fr, int fq) const {
        const int col0 = (u.pn & 3) * BM + wc * 32 + 8 * fq; bf16* base = YP + (size_t)(u.pn >> 2) * split_stride;
#pragma unroll
        for (int ai = 0; ai < 2; ++ai)
#pragma unroll
            for (int m = 0; m < 4; ++m) { const int rl = ai * HALF + wr * 64 + m * 16 + fr; const float g = gws[u.pm * BM + rl];
#pragma unroll
                for (int bj = 0; bj < 2; ++bj) { const f32x4 v0 = acc[ai][bj][m][0] * g, v1 = acc[ai][bj][m][1] * g;
                    v4u o; o.x = cvt_pk_bf16(v0[0], v0[1]); o.y = cvt_pk_bf16(v0[2], v0[3]); o.z = cvt_pk_bf16(v1[0], v1[1]); o.w = cvt_pk_bf16(v1[2], v1[3]);
                    *(v4u*)(base + (size_t)((u.pm - pm0) * BM + rl) * DM + col0 + bj * HALF) = o; } }
    }
};
struct EpiSwiglu {
    static constexpr bool PERM = true;
    bf16* H; int ldh; int pm0; const float* rs; bf16* H2; int hsplit;
    __device__ __forceinline__ void operator()(const f32x4 (&acc)[2][2][4][2], const Unit& u, int wr, int wc, int fr, int fq) const {
        const int lt = u.pm - pm0; bf16* Hb = (H2 && lt >= hsplit) ? H2 : H;
        const int row0 = ((H2 && lt >= hsplit) ? lt - hsplit : lt) * BM + wr * 64 + fr, col0 = u.pn * HALF + wc * 32 + 8 * fq;
        const f32x8 rstd = row_rstd8(rs, u.pm * BM + wr * 64 + fr, fq);
#pragma unroll
        for (int ai = 0; ai < 2; ++ai)
#pragma unroll
            for (int m = 0; m < 4; ++m) { float h[8];
#pragma unroll
                for (int n = 0; n < 2; ++n)
#pragma unroll
                    for (int j = 0; j < 4; ++j) { const float g = acc[ai][0][m][n][j] * rstd[ai * 4 + m], up = acc[ai][1][m][n][j] * rstd[ai * 4 + m]; h[n * 4 + j] = g * up * __builtin_amdgcn_rcpf(1.0f + __builtin_amdgcn_exp2f(-g * LOG2E)); }
                v4u w; w.x = cvt_pk_bf16(h[0], h[1]); w.y = cvt_pk_bf16(h[2], h[3]); w.z = cvt_pk_bf16(h[4], h[5]); w.w = cvt_pk_bf16(h[6], h[7]);
                *(v4u*)(Hb + (size_t)(row0 + ai * HALF + m * 16) * ldh + col0) = w; }
    }
};
struct EpiMoeDown {
    static constexpr bool PERM = false;
    float* out; const int* tok; const float* gw; int pm0; float scale;
    __device__ __forceinline__ void operator()(const f32x4 (&acc)[2][2][4][2], const Unit& u, int wr, int wc, int fr, int fq) const {
        const int col0 = u.pn * BM + wc * 32 + 4 * fq;
#pragma unroll
        for (int ai = 0; ai < 2; ++ai)
#pragma unroll
            for (int m = 0; m < 4; ++m) { const int slot = u.pm * BM + ai * HALF + wr * 64 + m * 16 + fr; const int t = tok[slot];
                if (t >= 0) { const float g = gw[t] * scale; float* rowp = out + (size_t)t * DM + col0;
#pragma unroll
                    for (int bj = 0; bj < 2; ++bj)
#pragma unroll
                        for (int n = 0; n < 2; ++n) { f32x4* p = (f32x4*)(rowp + bj * HALF + n * 16); *p = *p + acc[ai][bj][m][n] * g; } } }
    }
};

template <class Epi, class Sched, bool ALIGN_EPI = true>
__device__ __forceinline__ void gemm_phase(LAS unsigned char* lds, const GemmK gk, const Sched& S, const Epi& E) {
    int tid = threadIdx.x; asm volatile("" : "+v"(tid));
    const int wid = __builtin_amdgcn_readfirstlane(tid >> 6), lane = tid & 63, wr = wid >> 2, wc = wid & 3, fr = lane & 15, fq = lane >> 4;
    int nt = gk.K / BK; asm volatile("" : "+s"(nt));
    unsigned voffA[2], voffB[2];
#pragma unroll
    for (int i = 0; i < 2; ++i) { int R, C; stage_rc(tid * 16 + i * 8192, R, C); const int Rb = Epi::PERM ? ((R & ~31) + perm32(R & 31)) : R;
        voffA[i] = (unsigned)R * gk.pitchA + (unsigned)C * 2u; voffB[i] = (unsigned)Rb * gk.pitchB + (unsigned)C * 2u; }
    const size_t hstepA = (size_t)HALF * gk.pitchA, hstepB = (size_t)HALF * gk.pitchB;
    const int ksh = gk.kshA; const unsigned kmask = (1u << ksh) - 1u; const size_t gstr = gk.gstrA;
#define PG8_KOA(t) ((size_t)((unsigned)(t) >> ksh) * gstr + (size_t)((unsigned)(t) & kmask) * 128u)
    const unsigned ldsw = (unsigned)wid * 1024u;
    const int aoff = lds_byte(wr * 64 + fr, fq * 8), boff = lds_byte(wc * 32 + fr, fq * 8);
#define PG8_SA(b, h) (((b) * 2 + (h)) * HTB)
#define PG8_SB(b, h) ((4 + (b) * 2 + (h)) * HTB)
#define PG8_STAGE(bufoff, gbase, voff) do { _Pragma("unroll") for (int _i = 0; _i < 2; ++_i) \
        __builtin_amdgcn_global_load_lds((const unsigned*)((const char*)(gbase) + (voff)[_i]), (LAS unsigned*)(lds + (bufoff) + ldsw + _i * 8192), 16, 0, 0); } while (0)
#define PG8_LDA(dst, b, h) do { _Pragma("unroll") for (int m = 0; m < 4; ++m) _Pragma("unroll") for (int k = 0; k < 2; ++k) dst[m][k] = *(const LAS bf16x8*)(lds + PG8_SA(b, h) + aoff + m * 2048 + k * 1024); } while (0)
#define PG8_LDB(dst, b, h) do { _Pragma("unroll") for (int n = 0; n < 2; ++n) _Pragma("unroll") for (int k = 0; k < 2; ++k) dst[n][k] = *(const LAS bf16x8*)(lds + PG8_SB(b, h) + boff + n * 2048 + k * 1024); } while (0)
#define PG8_MMA(ai, bj, At, Bt) do { __builtin_amdgcn_s_setprio(1); _Pragma("unroll") for (int m = 0; m < 4; ++m) _Pragma("unroll") for (int n = 0; n < 2; ++n) _Pragma("unroll") for (int k = 0; k < 2; ++k) \
        acc[ai][bj][m][n] = __builtin_amdgcn_mfma_f32_16x16x32_bf16(Bt[n][k], At[m][k], acc[ai][bj][m][n], 0, 0, 0); __builtin_amdgcn_s_setprio(0); } while (0)
#define PG8_WAIT_V(n) asm volatile("s_waitcnt vmcnt(" #n ")" ::: "memory")
#define PG8_WAIT_L(n) asm volatile("s_waitcnt lgkmcnt(" #n ")" ::: "memory")
#define PG8_BAR __builtin_amdgcn_s_barrier()
#define PG8_SCHED __builtin_amdgcn_sched_barrier(0)
    Unit cur, nxt; int ui = 0;
    if (!S.next(0, cur)) return;
    f32x4 acc[2][2][4][2];
#pragma unroll
    for (int a = 0; a < 2; ++a)
#pragma unroll
        for (int b = 0; b < 2; ++b)
#pragma unroll
            for (int m = 0; m < 4; ++m)
#pragma unroll
                for (int n = 0; n < 2; ++n) acc[a][b][m][n] = (f32x4){0.f, 0.f, 0.f, 0.f};
    bf16x8 At[4][2], B0[2][2], B1[2][2];
    const char* cA = cur.A; const char* cB = cur.B;
    PG8_STAGE(PG8_SB(0, 0), cB, voffB); PG8_STAGE(PG8_SB(0, 1), cB + hstepB, voffB); PG8_STAGE(PG8_SA(0, 0), cA, voffA); PG8_STAGE(PG8_SA(0, 1), cA + hstepA, voffA);
    if (wr == 1) PG8_BAR;
    PG8_WAIT_V(2); PG8_BAR;
    PG8_STAGE(PG8_SB(1, 0), cB + 128, voffB); PG8_STAGE(PG8_SA(1, 0), cA + 128, voffA); PG8_STAGE(PG8_SB(1, 1), cB + hstepB + 128, voffB);
    PG8_WAIT_V(6); PG8_BAR;
    for (;;) {
        const bool has_next = S.next(ui + 1, nxt);
        const char* nA = has_next ? nxt.A : cA; const char* nB = has_next ? nxt.B : cB;
        for (int t = 0; t < nt; t += 2) {
            const bool last = (t == nt - 2);
            const char* a1 = cA + PG8_KOA(t + 1);
            const char* a2 = last ? nA : cA + PG8_KOA(t + 2); const char* b2 = last ? nB : cB + (size_t)(t + 2) * 128u;
            const char* a3 = a2 + 128; const char* b3 = b2 + 128;
            PG8_LDB(B0, 0, 0); PG8_LDB(B1, 0, 1); PG8_SCHED; PG8_LDA(At, 0, 0); PG8_STAGE(PG8_SA(1, 1), a1 + hstepA, voffA);
            PG8_WAIT_V(8); PG8_WAIT_L(0); PG8_BAR; PG8_MMA(0, 0, At, B0); PG8_MMA(0, 1, At, B1); PG8_BAR; PG8_SCHED;
            PG8_LDA(At, 0, 1); PG8_STAGE(PG8_SB(0, 0), b2, voffB); PG8_STAGE(PG8_SB(0, 1), b2 + hstepB, voffB); PG8_STAGE(PG8_SA(0, 0), a2, voffA);
            PG8_WAIT_V(8); PG8_WAIT_L(0); PG8_BAR; PG8_MMA(1, 0, At, B0); PG8_MMA(1, 1, At, B1); PG8_BAR; PG8_SCHED;
            PG8_LDB(B0, 1, 0); PG8_LDB(B1, 1, 1); PG8_SCHED; PG8_LDA(At, 1, 0); PG8_STAGE(PG8_SA(0, 1), a2 + hstepA, voffA);
            PG8_WAIT_V(8); PG8_WAIT_L(0); PG8_BAR; PG8_MMA(0, 0, At, B0); PG8_MMA(0, 1, At, B1); PG8_BAR; PG8_SCHED;
            PG8_LDA(At, 1, 1); PG8_STAGE(PG8_SB(1, 0), b3, voffB); PG8_STAGE(PG8_SB(1, 1), b3 + hstepB, voffB); PG8_STAGE(PG8_SA(1, 0), a3, voffA);
            PG8_WAIT_V(8); PG8_WAIT_L(0); PG8_BAR; PG8_MMA(1, 0, At, B0); PG8_MMA(1, 1, At, B1); PG8_BAR; PG8_SCHED;
        }
        if constexpr (ALIGN_EPI) { if (wr == 0) PG8_BAR; }
        E(acc, cur, wr, wc, fr, fq);
        if (!has_next) break;
#pragma unroll
        for (int a = 0; a < 2; ++a)
#pragma unroll
            for (int b = 0; b < 2; ++b)
#pragma unroll
                for (int m = 0; m < 4; ++m)
#pragma unroll
                    for (int n = 0; n < 2; ++n) acc[a][b][m][n] = (f32x4){0.f, 0.f, 0.f, 0.f};
        cur = nxt; cA = nA; cB = nB; ++ui;
        if constexpr (ALIGN_EPI) { if (wr == 1) PG8_BAR; }
    }
    PG8_WAIT_V(0);
    if constexpr (!ALIGN_EPI) { if (wr == 0) PG8_BAR; }
    PG8_BAR;
#undef PG8_KOA
#undef PG8_SA
#undef PG8_SB
#undef PG8_STAGE
#undef PG8_LDA
#undef PG8_LDB
#undef PG8_MMA
#undef PG8_WAIT_V
#undef PG8_WAIT_L
#undef PG8_BAR
#undef PG8_SCHED
}
}
#define XB_TMO      128
#define XB_XCNT(j)  (256  + 64 * (j))
#define XB_XSUB(j)  (1280 + 64 * (j))
#define XB_XGEN(j)  (2304 + 64 * (j))
#define XB_TOP      3328
#define XB_TOPGEN   3392
#define XCD_BAR_WORDS 3456
#define XB_SPIN_CAP (1u << 22)

__device__ __forceinline__ unsigned xb_ld(unsigned* p)              { return __hip_atomic_load(p, __ATOMIC_RELAXED, __HIP_MEMORY_SCOPE_AGENT); }
__device__ __forceinline__ unsigned xb_add(unsigned* p, unsigned v) { return __hip_atomic_fetch_add(p, v, __ATOMIC_RELAXED, __HIP_MEMORY_SCOPE_AGENT); }
__device__ __forceinline__ unsigned xb_xcc_id() { return (unsigned)__builtin_amdgcn_s_getreg((3 << 11) | 20) & 0xFu; }
#define XB_SPIN(cond, bar) do { unsigned _sp = 0; while (cond) { __builtin_amdgcn_s_sleep(1); \
    if ((++_sp & 255u) == 0u) { if (xb_ld(&(bar)[XB_TMO])) break; if (_sp > XB_SPIN_CAP) { atomicAdd(&(bar)[XB_TMO], 1u); break; } } } } while (0)

struct XcdBarrier { unsigned* bar; unsigned x; volatile LAS unsigned* st; };

__device__ __forceinline__ XcdBarrier xcd_barrier_post(unsigned* bar, volatile LAS unsigned* st) {
    XcdBarrier b; b.bar = bar; b.x = xb_xcc_id(); b.st = st;
    if (threadIdx.x == 0) (void)xb_add(&bar[XB_XCNT(b.x)], 1u);
    return b;
}
__device__ __forceinline__ void xcd_barrier_complete(unsigned* bar, unsigned x, unsigned& nloc, unsigned& nx) {
    const unsigned G = gridDim.x * gridDim.y * gridDim.z;
    unsigned sum, cnt, mine, sp = 0u;
    for (;;) {
        sum = 0u; cnt = 0u; mine = 0u;
#pragma unroll
        for (unsigned j = 0; j < 16; ++j) { const unsigned c = xb_ld(&bar[XB_XCNT(j)]); sum += c; cnt += (c > 0u) ? 1u : 0u; mine = (j == x) ? c : mine; }
        if (sum == G) break;
        __builtin_amdgcn_s_sleep(1);
        if ((++sp & 255u) == 0u) { if (xb_ld(&bar[XB_TMO])) break; if (sp > XB_SPIN_CAP) { atomicAdd(&bar[XB_TMO], 1u); break; } }
    }
    nloc = mine > 0u ? mine : 1u; nx = cnt > 0u ? cnt : 1u;
}
__device__ __forceinline__ void xcd_barrier(const XcdBarrier& b) {
    asm volatile("s_waitcnt vmcnt(0)" ::: "memory");
    __syncthreads();
    if (threadIdx.x == 0) {
        unsigned* bar = b.bar;
        __builtin_amdgcn_s_waitcnt(0);
        unsigned nloc = b.st[0], nx = b.st[1];
        if (nloc == 0u) { xcd_barrier_complete(bar, b.x, nloc, nx); b.st[0] = nloc; b.st[1] = nx; }
        const unsigned old = xb_add(&bar[XB_XSUB(b.x)], 1u);
        const unsigned gen = old / nloc;
        if (old + 1u == (gen + 1u) * nloc) {
            __builtin_amdgcn_fence(__ATOMIC_RELEASE, "agent");
            asm volatile("s_waitcnt vmcnt(0)" ::: "memory");
            const unsigned og = xb_add(&bar[XB_TOP], 1u);
            const unsigned tg = og / nx;
            if (og + 1u == (tg + 1u) * nx) xb_add(&bar[XB_TOPGEN], 1u);
            else XB_SPIN(xb_ld(&bar[XB_TOPGEN]) == tg, bar);
            __builtin_amdgcn_fence(__ATOMIC_ACQUIRE, "agent");
            xb_add(&bar[XB_XGEN(b.x)], 1u);
            asm volatile("s_waitcnt vmcnt(0)" ::: "memory");
        } else {
            XB_SPIN(xb_ld(&bar[XB_XGEN(b.x)]) == gen, bar);
            __builtin_amdgcn_fence(__ATOMIC_ACQUIRE, "agent");
            asm volatile("s_waitcnt vmcnt(0)" ::: "memory");
        }
    }
    __syncthreads();
}

struct Frame {
    LAS unsigned char* lds;
    char* ldsg;
    volatile LAS unsigned* MISC;
    gu32* ctl;
    int tid, lane, wave, vcu, G;
    const __attribute__((address_space(4))) char* kap;
    float* out; unsigned char* ws;
};
#define FIN(i) (*(const float* const __attribute__((address_space(4)))*)(F.kap + 8 * (i)))
#define PHASE_FENCE() do { unsigned long long k_ = (unsigned long long)F.kap; asm volatile("" : "+s"(k_)); F.kap = (const __attribute__((address_space(4))) char*)k_; \
    int t_ = F.tid; asm volatile("" : "+v"(t_)); F.tid = t_; F.lane = t_ & 63; } while (0)
#define WSP(T, off) ((T*)(F.ws + (off)))
#define GRP(g) (WSP(bf16, WS_PROJ) + (size_t)(g) * GS)
#define QKVG(g) (WSP(bf16, WS_QKV) + (size_t)(g) * GS)

__device__ __forceinline__ void rms_row(const float* xrow, const float* gain, int lane, f32x4 (&v)[4]) {
    const GAS f32x4* xr = (const GAS f32x4*)xrow + lane; float s = 0.f;
#pragma unroll
    for (int j = 0; j < 4; ++j) { v[j] = xr[64 * j]; s += (v[j].x * v[j].x + v[j].y * v[j].y) + (v[j].z * v[j].z + v[j].w * v[j].w); }
    const float rstd = 1.0f / sqrtf(wave_sum(s) * (1.f / DM) + RMS_EPS);
#pragma unroll
    for (int j = 0; j < 4; ++j) { const f32x4 g = ((const GAS f32x4*)gain)[lane + 64 * j]; v[j] = v[j] * rstd * g; }
}
__device__ __forceinline__ void store_row_bf16(bf16* orow, int lane, const f32x4 (&v)[4]) {
    GAS unsigned long long* o8 = (GAS unsigned long long*)orow + lane;
#pragma unroll
    for (int j = 0; j < 4; ++j) o8[64 * j] = (unsigned long long)cvtpk(v[j].x, v[j].y) | ((unsigned long long)cvtpk(v[j].z, v[j].w) << 32);
}
__device__ __forceinline__ void load_row_bf16(const bf16* row, int lane, float (&v)[16]) {
    const v4u a = ((const GAS v4u*)row)[lane], b = ((const GAS v4u*)row)[64 + lane];
#pragma unroll
    for (int q = 0; q < 4; ++q) { v[2 * q] = __uint_as_float(a[q] << 16); v[2 * q + 1] = __uint_as_float(a[q] & 0xffff0000u); v[8 + 2 * q] = __uint_as_float(b[q] << 16); v[8 + 2 * q + 1] = __uint_as_float(b[q] & 0xffff0000u); }
}
__device__ __forceinline__ void store_row16_bf16(bf16* row, int lane, const float (&v)[16]) {
    ((GAS v4u*)row)[lane] = (v4u){cvtpk(v[0], v[1]), cvtpk(v[2], v[3]), cvtpk(v[4], v[5]), cvtpk(v[6], v[7])};
    ((GAS v4u*)row)[64 + lane] = (v4u){cvtpk(v[8], v[9]), cvtpk(v[10], v[11]), cvtpk(v[12], v[13]), cvtpk(v[14], v[15])};
}
__device__ __forceinline__ void rms16(float (&v)[16], const float* gain, int lane) {
    float s = 0.f;
#pragma unroll
    for (int i = 0; i < 16; ++i) s += v[i] * v[i];
    const float rstd = 1.0f / sqrtf(wave_sum(s) * (1.f / DM) + RMS_EPS);
    const f32x4 g0 = ((const GAS f32x4*)gain)[2 * lane], g1 = ((const GAS f32x4*)gain)[2 * lane + 1], g2 = ((const GAS f32x4*)gain)[128 + 2 * lane], g3 = ((const GAS f32x4*)gain)[128 + 2 * lane + 1];
#pragma unroll
    for (int i = 0; i < 4; ++i) { v[i] *= rstd * g0[i]; v[4 + i] *= rstd * g1[i]; v[8 + i] *= rstd * g2[i]; v[12 + i] *= rstd * g3[i]; }
}
__device__ __forceinline__ void norm_phase(Frame& F, const float* srcf, const bf16* srcb, const float* gain) {
    const int gw = F.vcu * NWAVES + F.wave, NGW = F.G * NWAVES;
    if (srcf) { for (int m = gw; m < M; m += 2 * NGW) { f32x4 v[4], w[4]; const int mb = m + NGW;
            const GAS f32x4* xa = (const GAS f32x4*)(srcf + (size_t)m * DM) + F.lane; const GAS f32x4* xb = (const GAS f32x4*)(srcf + (size_t)(mb < M ? mb : m) * DM) + F.lane;
#pragma unroll
            for (int j = 0; j < 4; ++j) { v[j] = xa[64 * j]; w[j] = xb[64 * j]; }
            float sa = 0.f, sb = 0.f;
#pragma unroll
            for (int j = 0; j < 4; ++j) { sa += (v[j].x * v[j].x + v[j].y * v[j].y) + (v[j].z * v[j].z + v[j].w * v[j].w); sb += (w[j].x * w[j].x + w[j].y * w[j].y) + (w[j].z * w[j].z + w[j].w * w[j].w); }
            const float ra = 1.0f / sqrtf(wave_sum(sa) * (1.f / DM) + RMS_EPS), rb = 1.0f / sqrtf(wave_sum(sb) * (1.f / DM) + RMS_EPS);
#pragma unroll
            for (int j = 0; j < 4; ++j) { const f32x4 g = ((const GAS f32x4*)gain)[F.lane + 64 * j]; v[j] = v[j] * ra * g; w[j] = w[j] * rb * g; }
            store_row_bf16(WSP(bf16, WS_XN) + (size_t)m * DM, F.lane, v); if (mb < M) store_row_bf16(WSP(bf16, WS_XN) + (size_t)mb * DM, F.lane, w); } }
    else { for (int m = gw; m < M; m += NGW) { float v[16]; load_row_bf16(srcb + (size_t)m * DM, F.lane, v); rms16(v, gain, F.lane); store_row16_bf16(WSP(bf16, WS_XN) + (size_t)m * DM, F.lane, v); } }
}

struct SrcCol { const float* W; int col; int ldw; };
template <class Fn>
__device__ __forceinline__ void xpose_load(const Fn& fn, int K, const float* kgain, int item, int lane, float (&v)[32]) {
    const int nkb = K / 64, rb = item / nkb, kb = item % nkb, k0 = 64 * kb, r0 = 32 * rb;
    const SrcCol s = fn(r0 + (lane & 31));
#pragma unroll
    for (int i = 0; i < 32; ++i) { const int kk = 2 * i + (lane >> 5); float x = 0.f; if (s.W) { x = s.W[(size_t)(k0 + kk) * s.ldw + s.col]; if (kgain) x *= kgain[k0 + kk]; } v[i] = x; }
}
__device__ __forceinline__ void xpose_store(int K, bf16* WT, LAS float* scr, int item, int lane, const float (&v)[32]) {
    const int nkb = K / 64, rb = item / nkb, kb = item % nkb, k0 = 64 * kb, r0 = 32 * rb;
#pragma unroll
    for (int i = 0; i < 32; ++i) scr[(2 * i + (lane >> 5)) * 33 + (lane & 31)] = v[i];
    LDS_WAIT(); asm volatile("" ::: "memory");
    const int c = lane & 7;
#pragma unroll
    for (int j = 0; j < 4; ++j) { const int n = (lane >> 3) + 8 * j; const LAS float* sp = scr + (8 * c) * 33 + n;
        v4u o; o.x = cvtpk(sp[0 * 33], sp[1 * 33]); o.y = cvtpk(sp[2 * 33], sp[3 * 33]); o.z = cvtpk(sp[4 * 33], sp[5 * 33]); o.w = cvtpk(sp[6 * 33], sp[7 * 33]);
        *(GAS v4u*)(WT + (size_t)(r0 + n) * K + k0 + 8 * c) = o; }
    LDS_WAIT(); asm volatile("" ::: "memory");
}
template <class Fn>
__device__ __forceinline__ void xpose_matrix(const Fn& fn, int K, bf16* WT, const float* kgain, LAS float* scr, int first, int nitems, int stride, int lane) {
    float va[32], vb[32];
    int it = first;
    if (it < nitems) xpose_load(fn, K, kgain, it, lane, va);
    while (it < nitems) {
        const int i1 = it + stride, i2 = i1 + stride;
        if (i1 < nitems) xpose_load(fn, K, kgain, i1, lane, vb);
        xpose_store(K, WT, scr, it, lane, va);
        if (i1 >= nitems) break;
        if (i2 < nitems) xpose_load(fn, K, kgain, i2, lane, va);
        xpose_store(K, WT, scr, i1, lane, vb);
        it = i2;
    }
}
__device__ __forceinline__ int incol(int rho) {
    const int g = rho >> 7, c = rho & 127;
    if (g < 4) return rho;
    if (g < 6) return 512 + (rho - 512);
    if (g < 8) return 768 + (rho - 768);
    if (g < 12) return 1092 + (rho - 1024);
    if (g < 18) return 1604 + (rho - 1536);
    if (g == 18) { if (c < 64) return 1024 + c; if (c < 68) return 1088 + (c - 64); if (c < 80) return 2372 + (c - 68); return -1; }
    return -1;
}
struct FnIn { const float* W; __device__ __forceinline__ SrcCol operator()(int r) const { const int c = incol(r); return SrcCol{c >= 0 ? W : nullptr, c, 2384}; } };
struct FnPlain { const float* W; int ldw; int coff; __device__ __forceinline__ SrcCol operator()(int r) const { return SrcCol{W, r + coff, ldw}; } };
struct FnGU { const float* Wg; const float* Wu; int ldw; __device__ __forceinline__ SrcCol operator()(int r) const { const int pn = r >> 8, c = r & 127;
    const long long d = (r & 128) ? ((const char*)Wu - (const char*)Wg) : 0ll;
    return SrcCol{(const float*)((const char*)Wg + d), pn * 128 + c, ldw}; } };
namespace att {
constexpr int KVBLK = 64, SHM_K = KVBLK * 128 * 2, SHM_V = KVBLK * 128 * 2;
#define KSWZ(row, colB) ((row) * 256 + ((colB) ^ (((row) & 7) << 4)))
__device__ __forceinline__ int v_st(int k, int c) { const int kk = (k & ~0xC) | ((k & 4) << 1) | ((k & 8) >> 1); return ((kk >> 3) * 4 + (c >> 5)) * 512 + ((kk & 7) * 32 + (c & 31)) * 2; }
__device__ __forceinline__ int v_rd_base(int lane) { return ((lane & 3) << 3) | (((lane >> 2) & 3) << 6) | (((lane >> 4) & 1) << 5) | (((lane >> 5) & 1) << 8); }
constexpr int v_rd_off(int d0, int ks, int half) { return d0 * 512 + ks * 4096 + half * 2048; }
__device__ __forceinline__ int crow(int r, int hi) { return (r & 3) + 8 * (r >> 2) + 4 * hi; }
__device__ __forceinline__ void qkt(f32x16& p0, f32x16& p1, const char* K_lds, int r32, int hi, const bf16x8* qr) {
    p0 = f32x16{}; p1 = f32x16{};
    const char* kb[4];
#pragma unroll
    for (int dd = 0; dd < 4; ++dd) kb[dd] = K_lds + KSWZ(r32, (dd * 16 + hi * 8) * 2);
#pragma unroll
    for (int d0 = 0; d0 < 8; ++d0) { const char* a = kb[d0 & 3] + (d0 >> 2) * 128;
        bf16x8 b0 = *reinterpret_cast<const bf16x8*>(a);
        bf16x8 b1 = *reinterpret_cast<const bf16x8*>(a + 32 * 256);
        p0 = __builtin_amdgcn_mfma_f32_32x32x16_bf16(b0, qr[d0], p0, 0, 0, 0);
        p1 = __builtin_amdgcn_mfma_f32_32x32x16_bf16(b1, qr[d0], p1, 0, 0, 0);
        if (d0 == 3) SBAR(); }
}
__device__ __forceinline__ void qkt_lq(f32x16& p0, f32x16& p1, const char* K_lds, const char* Q_lds, int r32, int hi) {
    p0 = f32x16{}; p1 = f32x16{};
    int ko[4];
#pragma unroll
    for (int dd = 0; dd < 4; ++dd) ko[dd] = KSWZ(r32, (dd * 16 + hi * 8) * 2);
#pragma unroll
    for (int d0 = 0; d0 < 8; ++d0) { const int a = ko[d0 & 3] + (d0 >> 2) * 128;
        bf16x8 b0 = *reinterpret_cast<const bf16x8*>(K_lds + a);
        bf16x8 b1 = *reinterpret_cast<const bf16x8*>(K_lds + a + 32 * 256);
        bf16x8 q = *reinterpret_cast<const bf16x8*>(Q_lds + a);
        p0 = __builtin_amdgcn_mfma_f32_32x32x16_bf16(b0, q, p0, 0, 0, 0);
        p1 = __builtin_amdgcn_mfma_f32_32x32x16_bf16(b1, q, p1, 0, 0, 0);
        if (d0 == 3) SBAR(); }
}
__device__ __forceinline__ void pv_tile(f32x16* o, int vb0, bf16x8 pa0, bf16x8 pa1, bf16x8 pa2, bf16x8 pa3) {
#define TRRD(dst, off) asm volatile("ds_read_b64_tr_b16 %0, %1 offset:%2" : "=&v"(dst) : "v"(vb0), "i"(off) : "memory")
#define PV_RD(S, d0) do { constexpr int b_ = v_rd_off(d0, 0, 0); \
        TRRD(S##l0, b_); TRRD(S##h0, b_ + 2048); TRRD(S##l1, b_ + 4096); TRRD(S##h1, b_ + 6144); TRRD(S##l2, b_ + 8192); TRRD(S##h2, b_ + 10240); TRRD(S##l3, b_ + 12288); TRRD(S##h3, b_ + 14336); } while (0)
#define PV_MM(S, d0) do { \
        o[d0] = __builtin_amdgcn_mfma_f32_32x32x16_bf16(pa0, (bf16x8){S##l0[0], S##l0[1], S##l0[2], S##l0[3], S##h0[0], S##h0[1], S##h0[2], S##h0[3]}, o[d0], 0, 0, 0);   \
        o[d0] = __builtin_amdgcn_mfma_f32_32x32x16_bf16(pa1, (bf16x8){S##l1[0], S##l1[1], S##l1[2], S##l1[3], S##h1[0], S##h1[1], S##h1[2], S##h1[3]}, o[d0], 0, 0, 0);   \
        o[d0] = __builtin_amdgcn_mfma_f32_32x32x16_bf16(pa2, (bf16x8){S##l2[0], S##l2[1], S##l2[2], S##l2[3], S##h2[0], S##h2[1], S##h2[2], S##h2[3]}, o[d0], 0, 0, 0);   \
        o[d0] = __builtin_amdgcn_mfma_f32_32x32x16_bf16(pa3, (bf16x8){S##l3[0], S##l3[1], S##l3[2], S##l3[3], S##h3[0], S##h3[1], S##h3[2], S##h3[3]}, o[d0], 0, 0, 0); } while (0)
    s16x4 Al0, Al1, Al2, Al3, Ah0, Ah1, Ah2, Ah3, Bl0, Bl1, Bl2, Bl3, Bh0, Bh1, Bh2, Bh3;
    PV_RD(A, 0); PV_RD(B, 1);
    asm volatile("s_waitcnt lgkmcnt(8)" ::: "memory"); SBAR(); PV_MM(A, 0); SBAR();
    PV_RD(A, 2);
    asm volatile("s_waitcnt lgkmcnt(8)" ::: "memory"); SBAR(); PV_MM(B, 1); SBAR();
    PV_RD(B, 3);
    asm volatile("s_waitcnt lgkmcnt(8)" ::: "memory"); SBAR(); PV_MM(A, 2); SBAR();
    asm volatile("s_waitcnt lgkmcnt(0)" ::: "memory"); SBAR(); PV_MM(B, 3);
#undef PV_RD
#undef PV_MM
#undef TRRD
}
__device__ __forceinline__ void pack_p(const f32x16& p0, const f32x16& p1, bf16x8& pa0, bf16x8& pa1, bf16x8& pa2, bf16x8& pa3) {
#define PK4(P, B_, OUT) do { unsigned a0 = cvtpk(P[B_+0], P[B_+1]), a1 = cvtpk(P[B_+2], P[B_+3]);                          \
        unsigned b0 = cvtpk(P[B_+4], P[B_+5]), b1 = cvtpk(P[B_+6], P[B_+7]);                                             \
        auto r0 = __builtin_amdgcn_permlane32_swap(a0, b0, false, false); auto r1 = __builtin_amdgcn_permlane32_swap(a1, b1, false, false); \
        v4u w = {r0[0], r1[0], r0[1], r1[1]}; OUT = __builtin_bit_cast(bf16x8, w); } while (0)
    PK4(p0, 0, pa0); PK4(p0, 8, pa1); PK4(p1, 0, pa2); PK4(p1, 8, pa3);
#undef PK4
}
__device__ __forceinline__ float xhalf_max(float v) { auto rr = __builtin_amdgcn_permlane32_swap(__float_as_uint(v), __float_as_uint(v), false, false); return fmaxf(__uint_as_float(rr[0]), __uint_as_float(rr[1])); }
__device__ __forceinline__ float xhalf_sum(float v) { auto rr = __builtin_amdgcn_permlane32_swap(__float_as_uint(v), __float_as_uint(v), false, false); return __uint_as_float(rr[0]) + __uint_as_float(rr[1]); }
typedef float f32x8v __attribute__((ext_vector_type(8)));
typedef float f32x4v __attribute__((ext_vector_type(4)));
typedef float f32x2v __attribute__((ext_vector_type(2)));
__device__ __forceinline__ float sum32(const f32x16& a, const f32x16& b) {
    const f32x16 s = a + b;
    const f32x8v h = __builtin_shufflevector(s, s, 0, 1, 2, 3, 4, 5, 6, 7) + __builtin_shufflevector(s, s, 8, 9, 10, 11, 12, 13, 14, 15);
    const f32x4v f = __builtin_shufflevector(h, h, 0, 1, 2, 3) + __builtin_shufflevector(h, h, 4, 5, 6, 7);
    const f32x2v t = __builtin_shufflevector(f, f, 0, 1) + __builtin_shufflevector(f, f, 2, 3);
    return t[0] + t[1];
}
__device__ __forceinline__ void softmax_step(f32x16& p0, f32x16& p1, float& m_reg, float& l_reg, f32x16* o, float* al_l, int r32, int hi) {
    float pmax = p0[0];
#pragma unroll
    for (int r = 1; r < 16; ++r) pmax = fmaxf(pmax, p0[r]);
#pragma unroll
    for (int r = 0; r < 16; ++r) pmax = fmaxf(pmax, p1[r]);
    pmax = xhalf_max(pmax);
    float mn, alpha;
    if (__all(pmax - m_reg <= 8.f)) { mn = m_reg; alpha = 1.f; }
    else { mn = fmaxf(m_reg, pmax); alpha = __builtin_amdgcn_exp2f(m_reg - mn); m_reg = mn; }
    { const float nm = -mn; p0 = p0 + nm; p1 = p1 + nm; }
#pragma unroll
    for (int r = 0; r < 16; ++r) { p0[r] = __builtin_amdgcn_exp2f(p0[r]); p1[r] = __builtin_amdgcn_exp2f(p1[r]); }
    float ps = sum32(p0, p1);
    ps = xhalf_sum(ps);
    l_reg = l_reg * alpha + ps;
    if (__any(alpha < 1.f)) { if (hi == 0) al_l[r32] = alpha; asm volatile("s_waitcnt lgkmcnt(0)" ::: "memory");
#pragma unroll
        for (int d_ = 0; d_ < 4; ++d_)
#pragma unroll
            for (int r = 0; r < 16; ++r) o[d_][r] *= al_l[crow(r, hi)];
        asm volatile("s_waitcnt lgkmcnt(0)" ::: "memory"); }
}
__device__ __forceinline__ void softmax_step_row(f32x16& p0, f32x16& p1, bool on, float& m_reg, float& l_reg, f32x16* o, float* al_l, int r32, int hi) {
    float pmax = p0[0];
#pragma unroll
    for (int r = 1; r < 16; ++r) pmax = fmaxf(pmax, p0[r]);
#pragma unroll
    for (int r = 0; r < 16; ++r) pmax = fmaxf(pmax, p1[r]);
    pmax = on ? pmax : -__builtin_inff();
    pmax = xhalf_max(pmax);
    float mn, alpha;
    if (__all(pmax - m_reg <= 8.f)) { mn = m_reg; alpha = 1.f; }
    else { mn = fmaxf(m_reg, pmax); alpha = __builtin_amdgcn_exp2f(m_reg - mn); m_reg = mn; }
    const float me = on ? mn : __builtin_inff();
    { const float nm = -me; p0 = p0 + nm; p1 = p1 + nm; }
#pragma unroll
    for (int r = 0; r < 16; ++r) { p0[r] = __builtin_amdgcn_exp2f(p0[r]); p1[r] = __builtin_amdgcn_exp2f(p1[r]); }
    float ps = sum32(p0, p1);
    ps = xhalf_sum(ps);
    l_reg = l_reg * alpha + ps;
    if (__any(alpha < 1.f)) { if (hi == 0) al_l[r32] = alpha; asm volatile("s_waitcnt lgkmcnt(0)" ::: "memory");
#pragma unroll
        for (int d_ = 0; d_ < 4; ++d_)
#pragma unroll
            for (int r = 0; r < 16; ++r) o[d_][r] *= al_l[crow(r, hi)];
        asm volatile("s_waitcnt lgkmcnt(0)" ::: "memory"); }
}
struct DmaOff { unsigned k[2], v[2]; };
__device__ __forceinline__ void dma_offsets(DmaOff& d, int tid) {
#pragma unroll
    for (int i = 0; i < 2; ++i) { const int L = i * 8192 + tid * 16;
        const int row = L >> 8, pos = (L >> 4) & 15, c = pos ^ (row & 7); d.k[i] = (unsigned)(row * 256 + c * 16);
        const int sub = L >> 9, within = L & 511, kk = (sub >> 2) * 8 + (within >> 6), ccol = (within & 63) >> 1, cblk = sub & 3;
        const int k = (kk & ~0xC) | ((kk & 4) << 1) | ((kk & 8) >> 1); d.v[i] = (unsigned)(k * 256 + (cblk * 32 + ccol) * 2); }
}
__device__ __forceinline__ void dma_tile(const DmaOff& d, const bf16* Kp, const bf16* Vp, int key0, LAS unsigned char* buf, int wid) {
    const char* kb = (const char*)(Kp + (size_t)key0 * 128); const char* vb = (const char*)(Vp + (size_t)key0 * 128);
#pragma unroll
    for (int i = 0; i < 2; ++i) {
        __builtin_amdgcn_global_load_lds((const unsigned*)(kb + d.k[i]), (LAS unsigned*)(buf + 16384 + i * 8192 + wid * 1024), 16, 0, 0);
        __builtin_amdgcn_global_load_lds((const unsigned*)(vb + d.v[i]), (LAS unsigned*)(buf + i * 8192 + wid * 1024), 16, 0, 0); }
}
}
constexpr int AL_BUF = 0  , AL_Q = 65536  ;
constexpr int AL_WS = MISC_OFF + 2048  , AL_TBL = AL_WS + 2048  , AL_UNI = AL_TBL + 4 * 320 * 4  , AL_TRI = AL_UNI + 256  , AL_GB = AL_TRI + 2048  , AL_TBL132 = MISC_OFF + 12288  ;
static_assert(AL_Q + 65536 <= RING_BYTES && AL_GB + 128 <= AL_TBL132 && AL_TBL132 + 4 * 132 * 4 <= LDS_BYTES, "attention LDS map");

__device__ __forceinline__ void fill_bias_tbl132(Frame& F, float* tbl, int h0) {
    const float* rb = FIN(I_RELB);
    for (int i = F.tid; i < 4 * 132; i += NTHR) { const int h = i / 132, d = i % 132; const int dd = d > 128 ? 128 : d;
        tbl[i] = (rb[rel_bucket_dev(dd) * 8 + h0 + h] - rb[31 * 8 + h0 + h]) * LOG2E; }
}
__device__ __forceinline__ void fill_bias_tbl(Frame& F, float* tbl, int h0) {
    const float* rb = FIN(I_RELB);
    for (int i = F.tid; i < 4 * 320; i += NTHR) { const int h = i / 320, d = i % 320 - 96;
        tbl[i] = (d >= 0 && d < 113) ? (rb[rel_bucket_dev(d) * 8 + h0 + h] - rb[31 * 8 + h0 + h]) * LOG2E : 0.f; }
}

template <int MODE>
__device__ __forceinline__ void attn_unit(Frame& F, int b, int qt) {
    using namespace att;
    char* lds = F.ldsg;
    int tid = F.tid; asm volatile("" : "+v"(tid));
    const int wid = F.wave, lane = tid & 63, r32 = lane & 31, hi = lane >> 5;
    const int hd = wid & 3, qh = wid >> 2, q0 = qt * 64, tw = q0 + 32 * qh, t = tw + r32;
    const size_t rowg = (size_t)b * SEQ;
    float* wsf = (float*)(lds + AL_WS) + wid * 64; float* li_l = wsf; float* al_l = wsf + 32;
    const float* tbl = (const float*)(lds + AL_TBL) + hd * 320;
    const bf16* Qp = GRP((MODE == 0 ? G_QA : G_QB) + hd) + (rowg + t) * 128;
    const bf16* Kp = (MODE == 0 ? WSP(bf16, WS_AK) : MODE == 1 ? GRP(G_SK) : GRP(G_WK)) + rowg * 128;
    const bf16* Vp = (MODE == 0 ? WSP(bf16, WS_AV) : MODE == 1 ? GRP(G_SV) : GRP(G_WV)) + rowg * 128;
    bf16x8 qr[8];
#pragma unroll
    for (int d0 = 0; d0 < 8; ++d0) qr[d0] = *(const bf16x8*)(Qp + d0 * 16 + hi * 8);
    unsigned long long todo = (qt == 63) ? ~0ull : ((2ull << qt) - 1ull);
    unsigned long long bm64 = 0ull;
    if (MODE == 1) {
        bm64 = WSP(unsigned long long, WS_BLK)[rowg + t];
        volatile LAS unsigned* uni = (volatile LAS unsigned*)(F.lds + AL_UNI);
        if (tid < 2) uni[tid] = 0u;
        __syncthreads();
        __hip_atomic_fetch_or((LAS unsigned*)(F.lds + AL_UNI), (unsigned)bm64, __ATOMIC_RELAXED, __HIP_MEMORY_SCOPE_WORKGROUP);
        __hip_atomic_fetch_or((LAS unsigned*)(F.lds + AL_UNI) + 1, (unsigned)(bm64 >> 32), __ATOMIC_RELAXED, __HIP_MEMORY_SCOPE_WORKGROUP);
        __syncthreads();
        const unsigned long long um = (unsigned long long)uni[0] | ((unsigned long long)uni[1] << 32);
        todo &= um;
    }
    if (MODE == 2) { const int jl = q0 >= 511 ? ((q0 - 511) >> 6) : 0; todo &= ~((1ull << jl) - 1ull); }
    todo = ((unsigned long long)__builtin_amdgcn_readfirstlane((unsigned)todo)) | ((unsigned long long)__builtin_amdgcn_readfirstlane((unsigned)(todo >> 32)) << 32);
    const unsigned* bmrow = WSP(unsigned, WS_BM) + (rowg + t) * 128;
    float m_reg = -1e30f, l_reg = 0.f; f32x16 o[4] = {};
    const int vrb = v_rd_base(lane);
    DmaOff dof; dma_offsets(dof, tid);
    int j = __builtin_ctzll(todo); todo &= todo - 1ull;
    int buf = 0;
    v2u wsel = {0u, 0u}, wnx = {0u, 0u};
    if (MODE == 0) wnx = *(const v2u*)(bmrow + 2 * j);
    dma_tile(dof, Kp, Vp, j * 64, F.lds + AL_BUF, wid);
    for (;;) {
        asm volatile("s_waitcnt vmcnt(0)" ::: "memory");
        __syncthreads();
        const int jn = todo ? __builtin_ctzll(todo) : -1;
        if (MODE == 0) { wsel = wnx; if (jn >= 0) wnx = *(const v2u*)(bmrow + 2 * jn); }
        if (jn >= 0) { todo &= todo - 1ull; dma_tile(dof, Kp, Vp, jn * 64, F.lds + AL_BUF + (buf ^ 1) * 32768, wid); }
        const char* V_lds = lds + AL_BUF + buf * 32768; const char* K_lds = V_lds + 16384;
        const int vb0 = (int)(uintptr_t)(lds + AL_BUF + buf * 32768) + vrb;
        const int kb = j * 64;
        bool act = true;
        if (MODE == 1) act = __any((int)((bm64 >> j) & 1ull));
        if (MODE == 2) act = (kb <= tw + 31) && (kb + 63 >= tw - 511);
        if (MODE == 0) act = (kb <= tw + 31);
        if (act) {
            f32x16 p0, p1;
            qkt(p0, p1, K_lds, r32, hi, qr); SBAR();
            const float NEG = -__builtin_inff(); bool rowon = true;
            const int dq = t - kb - 4 * hi;
            if (tw - (kb + 63) < 128) {
                const float* tp = tbl + (dq + 37);
#pragma unroll
                for (int r = 0; r < 16; ++r) { const int c = (r & 3) + 8 * (r >> 2); p0[r] += tp[59 - c]; p1[r] += tp[27 - c]; }
            }
            if (MODE == 0) {
                const unsigned w0 = wsel.x >> (4 * hi), w1 = wsel.y >> (4 * hi);
#pragma unroll
                for (int r = 0; r < 16; ++r) { const int c = (r & 3) + 8 * (r >> 2);
                    const unsigned m0 = (unsigned)__builtin_amdgcn_sbfe((int)w0, c, 1), m1 = (unsigned)__builtin_amdgcn_sbfe((int)w1, c, 1);
                    p0[r] = __uint_as_float((__float_as_uint(p0[r]) & m0) | (0xff800000u & ~m0));
                    p1[r] = __uint_as_float((__float_as_uint(p1[r]) & m1) | (0xff800000u & ~m1)); }
            } else {
                if (MODE == 1) {
                    if (kb + 63 > tw) {
                        const int dqs = ((bm64 >> j) & 1ull) ? dq : -0x40000000;
#pragma unroll
                        for (int r = 0; r < 16; ++r) { const int c = (r & 3) + 8 * (r >> 2);
                            if (dqs < c) p0[r] = NEG;
                            if (dqs < c + 32) p1[r] = NEG; }
                    } else rowon = ((bm64 >> j) & 1ull) != 0ull;
                } else if (tw - (kb + 63) < 0 || tw + 31 - kb >= 512) {
#pragma unroll
                    for (int r = 0; r < 16; ++r) { const int c = (r & 3) + 8 * (r >> 2);
                        if ((unsigned)(dq - c) >= 512u) p0[r] = NEG;
                        if ((unsigned)(dq - c - 32) >= 512u) p1[r] = NEG; }
                }
            }
            SBAR(); if (MODE == 1) softmax_step_row(p0, p1, rowon, m_reg, l_reg, o, al_l, r32, hi); else softmax_step(p0, p1, m_reg, l_reg, o, al_l, r32, hi); SBAR();
            bf16x8 pa0, pa1, pa2, pa3;
            pack_p(p0, p1, pa0, pa1, pa2, pa3); SBAR();
            pv_tile(o, vb0, pa0, pa1, pa2, pa3); SBAR();
        }
        if (jn < 0) break;
        j = jn; buf ^= 1;
    }
    {
        float fac = l_reg > 0.f ? 1.0f / l_reg : 0.f;
        if (MODE != 0) { const float gl = bf2f(GRP(G_MISC)[(rowg + t) * 128 + 68 + MODE * 4 + hd]); fac *= 1.0f / (1.0f + __expf(-gl)); }
        if (hi == 0) li_l[r32] = fac;
        asm volatile("s_waitcnt lgkmcnt(0)" ::: "memory");
        float rli[16];
#pragma unroll
        for (int r = 0; r < 16; ++r) rli[r] = li_l[crow(r, hi)];
        const size_t row0 = rowg + tw;
        if (MODE == 1) {
            const float* OCp = WSP(float, WS_OC) + row0 * 512 + hd * 128; float* OC2p = WSP(float, WS_OC2) + row0 * 512 + hd * 128;
#pragma unroll
            for (int r = 0; r < 16; ++r) { const int orow = crow(r, hi);
#pragma unroll
                for (int d0 = 0; d0 < 4; ++d0) { const size_t ix = (size_t)orow * 512 + d0 * 32 + r32; OC2p[ix] = OCp[ix] + o[d0][r] * rli[r]; } }
        } else {
            bf16* Op = WSP(bf16, WS_O) + row0 * DM + (MODE == 2 ? 512 : 0) + hd * 128;
            const float* OCp = WSP(float, WS_OC2) + row0 * 512 + hd * 128;
#pragma unroll
            for (int r = 0; r < 16; ++r) { const int orow = crow(r, hi);
#pragma unroll
                for (int d0 = 0; d0 < 4; ++d0) { float v = o[d0][r] * rli[r];
                    if (MODE == 2) v += OCp[(size_t)orow * 512 + d0 * 32 + r32];
                    const float vn = __shfl_xor(v, 1);
                    if ((r32 & 1) == 0) *(unsigned*)(Op + (size_t)orow * DM + d0 * 32 + r32) = cvtpk(v, vn); } }
        }
    }
    __syncthreads();
}
__device__ __forceinline__ float idx_k2f(unsigned k) { return __uint_as_float((k & 0x80000000u) ? (k & 0x7fffffffu) : ~k); }
__device__ __forceinline__ unsigned idx_f2k(float f) { const unsigned u = __float_as_uint(f); return (u >> 31) ? ~u : (u | 0x80000000u); }
__device__ __forceinline__ unsigned half_sum_dpp(unsigned x) {
    x += (unsigned)__builtin_amdgcn_update_dpp(0, (int)x, 0x111, 0xf, 0xf, true);
    x += (unsigned)__builtin_amdgcn_update_dpp(0, (int)x, 0x112, 0xf, 0xf, true);
    x += (unsigned)__builtin_amdgcn_update_dpp(0, (int)x, 0x114, 0xf, 0xf, true);
    x += (unsigned)__builtin_amdgcn_update_dpp(0, (int)x, 0x118, 0xf, 0xf, true);
    x += (unsigned)__builtin_amdgcn_update_dpp(0, (int)x, 0x142, 0xa, 0xf, true);
    return x;
}
constexpr int IL_CAND = MISC_OFF + 2048, IL_HIST = IL_CAND + 4096;
__device__ __forceinline__ unsigned wave_sum_dpp63(unsigned x) {
    x = half_sum_dpp(x); x += (unsigned)__builtin_amdgcn_update_dpp(0, (int)x, 0x143, 0xc, 0xf, true); return (unsigned)__builtin_amdgcn_readlane((int)x, 63); }
__device__ __forceinline__ void idx_unit(Frame& F, int b, int tq, unsigned sub) {
    int tid = F.tid; asm volatile("" : "+v"(tid));
    const int wid = F.wave, lane = tid & 63, r32 = lane & 31, hi = lane >> 5;
    const int t0 = tq * 8; const size_t rowg = (size_t)b * SEQ;
    unsigned* bmrow = WSP(unsigned, WS_BM) + (rowg + t0) * 128;
    const int NT = 2 * (t0 >> 6) + 2;
    if (t0 + 8 <= 256) {
        for (int i = tid; i < 8 * NT; i += NTHR) { const int q = i / NT, wd = i % NT, t = t0 + q, lo = wd * 32;
            const unsigned word = (t >= lo + 31) ? 0xffffffffu : (t < lo ? 0u : ((2u << (t - lo)) - 1u)); bmrow[q * 128 + wd] = word; }
        return;
    }
    LAS unsigned* S = (LAS unsigned*)F.lds;
    const bf16* misc = GRP(G_MISC);
    const bf16* ikt = WSP(bf16, WS_IKT) + (size_t)b * 128 * 2048 + lane * 8;
    {
        bf16x8 aq[4];
        { const int ql = r32 >> 2, h = r32 & 3; const bf16* p = GRP(G_IQ + (h >> 1)) + (rowg + t0 + ql) * 128 + (h & 1) * 64 + hi * 8;
#pragma unroll
          for (int c = 0; c < 4; ++c) aq[c] = *(const bf16x8*)(p + c * 16); }
        float wq[4][4];
#pragma unroll
        for (int qj = 0; qj < 4; ++qj) { const v2u w = *(const v2u*)(misc + (rowg + t0 + 2 * qj + hi) * 128 + 64);
            wq[qj][0] = __uint_as_float(w.x << 16); wq[qj][1] = __uint_as_float(w.x & 0xffff0000u); wq[qj][2] = __uint_as_float(w.y << 16); wq[qj][3] = __uint_as_float(w.y & 0xffff0000u); }
#define IDX_LOAD(s, set) do { _Pragma("unroll") for (int u = 0; u < 2; ++u) { int tile = wid + 8 * (2 * (s) + u); tile = tile < NT ? tile : NT - 1; const bf16* kp = ikt + (size_t)tile * 2048; \
            _Pragma("unroll") for (int c = 0; c < 4; ++c) bk[set][u][c] = *(const bf16x8*)(kp + c * 512); } } while (0)
#define IDX_MMA(set) do { _Pragma("unroll") for (int u = 0; u < 2; ++u) { acc[u] = f32x16{}; \
            _Pragma("unroll") for (int c = 0; c < 4; ++c) acc[u] = __builtin_amdgcn_mfma_f32_32x32x16_bf16(aq[c], bk[set][u][c], acc[u], 0, 0, 0); } } while (0)
#define IDX_COMB(s) do { _Pragma("unroll") for (int u = 0; u < 2; ++u) { const int tile = wid + 8 * (2 * (s) + u), kb = tile * 32; \
            if (tile < NT) { _Pragma("unroll") for (int qj = 0; qj < 4; ++qj) { float s_ = 0.f; \
                _Pragma("unroll") for (int h = 0; h < 4; ++h) s_ = fmaf(__builtin_amdgcn_fmed3f(acc[u][4 * qj + h], 0.f, __builtin_inff()), wq[qj][h], s_);     \
                S[(2 * qj + hi) * 4096 + kb + r32] = (kb + r32 <= t0 + 2 * qj + hi) ? idx_f2k(s_) : 0u; } } } } while (0)
#pragma unroll 1
        for (int rk = 0; rk < 1 + (int)(sub & 1u); ++rk) {
            bf16x8 bk[3][2][4]; f32x16 acc[2];
            IDX_LOAD(0, 0); if (wid + 16 < NT) IDX_LOAD(1, 1); if (wid + 32 < NT) IDX_LOAD(2, 2);
#pragma unroll
            for (int s = 0; s < 8; ++s) if (wid + 16 * s < NT) {
                IDX_MMA(s % 3); SBAR(); if (s + 3 < 8 && wid + 16 * (s + 3) < NT) IDX_LOAD(s + 3, s % 3); SBAR(); IDX_COMB(s); SBAR(); }
        }
#undef IDX_LOAD
#undef IDX_MMA
#undef IDX_COMB
    }
    __syncthreads();
    const int t = t0 + wid, NJ = (t >> 6) + 1;
    unsigned kreg[64];
#pragma unroll
    for (int j = 0; j < 64; ++j) { const unsigned v = S[wid * 4096 + 64 * j + lane]; kreg[j] = (j < NJ) ? v : 0u; }
    const int NG = (NJ + 15) >> 4;
    unsigned lo = 1u, hi_ = 0xffffffffu, clo = (unsigned)(t + 1), chi = 0u; float wlo = 0.f, whi = 0.f; int last = 0;
#pragma unroll 1
    for (int rs = 0; rs < 1 + (int)((sub >> 1) & 1u); ++rs) {
    {
        LAS unsigned* hist = (LAS unsigned*)(F.lds + IL_HIST) + wid * 256;
        *(LAS v4u*)(hist + 4 * lane) = (v4u){0u, 0u, 0u, 0u};
        asm volatile("s_waitcnt lgkmcnt(0)" ::: "memory");
#pragma unroll
        for (int g = 0; g < 4; ++g) if (g < NG) {
#pragma unroll
            for (int j = 0; j < 16; ++j) { const unsigned k = kreg[16 * g + j];
                if (k) { int b_ = (int)floorf(idx_k2f(k)) + 128; b_ = b_ < 0 ? 0 : (b_ > 255 ? 255 : b_); __hip_atomic_fetch_add(hist + (255 - b_), 1u, __ATOMIC_RELAXED, __HIP_MEMORY_SCOPE_WAVEFRONT); } } }
        asm volatile("s_waitcnt lgkmcnt(0)" ::: "memory");
        const v4u h4 = *(LAS v4u*)(hist + 4 * lane);
        unsigned pre = h4.x + h4.y + h4.z + h4.w;
        pre += (unsigned)__builtin_amdgcn_update_dpp(0, (int)pre, 0x111, 0xf, 0xf, true);
        pre += (unsigned)__builtin_amdgcn_update_dpp(0, (int)pre, 0x112, 0xf, 0xf, true);
        pre += (unsigned)__builtin_amdgcn_update_dpp(0, (int)pre, 0x114, 0xf, 0xf, true);
        pre += (unsigned)__builtin_amdgcn_update_dpp(0, (int)pre, 0x118, 0xf, 0xf, true);
        pre += (unsigned)__builtin_amdgcn_update_dpp(0, (int)pre, 0x142, 0xa, 0xf, true);
        pre += (unsigned)__builtin_amdgcn_update_dpp(0, (int)pre, 0x143, 0xc, 0xf, true);
        const unsigned long long ge = __ballot(pre >= 256u);
        const int L = __builtin_ctzll(ge);
        const unsigned pL = (unsigned)__builtin_amdgcn_readlane((int)pre, L);
        const unsigned b0 = (unsigned)__builtin_amdgcn_readlane((int)h4.x, L), b1 = (unsigned)__builtin_amdgcn_readlane((int)h4.y, L), b2 = (unsigned)__builtin_amdgcn_readlane((int)h4.z, L), b3 = (unsigned)__builtin_amdgcn_readlane((int)h4.w, L);
        unsigned above = pL - (b0 + b1 + b2 + b3); int bsel = 4 * L; unsigned cb = b0;
        if (above + cb < 256u) { above += cb; cb = b1; bsel = 4 * L + 1; if (above + cb < 256u) { above += cb; cb = b2; bsel = 4 * L + 2; if (above + cb < 256u) { above += cb; cb = b3; bsel = 4 * L + 3; } } }
        const int B = 255 - bsel;
        lo = B == 0 ? 1u : idx_f2k((float)(B - 128)); hi_ = B == 255 ? 0xffffffffu : idx_f2k((float)(B - 127));
        chi = above; clo = above + cb;
    }
    wlo = (float)clo - 255.5f; whi = (float)chi - 255.5f; last = 0;
#pragma unroll 1
    for (int it = 0; it < 72; ++it) {
        if (clo - chi <= 64u || hi_ - lo == 1u) break;
        unsigned mid;
        { const float lf = idx_k2f(lo), hf = idx_k2f(hi_); float mf = lf + (hf - lf) * (wlo / (wlo - whi));
          mid = idx_f2k(mf);
          if (it >= 36 || !(fabsf(lf) < 1e30f && fabsf(hf) < 1e30f)) mid = lo + ((hi_ - lo) >> 1);
          mid = mid <= lo ? lo + 1u : (mid >= hi_ ? hi_ - 1u : mid);
          mid = (unsigned)__builtin_amdgcn_readfirstlane((int)mid); }
        unsigned cnt = 0u;
#pragma unroll
        for (int g = 0; g < 4; ++g) if (g < NG) {
#pragma unroll
            for (int j = 0; j < 16; ++j) cnt += (kreg[16 * g + j] >= mid) ? 1u : 0u; }
        const unsigned tot = wave_sum_dpp63(cnt);
        if (tot >= 256u) { lo = mid; clo = tot; wlo = (float)tot - 255.5f; if (last == 1) whi *= 0.5f; last = 1; }
        else { hi_ = mid; chi = tot; whi = (float)tot - 255.5f; if (last == 2) wlo *= 0.5f; last = 2; }
    }
    }
    unsigned T = lo; int J = 0x7fffffff; bool tie = true;
    const int need = 256 - (int)chi;
    if (clo - chi <= 64u) {
        volatile LAS unsigned* cand = (volatile LAS unsigned*)(F.lds + IL_CAND) + wid * 128;
        int pos = 0;
#pragma unroll
        for (int j = 0; j < 64; ++j) if ((j >> 4) < NG) { const unsigned kq = kreg[j]; const bool inb = kq >= lo && kq < hi_; const unsigned long long bal = __ballot(inb);
            if (bal) { const int slot = pos + __builtin_amdgcn_mbcnt_hi((unsigned)(bal >> 32), __builtin_amdgcn_mbcnt_lo((unsigned)bal, 0u));
                if (inb) { cand[2 * slot] = kreg[j]; cand[2 * slot + 1] = (unsigned)(64 * j + lane); } pos += __popcll(bal); } }
        const int m = pos;
        asm volatile("s_waitcnt lgkmcnt(0)" ::: "memory");
        const unsigned ki = lane < m ? cand[2 * lane] : 0u; const unsigned ii = lane < m ? cand[2 * lane + 1] : 0u;
        int rk = 0;
        for (int jx = 0; jx < m; ++jx) { const unsigned kj = (unsigned)__builtin_amdgcn_readlane((int)ki, jx), ij = (unsigned)__builtin_amdgcn_readlane((int)ii, jx); rk += (kj > ki || (kj == ki && ij < ii)) ? 1 : 0; }
        const unsigned long long hit = __ballot(lane < m && rk == need - 1);
        const int src = hit ? __builtin_ctzll(hit) : 0;
        T = (unsigned)__builtin_amdgcn_readlane((int)ki, src); J = (int)__builtin_amdgcn_readlane((int)ii, src);
        tie = __builtin_popcountll(__ballot(lane < m && ki == T)) != 1;
    } else if (clo > 256u) {
        int ilo = -1, ihi = t;
        for (int it = 0; it < 16 && ihi - ilo > 1; ++it) { const int imid = (ilo + ihi) >> 1; unsigned cnt = 0u;
#pragma unroll
            for (int j = 0; j < 64; ++j) if ((j >> 4) < NG) cnt += (kreg[j] == T && 64 * j + lane <= imid) ? 1u : 0u;
            const int tot = (int)wave_sum_dpp63(cnt);
            if (tot >= need) ihi = imid; else ilo = imid; }
        J = ihi;
    }
    unsigned long long w64 = 0ull;
    if (!tie) {
        int wl = 0, wh = 0;
#pragma unroll
        for (int j = 0; j < 64; ++j) if ((j >> 4) < NG) { const unsigned long long bal = __ballot(kreg[j] >= T); asm volatile("s_nop 4\n\tv_writelane_b32 %0, %2, %4\n\tv_writelane_b32 %1, %3, %4" : "+v"(wl), "+v"(wh) : "s"((unsigned)bal), "s"((unsigned)(bal >> 32)), "n"(j)); }
        w64 = (unsigned long long)(unsigned)wl | ((unsigned long long)(unsigned)wh << 32);
    } else {
#pragma unroll
        for (int j = 0; j < 64; ++j) if ((j >> 4) < NG) { const unsigned k = kreg[j]; const unsigned long long bal = __ballot(k > T || (k == T && 64 * j + lane <= J)); if (lane == j) w64 = bal; }
    }
    if (lane < NJ) *(unsigned long long*)(bmrow + wid * 128 + 2 * lane) = w64;
    __syncthreads();
}

__device__ __forceinline__ float gelu_tanh(float x) { const float y = 0.7978845608028654f * (x + 0.044715f * x * x * x); const float e = __expf(2.0f * y); return 0.5f * x * (2.0f - 2.0f / (1.0f + e)); }
__device__ __forceinline__ void cmp_finalize_item(Frame& F, int b, int j, int rc) {
    float* hid = (float*)F.ldsg + 2048;
    const float* W2 = FIN(I_EV_CW2) + (size_t)j * 128 * 128;
    const float* UV = WSP(float, WS_UV) + ((size_t)j * 2048 + (size_t)b * 256) * 256; const float* UVb = WSP(float, WS_UVB) + ((size_t)j * 2048 + (size_t)b * 256) * 256;
    const float* cbp = WSP(float, WS_TAB) + (size_t)j * 16 * 128;
    const int n0 = rc * 16;
    for (int i = F.tid; i < 16 * 128; i += NTHR) { const int r = i >> 7, c = i & 127, n = n0 + r;
        float cbv = 0.f;
#pragma unroll
        for (int q = 0; q < 16; ++q) cbv += cbp[q * 128 + c];
        float v = 0.f; if (n < 255) v = gelu_tanh((UV[(size_t)n * 256 + c] + UVb[(size_t)n * 256 + c]) + (UV[(size_t)(n + 1) * 256 + 128 + c] + UVb[(size_t)(n + 1) * 256 + 128 + c]) + cbv);
        hid[i] = v; }
    __syncthreads();
    const int c2 = F.tid & 127, rg = F.tid >> 7;
    float acc[4] = {0.f, 0.f, 0.f, 0.f};
#pragma unroll 4
    for (int c = 0; c < 128; ++c) { const float w = W2[c * 128 + c2];
#pragma unroll
        for (int q = 0; q < 4; ++q) acc[q] = fmaf(hid[(rg + 4 * q) * 128 + c], w, acc[q]); }
#pragma unroll
    for (int q = 0; q < 4; ++q) { const int n = n0 + rg + 4 * q; const float a = n >= 255 ? 0.f : acc[q];
        if (j == 0) WSP(bf16, WS_CK)[((size_t)b * 256 + n) * 128 + c2] = (bf16)f2bf(a);
        else WSP(bf16, WS_CV)[((size_t)b * 256 + n) * 128 + c2] = (bf16)f2bf(a); }
    __syncthreads();
}
constexpr int CL_S = 0;
constexpr int CL_P = 64 * 260 * 4;
constexpr int CL_IMP = CL_P + 64 * 264 * 2;
constexpr int CL_TBL = CL_IMP + 16 * 64 * 4;
static_assert(CL_TBL + 4 * 132 * 4 <= RING_BYTES, "cmp LDS map");
__device__ __forceinline__ void cmp_unit(Frame& F, int b, int qt16, unsigned sub) {
    char* lds = F.ldsg;
    float* S = (float*)(lds + CL_S); bf16* Pb = (bf16*)(lds + CL_P); float* impL = (float*)(lds + CL_IMP); const float* tbl = (const float*)(lds + CL_TBL);
    int tid = F.tid; asm volatile("" : "+v"(tid));
    const int wid = F.wave, lane = tid & 63, l15 = lane & 15, l4 = lane >> 4;
    const int q0 = qt16 * 16; const size_t rowg = (size_t)b * SEQ;
#pragma unroll 1
    for (int r1 = 0; r1 < 1 + (int)(sub & 1u); ++r1) {
    {
        const int rb = wid & 3;
        const bf16* qp = GRP(G_QB + rb) + (rowg + q0 + l15) * 128 + l4 * 8;
        bf16x8 qa[4];
#pragma unroll
        for (int c = 0; c < 4; ++c) qa[c] = *(const bf16x8*)(qp + c * 32);
        const bf16* ckb = WSP(bf16, WS_CK) + (size_t)b * 256 * 128;
#pragma unroll
        for (int i = 0; i < 8; ++i) { const int kb = (wid >> 2) * 8 + i;
            const bf16* kp = ckb + (size_t)(kb * 16 + l15) * 128 + l4 * 8;
            f32x4 acc = {0.f, 0.f, 0.f, 0.f};
#pragma unroll
            for (int c = 0; c < 4; ++c) { const bf16x8 bk = *(const bf16x8*)(kp + c * 32); acc = __builtin_amdgcn_mfma_f32_16x16x32_bf16(qa[c], bk, acc, 0, 0, 0); }
            const int n = kb * 16 + l15, kend = 16 * n + 31;
#pragma unroll
            for (int jj = 0; jj < 4; ++jj) { const int ql = l4 * 4 + jj, t = q0 + ql; int d = t - kend; const bool valid = (d >= 0) && (n < 255); d = d < 0 ? 0 : (d > 128 ? 128 : d);
                S[(rb * 16 + ql) * 260 + n] = valid ? acc[jj] + tbl[rb * 132 + d] : -__builtin_inff(); } }
    }
    __syncthreads();
#pragma unroll 1
    for (int rr = 0; rr < 8; ++rr) { const int row = wid * 8 + rr;
        f32x4 v = *(const f32x4*)(S + row * 260 + lane * 4);
        const float mx = wave_max(fmaxf(fmaxf(v[0], v[1]), fmaxf(v[2], v[3])));
        f32x4 p = {0.f, 0.f, 0.f, 0.f};
        if (mx > -1e37f) { p[0] = __builtin_amdgcn_exp2f(v[0] - mx); p[1] = __builtin_amdgcn_exp2f(v[1] - mx); p[2] = __builtin_amdgcn_exp2f(v[2] - mx); p[3] = __builtin_amdgcn_exp2f(v[3] - mx);
            const float inv = 1.0f / wave_sum((p[0] + p[1]) + (p[2] + p[3])); p = p * inv; }
        *(f32x4*)(S + row * 260 + lane * 4) = p;
        *(v2u*)(Pb + row * 264 + lane * 4) = (v2u){cvtpk(p[0], p[1]), cvtpk(p[2], p[3])}; }
    __syncthreads();
    }
#pragma unroll 1
    for (int r3 = 0; r3 < 1 + (int)((sub >> 1) & 1u); ++r3) {
    for (int i = tid; i < 16 * 64; i += NTHR) { const int q = i >> 6, m = i & 63; float s = 0.f;
#pragma unroll
        for (int h = 0; h < 4; ++h)
#pragma unroll
            for (int dn = -1; dn <= 3; ++dn) { const int n = 4 * m + dn; if (n >= 0 && n < 255) s += S[(h * 16 + q) * 260 + n]; }
        impL[i] = s; }
    __syncthreads();
#pragma unroll 1
    for (int qq = 0; qq < 2; ++qq) { const int q = wid * 2 + qq, t = q0 + q, cur = t >> 6, m = lane;
        const bool forced = (m == 0) || (m == cur) || (m == cur - 1);
        const bool cand = !forced && (m < cur);
        float val = cand ? impL[q * 64 + m] : -__builtin_inff();
        bool sel = forced;
        const int picks = 8 - __popcll(__ballot(forced));
        for (int p = 0; p < picks; ++p) { const float vm = wave_max(val); if (!(vm > -__builtin_inff())) break;
            const unsigned long long win = __ballot(val == vm); const int first = __builtin_ctzll(win);
            if (lane == first) { sel = true; val = -__builtin_inff(); } }
        const unsigned long long msk = __ballot(sel);
        if (lane == 0) WSP(unsigned long long, WS_BLK)[rowg + t] = msk; }
    }
#pragma unroll 1
    for (int r5 = 0; r5 < 1 + (int)((sub >> 2) & 1u); ++r5)
    {
        const int rb = wid & 3;
        const bf16* cvt = WSP(bf16, WS_CVT) + (size_t)b * 128 * 256;
        float g0[4];
#pragma unroll
        for (int jj = 0; jj < 4; ++jj) { const float gl = bf2f(GRP(G_MISC)[(rowg + q0 + l4 * 4 + jj) * 128 + 68 + rb]); g0[jj] = 1.0f / (1.0f + __expf(-gl)); }
#pragma unroll
        for (int i = 0; i < 4; ++i) { const int db = (wid >> 2) * 4 + i;
            f32x4 acc = {0.f, 0.f, 0.f, 0.f};
#pragma unroll
            for (int kc = 0; kc < 8; ++kc) { const bf16x8 pa = *(const bf16x8*)(Pb + (rb * 16 + l15) * 264 + kc * 32 + l4 * 8);
                const bf16x8 vb = *(const bf16x8*)(cvt + (size_t)(db * 16 + l15) * 256 + kc * 32 + l4 * 8);
                acc = __builtin_amdgcn_mfma_f32_16x16x32_bf16(pa, vb, acc, 0, 0, 0); }
#pragma unroll
            for (int jj = 0; jj < 4; ++jj) WSP(float, WS_OC)[(rowg + q0 + l4 * 4 + jj) * 512 + rb * 128 + db * 16 + l15] = acc[jj] * g0[jj]; }
    }
    __syncthreads();
}

constexpr int CL2_IMP = 65536;
__device__ __forceinline__ void cmp_unit64(Frame& F, int b, int qt) {
    using namespace att;
    char* lds = F.ldsg;
    int tid = F.tid; asm volatile("" : "+v"(tid));
    const int wid = F.wave, lane = tid & 63, r32 = lane & 31, hi = lane >> 5;
    const int hd = wid & 3, qh = wid >> 2, q0 = qt * 64, tw = q0 + 32 * qh, t = tw + r32;
    const size_t rowg = (size_t)b * SEQ;
    float* wsf = (float*)(lds + AL_WS) + wid * 64; float* li_l = wsf;
    const float* tbl = (const float*)(lds + AL_TBL132) + hd * 132;
    float* impW = (float*)(lds + CL2_IMP);
    const bf16* Qp = GRP(G_QB + hd) + (rowg + t) * 128;
    const bf16* Kp = WSP(bf16, WS_CK) + (size_t)b * 256 * 128; const bf16* Vp = WSP(bf16, WS_CV) + (size_t)b * 256 * 128;
    bf16x8 qr[8];
#pragma unroll
    for (int d0 = 0; d0 < 8; ++d0) qr[d0] = *(const bf16x8*)(Qp + d0 * 16 + hi * 8);
    const int vrb = v_rd_base(lane);
    DmaOff dof; dma_offsets(dof, tid);
    float m_reg = -1e30f, l_reg = 0.f;
    const float NEG = -__builtin_inff();
#define CMP_SCORES(j) \
            const char* V_lds = lds + AL_BUF + buf * 32768; const char* K_lds = V_lds + 16384; \
            f32x16 p0, p1; \
            qkt(p0, p1, K_lds, r32, hi, qr); SBAR(); \
            if (16 * (64 * (j) + 63) + 31 + 128 > tw) {            \
                _Pragma("unroll") for (int rq = 0; rq < 4; ++rq) { \
                    _Pragma("unroll") for (int ri = 0; ri < 4; ++ri) { const int r = 4 * rq + ri; const int n0 = 64 * (j) + (r & 3) + 8 * (r >> 2) + 4 * hi, n1 = n0 + 32; \
                        int d0 = t - (16 * n0 + 31), d1 = t - (16 * n1 + 31); \
                        const bool v0 = d0 >= 0, v1 = d1 >= 0 && n1 < 255; \
                        d0 = d0 < 0 ? 0 : (d0 > 128 ? 128 : d0); d1 = d1 < 0 ? 0 : (d1 > 128 ? 128 : d1); \
                        p0[r] = v0 ? p0[r] + tbl[d0] : NEG; p1[r] = v1 ? p1[r] + tbl[d1] : NEG; } \
                    SBAR(); } \
            } else if ((j) == 3) { if (hi == 1) p1[15] = NEG; }    \
            SBAR();
    {
        int buf = 0;
        dma_tile(dof, Kp, Vp, 0, F.lds + AL_BUF, wid);
#pragma unroll 1
        for (int j = 0; j < 4; ++j) {
            asm volatile("s_waitcnt vmcnt(0)" ::: "memory");
            __syncthreads();
            dma_tile(dof, Kp, Vp, ((j + 1) & 3) * 64, F.lds + AL_BUF + (buf ^ 1) * 32768, wid);
            CMP_SCORES(j)
            float pmax = p0[0];
#pragma unroll
            for (int r = 1; r < 16; ++r) pmax = fmaxf(pmax, p0[r]);
#pragma unroll
            for (int r = 0; r < 16; ++r) pmax = fmaxf(pmax, p1[r]);
            pmax = xhalf_max(pmax);
            const float mn = fmaxf(m_reg, pmax); float ps = 0.f;
#pragma unroll
            for (int r = 0; r < 16; ++r) ps += __builtin_amdgcn_exp2f(p0[r] - mn) + __builtin_amdgcn_exp2f(p1[r] - mn);
            ps = xhalf_sum(ps);
            l_reg = l_reg * __builtin_amdgcn_exp2f(m_reg - mn) + ps; m_reg = mn;
            buf ^= 1;
        }
    }
    const float inv_l = l_reg > 0.f ? 1.0f / l_reg : 0.f;
    float carry = 0.f; f32x16 o[4] = {};
    {
        int buf = 0;
#pragma unroll 1
        for (int j = 0; j < 4; ++j) {
            asm volatile("s_waitcnt vmcnt(0)" ::: "memory");
            __syncthreads();
            if (j < 3) dma_tile(dof, Kp, Vp, (j + 1) * 64, F.lds + AL_BUF + (buf ^ 1) * 32768, wid);
            CMP_SCORES(j)
            const int vb0 = (int)(uintptr_t)(lds + AL_BUF + buf * 32768) + vrb;
#pragma unroll
            for (int r = 0; r < 16; ++r) { p0[r] = __builtin_amdgcn_exp2f(p0[r] - m_reg) * inv_l; p1[r] = __builtin_amdgcn_exp2f(p1[r] - m_reg) * inv_l; }
            float oa[4], ob[4];
#pragma unroll
            for (int g = 0; g < 4; ++g) { auto ra = __builtin_amdgcn_permlane32_swap(__float_as_uint(p0[4 * g + 3]), __float_as_uint(p0[4 * g + 3]), false, false);
                auto rb = __builtin_amdgcn_permlane32_swap(__float_as_uint(p1[4 * g + 3]), __float_as_uint(p1[4 * g + 3]), false, false);
                oa[g] = __uint_as_float(hi ? ra[0] : ra[1]); ob[g] = __uint_as_float(hi ? rb[0] : rb[1]); }
            float* iw = impW + ((size_t)hd * 64 + 32 * qh + r32) * 64 + 16 * j + hi;
#pragma unroll
            for (int g = 0; g < 4; ++g) {
                const float pla = hi ? oa[g] : (g > 0 ? oa[g - 1] : carry);
                const float plb = hi ? ob[g] : (g > 0 ? ob[g - 1] : oa[3]);
                iw[2 * g] = ((p0[4 * g] + p0[4 * g + 1]) + (p0[4 * g + 2] + p0[4 * g + 3])) + pla;
                iw[8 + 2 * g] = ((p1[4 * g] + p1[4 * g + 1]) + (p1[4 * g + 2] + p1[4 * g + 3])) + plb; }
            carry = ob[3];
            bf16x8 pa0, pa1, pa2, pa3;
            pack_p(p0, p1, pa0, pa1, pa2, pa3); SBAR();
            pv_tile(o, vb0, pa0, pa1, pa2, pa3); SBAR();
            buf ^= 1;
        }
    }
#undef CMP_SCORES
    __syncthreads();
#pragma unroll 1
    for (int qq = 0; qq < 8; ++qq) { const int q = wid * 8 + qq, tq = q0 + q, cur = tq >> 6, m = lane;
        const bool forced = (m == 0) || (m == cur) || (m == cur - 1);
        const bool cand = !forced && (m < cur);
        float val = cand ? ((impW[(0 * 64 + q) * 64 + m] + impW[(1 * 64 + q) * 64 + m]) + (impW[(2 * 64 + q) * 64 + m] + impW[(3 * 64 + q) * 64 + m])) : -__builtin_inff();
        bool sel = forced;
        const int picks = 8 - __popcll(__ballot(forced));
        for (int p = 0; p < picks; ++p) { const float vm = wave_max(val); if (!(vm > -__builtin_inff())) break;
            const unsigned long long win = __ballot(val == vm); const int first = __builtin_ctzll(win);
            if (lane == first) { sel = true; val = -__builtin_inff(); } }
        const unsigned long long msk = __ballot(sel);
        if (lane == 0) WSP(unsigned long long, WS_BLK)[rowg + tq] = msk; }
    {
        const float gl = bf2f(GRP(G_MISC)[(rowg + t) * 128 + 68 + hd]);
        if (hi == 0) li_l[r32] = 1.0f / (1.0f + __expf(-gl));
        asm volatile("s_waitcnt lgkmcnt(0)" ::: "memory");
        float* OCp = WSP(float, WS_OC) + (rowg + tw) * 512 + hd * 128;
#pragma unroll
        for (int r = 0; r < 16; ++r) { const int orow = crow(r, hi); const float g0 = li_l[orow];
#pragma unroll
            for (int d0 = 0; d0 < 4; ++d0) OCp[(size_t)orow * 512 + d0 * 32 + r32] = o[d0][r] * g0; }
    }
    __syncthreads();
}
__device__ __forceinline__ void stick_unit(Frame& F, int b, int h, int qb) {
    using namespace att;
    char* lds = F.ldsg;
    int tid = F.tid; asm volatile("" : "+v"(tid));
    const int wid = F.wave, lane = tid & 63, r32 = lane & 31, hi = lane >> 5;
    const size_t rowg = (size_t)b * SEQ;
    const int tw = qb * 256 + wid * 32, t = tw + r32;
    const bf16* Qp = QKVG(h) + (rowg + t) * 128;
    const bf16* Kp = QKVG(8 + h) + rowg * 128;
    const bf16* Vp = QKVG(16 + h) + rowg * 128;
    char* Qw = lds + AL_Q + wid * 8192;
#pragma unroll
    for (int d0 = 0; d0 < 8; ++d0) { const bf16x8 v = *(const bf16x8*)(Qp + d0 * 16 + hi * 8); *(bf16x8*)(Qw + KSWZ(r32, (d0 * 16 + hi * 8) * 2)) = v; }
    asm volatile("s_waitcnt lgkmcnt(0)" ::: "memory");
    {
        bf16x8 trd0, trd1;
#pragma unroll
        for (int jj = 0; jj < 8; ++jj) { const int k0 = 8 * (jj >> 2) + 4 * hi + (jj & 3);
            trd0[jj] = (short)((k0 >= r32) ? 0x3F80 : 0); trd1[jj] = (short)((16 + k0 >= r32) ? 0x3F80 : 0); }
        if (wid == 0) { *(bf16x8*)(lds + AL_TRI + lane * 32) = trd0; *(bf16x8*)(lds + AL_TRI + lane * 32 + 16) = trd1; }
    }
    const bf16x8 ones = {(short)0x3F80, (short)0x3F80, (short)0x3F80, (short)0x3F80, (short)0x3F80, (short)0x3F80, (short)0x3F80, (short)0x3F80};
    f32x16 o[4] = {};
    float carry = 0.f;
    const int vrb = v_rd_base(lane);
    DmaOff dof; dma_offsets(dof, tid);
    int j = qb * 4 + 3, buf = 0;
    bool wdone = false; int par = 0;
    volatile LAS unsigned* fl = (volatile LAS unsigned*)(F.lds + AL_UNI + 64);
    dma_tile(dof, Kp, Vp, j * 64, F.lds + AL_BUF, wid);
    for (;;) {
        if (lane == 0) fl[par * 8 + wid] = wdone ? 1u : 0u;
        asm volatile("s_waitcnt vmcnt(0)" ::: "memory");
        __syncthreads();
        { unsigned a = 1u;
#pragma unroll
          for (int w = 0; w < 8; ++w) a &= fl[par * 8 + w];
          par ^= 1; if (a) break; }
        if (j > 0) dma_tile(dof, Kp, Vp, (j - 1) * 64, F.lds + AL_BUF + (buf ^ 1) * 32768, wid);
        const char* K_lds = lds + AL_BUF + buf * 32768 + 16384;
        const int vb0 = (int)(uintptr_t)(lds + AL_BUF + buf * 32768) + vrb;
        const int kb = j * 64;
        if (!wdone && kb < tw + 32) {
            f32x16 s0, s1;
            qkt_lq(s0, s1, K_lds, Qw, r32, hi);
            const int dq = t - kb - 4 * hi;
            const bool diag = (kb + 63 >= tw);
            bf16x8 cb0, cb1, cb2, cb3; float csum = 0.f;
#define ST_C(ZV, OFF, R) ({ const int c_ = ((R) & 3) + 8 * ((R) >> 2); float z_ = ZV[R]; \
                float a_ = -__builtin_amdgcn_logf(1.0f + __builtin_amdgcn_exp2f(fminf(z_, 126.f))); a_ = fminf(a_, -z_); \
                if (diag && (dq - c_ - (OFF) < 1)) { a_ = 0.f; z_ = -__builtin_inff(); } \
                csum += a_; ZV[R] = z_ + carry; a_; })
#define ST_PK(ZV, OFF, B_) ({ v4u w_; { const float e0 = ST_C(ZV, OFF, B_ + 0), e1 = ST_C(ZV, OFF, B_ + 1), e2 = ST_C(ZV, OFF, B_ + 2), e3 = ST_C(ZV, OFF, B_ + 3); w_.x = cvtpk(e0, e1); w_.y = cvtpk(e2, e3); } SBAR(); \
                { const float e4 = ST_C(ZV, OFF, B_ + 4), e5 = ST_C(ZV, OFF, B_ + 5), e6 = ST_C(ZV, OFF, B_ + 6), e7 = ST_C(ZV, OFF, B_ + 7); w_.z = cvtpk(e4, e5); w_.w = cvtpk(e6, e7); } __builtin_bit_cast(bf16x8, w_); })
            SBAR(); cb0 = ST_PK(s0, 0, 0); SBAR(); cb1 = ST_PK(s0, 0, 8); SBAR(); cb2 = ST_PK(s1, 32, 0); SBAR(); cb3 = ST_PK(s1, 32, 8); SBAR();
#undef ST_PK
#undef ST_C
            const bf16x8 trd0 = *(const bf16x8*)(lds + AL_TRI + lane * 32), trd1 = *(const bf16x8*)(lds + AL_TRI + lane * 32 + 16);
            s1 = __builtin_amdgcn_mfma_f32_32x32x16_bf16(trd0, cb2, s1, 0, 0, 0);
            s1 = __builtin_amdgcn_mfma_f32_32x32x16_bf16(trd1, cb3, s1, 0, 0, 0);
            s0 = __builtin_amdgcn_mfma_f32_32x32x16_bf16(trd0, cb0, s0, 0, 0, 0);
            s0 = __builtin_amdgcn_mfma_f32_32x32x16_bf16(trd1, cb1, s0, 0, 0, 0);
            s0 = __builtin_amdgcn_mfma_f32_32x32x16_bf16(ones, cb2, s0, 0, 0, 0);
            s0 = __builtin_amdgcn_mfma_f32_32x32x16_bf16(ones, cb3, s0, 0, 0, 0);
            carry += xhalf_sum(csum);
#pragma unroll
            for (int r = 0; r < 16; ++r) { s0[r] = __builtin_amdgcn_exp2f(s0[r]); s1[r] = __builtin_amdgcn_exp2f(s1[r]); }
            bf16x8 pa0, pa1, pa2, pa3;
            pack_p(s0, s1, pa0, pa1, pa2, pa3);
            pv_tile(o, vb0, pa0, pa1, pa2, pa3);
            if (__all(carry < -160.f)) wdone = true;
        }
        if (j == 0) wdone = true;
        j = j > 0 ? j - 1 : 0; buf ^= 1;
    }
    asm volatile("s_waitcnt vmcnt(0)" ::: "memory");
    bf16* Op = WSP(bf16, WS_O) + (rowg + tw) * DM + h * 128;
#pragma unroll
    for (int r = 0; r < 16; ++r) { const int orow = crow(r, hi);
#pragma unroll
        for (int d0 = 0; d0 < 4; ++d0) { const float v = o[d0][r]; const float vn = __shfl_xor(v, 1);
            if ((r32 & 1) == 0) *(unsigned*)(Op + (size_t)orow * DM + d0 * 32 + r32) = cvtpk(v, vn); } }
    __syncthreads();
}
__device__ __forceinline__ void router_phase(Frame& F) {
    const int lane = F.lane;
    const float* wr = FIN(I_OD_WR);
    int* list = WSP(int, WS_LIST); float* gwt = WSP(float, WS_GW);
    volatile LAS unsigned* lcnt = (volatile LAS unsigned*)(F.lds);
    volatile LAS unsigned* rec = (volatile LAS unsigned*)(F.lds + 256);
    const int nper = (M + F.G - 1) / F.G, m0 = (int)blockIdx.x * nper, m1 = (m0 + nper < M) ? m0 + nper : M;
    if (F.tid < 32) lcnt[F.tid] = 0u;
    __syncthreads();
    f32x4 wq[16][2];
#pragma unroll
    for (int i = 0; i < 16; ++i) { const int k = (i < 8 ? 0 : 512) + 8 * lane + (i & 7); wq[i][0] = *(const f32x4*)(wr + (size_t)k * 8); wq[i][1] = *(const f32x4*)(wr + (size_t)k * 8 + 4); }
    for (int m = m0 + F.wave; m < m1; m += NWAVES) {
        float v[16]; load_row_bf16(WSP(bf16, WS_XB3) + (size_t)m * DM, lane, v); rms16(v, FIN(I_OD_NFFN), lane);
        float lg[8];
#pragma unroll
        for (int e = 0; e < 8; ++e) lg[e] = 0.f;
#pragma unroll
        for (int i = 0; i < 16; ++i) { const f32x4 w0 = wq[i][0], w1 = wq[i][1]; const float x = v[i];
            lg[0] = fmaf(x, w0[0], lg[0]); lg[1] = fmaf(x, w0[1], lg[1]); lg[2] = fmaf(x, w0[2], lg[2]); lg[3] = fmaf(x, w0[3], lg[3]);
            lg[4] = fmaf(x, w1[0], lg[4]); lg[5] = fmaf(x, w1[1], lg[5]); lg[6] = fmaf(x, w1[2], lg[6]); lg[7] = fmaf(x, w1[3], lg[7]); }
#pragma unroll
        for (int e = 0; e < 8; ++e) lg[e] = wave_sum(lg[e]);
        int i0 = 0; float v0 = lg[0];
#pragma unroll
        for (int e = 1; e < 8; ++e) if (lg[e] > v0) { v0 = lg[e]; i0 = e; }
        int i1 = -1; float v1 = -__builtin_inff();
#pragma unroll
        for (int e = 0; e < 8; ++e) if (e != i0 && lg[e] > v1) { v1 = lg[e]; i1 = e; }
        const float e1 = __expf(v1 - v0), w0 = 1.0f / (1.0f + e1), w1 = e1 * w0;
        if (lane == 0) {
            const unsigned s0 = __hip_atomic_fetch_add((LAS unsigned*)F.lds + i0, 1u, __ATOMIC_RELAXED, __HIP_MEMORY_SCOPE_WORKGROUP);
            const unsigned s1 = __hip_atomic_fetch_add((LAS unsigned*)F.lds + 8 + i1, 1u, __ATOMIC_RELAXED, __HIP_MEMORY_SCOPE_WORKGROUP);
            rec[2 * (m - m0)] = (unsigned)i0 | (s0 << 8); rec[2 * (m - m0) + 1] = (unsigned)i1 | (s1 << 8);
            gwt[m] = w0; gwt[M + m] = w1;
        }
    }
    __syncthreads();
    if (F.tid < 16) lcnt[16 + F.tid] = atomicAdd((unsigned*)(F.ctl + CW_CNT) + F.tid, lcnt[F.tid]);
    __syncthreads();
    for (int i = F.tid; i < m1 - m0; i += NTHR) { const unsigned r0 = rec[2 * i], r1 = rec[2 * i + 1]; const int i0 = r0 & 255, i1 = r1 & 255;
        list[(size_t)i0 * M + lcnt[16 + i0] + (r0 >> 8)] = m0 + i; list[(size_t)(8 + i1) * M + lcnt[24 + i1] + (r1 >> 8)] = m0 + i; }
    __syncthreads();
}
struct MoeLayout { int off[17]; };
__device__ __forceinline__ void moe_layout(Frame& F, MoeLayout& L) {
    int o = 0;
#pragma unroll
    for (int l = 0; l < 16; ++l) { L.off[l] = o; const int c = (int)__hip_atomic_load(F.ctl + CW_CNT + l, RLX_AGENT); o += (c + 255) & ~255; }
    L.off[16] = o;
}
__device__ __forceinline__ void gather_phase(Frame& F) {
    const int gw = F.vcu * NWAVES + F.wave, NGW = F.G * NWAVES, lane = F.lane;
    MoeLayout L; moe_layout(F, L);
    const int* list = WSP(int, WS_LIST); int* inv = WSP(int, WS_INV); float* gws = WSP(float, WS_GWS); const float* gwt = WSP(float, WS_GW);
    bf16* XS = WSP(bf16, WS_XS);
    for (int s = gw; s < L.off[16]; s += NGW) {
        int l = 0, offl = 0;
#pragma unroll
        for (int q = 1; q < 16; ++q) if (s >= L.off[q]) { l = q; offl = L.off[q]; }
        const int idx = s - offl; const int c = (int)__hip_atomic_load(F.ctl + CW_CNT + l, RLX_AGENT);
        const int t = idx < c ? list[(size_t)l * M + idx] : -1;
        float v[16];
        if (t >= 0) { load_row_bf16(WSP(bf16, WS_XB3) + (size_t)t * DM, lane, v); rms16(v, FIN(I_OD_NFFN), lane); }
        else {
#pragma unroll
            for (int i = 0; i < 16; ++i) v[i] = 0.f; }
        store_row16_bf16(XS + (size_t)s * DM, lane, v);
        if (lane == 0) { const int k = l >> 3; gws[s] = t >= 0 ? gwt[(size_t)k * M + t] : 0.f; if (t >= 0) inv[(size_t)k * M + t] = s; }
    }
}
struct MoeSched {
    pg8::GridOrder o; int t0; const char* A; size_t tstepA; const char* W; size_t tstepB; int off[17]; bool a_local; const char* A2;
    __device__ __forceinline__ bool next(int i, pg8::Unit& u) const {
        int pm, pn; if (!o.at(i, pm, pn)) return false; pm += t0; u.pm = pm; u.pn = pn;
        int l = 0;
#pragma unroll
        for (int q = 1; q < 16; ++q) if (pm * 256 >= off[q]) l = q;
        const int lt = pm - t0;
        u.aux = l; u.A = !a_local ? A + (size_t)pm * tstepA : (lt >= HM_SPLIT ? A2 + (size_t)(lt - HM_SPLIT) * tstepA : A + (size_t)lt * tstepA); u.B = W + (size_t)(l & 7) * MW_E + (size_t)pn * tstepB; return true;
    }
};

struct MoeSplitSched {
    pg8::GridOrder o; int t0; const char* A; size_t tstepA; const char* W; size_t tstepB; int off[17];
    __device__ __forceinline__ bool next(int i, pg8::Unit& u) const {
        int pm, pn; if (!o.at(i, pm, pn)) return false; pm += t0; u.pm = pm; u.pn = pn;
        int l = 0;
#pragma unroll
        for (int q = 1; q < 16; ++q) if (pm * 256 >= off[q]) l = q;
        u.aux = l; const size_t ko = (size_t)(pn >> 2) * (EFF / MOE_SPLITS) * 2;
        u.A = A + (size_t)(pm - t0) * tstepA + ko; u.B = W + (size_t)(l & 7) * MW_E + (size_t)(pn & 3) * tstepB + ko; return true;
    }
};

constexpr int N_PHASES = 27;
struct Args { const float* in[N_IN]; float* out; unsigned char* ws; int ph_lo, ph_hi; unsigned rep_mask, pad; };
__global__ void __launch_bounds__(NTHR, 2) fwd(Args args) {
    extern __shared__ __attribute__((aligned(16))) unsigned char lds[];
    Frame F;
    F.lds = (LAS unsigned char*)lds; F.ldsg = (char*)lds;
    F.MISC = (volatile LAS unsigned*)(F.lds + MISC_OFF);
    F.tid = threadIdx.x; F.lane = F.tid & 63; F.wave = __builtin_amdgcn_readfirstlane(F.tid >> 6);
    F.G = gridDim.x; { const int bx = blockIdx.x; F.vcu = (F.G % 8 == 0) ? (bx % 8) * (F.G / 8) + bx / 8 : bx; }
    F.ws = args.ws; F.ctl = (gu32*)(args.ws + WS_CTL); F.out = args.out;
    F.kap = (const __attribute__((address_space(4))) char*)__builtin_amdgcn_kernarg_segment_ptr();
    static_assert(offsetof(Args, in) == 0, "FIN() reads the input pointers at the start of the kernarg segment");
    for (int u = F.tid; u < 64; u += NTHR) ((LAS unsigned*)(F.lds + MISC_OFF))[u] = 0u;
    __syncthreads();
    const int lo = args.ph_lo, hi = args.ph_hi;
    const bool multi = (hi - lo) > 1;
    XcdBarrier bar; bar.bar = (unsigned*)(F.ctl + CW_BAR); bar.x = 0; bar.st = nullptr;
    if (multi) bar = xcd_barrier_post((unsigned*)(F.ctl + CW_BAR), F.MISC + 8);
#ifdef PHASE_ONLY
#define IN(k) ((k) == PHASE_ONLY && lo <= (k) && (k) < hi)
#else
#define IN(k) (lo <= (k) && (k) < hi)
#endif
#ifndef PROBE_BUILD
#define PROBE_BUILD 0
#endif
#if PROBE_BUILD
    const unsigned repmask = args.rep_mask;
#define REPLOOP(k) _Pragma("unroll 1") for (int rep_ = 0, nrep_ = 1 + (int)((repmask >> (k)) & 1u); rep_ < nrep_; ++rep_)
#else
#ifdef SUBPROBE
    const unsigned repmask = args.rep_mask;
#else
    const unsigned repmask = 0u;
#endif
#define REPLOOP(k)
#endif
#define SEAM(k) do { if (IN(k) && IN((k) + 1)) xcd_barrier(bar); PHASE_FENCE(); } while (0)
    const int gwv = F.vcu * NWAVES + F.wave, NGW = F.G * NWAVES;
    const int bx = blockIdx.x;

    REPLOOP(0) {
    if (IN(0)) {
        LAS float* scr = (LAS float*)(F.lds + F.wave * 16384);
        int ibase = 0;
#define XPOSE_MAT(fn, destrows, K, WT, kgain) do { const int _n = ((destrows) / 32) * ((K) / 64); const int _s = (gwv + NGW - (ibase % NGW)) % NGW; \
            xpose_matrix(fn, K, WT, kgain, scr, _s, _n, NGW, F.lane); ibase += _n; } while (0)
        { FnIn f{FIN(I_EV_WIN)}; XPOSE_MAT(f, NPROJ, 1024, WSP(bf16, WS_WIN), (const float*)nullptr); }
        { FnPlain f{FIN(I_EV_WUK), 128, 0}; XPOSE_MAT(f, 128, 256, WSP(bf16, WS_WUKV), FIN(I_EV_KVN)); }
        { FnPlain f{FIN(I_EV_WUV), 128, 0}; XPOSE_MAT(f, 128, 256, WSP(bf16, WS_WUKV) + 128 * 256, FIN(I_EV_KVN)); }
#pragma unroll 1
        for (int j = 0; j < 2; ++j) { const float* W1 = FIN(I_EV_CW1) + (size_t)j * 4096 * 128; bf16* d = WSP(bf16, WS_WC1) + (size_t)j * 256 * 2048;
            { FnPlain f{W1, 128, 0}; XPOSE_MAT(f, 128, 2048, d, (const float*)nullptr); }
            { FnPlain f{W1 + (size_t)2048 * 128, 128, 0}; XPOSE_MAT(f, 128, 2048, d + (size_t)128 * 2048, (const float*)nullptr); } }
        { FnPlain f{FIN(I_EV_WOUT), 1024, 0}; XPOSE_MAT(f, 1024, 1024, WSP(bf16, WS_WOUT0), (const float*)nullptr); }
        { FnGU f{FIN(I_EV_WG), FIN(I_EV_WU), DFF}; XPOSE_MAT(f, 2 * DFF, 1024, WSP(bf16, WS_WGU0), FIN(I_EV_NFFN)); }
        { FnPlain f{FIN(I_EV_WD), 1024, 0}; XPOSE_MAT(f, 1024, DFF, WSP(bf16, WS_WDN0), (const float*)nullptr); }
        { FnPlain f{FIN(I_OD_WQKV), 3072, 0}; XPOSE_MAT(f, 3072, 1024, WSP(bf16, WS_WQKV), FIN(I_OD_NMIX)); }
        { FnPlain f{FIN(I_OD_WOUT), 1024, 0}; XPOSE_MAT(f, 1024, 1024, WSP(bf16, WS_WOUT1), (const float*)nullptr); }
        norm_phase(F, FIN(I_X), nullptr, FIN(I_EV_NMIX));
        for (int oi = gwv; oi < 32; oi += NGW) { const int j = oi >> 4, part = oi & 15; const float* pos = FIN(I_EV_CPOS) + (size_t)j * 4096 + part * 256; const float* W1 = FIN(I_EV_CW1) + ((size_t)j * 4096 + part * 256) * 128;
            float s0 = 0.f, s1 = 0.f;
#pragma unroll 8
            for (int i = 0; i < 256; ++i) { const float pv_ = pos[i]; s0 = fmaf(pv_, W1[(size_t)i * 128 + F.lane], s0); s1 = fmaf(pv_, W1[(size_t)i * 128 + 64 + F.lane], s1); }
            WSP(float, WS_TAB)[(size_t)oi * 128 + F.lane] = s0; WSP(float, WS_TAB)[(size_t)oi * 128 + 64 + F.lane] = s1; }
    }
    }
    SEAM(0);
    REPLOOP(1) {
    if (IN(1)) {
        pg8::PlainSched S; S.init(M, NPROJ, F.G, bx, WSP(bf16, WS_XN), 2048, WSP(bf16, WS_WIN), 2048);
        pg8::EpiGroups E{WSP(bf16, WS_PROJ), GS, 0x0F0Fu, QSCALE, G_PAD, nullptr};
        pg8::gemm_phase<pg8::EpiGroups, pg8::PlainSched>(F.lds, pg8::GemmK{1024, 2048u, 2048u, 30, 0u}, S, E);
    }
    }
    SEAM(1);
    REPLOOP(2) {
    if (IN(2)) {
        for (int ti = gwv; ti < BATCH * 128; ti += NGW) { const int r32_ = F.lane & 31, hi_ = F.lane >> 5;
            const bf16* src = GRP(G_MISC) + ((size_t)ti * 32 + r32_) * 128 + hi_ * 8; bf16* dst = WSP(bf16, WS_IKT) + (size_t)ti * 2048 + F.lane * 8;
#pragma unroll
            for (int c = 0; c < 4; ++c) *(v4u*)(dst + c * 512) = *(const v4u*)(src + c * 16); }
        if (bx < 128) {
            LAS float* rstd = (LAS float*)(F.lds + MISC_OFF + 1024);
            { const int r = F.tid >> 1, g = F.tid & 1; const bf16* p = GRP(G_LAT + g) + ((size_t)bx * 256 + r) * 128; float s = 0.f;
#pragma unroll
              for (int i = 0; i < 16; ++i) { const v4u w = *(const v4u*)(p + i * 8);
#pragma unroll
                  for (int q = 0; q < 4; ++q) { const float a = __builtin_bit_cast(float, w[q] << 16), c = __builtin_bit_cast(float, w[q] & 0xffff0000u); s += a * a + c * c; } }
              s += __shfl_xor(s, 1);
              if (g == 0) rstd[r] = 1.0f / sqrtf(s * (1.f / 256.f) + RMS_EPS); }
            __syncthreads();
            pg8::OneSched S;
            S.u.pm = bx; S.u.pn = 0; S.u.aux = 0; S.u.A = (const char*)(GRP(G_LAT) + (size_t)bx * 256 * 128); S.u.B = (const char*)WSP(bf16, WS_WUKV);
            pg8::EpiAkv E{WSP(bf16, WS_AK), WSP(bf16, WS_AV), rstd};
            pg8::gemm_phase<pg8::EpiAkv, pg8::OneSched>(F.lds, pg8::GemmK{256, 256u, 512u, 1, (unsigned)(GS * 2)}, S, E);
        } else if (bx < 160) {
            const int u = bx - 128, j = u >> 4, pm = (u >> 1) & 7, kh = u & 1;
            pg8::OneSched S;
            S.u.pm = pm; S.u.pn = 0; S.u.aux = 0; S.u.A = (const char*)(GRP(j == 0 ? G_CKR : G_CVR) + (size_t)pm * 256 * 2048 + (size_t)kh * 1024); S.u.B = (const char*)(WSP(bf16, WS_WC1) + (size_t)j * 256 * 2048 + (size_t)kh * 1024);
            pg8::EpiF32 E{nullptr, (kh ? WSP(float, WS_UVB) : WSP(float, WS_UV)) + (size_t)j * 2048 * 256, 256, 1.f};
            pg8::gemm_phase<pg8::EpiF32, pg8::OneSched>(F.lds, pg8::GemmK{1024, 4096u, 4096u, 30, 0u}, S, E);
        }
    }
    }
    SEAM(2);
    REPLOOP(3) {
    if (IN(3)) {
        for (int it = bx; it < 256; it += F.G) cmp_finalize_item(F, it >> 5, (it >> 4) & 1, it & 15);
#ifdef SUBPROBE
#pragma unroll 1
        for (int rq = 0; rq < 1 + (int)((repmask >> 22) & 1u); ++rq)
#endif
        for (int r = 0; r < 4096 / 256 + 1; ++r) { const int cc = (r & 1) ? (F.G - 1 - bx) : bx; const int ui = r * F.G + cc; if (ui >= 4096) break;
            const int tq = 511 - (ui >> 3), b = ui & 7; idx_unit(F, b, tq, repmask >> 24); }
    }
    }
    SEAM(3);
    PHASE_FENCE();
    REPLOOP(5) {
    if (IN(5)) {
        fill_bias_tbl(F, (float*)(F.ldsg + AL_TBL), 0); __syncthreads();
#pragma unroll 1
        for (int p2 = 2 * bx; p2 < 512; p2 += 2 * F.G) {
#pragma unroll 1
            for (int u = 0; u < 2; ++u) { const int p = p2 >> 1, b = p >> 5, q = p & 31; attn_unit<0>(F, b, u ? q : 63 - q); } }
        __syncthreads();
        fill_bias_tbl(F, (float*)(F.ldsg + AL_TBL), 4); fill_bias_tbl132(F, (float*)(F.ldsg + AL_TBL132), 4); __syncthreads();
#pragma unroll 1
        for (int p2 = 2 * bx; p2 < 512; p2 += 2 * F.G) {
#pragma unroll 1
            for (int u = 0; u < 2; ++u) { const int p = p2 >> 1, b = p >> 5, q = p & 31, qt = u ? q : 63 - q;
                cmp_unit64(F, b, qt); asm volatile("s_waitcnt vmcnt(0)" ::: "memory"); __syncthreads();
                attn_unit<1>(F, b, qt); attn_unit<2>(F, b, qt); } }
    }
    }
    SEAM(5);
    REPLOOP(6) {
    if (IN(6)) {
        pg8::PlainSched S; S.init(M, DM, F.G, bx, WSP(bf16, WS_O), 2048, WSP(bf16, WS_WOUT0), 2048);
        pg8::EpiRes E{FIN(I_X), nullptr, WSP(bf16, WS_XB), WSP(float, WS_RS0), 1.f};
        pg8::gemm_phase<pg8::EpiRes, pg8::PlainSched>(F.lds, pg8::GemmK{1024, 2048u, 2048u, 30, 0u}, S, E);
    }
    }
    if (IN(6) && IN(8)) xcd_barrier(bar); PHASE_FENCE();
    REPLOOP(8) {
    if (IN(8)) {
        pg8::PlainSched S; S.init(M, 2 * DFF, F.G, bx, WSP(bf16, WS_XB), 2048, WSP(bf16, WS_WGU0), 2048);
        pg8::EpiSwiglu E{WSP(bf16, WS_H0), DFF, 0, WSP(float, WS_RS0), nullptr, 0};
        pg8::gemm_phase<pg8::EpiSwiglu, pg8::PlainSched>(F.lds, pg8::GemmK{1024, 2048u, 2048u, 30, 0u}, S, E);
    }
    }
    SEAM(8);
    if (IN(9)) {
        pg8::PlainSched S; S.init(M, DM, F.G, bx, WSP(bf16, WS_H0), DFF * 2, WSP(bf16, WS_WDN0), DFF * 2);
        pg8::EpiRes E{nullptr, WSP(bf16, WS_XB), WSP(bf16, WS_XB), WSP(float, WS_RS1), ((repmask >> 10) & 1u) ? 0.5f : 1.f};
        REPLOOP(10) pg8::gemm_phase<pg8::EpiRes, pg8::PlainSched>(F.lds, pg8::GemmK{DFF, DFF * 2u, DFF * 2u, 30, 0u}, S, E);
    }
    if (IN(9) && IN(11)) xcd_barrier(bar); PHASE_FENCE();
    REPLOOP(11) {
    if (IN(11)) {
        pg8::PlainSched S; S.init(M, 3072, F.G, bx, WSP(bf16, WS_XB), 2048, WSP(bf16, WS_WQKV), 2048);
        pg8::EpiGroups E{WSP(bf16, WS_QKV), GS, 0xFFu, QSCALE, 1000, WSP(float, WS_RS1)};
        pg8::gemm_phase<pg8::EpiGroups, pg8::PlainSched>(F.lds, pg8::GemmK{1024, 2048u, 2048u, 30, 0u}, S, E);
    }
    }
    SEAM(11);
    REPLOOP(12) {
    if (IN(12)) {
        for (int ui = bx; ui < 1024; ui += F.G) { const int qb = 15 - (ui >> 6), bh = ui & 63; stick_unit(F, bh >> 3, bh & 7, qb); }
    }
    }
    SEAM(12);
    if (IN(13)) {
        pg8::PlainSched S; S.init(M, DM, F.G, bx, WSP(bf16, WS_O), 2048, WSP(bf16, WS_WOUT1), 2048);
        pg8::EpiRes E{nullptr, WSP(bf16, WS_XB), WSP(bf16, WS_XB3), WSP(float, WS_RS0), 1.f};
        REPLOOP(14) pg8::gemm_phase<pg8::EpiRes, pg8::PlainSched>(F.lds, pg8::GemmK{1024, 2048u, 2048u, 30, 0u}, S, E);
        LAS float* scr = (LAS float*)(F.lds + F.wave * 16384);
        REPLOOP(13) {
        int ibase = 0;
#pragma unroll 1
        for (int e = 0; e < NEXP; ++e) {
            { FnGU f{FIN(I_OD_WG) + (size_t)e * 1024 * EFF, FIN(I_OD_WU) + (size_t)e * 1024 * EFF, EFF}; XPOSE_MAT(f, 2 * EFF, 1024, (bf16*)(F.ws + WS_MW + (size_t)e * MW_E), (const float*)nullptr); }
            { FnPlain f{FIN(I_OD_WD) + (size_t)e * EFF * 1024, 1024, 0}; XPOSE_MAT(f, 1024, EFF, (bf16*)(F.ws + WS_MW + (size_t)e * MW_E + MW_DN), (const float*)nullptr); }
        }
        }
    }
    SEAM(13);
    if (IN(14)) router_phase(F);
    SEAM(14);
    REPLOOP(15) { if (IN(15)) gather_phase(F); }
    SEAM(15);
#pragma unroll 1
    for (int ch = 0; ch < 3; ++ch) {
        const int t0 = ch * HM_TILES, ph = 16 + 2 * ch;
        MoeLayout L; moe_layout(F, L);
        const int ntile = L.off[16] >> 8;
        const int nt = (ntile - t0) < HM_TILES ? (ntile - t0) : HM_TILES;
        if (IN(ph) && nt > 0) {
            MoeSched S; S.o.init(nt, 2 * EFF / 256, F.G, bx); S.t0 = t0; S.A = (const char*)WSP(bf16, WS_XS); S.tstepA = 256 * 2048; S.W = (const char*)(F.ws + WS_MW); S.tstepB = 256 * 2048; S.a_local = false; S.A2 = nullptr;
#pragma unroll
            for (int q = 0; q < 17; ++q) S.off[q] = L.off[q];
            pg8::EpiSwiglu E{WSP(bf16, WS_HM), EFF, t0, nullptr, (bf16*)F.out, HM_SPLIT};
            REPLOOP(16) pg8::gemm_phase<pg8::EpiSwiglu, MoeSched>(F.lds, pg8::GemmK{1024, 2048u, 2048u, 30, 0u}, S, E);
        }
        SEAM(ph);
        const bool split = ch == 2 && nt > 0 && nt <= MOE_SPLIT_TILES;
        if (IN(ph + 1) && split) {
            MoeSplitSched S; S.o.init(nt, 4 * MOE_SPLITS, F.G, bx); S.t0 = t0; S.A = (const char*)WSP(bf16, WS_HM); S.tstepA = (size_t)256 * EFF * 2; S.W = (const char*)(F.ws + WS_MW + MW_DN); S.tstepB = (size_t)256 * EFF * 2;
#pragma unroll
            for (int q = 0; q < 17; ++q) S.off[q] = L.off[q];
            pg8::EpiMoeYp E{WSP(bf16, WS_YP), WSP(float, WS_GWS), t0, (size_t)MOE_SPLIT_TILES * 256 * DM};
            pg8::gemm_phase<pg8::EpiMoeYp, MoeSplitSched>(F.lds, pg8::GemmK{EFF / MOE_SPLITS, EFF * 2u, EFF * 2u, 30, 0u}, S, E);
        }
        if (IN(ph + 1) && nt > 0 && !split) {
            MoeSched S; S.o.init(nt, DM / 256, F.G, bx); S.t0 = t0; S.A = (const char*)WSP(bf16, WS_HM); S.tstepA = (size_t)256 * EFF * 2; S.W = (const char*)(F.ws + WS_MW + MW_DN); S.tstepB = (size_t)256 * EFF * 2; S.a_local = true; S.A2 = (const char*)F.out;
#pragma unroll
            for (int q = 0; q < 17; ++q) S.off[q] = L.off[q];
            pg8::EpiMoeY E{WSP(bf16, WS_XS), WSP(float, WS_GWS)};
            REPLOOP(17) pg8::gemm_phase<pg8::EpiMoeY, MoeSched>(F.lds, pg8::GemmK{EFF, EFF * 2u, EFF * 2u, 30, 0u}, S, E);
        }
        SEAM(ph + 1);
    }
    REPLOOP(18)
    if (IN(26)) {
        const bf16* XS0 = WSP(bf16, WS_XS); const int* inv = WSP(int, WS_INV);
        MoeLayout L; moe_layout(F, L);
        const int ntl = (L.off[16] >> 8) - 2 * HM_TILES; const int srow = (ntl > 0 && ntl <= MOE_SPLIT_TILES) ? 2 * HM_TILES * 256 : 0x7fffffff;
#define FIN_ROW(m_, v_) do { load_row_bf16(WSP(bf16, WS_XB3) + (size_t)(m_) * DM, F.lane, v_); \
            _Pragma("unroll 1") for (int k = 0; k < 2; ++k) { const int s = inv[(size_t)k * M + (m_)]; float y[16]; \
                if (s < srow) { load_row_bf16(XS0 + (size_t)s * DM, F.lane, y); _Pragma("unroll") for (int i = 0; i < 16; ++i) v_[i] += y[i]; } \
                else { _Pragma("unroll 1") for (int sp = 0; sp < MOE_SPLITS; ++sp) { load_row_bf16(WSP(bf16, WS_YP) + ((size_t)sp * MOE_SPLIT_TILES * 256 + (s - srow)) * DM, F.lane, y); \
                        _Pragma("unroll") for (int i = 0; i < 16; ++i) v_[i] += y[i]; } } } } while (0)
#define FIN_OUT(m_, v_) do { rms16(v_, FIN(I_FNORM), F.lane); GAS f32x4* o = (GAS f32x4*)(F.out + (size_t)(m_) * DM); \
            o[2 * F.lane] = (f32x4){v_[0], v_[1], v_[2], v_[3]}; o[2 * F.lane + 1] = (f32x4){v_[4], v_[5], v_[6], v_[7]}; \
            o[128 + 2 * F.lane] = (f32x4){v_[8], v_[9], v_[10], v_[11]}; o[128 + 2 * F.lane + 1] = (f32x4){v_[12], v_[13], v_[14], v_[15]}; } while (0)
        for (int m = gwv; m < M; m += 2 * NGW) { float va[16], vb[16]; const int mb = m + NGW;
            FIN_ROW(m, va); if (mb < M) FIN_ROW(mb, vb);
            FIN_OUT(m, va); if (mb < M) FIN_OUT(mb, vb); }
#undef FIN_ROW
#undef FIN_OUT
    }
#undef IN
#undef SEAM
#undef XPOSE_MAT
}

#ifndef PROBE_REP
#define PROBE_REP 0u
#endif
#ifndef MK_FUSED
#define MK_FUSED 1
#endif
extern "C" void kernel_launch(void* const* d_in, const int* in_sizes, int n_in, void* d_out, int out_size, void* d_ws, size_t ws_size, hipStream_t stream) {
    static int grid = 0;
    if (grid == 0) {
        if (n_in != N_IN || in_sizes[0] != M * DM || out_size != M * DM || ws_size < WS_END) {
            fprintf(stderr, "kernel_launch: built for %d inputs, x/out of %d floats, >= %zu bytes of workspace; got n_in %d, in0 %d, out %d, ws %zu; nothing launched\n", N_IN, M * DM, (size_t)WS_END, n_in, n_in > 0 ? in_sizes[0] : -1, out_size, ws_size);
            grid = -1; return; }
        int dev = 0, cus = 0, per_cu = 0;
        if (hipGetDevice(&dev) != hipSuccess || hipDeviceGetAttribute(&cus, hipDeviceAttributeMultiprocessorCount, dev) != hipSuccess) { fprintf(stderr, "kernel_launch: device query failed\n"); grid = -1; return; }
        if (hipFuncSetAttribute((const void*)fwd, hipFuncAttributeMaxDynamicSharedMemorySize, LDS_BYTES) != hipSuccess) { fprintf(stderr, "kernel_launch: hipFuncSetAttribute failed\n"); grid = -1; return; }
        if (hipOccupancyMaxActiveBlocksPerMultiprocessor(&per_cu, (const void*)fwd, NTHR, LDS_BYTES) != hipSuccess || per_cu < 1)
            fprintf(stderr, "kernel_launch: note: occupancy query reports %d workgroups per CU\n", per_cu);
        (void)hipGetLastError();
        grid = cus;
    }
    if (grid < 0) return;
    if (hipMemsetAsync((char*)d_ws + WS_CTL, 0, CTL_ZERO_BYTES, stream) != hipSuccess) { fprintf(stderr, "kernel_launch: memset failed\n"); return; }
    Args a{};
    for (int i = 0; i < N_IN; ++i) a.in[i] = (const float*)d_in[i];
    a.out = (float*)d_out; a.ws = (unsigned char*)d_ws; a.rep_mask = PROBE_REP; a.pad = 0u;
#if MK_FUSED
    a.ph_lo = 0; a.ph_hi = N_PHASES;
    hipLaunchKernelGGL(fwd, dim3(grid), dim3(NTHR), LDS_BYTES, stream, a);
#else
    for (int p = 0; p < N_PHASES; ++p) { a.ph_lo = p; a.ph_hi = p + 1; hipLaunchKernelGGL(fwd, dim3(grid), dim3(NTHR), LDS_BYTES, stream, a); }
#endif
    const hipError_t le = hipPeekAtLastError();
    if (le != hipSuccess) fprintf(stderr, "kernel_launch: launch failed: %s\n", hipGetErrorName(le));
}
```
